# Optimizing an MI355X kernel written in HIP

```python
import math
import jax, jax.numpy as jnp
from jax import lax
import numpy as np

D_MODEL = 1024
BATCH = 4
SEQ = 8192
DEPTH = 4

GRID_W = 64
CTX_LEN = 256
N_MIXERS = 3
MIXER_POOL = 0
MIXER_NA = 1
MIXER_GQA = 2
POOL_WINDOWS = (2, 4, 8, 16)
POOL_GROUPS = len(POOL_WINDOWS)
POOL_CH = D_MODEL // POOL_GROUPS
HEAD_DIM = 64
NA_HEADS = D_MODEL // HEAD_DIM
NA_KH = 8
NA_KW = 16
GQA_Q_HEADS = D_MODEL // HEAD_DIM
GQA_KV_HEADS = 4
GQA_GROUP = GQA_Q_HEADS // GQA_KV_HEADS
Q_BLOCK = 128
ROPE_THETA = 10000.0
N_EXPERTS = 16
EXPERT_FF = 2 * D_MODEL
EC_CAPACITY = 2
N_MOD = 6
LN_EPS = 1e-5
RMS_EPS = 1e-6

kernel_name = "hybrid_pool_na_gqa_ecmoe_dit"


def _layers_of(m):
    return [i for i in range(DEPTH) if i % N_MIXERS == m]


def _ctx_needed_after(i):
    return any(j % N_MIXERS != MIXER_POOL for j in range(i + 1, DEPTH))


def _layer_norm(x, g, b):
    xf = x.astype(jnp.float32)
    mu = xf.mean(-1, keepdims=True)
    xc = xf - mu
    var = (xc * xc).mean(-1, keepdims=True)
    return (xc * lax.rsqrt(var + LN_EPS) * g.astype(jnp.float32) + b.astype(jnp.float32)).astype(x.dtype)


def _rms_norm(x, g):
    xf = x.astype(jnp.float32)
    ms = (xf * xf).mean(-1, keepdims=True)
    return (xf * lax.rsqrt(ms + RMS_EPS) * g.astype(jnp.float32)).astype(x.dtype)


def _modulate(x, shift, scale):
    return x * (1 + scale) + shift


def _joint_softmax(s_a, s_b):
    p = jax.nn.softmax(jnp.concatenate([s_a, s_b], axis=-1).astype(jnp.float32), axis=-1)
    na = s_a.shape[-1]
    return p[..., :na], p[..., na:]


def _axial_rope_tables(n):
    t = jnp.arange(n, dtype=jnp.int32)
    row = (t // GRID_W).astype(jnp.float32)
    col = (t % GRID_W).astype(jnp.float32)
    axis_dims = HEAD_DIM // 2
    inv_freq = jnp.power(ROPE_THETA, -jnp.arange(0, axis_dims, 2, dtype=jnp.float32) / axis_dims)
    ang = jnp.concatenate([row[:, None] * inv_freq, col[:, None] * inv_freq], axis=-1)
    return jnp.cos(ang), jnp.sin(ang)


def _apply_rope(x, cos, sin):
    xf = x.astype(jnp.float32).reshape(x.shape[:-1] + (HEAD_DIM // 2, 2))
    x1, x2 = xf[..., 0], xf[..., 1]
    c = cos[None, :, None, :]
    s = sin[None, :, None, :]
    out = jnp.stack([x1 * c - x2 * s, x1 * s + x2 * c], axis=-1).reshape(x.shape)
    return out.astype(x.dtype)


def _pool_mixer(h, w_groups, layer_scale):
    B, n, D = h.shape
    hf = h.astype(jnp.float32)
    cs = jnp.concatenate([jnp.zeros((B, 1, D), jnp.float32), jnp.cumsum(hf, axis=1)], axis=1)
    pos = jnp.arange(n)
    parts = []
    for g, w in enumerate(POOL_WINDOWS):
        lo = jnp.clip(pos - w // 2, 0, n - 1)
        hi = jnp.clip(pos + (w - w // 2 - 1), 0, n - 1)
        csg = cs[:, :, g * POOL_CH:(g + 1) * POOL_CH]
        count = (hi - lo + 1).astype(jnp.float32)[None, :, None]
        mean = (csg[:, hi + 1] - csg[:, lo]) / count
        parts.append(mean - hf[:, :, g * POOL_CH:(g + 1) * POOL_CH])
    d = jnp.stack(parts, axis=2).astype(h.dtype)
    y = jnp.einsum('bngc,gcd->bngd', d, w_groups).reshape(B, n, D)
    return y * layer_scale


def _na_mixer(h, hc, wqkv, wo, rpb, update_ctx):
    B, n, D = h.shape
    L = hc.shape[1]
    rows = n // GRID_W
    kh = min(NA_KH, rows)
    scale = HEAD_DIM ** -0.5
    qkv = (h @ wqkv).reshape(B, rows, GRID_W, 3, NA_HEADS, HEAD_DIM)
    q = qkv[:, :, :, 0].transpose(0, 3, 1, 2, 4)
    k = qkv[:, :, :, 1].transpose(0, 3, 1, 2, 4)
    v = qkv[:, :, :, 2].transpose(0, 3, 1, 2, 4)
    qkv_c = (hc @ wqkv).reshape(B, L, 3, NA_HEADS, HEAD_DIM)
    qc = qkv_c[:, :, 0].transpose(0, 2, 1, 3)
    kc = qkv_c[:, :, 1].transpose(0, 2, 1, 3)
    vc = qkv_c[:, :, 2].transpose(0, 2, 1, 3)
    col = np.arange(GRID_W)
    c0 = np.clip(col - NA_KW // 2, 0, GRID_W - NA_KW)
    col_idx = c0[:, None] + np.arange(NA_KW)[None, :]
    dc_idx = col_idx - col[:, None] + (NA_KW - 1)

    def row_block(r):
        r0 = jnp.clip(r - kh // 2, 0, rows - kh)
        k_rows = lax.dynamic_slice_in_dim(k, r0, kh, axis=2)
        v_rows = lax.dynamic_slice_in_dim(v, r0, kh, axis=2)
        k_nb = k_rows[:, :, :, col_idx, :].transpose(0, 1, 3, 2, 4, 5).reshape(B, NA_HEADS, GRID_W, kh * NA_KW, HEAD_DIM)
        v_nb = v_rows[:, :, :, col_idx, :].transpose(0, 1, 3, 2, 4, 5).reshape(B, NA_HEADS, GRID_W, kh * NA_KW, HEAD_DIM)
        q_r = lax.dynamic_index_in_dim(q, r, axis=2, keepdims=False)
        dr_idx = r0 + jnp.arange(kh) - r + (NA_KH - 1)
        bias = rpb[:, dr_idx][:, :, dc_idx]
        bias = bias.transpose(0, 2, 1, 3).reshape(NA_HEADS, GRID_W, kh * NA_KW).astype(jnp.float32)
        s_loc = jnp.einsum('bhwd,bhwkd->bhwk', q_r, k_nb).astype(jnp.float32) * scale + bias[None]
        s_ctx = jnp.einsum('bhwd,bhld->bhwl', q_r, kc).astype(jnp.float32) * scale
        p_loc, p_ctx = _joint_softmax(s_loc, s_ctx)
        return (jnp.einsum('bhwk,bhwkd->bhwd', p_loc.astype(v.dtype), v_nb)
                + jnp.einsum('bhwl,bhld->bhwd', p_ctx.astype(v.dtype), vc))

    o = lax.map(row_block, jnp.arange(rows))
    o = o.transpose(1, 0, 3, 2, 4).reshape(B, n, D)
    y = o @ wo
    yc = None
    if update_ctx:
        sc = jnp.einsum('bhld,bhmd->bhlm', qc, kc).astype(jnp.float32) * scale
        pc = jax.nn.softmax(sc, axis=-1).astype(vc.dtype)
        oc = jnp.einsum('bhlm,bhmd->bhld', pc, vc).transpose(0, 2, 1, 3).reshape(B, L, D)
        yc = oc @ wo
    return y, yc


def _gqa_mixer(h, hc, wqkv, q_g, k_g, wo, cos, sin, update_ctx):
    B, n, D = h.shape
    L = hc.shape[1]
    scale = HEAD_DIM ** -0.5
    dq = GQA_Q_HEADS * HEAD_DIM
    dkv = GQA_KV_HEADS * HEAD_DIM

    def split_heads(t, length):
        q = t[..., :dq].reshape(B, length, GQA_Q_HEADS, HEAD_DIM)
        k = t[..., dq:dq + dkv].reshape(B, length, GQA_KV_HEADS, HEAD_DIM)
        v = t[..., dq + dkv:].reshape(B, length, GQA_KV_HEADS, HEAD_DIM)
        return _rms_norm(q, q_g), _rms_norm(k, k_g), v

    q, k, v = split_heads(h @ wqkv, n)
    q = _apply_rope(q, cos, sin)
    k = _apply_rope(k, cos, sin)
    qc, kc, vc = split_heads(hc @ wqkv, L)
    q = q.reshape(B, n, GQA_KV_HEADS, GQA_GROUP, HEAD_DIM).transpose(0, 2, 3, 1, 4)
    k = k.transpose(0, 2, 1, 3)
    v = v.transpose(0, 2, 1, 3)
    kc = kc.transpose(0, 2, 1, 3)
    vc = vc.transpose(0, 2, 1, 3)
    nb = n // Q_BLOCK
    q_blocks = jnp.moveaxis(q.reshape(B, GQA_KV_HEADS, GQA_GROUP, nb, Q_BLOCK, HEAD_DIM), 3, 0)

    def block(qi):
        s_lat = jnp.einsum('bkgqd,bknd->bkgqn', qi, k).astype(jnp.float32) * scale
        s_ctx = jnp.einsum('bkgqd,bkld->bkgql', qi, kc).astype(jnp.float32) * scale
        p_lat, p_ctx = _joint_softmax(s_lat, s_ctx)
        return (jnp.einsum('bkgqn,bknd->bkgqd', p_lat.astype(v.dtype), v)
                + jnp.einsum('bkgql,bkld->bkgqd', p_ctx.astype(v.dtype), vc))

    o = lax.map(block, q_blocks)
    o = jnp.moveaxis(o, 0, 3).reshape(B, GQA_KV_HEADS, GQA_GROUP, n, HEAD_DIM)
    o = o.transpose(0, 3, 1, 2, 4).reshape(B, n, dq)
    y = o @ wo
    yc = None
    if update_ctx:
        qcg = qc.reshape(B, L, GQA_KV_HEADS, GQA_GROUP, HEAD_DIM).transpose(0, 2, 3, 1, 4)
        sc = jnp.einsum('bkgld,bkmd->bkglm', qcg, kc).astype(jnp.float32) * scale
        pc = jax.nn.softmax(sc, axis=-1).astype(vc.dtype)
        oc = jnp.einsum('bkglm,bkmd->bkgld', pc, vc).transpose(0, 3, 1, 2, 4).reshape(B, L, dq)
        yc = oc @ wo
    return y, yc


def _ec_moe(h, router, w1, w3, w2):
    B, n, D = h.shape
    cap = EC_CAPACITY * n // N_EXPERTS
    aff = jax.nn.softmax((h @ router).astype(jnp.float32), axis=-1)
    gate, idx = lax.top_k(jnp.swapaxes(aff, 1, 2), cap)
    b_idx = jnp.arange(B)[:, None, None]
    xs = h[b_idx, idx]
    hid = jax.nn.silu(jnp.einsum('becd,edf->becf', xs, w1)) * jnp.einsum('becd,edf->becf', xs, w3)
    ys = jnp.einsum('becf,efd->becd', hid, w2) * gate[..., None].astype(h.dtype)
    return jnp.zeros_like(h).at[b_idx, idx].add(ys)


def setup_inputs(seed: int = 0) -> dict:
    key = jax.random.key(seed)
    ks = jax.random.split(key, 22)
    f32 = jnp.float32
    D = D_MODEL
    beta = (8.0 * DEPTH) ** -0.25
    n_pool, n_na, n_gqa = (len(_layers_of(m)) for m in range(N_MIXERS))
    qkv_width = (GQA_Q_HEADS + 2 * GQA_KV_HEADS) * HEAD_DIM

    def nrm(k, shape, s):
        return jax.random.normal(k, shape, f32) * s

    return {
        "x": nrm(ks[0], (BATCH, SEQ, D), 1.0),
        "c": nrm(ks[1], (BATCH, D), 1.0),
        "ctx": nrm(ks[2], (BATCH, CTX_LEN, D), 1.0),
        "c_ctx": nrm(ks[3], (D,), 1.0),
        "mod_w": nrm(ks[4], (DEPTH, D, N_MOD * D), 0.5 * D ** -0.5),
        "mod_b": nrm(ks[5], (DEPTH, N_MOD * D), 0.02),
        "ln_g": 1.0 + nrm(ks[6], (DEPTH, 2, D), 0.02),
        "ln_b": nrm(ks[7], (DEPTH, 2, D), 0.02),
        "pool_w": nrm(ks[8], (n_pool, POOL_GROUPS, POOL_CH, POOL_CH), beta * POOL_CH ** -0.5),
        "pool_scale": 1.0 + nrm(ks[9], (n_pool, D), 0.02),
        "na_wqkv": nrm(ks[10], (n_na, D, 3 * D), D ** -0.5),
        "na_wo": nrm(ks[11], (n_na, D, D), beta * D ** -0.5),
        "na_rpb": nrm(ks[12], (n_na, NA_HEADS, 2 * NA_KH - 1, 2 * NA_KW - 1), 0.1),
        "gqa_wqkv": nrm(ks[13], (n_gqa, D, qkv_width), D ** -0.5),
        "gqa_q_norm": 1.0 + nrm(ks[14], (n_gqa, HEAD_DIM), 0.02),
        "gqa_k_norm": 1.0 + nrm(ks[15], (n_gqa, HEAD_DIM), 0.02),
        "gqa_wo": nrm(ks[16], (n_gqa, GQA_Q_HEADS * HEAD_DIM, D), beta * (GQA_Q_HEADS * HEAD_DIM) ** -0.5),
        "moe_router": nrm(ks[17], (DEPTH, D, N_EXPERTS), D ** -0.5),
        "moe_w1": nrm(ks[18], (DEPTH, N_EXPERTS, D, EXPERT_FF), D ** -0.5),
        "moe_w3": nrm(ks[19], (DEPTH, N_EXPERTS, D, EXPERT_FF), D ** -0.5),
        "moe_w2": nrm(ks[20], (DEPTH, N_EXPERTS, EXPERT_FF, D), beta * EXPERT_FF ** -0.5),
    }


def reference(x, c, ctx, c_ctx, mod_w, mod_b, ln_g, ln_b, pool_w, pool_scale, na_wqkv, na_wo, na_rpb,
              gqa_wqkv, gqa_q_norm, gqa_k_norm, gqa_wo, moe_router, moe_w1, moe_w3, moe_w2):
    n = x.shape[1]
    alpha = (2.0 * DEPTH) ** 0.25
    cos, sin = _axial_rope_tables(n)
    for i in range(DEPTH):
        m = i % N_MIXERS
        j = i // N_MIXERS
        update_ctx = _ctx_needed_after(i)
        ctx_keys = m != MIXER_POOL
        mod = jax.nn.silu(c) @ mod_w[i] + mod_b[i]
        sh_a, sc_a, g_a, sh_f, sc_f, g_f = jnp.split(mod[:, None, :], N_MOD, axis=-1)
        h = _modulate(x, sh_a, sc_a)
        hc = None
        if update_ctx or ctx_keys:
            mod_c = jax.nn.silu(c_ctx) @ mod_w[i] + mod_b[i]
            csh_a, csc_a, cg_a, csh_f, csc_f, cg_f = jnp.split(mod_c, N_MOD)
            hc = _modulate(ctx, csh_a, csc_a)
        if m == MIXER_POOL:
            y = _pool_mixer(h, pool_w[j], pool_scale[j])
            yc = _pool_mixer(hc, pool_w[j], pool_scale[j]) if update_ctx else None
        elif m == MIXER_NA:
            y, yc = _na_mixer(h, hc, na_wqkv[j], na_wo[j], na_rpb[j], update_ctx)
        else:
            y, yc = _gqa_mixer(h, hc, gqa_wqkv[j], gqa_q_norm[j], gqa_k_norm[j], gqa_wo[j], cos, sin, update_ctx)
        x = _layer_norm(alpha * x + g_a * y, ln_g[i, 0], ln_b[i, 0])
        f = _ec_moe(_modulate(x, sh_f, sc_f), moe_router[i], moe_w1[i], moe_w3[i], moe_w2[i])
        x = _layer_norm(alpha * x + g_f * f, ln_g[i, 1], ln_b[i, 1])
        if update_ctx:
            ctx = _layer_norm(alpha * ctx + cg_a * yc, ln_g[i, 0], ln_b[i, 0])
            fc = _ec_moe(_modulate(ctx, csh_f, csc_f), moe_router[i], moe_w1[i], moe_w3[i], moe_w2[i])
            ctx = _layer_norm(alpha * ctx + cg_f * fc, ln_g[i, 1], ln_b[i, 1])
    return x
```

```cpp
#include <hip/hip_runtime.h>
#include <hip/hip_bf16.h>
#include <cstdio>
#include <cstdint>
#include <cmath>

namespace pg8 {
#define PG8_LAS __attribute__((address_space(3)))
typedef unsigned short bf16_t;
typedef short bf16x8 __attribute__((ext_vector_type(8)));
typedef float f32x4 __attribute__((ext_vector_type(4)));
typedef unsigned u32x4 __attribute__((ext_vector_type(4)));
typedef unsigned u32x2 __attribute__((ext_vector_type(2)));
constexpr int BM = 256, BK = 64, HALF = 128, HTB = HALF * BK * 2, STAGE_BYTES = 8 * HTB, NXCD = 8, WGM = 8;

__host__ __device__ __forceinline__ int lds_byte(int r, int c) { const int st = (r >> 4) * 2 + (c >> 5), rr = r & 15, cc = c & 31, ob = rr * 64 + cc * 2; return st * 1024 + (ob ^ (((ob >> 9) & 1) << 5)); }
__host__ __device__ __forceinline__ void stage_rc(int b, int& R, int& C) { const int st = b / 1024, sb = b % 1024, swz = sb ^ (((sb >> 9) & 1) << 5); R = (st >> 1) * 16 + swz / 64; C = (st & 1) * 32 + (swz % 64) / 2; }
__host__ __device__ __forceinline__ int perm32(int rho) { const int n = rho >> 4, i = rho & 15; return 8 * (i >> 2) + 4 * n + (i & 3); }

struct Unit { int pm, pn, e; };
struct Gemm { const bf16_t* A; const bf16_t* Bt; int lda, ldb, K, a_pn_off; size_t b_e_stride; };

struct Order {
    int nM, nN, nwg, G, c, tpe, tstride;
    __device__ void init(int nM_, int nN_, int G_, int c_, int tpe_, int tstride_) { nM = nM_; nN = nN_; nwg = nM * nN; G = G_; c = c_; tpe = tpe_; tstride = tstride_; }
    __device__ bool next(int i, Unit& u) const {
        const long L = (long)i * G + c; if (L >= nwg) return false;
        int wgid = (int)L; { const int q = nwg / NXCD, r = nwg % NXCD, xcd = wgid % NXCD, off = wgid / NXCD; wgid = (xcd < r ? xcd * (q + 1) : r * (q + 1) + (xcd - r) * q) + off; }
        const int nig = WGM * nN, gid = wgid / nig, fm = gid * WGM, gsz = (nM - fm) < WGM ? (nM - fm) : WGM;
        const int v = fm + ((wgid % nig) % gsz); u.pn = (wgid % nig) / gsz;
        u.e = v / tpe; u.pm = u.e * tstride + (v - u.e * tpe); return true;
    }
};

__device__ __forceinline__ unsigned cvt_pk_bf16(float lo, float hi) { unsigned r; asm volatile("v_cvt_pk_bf16_f32 %0, %1, %2" : "=v"(r) : "v"(lo), "v"(hi)); return r; }

struct EpiBf16 {
    static constexpr bool PERM = true;
    bf16_t* O; int ldc; int split_cols; size_t split_stride; float scale0;
    __device__ __forceinline__ void operator()(const f32x4 (&acc)[2][2][4][2], const Unit& u, int wr, int wc, int fr, int fq) const {
        const int row0 = u.pm * BM + wr * 64 + fr; int colt = u.pn * BM; bf16_t* base = O;
        float sc = 1.f; if (split_cols) { const int t = colt / split_cols; base += (size_t)t * split_stride; colt -= t * split_cols; if (t == 0) sc = scale0; }
        const int col0 = colt + wc * 32 + 8 * fq;
#pragma unroll
        for (int ai = 0; ai < 2; ++ai)
#pragma unroll
            for (int m = 0; m < 4; ++m) { bf16_t* rowp = base + (size_t)(row0 + ai * HALF + m * 16) * ldc + col0;
#pragma unroll
                for (int bj = 0; bj < 2; ++bj) { f32x4 v0 = acc[ai][bj][m][0] * sc, v1 = acc[ai][bj][m][1] * sc;
                    u32x4 w; w.x = cvt_pk_bf16(v0[0], v0[1]); w.y = cvt_pk_bf16(v0[2], v0[3]); w.z = cvt_pk_bf16(v1[0], v1[1]); w.w = cvt_pk_bf16(v1[2], v1[3]);
                    *(u32x4*)(rowp + bj * HALF) = w; } }
    }
};
struct EpiF32 {
    static constexpr bool PERM = false;
    float* C; int ldc; const float* colscale;
    __device__ __forceinline__ void operator()(const f32x4 (&acc)[2][2][4][2], const Unit& u, int wr, int wc, int fr, int fq) const {
        const int row0 = u.pm * BM + wr * 64 + fr, col0 = u.pn * BM + wc * 32 + 4 * fq;
        f32x4 sv[2][2];
#pragma unroll
        for (int bj = 0; bj < 2; ++bj)
#pragma unroll
            for (int n = 0; n < 2; ++n) sv[bj][n] = colscale ? *(const f32x4*)(colscale + col0 + bj * HALF + n * 16) : (f32x4){1.f, 1.f, 1.f, 1.f};
#pragma unroll
        for (int ai = 0; ai < 2; ++ai)
#pragma unroll
            for (int m = 0; m < 4; ++m) { float* rowp = C + (size_t)(row0 + ai * HALF + m * 16) * ldc + col0;
#pragma unroll
                for (int bj = 0; bj < 2; ++bj)
#pragma unroll
                    for (int n = 0; n < 2; ++n) *(f32x4*)(rowp + bj * HALF + n * 16) = acc[ai][bj][m][n] * sv[bj][n]; }
    }
};
struct EpiSwiGLU {
    static constexpr bool PERM = true;
    bf16_t* Hd; int ldh;
    __device__ __forceinline__ void operator()(const f32x4 (&acc)[2][2][4][2], const Unit& u, int wr, int wc, int fr, int fq) const {
        const int row0 = u.pm * BM + wr * 64 + fr; const int hc0 = (u.pn * BM + wc * 32 + 8 * fq) >> 1;
#pragma unroll
        for (int ai = 0; ai < 2; ++ai)
#pragma unroll
            for (int m = 0; m < 4; ++m) { bf16_t* rowp = Hd + (size_t)(row0 + ai * HALF + m * 16) * ldh + hc0;
#pragma unroll
                for (int bj = 0; bj < 2; ++bj) { const f32x4 a = acc[ai][bj][m][0], b = acc[ai][bj][m][1]; float h[4];
#pragma unroll
                    for (int i = 0; i < 4; ++i) { const float ex = __builtin_amdgcn_exp2f(-1.4426950408889634f * a[i]); h[i] = a[i] * __builtin_amdgcn_rcpf(1.0f + ex) * b[i]; }
                    u32x2 w; w.x = cvt_pk_bf16(h[0], h[1]); w.y = cvt_pk_bf16(h[2], h[3]);
                    *(u32x2*)(rowp + bj * (HALF / 2)) = w; } }
    }
};

template <class Epi, class Sched>
__device__ __forceinline__ void gemm_phase(PG8_LAS unsigned char* lds, const Gemm g, const Sched& S, const Epi& E, const int tid) {
    const int wid = __builtin_amdgcn_readfirstlane(tid >> 6), lane = tid & 63, wr = wid >> 2, wc = wid & 3, fr = lane & 15, fq = lane >> 4;
    const int K = g.K, nt = K / BK;
    unsigned voffA[2], voffB[2];
#pragma unroll
    for (int i = 0; i < 2; ++i) { int R, C; stage_rc(tid * 16 + i * 8192, R, C); const int Rb = Epi::PERM ? ((R & ~31) + perm32(R & 31)) : R;
        voffA[i] = (unsigned)(R * g.lda + C) * 2u; voffB[i] = (unsigned)(Rb * g.ldb + C) * 2u; }
    const size_t kstep = (size_t)(BK * 2);
    const size_t hA = (size_t)HALF * g.lda * 2, hB = (size_t)HALF * g.ldb * 2;
    const unsigned ldsw = (unsigned)wid * 1024u;
    const int aoff = lds_byte(wr * 64 + fr, fq * 8), boff = lds_byte(wc * 32 + fr, fq * 8);
#define PG8_APTR(u) ((const char*)g.A + ((size_t)(u).pm * BM * g.lda + (size_t)(u).pn * g.a_pn_off) * 2)
#define PG8_BPTR(u) ((const char*)g.Bt + ((size_t)(u).e * g.b_e_stride + (size_t)(u).pn * BM * g.ldb) * 2)
#define PG8_SA(b, h) (((b) * 2 + (h)) * HTB)
#define PG8_SB(b, h) ((4 + (b) * 2 + (h)) * HTB)
#define PG8_STAGE(bufoff, gbase, voff) do { _Pragma("unroll") for (int _i = 0; _i < 2; ++_i) \
        __builtin_amdgcn_global_load_lds((const unsigned*)((const char*)(gbase) + (voff)[_i]), (PG8_LAS unsigned*)(lds + (bufoff) + ldsw + _i * 8192), 16, 0, 0); } while (0)
#define PG8_LDA(dst, b, h) do { _Pragma("unroll") for (int m = 0; m < 4; ++m) _Pragma("unroll") for (int k = 0; k < 2; ++k) dst[m][k] = *(const PG8_LAS bf16x8*)(lds + PG8_SA(b, h) + aoff + m * 2048 + k * 1024); } while (0)
#define PG8_LDB(dst, b, h) do { _Pragma("unroll") for (int n = 0; n < 2; ++n) _Pragma("unroll") for (int k = 0; k < 2; ++k) dst[n][k] = *(const PG8_LAS bf16x8*)(lds + PG8_SB(b, h) + boff + n * 2048 + k * 1024); } while (0)
#define PG8_MMA(ai, bj, At, Bt) do { __builtin_amdgcn_s_setprio(1); _Pragma("unroll") for (int m = 0; m < 4; ++m) _Pragma("unroll") for (int n = 0; n < 2; ++n) _Pragma("unroll") for (int k = 0; k < 2; ++k) \
        acc[ai][bj][m][n] = __builtin_amdgcn_mfma_f32_16x16x32_bf16(Bt[n][k], At[m][k], acc[ai][bj][m][n], 0, 0, 0); __builtin_amdgcn_s_setprio(0); } while (0)
#define PG8_WAIT_V(n) asm volatile("s_waitcnt vmcnt(" #n ")" ::: "memory")
#define PG8_WAIT_L(n) asm volatile("s_waitcnt lgkmcnt(" #n ")" ::: "memory")
#define PG8_BAR __builtin_amdgcn_s_barrier()
#define PG8_SCHED __builtin_amdgcn_sched_barrier(0)
    Unit cur, nxt; int ui = 0;
    if (!S.next(0, cur)) return;
    f32x4 acc[2][2][4][2];
#pragma unroll
    for (int a = 0; a < 2; ++a)
#pragma unroll
        for (int b = 0; b < 2; ++b)
#pragma unroll
            for (int m = 0; m < 4; ++m)
#pragma unroll
                for (int n = 0; n < 2; ++n) acc[a][b][m][n] = (f32x4){0.f, 0.f, 0.f, 0.f};
    bf16x8 At[4][2], B0[2][2], B1[2][2];
    const char* cA = PG8_APTR(cur); const char* cB = PG8_BPTR(cur);
    PG8_STAGE(PG8_SB(0, 0), cB, voffB); PG8_STAGE(PG8_SB(0, 1), cB + hB, voffB); PG8_STAGE(PG8_SA(0, 0), cA, voffA); PG8_STAGE(PG8_SA(0, 1), cA + hA, voffA);
    if (wr == 1) PG8_BAR;
    PG8_WAIT_V(2); PG8_BAR;
    PG8_STAGE(PG8_SB(1, 0), cB + kstep, voffB); PG8_STAGE(PG8_SA(1, 0), cA + kstep, voffA); PG8_STAGE(PG8_SB(1, 1), cB + hB + kstep, voffB);
    PG8_WAIT_V(6); PG8_BAR;
    for (;;) {
        const bool has_next = S.next(ui + 1, nxt);
        const char* nA = has_next ? PG8_APTR(nxt) : cA; const char* nB = has_next ? PG8_BPTR(nxt) : cB;
        for (int t = 0; t < nt; t += 2) {
            const bool last = (t == nt - 2);
            const char* a1 = cA + (size_t)(t + 1) * kstep;
            const char* a2 = last ? nA : cA + (size_t)(t + 2) * kstep; const char* b2 = last ? nB : cB + (size_t)(t + 2) * kstep;
            const char* a3 = a2 + kstep; const char* b3 = b2 + kstep;
            PG8_LDB(B0, 0, 0); PG8_LDB(B1, 0, 1); PG8_SCHED; PG8_LDA(At, 0, 0); PG8_STAGE(PG8_SA(1, 1), a1 + hA, voffA);
            PG8_WAIT_V(8); PG8_WAIT_L(0); PG8_BAR; PG8_MMA(0, 0, At, B0); PG8_MMA(0, 1, At, B1); PG8_BAR; PG8_SCHED;
            PG8_LDA(At, 0, 1); PG8_STAGE(PG8_SB(0, 0), b2, voffB); PG8_STAGE(PG8_SB(0, 1), b2 + hB, voffB); PG8_STAGE(PG8_SA(0, 0), a2, voffA);
            PG8_WAIT_V(8); PG8_WAIT_L(0); PG8_BAR; PG8_MMA(1, 0, At, B0); PG8_MMA(1, 1, At, B1); PG8_BAR; PG8_SCHED;
            PG8_LDB(B0, 1, 0); PG8_LDB(B1, 1, 1); PG8_SCHED; PG8_LDA(At, 1, 0); PG8_STAGE(PG8_SA(0, 1), a2 + hA, voffA);
            PG8_WAIT_V(8); PG8_WAIT_L(0); PG8_BAR; PG8_MMA(0, 0, At, B0); PG8_MMA(0, 1, At, B1); PG8_BAR; PG8_SCHED;
            PG8_LDA(At, 1, 1); PG8_STAGE(PG8_SB(1, 0), b3, voffB); PG8_STAGE(PG8_SB(1, 1), b3 + hB, voffB); PG8_STAGE(PG8_SA(1, 0), a3, voffA);
            PG8_WAIT_V(8); PG8_WAIT_L(0); PG8_BAR; PG8_MMA(1, 0, At, B0); PG8_MMA(1, 1, At, B1); PG8_BAR; PG8_SCHED;
        }
        if (wr == 0) PG8_BAR;
        E(acc, cur, wr, wc, fr, fq);
        if (!has_next) break;
#pragma unroll
        for (int a = 0; a < 2; ++a)
#pragma unroll
            for (int b = 0; b < 2; ++b)
#pragma unroll
                for (int m = 0; m < 4; ++m)
#pragma unroll
                    for (int n = 0; n < 2; ++n) acc[a][b][m][n] = (f32x4){0.f, 0.f, 0.f, 0.f};
        cur = nxt; cA = nA; cB = nB; ++ui;
        if (wr == 1) PG8_BAR;
    }
    PG8_WAIT_V(0);
    PG8_BAR;
#undef PG8_APTR
#undef PG8_BPTR
#undef PG8_SA
#undef PG8_SB
#undef PG8_STAGE
#undef PG8_LDA
#undef PG8_LDB
#undef PG8_MMA
#undef PG8_WAIT_V
#undef PG8_WAIT_L
#undef PG8_BAR
#undef PG8_SCHED
}
}
namespace attn_body {
using bf16=__hip_bfloat16;
using bf16x8=__attribute__((ext_vector_type(8)))short;
using s16x4=__attribute__((ext_vector_type(4)))short;
using f32x16=__attribute__((ext_vector_type(16)))float;
using u32x4=__attribute__((ext_vector_type(4)))unsigned;
constexpr int D=64;
constexpr int NW=8,QBLK=32,QB=QBLK*NW,KVBLK=64;
__device__ __forceinline__ int crow(int r,int hi){return (r&3)+8*(r>>2)+4*hi;}
#define SBAR() __builtin_amdgcn_sched_barrier(0)
constexpr int NSLOT=3, SLOTB=8192;
constexpr int LDS_K=0, LDS_V=NSLOT*SLOTB, LDS_WS=2*NSLOT*SLOTB, LDS_OST=LDS_WS+NW*64*4, LDS_BYTES=LDS_OST+NW*4096;
constexpr int LDS_BIAS=LDS_BYTES;
constexpr float C2=0.125f*1.4426950408889634f;
__device__ __forceinline__ void glds16(const void*gsrc,unsigned lds_dst){unsigned keep;
  asm volatile("s_mov_b32 %0, m0\n\ts_mov_b32 m0, %2\n\ts_nop 0\n\tglobal_load_lds_dwordx4 %1, off\n\ts_mov_b32 m0, %0":"=&s"(keep):"v"(gsrc),"s"(lds_dst):"memory");}
__device__ __forceinline__ float max3f(float a,float b,float c){float r;asm("v_max3_f32 %0, %1, %2, %3":"=v"(r):"v"(a),"v"(b),"v"(c));return r;}
__device__ __forceinline__ float max2f(float a,float b){float r;asm("v_max_f32_e32 %0, %1, %2":"=v"(r):"v"(a),"v"(b));return r;}
__device__ __forceinline__ float fadd_s(float a,float b){float r;asm("v_add_f32_e32 %0, %1, %2":"=v"(r):"v"(a),"v"(b));return r;}
__device__ __forceinline__ float fsub_s(float a,float b){float r;asm("v_sub_f32_e32 %0, %1, %2":"=v"(r):"v"(a),"v"(b));return r;}
typedef float f32x2_t __attribute__((ext_vector_type(2))); typedef __bf16 bf16x2_t __attribute__((ext_vector_type(2)));
__device__ __forceinline__ unsigned cvtpk_s(float lo,float hi){f32x2_t v={lo,hi};bf16x2_t b=__builtin_convertvector(v,bf16x2_t);return __builtin_bit_cast(unsigned,b);}
#define WAIT_BAR(N) asm volatile("s_waitcnt vmcnt(" #N ") lgkmcnt(0)\n\ts_barrier":::"memory")

__device__ __forceinline__ void qkt(f32x16&p0,f32x16&p1,const char*Kslot,const bf16x8*qr,const f32x16&negm,int r32,int hi){
  const char*kb=Kslot+hi*1024+r32*16;
  #pragma unroll
  for(int d0=0;d0<4;++d0){
    const bf16x8 b0=*reinterpret_cast<const bf16x8*>(kb+d0*2048);
    const bf16x8 b1=*reinterpret_cast<const bf16x8*>(kb+d0*2048+512);
    if(d0==0){p0=__builtin_amdgcn_mfma_f32_32x32x16_bf16(b0,qr[0],negm,0,0,0);p1=__builtin_amdgcn_mfma_f32_32x32x16_bf16(b1,qr[0],negm,0,0,0);}
    else{p0=__builtin_amdgcn_mfma_f32_32x32x16_bf16(b0,qr[d0],p0,0,0,0);p1=__builtin_amdgcn_mfma_f32_32x32x16_bf16(b1,qr[d0],p1,0,0,0);}}
}
typedef __attribute__((address_space(3))) const char* lds_cptr;
typedef short v4i16_t __attribute__((ext_vector_type(4)));
__device__ __forceinline__ void kload8(bf16x8*kf,lds_cptr kp){
  kf[0]=*(const __attribute__((address_space(3))) bf16x8*)(kp);      kf[1]=*(const __attribute__((address_space(3))) bf16x8*)(kp+512);
  kf[2]=*(const __attribute__((address_space(3))) bf16x8*)(kp+2048); kf[3]=*(const __attribute__((address_space(3))) bf16x8*)(kp+2560);
  kf[4]=*(const __attribute__((address_space(3))) bf16x8*)(kp+4096); kf[5]=*(const __attribute__((address_space(3))) bf16x8*)(kp+4608);
  kf[6]=*(const __attribute__((address_space(3))) bf16x8*)(kp+6144); kf[7]=*(const __attribute__((address_space(3))) bf16x8*)(kp+6656);
}
__device__ __forceinline__ void kload2(bf16x8*kf,lds_cptr kp,int j){ kf[2*j]=*(const __attribute__((address_space(3))) bf16x8*)(kp+j*2048); kf[2*j+1]=*(const __attribute__((address_space(3))) bf16x8*)(kp+j*2048+512); }
__device__ __forceinline__ s16x4 vtr(lds_cptr p){ return __builtin_bit_cast(s16x4,__builtin_amdgcn_ds_read_tr16_b64_v4i16((__attribute__((address_space(3))) v4i16_t*)p)); }
__device__ __forceinline__ float rowmax(const f32x16&p0,const f32x16&p1){
  float a=max3f(p0[0],p0[1],p1[0]),b=max3f(p0[2],p0[3],p1[1]);a=max3f(a,p1[2],p1[3]);
  #pragma unroll
  for(int r=4;r<16;r+=4){a=max3f(a,p0[r],p0[r+1]);b=max3f(b,p0[r+2],p0[r+3]);a=max3f(a,p1[r],p1[r+1]);b=max3f(b,p1[r+2],p1[r+3]);}
  const float m=max2f(a,b);
  auto rr=__builtin_amdgcn_permlane32_swap(__float_as_uint(m),__float_as_uint(m),false,false);
  return max2f(__uint_as_float(rr[0]),__uint_as_float(rr[1]));
}
__device__ __forceinline__ void pv(f32x16*o,int vb,bf16x8 pa0,bf16x8 pa1,bf16x8 pa2,bf16x8 pa3){
  #pragma unroll
  for(int d0=0;d0<2;++d0){s16x4 lo[4],hi[4];
    #pragma unroll
    for(int ks=0;ks<4;++ks){
      asm volatile("ds_read_b64_tr_b16 %0,%1 offset:%c2":"=&v"(lo[ks]):"v"(vb),"i"(d0*4096+ks*1024):"memory");
      asm volatile("ds_read_b64_tr_b16 %0,%1 offset:%c2":"=&v"(hi[ks]):"v"(vb),"i"(d0*4096+ks*1024+512):"memory");}
    asm volatile("s_waitcnt lgkmcnt(0)":::"memory");SBAR();
    #define PK(k) (bf16x8){lo[k][0],lo[k][1],lo[k][2],lo[k][3],hi[k][0],hi[k][1],hi[k][2],hi[k][3]}
    o[d0]=__builtin_amdgcn_mfma_f32_32x32x16_bf16(pa0,PK(0),o[d0],0,0,0);
    o[d0]=__builtin_amdgcn_mfma_f32_32x32x16_bf16(pa1,PK(1),o[d0],0,0,0);
    o[d0]=__builtin_amdgcn_mfma_f32_32x32x16_bf16(pa2,PK(2),o[d0],0,0,0);
    o[d0]=__builtin_amdgcn_mfma_f32_32x32x16_bf16(pa3,PK(3),o[d0],0,0,0);
    #undef PK
  }
}
struct TileRows { long base0, base1; int nfirst; __device__ __forceinline__ long operator()(int t) const { return t < nfirst ? base0 + 64l * t : base1 + 64l * (t - nfirst); } };
struct NoMask { static constexpr bool ACTIVE=false; __device__ __forceinline__ void apply(f32x16&,f32x16&,int) const {} };
struct NaMask {
  static constexpr bool ACTIVE=true;
  int kbase, qr, r0q, qcol, c0, hi; lds_cptr bias;
  __device__ __forceinline__ void apply(f32x16&p0,f32x16&p1,int t) const {
    if(t<4) return;
    const int kr=kbase+(t-4); const float NEG=-1.0e30f;
    if(kr<r0q||kr>r0q+7){
      #pragma unroll
      for(int r=0;r<16;++r){p0[r]=NEG;p1[r]=NEG;}
      return; }
    const int ib=(kr-qr+7)*31+(4*hi-qcol+15);
    const int cb=4*hi-c0;
    #pragma unroll
    for(int r=0;r<16;++r){ const int ko=(r&3)+8*(r>>2);
      const float b0=*(const __attribute__((address_space(3))) float*)(bias+4*(ib+ko));
      const float b1=*(const __attribute__((address_space(3))) float*)(bias+4*(ib+ko+32));
      p0[r]=((unsigned)(cb+ko)<16u)?p0[r]+b0:NEG;
      p1[r]=((unsigned)(cb+ko+32)<16u)?p1[r]+b1:NEG; }
  }
};

#ifndef ATTN_STORE16
#define ATTN_STORE16(p,v) (*(u32x4*)(p)=(v))
#endif
template<int THRL,class MK,bool USE_NEGM> __device__ __forceinline__ void attn_unit(const bf16*Qw0,int QP,const bf16*__restrict__ Kc,const bf16*__restrict__ Vc,int KP,const TileRows TR,const int NT,bf16*Ow0,int OP,char*shm,const MK&mk,const int tid){
  const int lane=tid&63,r32=lane&31,hi=lane>>5; const int wid=__builtin_amdgcn_readfirstlane(tid>>6);
  const bf16*Qw=Qw0+(long)(wid*QBLK)*QP;
  const unsigned lds0=(unsigned)(uintptr_t)shm;
  float*wsf=(float*)(shm+LDS_WS)+wid*64;
  const bf16*ksrc=Kc+(long)lane*KP+wid*8;
  const bf16*vsrc=Vc+(long)(16*(wid&3)+(lane>>2))*KP+(wid>>2)*32+(lane&3)*8;
  const unsigned kdst=lds0+LDS_K+wid*1024, vdst=lds0+LDS_V+wid*1024;
  #define DMA_K(t,slot) glds16(ksrc+TR(t)*KP,(unsigned)__builtin_amdgcn_readfirstlane(kdst+(slot)))
  #define DMA_V(t,slot) glds16(vsrc+TR(t)*KP,(unsigned)__builtin_amdgcn_readfirstlane(vdst+(slot)))
  const int vb0=(int)(lds0+LDS_V)+((lane>>4)&1)*32+(lane&3)*8+(4*hi+((lane&15)>>2))*64;
  const char*Kbase=shm+LDS_K; bf16x8 kf[8];
  const lds_cptr shm3=(lds_cptr)shm; const lds_cptr kp0=shm3+LDS_K+hi*1024+r32*16; const lds_cptr vp0=shm3+LDS_V+((lane>>4)&1)*32+(lane&3)*8+(4*hi+((lane&15)>>2))*64;
  DMA_K(0,0);DMA_V(0,0);DMA_K(1,SLOTB);
  bf16x8 qr[4];
  #pragma unroll
  for(int d0=0;d0<4;++d0)qr[d0]=*reinterpret_cast<const bf16x8*>(&Qw[(long)r32*QP+d0*16+hi*8]);
  float zz_; asm volatile("v_mov_b32 %0, 0":"=v"(zz_)); float mhat=zz_,l_reg=zz_;f32x16 o[2];
  _Pragma("unroll") for(int r=0;r<16;++r){o[0][r]=zz_;o[1][r]=zz_;}
  f32x16 negm; if(USE_NEGM){ _Pragma("unroll") for(int r=0;r<16;++r)negm[r]=zz_; asm volatile("":"+v"(negm)); }
  const f32x16 zero16=f32x16{};
  #define CIN (USE_NEGM?negm:zero16)
  #define SUBM(C0,C1) do{ if(!USE_NEGM){ _Pragma("unroll") for(int r=0;r<16;++r){C0[r]-=mhat;C1[r]-=mhat;} } }while(0)
  #define CMASK(P0,P1,t) mk.apply(P0,P1,t)
  bool resc=false;
  #define START(P0,P1) do{ const float rm=rowmax(P0,P1); resc=false; \
    { const float dl=rm; mhat=fadd_s(mhat,dl); \
      _Pragma("unroll") for(int r=0;r<16;++r){P0[r]=fsub_s(P0[r],dl);P1[r]=fsub_s(P1[r],dl);} \
      if(USE_NEGM){ _Pragma("unroll") for(int r=0;r<16;++r)negm[r]=-mhat; asm volatile("":"+v"(negm)); } } \
    _Pragma("unroll") for(int r=0;r<16;++r)P0[r]=__builtin_amdgcn_exp2f(P0[r]); }while(0)
  #define RESC() do{ if(resc){ asm volatile("s_waitcnt lgkmcnt(0)":::"memory"); \
      _Pragma("unroll") for(int d_=0;d_<2;++d_) _Pragma("unroll") for(int r=0;r<16;++r)o[d_][r]*=wsf[crow(r,hi)]; } }while(0)
  f32x16 pA0,pA1,pB0,pB1;
  int sl_prev=0,sl_cur=0,sl_next=SLOTB;
  #define ROT() do{sl_prev=sl_cur;sl_cur=sl_next;sl_next=(sl_next==(NSLOT-1)*SLOTB)?0:sl_next+SLOTB;}while(0)
  DMA_K(2,2*SLOTB);
  WAIT_BAR(3);
  qkt(pA0,pA1,Kbase,qr,CIN,r32,hi);asm volatile("s_nop 15\n\ts_nop 7":"+v"(pA0),"+v"(pA1));CMASK(pA0,pA1,0);
  START(pA0,pA1);
  _Pragma("unroll") for(int r=0;r<16;++r)pA1[r]=__builtin_amdgcn_exp2f(pA1[r]);
  WAIT_BAR(0);
  DMA_K(3,0);DMA_V(1,SLOTB);
  ROT();
  kload8(kf,kp0+sl_cur);
  WAIT_BAR(2);
  s16x4 vlo[8],vhi[8]; u32x4 pw0,pw1,pw2,pw3;
  #define PKW(P,B) cvtpk_s(P[B],P[B+1])
  #define PAF(k) __builtin_bit_cast(bf16x8,pw##k)
  #define VFR(i) (bf16x8){vlo[i][0],vlo[i][1],vlo[i][2],vlo[i][3],vhi[i][0],vhi[i][1],vhi[i][2],vhi[i][3]}
  #define PIN(x) asm volatile("":"+v"(x))
  #define MX3(a,b,c) __builtin_fmaxf(__builtin_fmaxf((a),(b)),(c))
  #define GAPA(MF,A0,A1,A2,A3,W0,W1,PW) do{ MF; sacc+=A0; sacc+=A1; sacc+=A2; sacc+=A3; PIN(sacc); W0; W1; PIN(PW); SBAR(); }while(0)
  #define EX(v) __builtin_amdgcn_exp2f(v)
  #define GAPB(MF,X,B) do{ MF; X[B]=EX(X[B]); X[B+1]=EX(X[B+1]); X[B+2]=EX(X[B+2]); X[B+3]=EX(X[B+3]); PIN(X); SBAR(); }while(0)
  #define VRD(i) do{ vlo[i]=vtr(vp_+(((i)>>2)*4096+((i)&3)*1024)); vhi[i]=vtr(vp_+(((i)>>2)*4096+((i)&3)*1024+512)); }while(0)
  #define KRD(G,j) do{ if(G){ kload2(kf,kp0+sl_next,j); SBAR(); } }while(0)
  #define STEP(C0,C1,P0,P1,t,GK,GV,GL) do{ SBAR(); \
    const lds_cptr vp_=vp0+sl_prev; \
    VRD(0); SBAR(); float sacc=(P0[0]+P0[1]); \
    GAPA(C0=__builtin_amdgcn_mfma_f32_32x32x16_bf16(kf[0],qr[0],CIN,0,0,0), P0[2],P0[3],P0[4],P0[5],     pw0[0]=PKW(P0,0), pw0[1]=PKW(P0,2), pw0); \
    VRD(4); SBAR(); GAPA(C1=__builtin_amdgcn_mfma_f32_32x32x16_bf16(kf[1],qr[0],CIN,0,0,0), P0[6],P0[7],P0[8],P0[9],     pw0[2]=PKW(P0,4), pw0[3]=PKW(P0,6), pw0); \
    VRD(1); SBAR(); GAPA(C0=__builtin_amdgcn_mfma_f32_32x32x16_bf16(kf[2],qr[1],C0,0,0,0),   P0[10],P0[11],P0[12],P0[13], pw1[0]=PKW(P0,8), pw1[1]=PKW(P0,10), pw1); \
    VRD(5); SBAR(); GAPA(C1=__builtin_amdgcn_mfma_f32_32x32x16_bf16(kf[3],qr[1],C1,0,0,0),   P0[14],P0[15],P1[0],P1[1],   pw1[2]=PKW(P0,12),pw1[3]=PKW(P0,14), pw1); \
    VRD(2); SBAR(); GAPA(C0=__builtin_amdgcn_mfma_f32_32x32x16_bf16(kf[4],qr[2],C0,0,0,0),   P1[2],P1[3],P1[4],P1[5],     pw2[0]=PKW(P1,0), pw2[1]=PKW(P1,2), pw2); \
    VRD(6); SBAR(); GAPA(C1=__builtin_amdgcn_mfma_f32_32x32x16_bf16(kf[5],qr[2],C1,0,0,0),   P1[6],P1[7],P1[8],P1[9],     pw2[2]=PKW(P1,4), pw2[3]=PKW(P1,6), pw2); \
    VRD(3); SBAR(); GAPA(C0=__builtin_amdgcn_mfma_f32_32x32x16_bf16(kf[6],qr[3],C0,0,0,0),   P1[10],P1[11],P1[12],P1[13], pw3[0]=PKW(P1,8), pw3[1]=PKW(P1,10), pw3); \
    VRD(7); SBAR(); GAPA(C1=__builtin_amdgcn_mfma_f32_32x32x16_bf16(kf[7],qr[3],C1,0,0,0),   P1[14],P1[15],0.f,0.f,       pw3[2]=PKW(P1,12),pw3[3]=PKW(P1,14), pw3); \
    l_reg+=sacc; \
    if(GK){DMA_K((t)+3,sl_cur);} if(GV){DMA_V((t)+1,sl_next);} \
    SUBM(C0,C1); CMASK(C0,C1,t); \
    { float a=MX3(C0[0],C0[1],C1[0]),b=MX3(C0[2],C0[3],C1[1]); a=MX3(a,C1[2],C1[3]); \
      _Pragma("unroll") for(int r=4;r<16;r+=4){a=MX3(a,C0[r],C0[r+1]);b=MX3(b,C0[r+2],C0[r+3]);a=MX3(a,C1[r],C1[r+1]);b=MX3(b,C1[r+2],C1[r+3]);} \
      float rm=__builtin_fmaxf(a,b); { auto rr=__builtin_amdgcn_permlane32_swap(__float_as_uint(rm),__float_as_uint(rm),false,false); rm=__builtin_fmaxf(__uint_as_float(rr[0]),__uint_as_float(rr[1])); } \
      resc=false; \
      if(__builtin_expect(__any(rm>(float)THRL),0)){ const float dl=__builtin_fmaxf(rm,0.f); mhat+=dl; \
        _Pragma("unroll") for(int r=0;r<16;++r){C0[r]-=dl;C1[r]-=dl;} \
        if(USE_NEGM){ _Pragma("unroll") for(int r=0;r<16;++r)negm[r]=-mhat; asm volatile("":"+v"(negm)); } \
        const float f=__builtin_amdgcn_exp2f(-dl); l_reg*=f; if(hi==0)wsf[r32]=f; resc=true; } } \
    SBAR(); \
    GAPB(o[0]=__builtin_amdgcn_mfma_f32_32x32x16_bf16(PAF(0),VFR(0),o[0],0,0,0), C0,0); \
    GAPB(o[1]=__builtin_amdgcn_mfma_f32_32x32x16_bf16(PAF(0),VFR(4),o[1],0,0,0), C0,4); \
    KRD(GL,0); GAPB(o[0]=__builtin_amdgcn_mfma_f32_32x32x16_bf16(PAF(1),VFR(1),o[0],0,0,0), C0,8); \
    KRD(GL,1); GAPB(o[1]=__builtin_amdgcn_mfma_f32_32x32x16_bf16(PAF(1),VFR(5),o[1],0,0,0), C0,12); \
    KRD(GL,2); GAPB(o[0]=__builtin_amdgcn_mfma_f32_32x32x16_bf16(PAF(2),VFR(2),o[0],0,0,0), C1,0); \
    KRD(GL,3); GAPB(o[1]=__builtin_amdgcn_mfma_f32_32x32x16_bf16(PAF(2),VFR(6),o[1],0,0,0), C1,4); \
    GAPB(o[0]=__builtin_amdgcn_mfma_f32_32x32x16_bf16(PAF(3),VFR(3),o[0],0,0,0), C1,8); \
    GAPB(o[1]=__builtin_amdgcn_mfma_f32_32x32x16_bf16(PAF(3),VFR(7),o[1],0,0,0), C1,12); \
    }while(0)
  int t=1;
  for(;t+5<NT;t+=2){
    STEP(pB0,pB1,pA0,pA1,t,true,true,true);     WAIT_BAR(2); RESC(); ROT();
    STEP(pA0,pA1,pB0,pB1,t+1,true,true,true);   WAIT_BAR(2); RESC(); ROT();
  }
  #define ENDW(tt) do{ if((tt)+3<NT){WAIT_BAR(2);} else if((tt)+2<NT){WAIT_BAR(1);} else {WAIT_BAR(0);} }while(0)
  for(;t+1<NT;t+=2){
    STEP(pB0,pB1,pA0,pA1,t,(t+3<NT),(t+1<NT),(t+1<NT));       ENDW(t);   RESC(); ROT();
    STEP(pA0,pA1,pB0,pB1,t+1,(t+4<NT),(t+2<NT),(t+2<NT));     ENDW(t+1); RESC(); ROT();
  }
  STEP(pB0,pB1,pA0,pA1,NT-1,false,false,false); RESC();
  { float sacc=pB0[0]+pB0[1]; _Pragma("unroll") for(int r=2;r<16;++r)sacc+=pB0[r]; _Pragma("unroll") for(int r=0;r<16;++r)sacc+=pB1[r]; l_reg+=sacc;
    pw0=(u32x4){PKW(pB0,0),PKW(pB0,2),PKW(pB0,4),PKW(pB0,6)};pw1=(u32x4){PKW(pB0,8),PKW(pB0,10),PKW(pB0,12),PKW(pB0,14)};pw2=(u32x4){PKW(pB1,0),PKW(pB1,2),PKW(pB1,4),PKW(pB1,6)};pw3=(u32x4){PKW(pB1,8),PKW(pB1,10),PKW(pB1,12),PKW(pB1,14)};
    SBAR(); pv(o,vb0+sl_cur,PAF(0),PAF(1),PAF(2),PAF(3)); }
  #undef PKW
  #undef PAF
  #undef VFR
  #undef PIN
  #undef MX3
  #undef GAPA
  #undef GAPB
  #undef EX
  #undef VRD
  #undef KRD
  #undef STEP
  #undef ENDW
  {auto rr=__builtin_amdgcn_permlane32_swap(__float_as_uint(l_reg),__float_as_uint(l_reg),false,false);l_reg=__uint_as_float(rr[0])+__uint_as_float(rr[1]);}
  if(hi==0)wsf[32+r32]=l_reg;asm volatile("s_waitcnt lgkmcnt(0)":::"memory");
  float rli[16];
  #pragma unroll
  for(int r=0;r<16;++r)rli[r]=__builtin_amdgcn_rcpf(wsf[32+crow(r,hi)]);
  bf16*Ow=Ow0+(long)(wid*QBLK)*OP;
  { bf16*stg=(bf16*)(shm+LDS_OST)+wid*2048;
    #pragma unroll
    for(int r=0;r<16;++r){const int orow=crow(r,hi);
      #pragma unroll
      for(int d0=0;d0<2;++d0)stg[orow*64+d0*32+r32]=__float2bfloat16(o[d0][r]*rli[r]);}
    asm volatile("s_waitcnt lgkmcnt(0)":::"memory");
    #pragma unroll
    for(int i=0;i<4;++i){const int row=i*8+(lane>>3),ch=lane&7; const u32x4 v=*(const u32x4*)(stg+row*64+ch*8); ATTN_STORE16(Ow+(long)row*OP+ch*8,v);} }
  asm volatile("s_waitcnt lgkmcnt(0)\n\ts_barrier":::"memory");
  #undef CIN
  #undef SUBM
  #undef DMA_K
  #undef DMA_V
  #undef CMASK
  #undef START
  #undef RESC
  #undef ROT
}
#undef SBAR
#undef WAIT_BAR
}
#ifndef MK_PER_PHASE
#define MK_PER_PHASE 0
#endif
constexpr int NWAVES = 8;
constexpr int NB = 4, SEQ = 8192, DM = 1024, LCTX = 256, DEPTH = 4;
constexpr int M_LAT = NB * SEQ, M_CTX = NB * LCTX, M_ALL = M_LAT + M_CTX;
constexpr int NE = 16, FF = 2048, CAP_LAT = 1024, CAP_CTX = 32;
constexpr int ETILES = 17, ESTR = ETILES * 256, NSLOTS = NE * ESTR;
constexpr int KVROWS = SEQ + LCTX;
constexpr int NMOD = 6 * DM;
constexpr float ALPHA = 1.681792830507429f, LN_EPS = 1e-5f, RMS_EPS = 1e-6f, LOG2E = 1.4426950408889634f;

constexpr size_t MiB = 1u << 20;
constexpr size_t WS_CTL = 0, CTL_ZERO_BYTES = 2 * MiB;
constexpr size_t WS_MOD = 2 * MiB, WS_AFF = 3 * MiB, WS_SEL = 6 * MiB, WS_SLOT = 9 * MiB;
constexpr size_t WS_POOLW = 10 * MiB, WS_NAQKV = 11 * MiB, WS_NAWO = 17 * MiB, WS_GQKV = 19 * MiB, WS_GWO = 22 * MiB;
constexpr size_t WS_W13 = 32 * MiB, WS_W2 = 544 * MiB, WS_X = 800 * MiB, WS_H = 932 * MiB, WS_R = 1000 * MiB, WS_END = 1544 * MiB;
constexpr size_t R_XS = 0, R_HID = 136 * MiB, R_YS = 408 * MiB;
constexpr size_t R_D = 0, R_Y = 200 * MiB;
constexpr size_t R_Q = 0, R_K = 66 * MiB, R_V = 132 * MiB;
constexpr size_t R_RAW = 0, R_GQ = 100 * MiB, R_GK = 164 * MiB, R_GV = 181 * MiB;
constexpr int CW_TMO = 0, CW_BAR = 4096;

constexpr int RING_BYTES = 135168;
constexpr int LDSCTL_OFF = RING_BYTES, MISC_OFF = LDSCTL_OFF + 320;
constexpr int LDS_BYTES = 147456;

#define GAS __attribute__((address_space(1)))
#define LAS __attribute__((address_space(3)))
typedef unsigned short bf16;
typedef unsigned v4u __attribute__((ext_vector_type(4)));
typedef unsigned v2u __attribute__((ext_vector_type(2)));
typedef float f32x4 __attribute__((ext_vector_type(4)));
typedef float f32x2 __attribute__((ext_vector_type(2)));
#define RLX_AGENT __ATOMIC_RELAXED, __HIP_MEMORY_SCOPE_AGENT
#define LDS_WAIT() asm volatile("s_waitcnt lgkmcnt(0)" ::: "memory")
__device__ __forceinline__ unsigned pk2(float lo, float hi) { return pg8::cvt_pk_bf16(lo, hi); }
__device__ __forceinline__ float bf_lo(unsigned u) { return __uint_as_float(u << 16); }
__device__ __forceinline__ float bf_hi(unsigned u) { return __uint_as_float(u & 0xffff0000u); }

#define XB_TMO      128
#define XB_XCNT(j)  (256  + 64 * (j))
#define XB_XSUB(j)  (1280 + 64 * (j))
#define XB_XGEN(j)  (2304 + 64 * (j))
#define XB_TOP      3328
#define XB_TOPGEN   3392
#define XCD_BAR_WORDS 3456
#define XB_SPIN_CAP (1u << 22)

__device__ __forceinline__ unsigned xb_ld(unsigned* p)              { return __hip_atomic_load(p, __ATOMIC_RELAXED, __HIP_MEMORY_SCOPE_AGENT); }
__device__ __forceinline__ unsigned xb_add(unsigned* p, unsigned v) { return __hip_atomic_fetch_add(p, v, __ATOMIC_RELAXED, __HIP_MEMORY_SCOPE_AGENT); }
__device__ __forceinline__ unsigned xb_xcc_id() { return (unsigned)__builtin_amdgcn_s_getreg((3 << 11) | 20) & 0xFu; }
#define XB_SPIN(cond, bar) do { unsigned _sp = 0; while (cond) { __builtin_amdgcn_s_sleep(1); \
    if ((++_sp & 255u) == 0u) { if (xb_ld(&(bar)[XB_TMO])) break; if (_sp > XB_SPIN_CAP) { atomicAdd(&(bar)[XB_TMO], 1u); break; } } } } while (0)

struct XcdBarrier { unsigned* bar; unsigned x; volatile LAS unsigned* st; };
__device__ __forceinline__ XcdBarrier xcd_barrier_post(unsigned* bar, volatile LAS unsigned* st) {
    XcdBarrier b; b.bar = bar; b.x = xb_xcc_id(); b.st = st;
    if (threadIdx.x == 0) (void)xb_add(&bar[XB_XCNT(b.x)], 1u);
    return b;
}
__device__ __forceinline__ void xcd_barrier_complete(unsigned* bar, unsigned x, unsigned& nloc, unsigned& nx) {
    const unsigned G = gridDim.x * gridDim.y * gridDim.z;
    unsigned sum, cnt, mine, sp = 0u;
    for (;;) {
        sum = 0u; cnt = 0u; mine = 0u;
#pragma unroll
        for (unsigned j = 0; j < 16; ++j) { const unsigned c = xb_ld(&bar[XB_XCNT(j)]); sum += c; cnt += (c > 0u) ? 1u : 0u; mine = (j == x) ? c : mine; }
        if (sum == G) break;
        __builtin_amdgcn_s_sleep(1);
        if ((++sp & 255u) == 0u) { if (xb_ld(&bar[XB_TMO])) break; if (sp > XB_SPIN_CAP) { atomicAdd(&bar[XB_TMO], 1u); break; } }
    }
    nloc = mine > 0u ? mine : 1u; nx = cnt > 0u ? cnt : 1u;
}
__device__ __forceinline__ void xcd_barrier(const XcdBarrier& b) {
    asm volatile("s_waitcnt vmcnt(0)" ::: "memory");
    __syncthreads();
    if (threadIdx.x == 0) {
        unsigned* bar = b.bar;
        __builtin_amdgcn_s_waitcnt(0);
        unsigned nloc = b.st[0], nx = b.st[1];
        if (nloc == 0u) { xcd_barrier_complete(bar, b.x, nloc, nx); b.st[0] = nloc; b.st[1] = nx; }
        const unsigned old = xb_add(&bar[XB_XSUB(b.x)], 1u);
        const unsigned gen = old / nloc;
        if (old + 1u == (gen + 1u) * nloc) {
            __builtin_amdgcn_fence(__ATOMIC_RELEASE, "agent");
            asm volatile("s_waitcnt vmcnt(0)" ::: "memory");
            const unsigned og = xb_add(&bar[XB_TOP], 1u);
            const unsigned tg = og / nx;
            if (og + 1u == (tg + 1u) * nx) xb_add(&bar[XB_TOPGEN], 1u);
            else XB_SPIN(xb_ld(&bar[XB_TOPGEN]) == tg, bar);
            __builtin_amdgcn_fence(__ATOMIC_ACQUIRE, "agent");
            xb_add(&bar[XB_XGEN(b.x)], 1u);
            asm volatile("s_waitcnt vmcnt(0)" ::: "memory");
        } else {
            XB_SPIN(xb_ld(&bar[XB_XGEN(b.x)]) == gen, bar);
            __builtin_amdgcn_fence(__ATOMIC_ACQUIRE, "agent");
            asm volatile("s_waitcnt vmcnt(0)" ::: "memory");
        }
    }
    __syncthreads();
}

__device__ __forceinline__ float wave_sum(float v) {
#pragma unroll
    for (int o = 1; o < 64; o <<= 1) v += __shfl_xor(v, o);
    return v;
}
__device__ __forceinline__ int wave_incl_scan(int v, int lane) {
#pragma unroll
    for (int o = 1; o < 64; o <<= 1) { const int t = __shfl_up(v, o); if (lane >= o) v += t; }
    return v;
}
__device__ __forceinline__ int block_excl_scan(int v, LAS int* tmp, int lane, int wave) {
    const int inc = wave_incl_scan(v, lane);
    if (lane == 63) tmp[wave] = inc;
    __syncthreads();
    int base = 0;
#pragma unroll
    for (int w = 0; w < NWAVES; ++w) { const int t = tmp[w]; base += (w < wave) ? t : 0; }
    __syncthreads();
    return base + inc - v;
}

struct Args { const float* in[21]; float* out; unsigned char* ws; int ph_lo, ph_hi, li, pad; };
enum { IN_X = 0, IN_C, IN_CTX, IN_CCTX, IN_MODW, IN_MODB, IN_LNG, IN_LNB, IN_POOLW, IN_POOLS, IN_NAQKV, IN_NAWO, IN_NARPB, IN_GQKV, IN_GQN, IN_GKN, IN_GWO, IN_ROUTER, IN_W1, IN_W3, IN_W2 };

__device__ __forceinline__ void p0_mod(const Args& a, LAS unsigned char* lds, int tid, int lane, int wave) {
    const int wg = blockIdx.x; if (wg >= 192) return;
    const int L = wg / 48, cb = wg % 48;
    LAS float* sl = (LAS float*)lds; LAS float* red = sl + 5 * 1024;
    const float* c = a.in[IN_C]; const float* cc = a.in[IN_CCTX];
    for (int i = tid; i < 5120; i += 512) { const int s = i >> 10, k = i & 1023; const float cv = s < 4 ? c[s * 1024 + k] : cc[k]; sl[i] = cv / (1.0f + expf(-cv)); }
    __syncthreads();
    float acc[5][2];
#pragma unroll
    for (int s = 0; s < 5; ++s) { acc[s][0] = 0.f; acc[s][1] = 0.f; }
    const float* wp = a.in[IN_MODW] + (size_t)L * DM * NMOD + cb * 128 + 2 * lane;
#pragma unroll 8
    for (int kk = 0; kk < 128; ++kk) { const int k = wave * 128 + kk; const f32x2 w = *(const f32x2*)(wp + (size_t)k * NMOD);
#pragma unroll
        for (int s = 0; s < 5; ++s) { const float sv = sl[s * 1024 + k]; acc[s][0] += sv * w.x; acc[s][1] += sv * w.y; } }
#pragma unroll
    for (int s = 0; s < 5; ++s) { red[(wave * 5 + s) * 128 + 2 * lane] = acc[s][0]; red[(wave * 5 + s) * 128 + 2 * lane + 1] = acc[s][1]; }
    __syncthreads();
    float* MOD = (float*)(a.ws + WS_MOD);
    for (int o = tid; o < 640; o += 512) { const int s = o >> 7, col = o & 127; float sum = 0.f;
#pragma unroll
        for (int w = 0; w < 8; ++w) sum += red[(w * 5 + s) * 128 + col];
        MOD[(size_t)(L * 5 + s) * NMOD + cb * 128 + col] = sum + a.in[IN_MODB][L * NMOD + cb * 128 + col]; }
    __syncthreads();
}
__device__ __forceinline__ void cvt_item(const float* W, int K, int N, bf16* WT, int mode, int sub, LAS float* scr, int lane) {
    const int nblk = N >> 6, kb = sub / nblk, nb = sub - kb * nblk, k0 = kb * 64, n0 = nb * 64;
    const int kr = lane >> 4, nc = lane & 15;
    f32x4 v[16];
#pragma unroll
    for (int i = 0; i < 16; ++i) v[i] = *(const f32x4*)(W + (size_t)(k0 + 4 * i + kr) * N + n0 + 4 * nc);
#pragma unroll
    for (int i = 0; i < 16; ++i) { LAS float* d = scr + (4 * i + kr) * 65 + 4 * nc; d[0] = v[i].x; d[1] = v[i].y; d[2] = v[i].z; d[3] = v[i].w; }
    LDS_WAIT();
    const int ch = lane & 7;
#pragma unroll
    for (int j = 0; j < 8; ++j) { const int n = 8 * j + (lane >> 3); const LAS float* s = scr + (8 * ch) * 65 + n;
        v4u o; o.x = pk2(s[0 * 65], s[1 * 65]); o.y = pk2(s[2 * 65], s[3 * 65]); o.z = pk2(s[4 * 65], s[5 * 65]); o.w = pk2(s[6 * 65], s[7 * 65]);
        const int nn = n0 + n; const int drow = mode == 0 ? nn : (((nn >> 2) << 3) + (nn & 3) + (mode == 2 ? 4 : 0));
        *(v4u*)(WT + (size_t)drow * K + k0 + 8 * ch) = o; }
    LDS_WAIT();
}
__device__ __forceinline__ void p0_convert(const Args& a, LAS unsigned char* lds, int gw, int NGW, int lane, int wave) {
    LAS float* scr = (LAS float*)(lds + wave * 16640);
    constexpr int I_POOL = 128, I_NAQKV = 768, I_NAWO = 256, I_GQKV = 384, I_GWO = 256, I_SMALL = I_POOL + I_NAQKV + I_NAWO + I_GQKV + I_GWO, I_LE = 1536, I_ALL = I_SMALL + 64 * I_LE;
    for (int it = gw; it < I_ALL; it += NGW) {
        int r = it;
        if (r >= I_SMALL) { r -= I_SMALL; const int le = r / I_LE, q = r - le * I_LE, which = q >> 9, sub = q & 511;
            if (which == 0) cvt_item(a.in[IN_W1] + (size_t)le * DM * FF, DM, FF, (bf16*)(a.ws + WS_W13) + (size_t)le * 2 * FF * DM, 1, sub, scr, lane);
            else if (which == 1) cvt_item(a.in[IN_W3] + (size_t)le * DM * FF, DM, FF, (bf16*)(a.ws + WS_W13) + (size_t)le * 2 * FF * DM, 2, sub, scr, lane);
            else cvt_item(a.in[IN_W2] + (size_t)le * FF * DM, FF, DM, (bf16*)(a.ws + WS_W2) + (size_t)le * DM * FF, 0, sub, scr, lane);
            continue; }
        if (r < I_POOL) { const int mi = r >> 4; cvt_item(a.in[IN_POOLW] + (size_t)mi * 65536, 256, 256, (bf16*)(a.ws + WS_POOLW) + (size_t)mi * 65536, 0, r & 15, scr, lane); continue; } r -= I_POOL;
        if (r < I_NAQKV) { cvt_item(a.in[IN_NAQKV], DM, 3 * DM, (bf16*)(a.ws + WS_NAQKV), 0, r, scr, lane); continue; } r -= I_NAQKV;
        if (r < I_NAWO) { cvt_item(a.in[IN_NAWO], DM, DM, (bf16*)(a.ws + WS_NAWO), 0, r, scr, lane); continue; } r -= I_NAWO;
        if (r < I_GQKV) { cvt_item(a.in[IN_GQKV], DM, 1536, (bf16*)(a.ws + WS_GQKV), 0, r, scr, lane); continue; } r -= I_GQKV;
        cvt_item(a.in[IN_GWO], DM, DM, (bf16*)(a.ws + WS_GWO), 0, r, scr, lane);
    }
}

__device__ __forceinline__ int row_s(int row) { return row < M_LAT ? (row >> 13) : 4; }
__device__ __forceinline__ const float* xrow(const Args& a, int L, int row) {
    if (L == 0) return row < M_LAT ? a.in[IN_X] + (size_t)row * DM : a.in[IN_CTX] + (size_t)(row - M_LAT) * DM;
    return (const float*)(a.ws + WS_X) + (size_t)row * DM;
}

template <int W> __device__ __forceinline__ f32x4 pool_sum(const float* base, int pos, int n) {
    f32x4 s = {0.f, 0.f, 0.f, 0.f};
#pragma unroll
    for (int i = 0; i < W; ++i) { const int idx = pos - W / 2 + i; const bool ok = idx >= 0 && idx < n; const int ic = idx < 0 ? 0 : (idx >= n ? n - 1 : idx);
        const f32x4 v = *(const f32x4*)(base + (size_t)ic * DM); s += ok ? v : (f32x4){0.f, 0.f, 0.f, 0.f}; }
    return s;
}
template <int G> __device__ __forceinline__ void pool_group(const float* xb, const float* scp, bf16* drow, int pos, int n, int lane) {
    constexpr int W = 2 << G; const int col = G * 256 + 4 * lane;
    const f32x4 sum = pool_sum<W>(xb + col, pos, n);
    const int lo = pos - W / 2 < 0 ? 0 : pos - W / 2, hi = pos + (W - W / 2 - 1) > n - 1 ? n - 1 : pos + (W - W / 2 - 1);
    const float inv = 1.0f / (float)(hi - lo + 1);
    const f32x4 xc = *(const f32x4*)(xb + (size_t)pos * DM + col), sc = *(const f32x4*)(scp + col);
    const f32x4 d = (sc + 1.0f) * (sum * inv - xc);
    v2u o; o.x = pk2(d.x, d.y); o.y = pk2(d.z, d.w);
    *(v2u*)(drow + col) = o;
}
__device__ __forceinline__ void ph_pooldiff(const Args& a, int L, int nrows, int gw, int NGW, int lane) {
    const float* MOD = (const float*)(a.ws + WS_MOD); bf16* Dm = (bf16*)(a.ws + WS_R + R_D);
    for (int row = gw; row < nrows; row += NGW) {
        int r0, pos, n;
        if (row < M_LAT) { r0 = row & ~(SEQ - 1); pos = row & (SEQ - 1); n = SEQ; } else { r0 = M_LAT + ((row - M_LAT) & ~(LCTX - 1)); pos = (row - M_LAT) & (LCTX - 1); n = LCTX; }
        const float* xb = xrow(a, L, r0); const float* scp = MOD + (size_t)(L * 5 + row_s(row)) * NMOD + DM;
        bf16* drow = Dm + (size_t)row * DM;
        pool_group<0>(xb, scp, drow, pos, n, lane); pool_group<1>(xb, scp, drow, pos, n, lane); pool_group<2>(xb, scp, drow, pos, n, lane); pool_group<3>(xb, scp, drow, pos, n, lane);
    }
}

__device__ __forceinline__ void ph_ln1(const Args& a, int L, int nrows, LAS unsigned char* lds, int gw, int NGW, int tid, int lane) {
    LAS float* RT = (LAS float*)lds;
    { const float* rt = a.in[IN_ROUTER] + (size_t)L * DM * NE;
      for (int i = tid; i < DM * NE; i += 512) { const int k = i >> 4, e = i & 15; RT[e * 1024 + k] = rt[i]; } }
    __syncthreads();
    const float* MOD = (const float*)(a.ws + WS_MOD); const float* Y = (const float*)(a.ws + WS_R + R_Y);
    float* X = (float*)(a.ws + WS_X); bf16* H = (bf16*)(a.ws + WS_H); float* AFF = (float*)(a.ws + WS_AFF);
    const f32x4* lg = (const f32x4*)(a.in[IN_LNG] + (size_t)(L * 2 + 0) * DM) + lane; const f32x4* lb = (const f32x4*)(a.in[IN_LNB] + (size_t)(L * 2 + 0) * DM) + lane;
    for (int row = gw; row < nrows; row += NGW) {
        const float* mp = MOD + (size_t)(L * 5 + row_s(row)) * NMOD;
        const f32x4* xr = (const f32x4*)xrow(a, L, row) + lane; const f32x4* yr = (const f32x4*)(Y + (size_t)row * DM) + lane;
        const f32x4* ga = (const f32x4*)(mp + 2 * DM) + lane; const f32x4* shf = (const f32x4*)(mp + 3 * DM) + lane; const f32x4* scf = (const f32x4*)(mp + 4 * DM) + lane;
        f32x4 v[4]; float s = 0.f;
#pragma unroll
        for (int j = 0; j < 4; ++j) { v[j] = xr[64 * j] * ALPHA + ga[64 * j] * yr[64 * j]; s += (v[j].x + v[j].y) + (v[j].z + v[j].w); }
        const float mean = wave_sum(s) * (1.f / DM); float s2 = 0.f;
#pragma unroll
        for (int j = 0; j < 4; ++j) { v[j] = v[j] - mean; s2 += (v[j].x * v[j].x + v[j].y * v[j].y) + (v[j].z * v[j].z + v[j].w * v[j].w); }
        const float rstd = 1.f / sqrtf(wave_sum(s2) * (1.f / DM) + LN_EPS);
        f32x4* xo = (f32x4*)(X + (size_t)row * DM) + lane; v2u* ho = (v2u*)(H + (size_t)row * DM) + lane;
        float lg16[16];
#pragma unroll
        for (int e = 0; e < 16; ++e) lg16[e] = 0.f;
#pragma unroll
        for (int j = 0; j < 4; ++j) { const f32x4 x1 = v[j] * rstd * lg[64 * j] + lb[64 * j]; xo[64 * j] = x1;
            const f32x4 h2 = x1 * (scf[64 * j] + 1.0f) + shf[64 * j];
            v2u o; o.x = pk2(h2.x, h2.y); o.y = pk2(h2.z, h2.w); ho[64 * j] = o;
#pragma unroll
            for (int e = 0; e < 16; ++e) { const f32x4 w = *(const LAS f32x4*)(RT + e * 1024 + 4 * (lane + 64 * j)); lg16[e] += (h2.x * w.x + h2.y * w.y) + (h2.z * w.z + h2.w * w.w); } }
        float mx = -3.0e38f;
#pragma unroll
        for (int e = 0; e < 16; ++e) { lg16[e] = wave_sum(lg16[e]); mx = fmaxf(mx, lg16[e]); }
        float den = 0.f, mine = 0.f;
#pragma unroll
        for (int e = 0; e < 16; ++e) { const float p = expf(lg16[e] - mx); den += p; mine = (lane == e) ? p : mine; }
        if (lane < 16) AFF[(size_t)row * NE + lane] = mine / den;
    }
    __syncthreads();
}

__device__ __forceinline__ void topk_problem(const Args& a, int row0, int n, int cap, int e, int slot0, LAS unsigned char* lds, int tid, int lane, int wave) {
    const float* AFF = (const float*)(a.ws + WS_AFF); int* SEL = (int*)(a.ws + WS_SEL); int* SLOT = (int*)(a.ws + WS_SLOT);
    LAS unsigned* vals = (LAS unsigned*)lds; LAS unsigned* hist = vals + 8192; LAS int* misc = (LAS int*)(hist + 256); LAS int* tmp = misc + 8;
    for (int i = tid; i < n; i += 512) vals[i] = __float_as_uint(AFF[(size_t)(row0 + i) * NE + e]);
    unsigned prefix = 0u; int kk = cap;
    for (int pass = 0; pass < 4; ++pass) {
        const int shift = 24 - 8 * pass;
        if (tid < 256) hist[tid] = 0u;
        __syncthreads();
        for (int i = tid; i < n; i += 512) { const unsigned v = vals[i]; if (((v >> shift) >> 8) == ((prefix >> shift) >> 8)) atomicAdd((unsigned*)&hist[(v >> shift) & 255u], 1u); }
        __syncthreads();
        if (wave == 0) {
            const int h0 = (int)hist[4 * lane], h1 = (int)hist[4 * lane + 1], h2 = (int)hist[4 * lane + 2], h3 = (int)hist[4 * lane + 3]; const int c = h0 + h1 + h2 + h3;
            int S = c;
#pragma unroll
            for (int o = 1; o < 64; o <<= 1) { const int t = __shfl_down(S, o); if (lane + o < 64) S += t; }
            const int above = S - c;
            if (above < kk && kk <= S) { int ab = above, bsel;
                if (ab + h3 >= kk) bsel = 3; else { ab += h3; if (ab + h2 >= kk) bsel = 2; else { ab += h2; if (ab + h1 >= kk) bsel = 1; else { ab += h1; bsel = 0; } } }
                misc[0] = 4 * lane + bsel; misc[1] = kk - ab; }
        }
        __syncthreads();
        prefix |= (unsigned)misc[0] << shift; kk = misc[1];
    }
    const unsigned T = prefix;
    const int per = n >= 512 ? n / 512 : 1, nact = n / per; const int i0 = tid * per; const bool act = tid < nact;
    int cgt = 0, ceq = 0;
    if (act) for (int j = 0; j < per; ++j) { const unsigned v = vals[i0 + j]; cgt += (v > T) ? 1 : 0; ceq += (v == T) ? 1 : 0; }
    const int eq_before = block_excl_scan(ceq, tmp, lane, wave);
    int take = kk - eq_before; take = take < 0 ? 0 : (take > ceq ? ceq : take);
    int p = block_excl_scan(cgt + take, tmp, lane, wave);
    if (act) { int er = eq_before;
        for (int j = 0; j < per; ++j) { const unsigned v = vals[i0 + j]; const bool sel = (v > T) || (v == T && er < kk); if (v == T) ++er;
            const int row = row0 + i0 + j;
            if (sel) { const int slot = slot0 + p; ++p; SLOT[slot] = row; SEL[(size_t)row * NE + e] = slot; } else SEL[(size_t)row * NE + e] = -1; } }
    __syncthreads();
}
__device__ __forceinline__ void ph_topk(const Args& a, bool upd, LAS unsigned char* lds, int tid, int lane, int wave) {
    const int nprob = upd ? 128 : 64;
    for (int p = blockIdx.x; p < nprob; p += gridDim.x) {
        if (p < 64) { const int b = p >> 4, e = p & 15; topk_problem(a, b * SEQ, SEQ, CAP_LAT, e, e * ESTR + b * CAP_LAT, lds, tid, lane, wave); }
        else { const int q = p - 64, b = q >> 4, e = q & 15; topk_problem(a, M_LAT + b * LCTX, LCTX, CAP_CTX, e, e * ESTR + 4 * CAP_LAT + b * CAP_CTX, lds, tid, lane, wave);
            if (b == 0 && tid < 128) ((int*)(a.ws + WS_SLOT))[e * ESTR + 4 * CAP_LAT + 4 * CAP_CTX + tid] = -1; }
    }
}
__device__ __forceinline__ void ph_gather(const Args& a, bool upd, int gw, int NGW, int lane) {
    const int* SLOT = (const int*)(a.ws + WS_SLOT); const bf16* H = (const bf16*)(a.ws + WS_H); bf16* XS = (bf16*)(a.ws + WS_R + R_XS);
    for (int slot = gw; slot < NSLOTS; slot += NGW) {
        const int within = slot % ESTR; if (!upd && within >= 4 * CAP_LAT) continue;
        const int tok = SLOT[slot];
        v4u v0 = {0u, 0u, 0u, 0u}, v1 = {0u, 0u, 0u, 0u};
        if (tok >= 0) { const v4u* s = (const v4u*)(H + (size_t)tok * DM); v0 = s[lane]; v1 = s[64 + lane]; }
        v4u* d = (v4u*)(XS + (size_t)slot * DM); d[lane] = v0; d[64 + lane] = v1;
    }
}
__device__ __forceinline__ void ph_ln2(const Args& a, int L, int nrows, int gw, int NGW, int lane) {
    const float* MOD = (const float*)(a.ws + WS_MOD); const float* AFF = (const float*)(a.ws + WS_AFF); const int* SEL = (const int*)(a.ws + WS_SEL);
    const bf16* YS = (const bf16*)(a.ws + WS_R + R_YS); float* X = (float*)(a.ws + WS_X); bf16* H = (bf16*)(a.ws + WS_H);
    const f32x4* lg = (const f32x4*)(a.in[IN_LNG] + (size_t)(L * 2 + 1) * DM) + lane; const f32x4* lb = (const f32x4*)(a.in[IN_LNB] + (size_t)(L * 2 + 1) * DM) + lane;
    const bool last = (L == DEPTH - 1); const bool wantH = (L == 0 || L == 1);
    for (int row = gw; row < nrows; row += NGW) {
        const int sI = row_s(row); const float* mp = MOD + (size_t)(L * 5 + sI) * NMOD;
        const f32x4* xr = (const f32x4*)(X + (size_t)row * DM) + lane; const f32x4* gf = (const f32x4*)(mp + 5 * DM) + lane;
        const int sv = SEL[(size_t)row * NE + (lane & 15)]; const float gv = AFF[(size_t)row * NE + (lane & 15)];
        f32x4 f[4];
#pragma unroll
        for (int j = 0; j < 4; ++j) f[j] = (f32x4){0.f, 0.f, 0.f, 0.f};
#pragma unroll
        for (int e = 0; e < 16; ++e) { const int se = __builtin_amdgcn_readlane(sv, e);
            if (se >= 0) { const float ge = __builtin_bit_cast(float, __builtin_amdgcn_readlane(__builtin_bit_cast(int, gv), e)); const v2u* yp = (const v2u*)(YS + (size_t)se * DM) + lane;
#pragma unroll
                for (int j = 0; j < 4; ++j) { const v2u w = yp[64 * j]; f[j].x += ge * bf_lo(w.x); f[j].y += ge * bf_hi(w.x); f[j].z += ge * bf_lo(w.y); f[j].w += ge * bf_hi(w.y); } } }
        f32x4 v[4]; float s = 0.f;
#pragma unroll
        for (int j = 0; j < 4; ++j) { v[j] = xr[64 * j] * ALPHA + gf[64 * j] * f[j]; s += (v[j].x + v[j].y) + (v[j].z + v[j].w); }
        const float mean = wave_sum(s) * (1.f / DM); float s2 = 0.f;
#pragma unroll
        for (int j = 0; j < 4; ++j) { v[j] = v[j] - mean; s2 += (v[j].x * v[j].x + v[j].y * v[j].y) + (v[j].z * v[j].z + v[j].w * v[j].w); }
        const float rstd = 1.f / sqrtf(wave_sum(s2) * (1.f / DM) + LN_EPS);
        f32x4* xo = (f32x4*)((last ? a.out : X) + (size_t)row * DM) + lane;
        const float* mpn = MOD + (size_t)((L + 1) * 5 + sI) * NMOD;
#pragma unroll
        for (int j = 0; j < 4; ++j) { const f32x4 x2 = v[j] * rstd * lg[64 * j] + lb[64 * j]; xo[64 * j] = x2;
            if (wantH) { const f32x4 h = x2 * (((const f32x4*)(mpn + DM))[lane + 64 * j] + 1.0f) + ((const f32x4*)mpn)[lane + 64 * j];
                v2u o; o.x = pk2(h.x, h.y); o.y = pk2(h.z, h.w); ((v2u*)(H + (size_t)row * DM))[lane + 64 * j] = o; } }
    }
}
__device__ __forceinline__ void rope_pair(float& x1, float& x2, int i, float rowp, float colp) {
    const float inv = __builtin_amdgcn_exp2f(-(float)(i & 15) * (13.287712379549449f / 16.0f));
    const float rev = ((i < 16) ? rowp : colp) * inv * 0.15915494309189535f;
    const float c = __builtin_amdgcn_cosf(rev), s = __builtin_amdgcn_sinf(rev);
    const float o1 = x1 * c - x2 * s, o2 = x1 * s + x2 * c; x1 = o1; x2 = o2;
}
__device__ __forceinline__ void ph_qknorm(const Args& a, int gw, int NGW, int lane) {
    const bf16* RAW = (const bf16*)(a.ws + WS_R + R_RAW); bf16* GQ = (bf16*)(a.ws + WS_R + R_GQ); bf16* GK = (bf16*)(a.ws + WS_R + R_GK); bf16* GV = (bf16*)(a.ws + WS_R + R_GV);
    const float* qg = a.in[IN_GQN]; const float* kg = a.in[IN_GKN];
    for (int row = gw; row < M_ALL; row += NGW) {
        const bool lat = row < M_LAT; const int b = lat ? (row >> 13) : ((row - M_LAT) >> 8), t = lat ? (row & (SEQ - 1)) : ((row - M_LAT) & (LCTX - 1));
        const size_t kvrow = (size_t)b * KVROWS + (lat ? t : SEQ + t);
        const float rowp = (float)(t >> 6), colp = (float)(t & 63);
        const bf16* raw = RAW + (size_t)row * 1536;
        if (lat) {
            const v4u w0 = *(const v4u*)(raw + 16 * lane), w1 = *(const v4u*)(raw + 16 * lane + 8);
            float q[16]; q[0] = bf_lo(w0.x); q[1] = bf_hi(w0.x); q[2] = bf_lo(w0.y); q[3] = bf_hi(w0.y); q[4] = bf_lo(w0.z); q[5] = bf_hi(w0.z); q[6] = bf_lo(w0.w); q[7] = bf_hi(w0.w);
            q[8] = bf_lo(w1.x); q[9] = bf_hi(w1.x); q[10] = bf_lo(w1.y); q[11] = bf_hi(w1.y); q[12] = bf_lo(w1.z); q[13] = bf_hi(w1.z); q[14] = bf_lo(w1.w); q[15] = bf_hi(w1.w);
            float ss = 0.f;
#pragma unroll
            for (int i = 0; i < 16; ++i) ss += q[i] * q[i];
            ss += __shfl_xor(ss, 1); ss += __shfl_xor(ss, 2);
            const float rinv = 1.0f / sqrtf(ss * (1.f / 64.f) + RMS_EPS); const int d0 = 16 * (lane & 3);
            unsigned o[8];
#pragma unroll
            for (int p = 0; p < 8; ++p) { float x1 = q[2 * p] * rinv * qg[d0 + 2 * p], x2 = q[2 * p + 1] * rinv * qg[d0 + 2 * p + 1]; rope_pair(x1, x2, (d0 >> 1) + p, rowp, colp);
                o[p] = pk2(x1 * attn_body::C2, x2 * attn_body::C2); }
            v4u* dst = (v4u*)(GQ + (size_t)row * DM + 16 * lane); dst[0] = (v4u){o[0], o[1], o[2], o[3]}; dst[1] = (v4u){o[4], o[5], o[6], o[7]};
        }
        { const v2u w = *(const v2u*)(raw + 1024 + 4 * lane); float k[4] = {bf_lo(w.x), bf_hi(w.x), bf_lo(w.y), bf_hi(w.y)};
          float ss = (k[0] * k[0] + k[1] * k[1]) + (k[2] * k[2] + k[3] * k[3]);
          ss += __shfl_xor(ss, 1); ss += __shfl_xor(ss, 2); ss += __shfl_xor(ss, 4); ss += __shfl_xor(ss, 8);
          const float rinv = 1.0f / sqrtf(ss * (1.f / 64.f) + RMS_EPS); const int d0 = 4 * (lane & 15);
          float x0 = k[0] * rinv * kg[d0], x1 = k[1] * rinv * kg[d0 + 1], x2 = k[2] * rinv * kg[d0 + 2], x3 = k[3] * rinv * kg[d0 + 3];
          if (lat) { rope_pair(x0, x1, (d0 >> 1), rowp, colp); rope_pair(x2, x3, (d0 >> 1) + 1, rowp, colp); }
          v2u o; o.x = pk2(x0, x1); o.y = pk2(x2, x3); *(v2u*)(GK + kvrow * 256 + 4 * lane) = o;
          *(v2u*)(GV + kvrow * 256 + 4 * lane) = *(const v2u*)(raw + 1280 + 4 * lane); }
    }
}
__device__ __forceinline__ void ph_attn_na(const Args& a, LAS unsigned char* ldsl, char* lds, int vcu, int G, int tid) {
    using attn_body::attn_unit; using attn_body::NaMask; using attn_body::NoMask; using attn_body::TileRows; using attn_body::lds_cptr; using attn_body::LDS_BIAS; typedef attn_body::bf16 abf;
    { LAS float* tab = (LAS float*)(ldsl + LDS_BIAS); const float* rpb = a.in[IN_NARPB];
      for (int i = tid; i < 16 * 465; i += 512) { const int h = i / 465, j = i - h * 465; tab[h * 512 + j] = rpb[i] * LOG2E; } }
    __syncthreads();
    const abf* Q = (const abf*)(a.ws + WS_R + R_Q); const abf* K = (const abf*)(a.ws + WS_R + R_K); const abf* V = (const abf*)(a.ws + WS_R + R_V);
    const int lane = tid & 63, r32 = lane & 31, hi = lane >> 5, wid = __builtin_amdgcn_readfirstlane(tid >> 6);
    constexpr int U = NB * 16 * 32;
    const bool xa = (G % 8 == 0); const int CX = xa ? G / 8 : G, UX = xa ? U / 8 : U, x = xa ? vcu / CX : 0, jj = xa ? vcu % CX : vcu;
    for (int k = jj; k < UX; k += CX) {
        const int lin = x * UX + k, bh = lin >> 5, rblk = lin & 31, b = bh >> 4, h = bh & 15, r = 4 * rblk;
        int kbase = r - 4; kbase = kbase < 0 ? 0 : (kbase > 116 ? 116 : kbase);
        NaMask mk; mk.kbase = kbase; mk.qr = r + (wid >> 1); { int t = mk.qr - 4; mk.r0q = t < 0 ? 0 : (t > 120 ? 120 : t); }
        mk.qcol = (wid & 1) * 32 + r32; { int t = mk.qcol - 8; mk.c0 = t < 0 ? 0 : (t > 48 ? 48 : t); } mk.hi = hi;
        mk.bias = (lds_cptr)(ldsl + LDS_BIAS + h * 2048);
        const TileRows TR{(long)M_LAT + b * LCTX, (long)b * SEQ + kbase * 64, 4};
        const abf* q0 = Q + ((size_t)b * SEQ + r * 64) * DM + h * 64;
        attn_unit<8, NaMask, false>(q0, DM, K + h * 64, V + h * 64, DM, TR, 16, (abf*)q0, DM, lds, mk, tid);
    }
    for (int u = vcu; u < NB * 16; u += G) {
        const int b = u >> 4, h = u & 15; const TileRows TR{(long)M_LAT + b * LCTX, 0, 1 << 30};
        const abf* q0 = Q + ((size_t)M_LAT + b * LCTX) * DM + h * 64; NoMask nm;
        attn_unit<8, NoMask, false>(q0, DM, K + h * 64, V + h * 64, DM, TR, 4, (abf*)q0, DM, lds, nm, tid);
    }
}
__device__ __forceinline__ void ph_attn_gqa(const Args& a, char* lds, int vcu, int G, int tid) {
    using attn_body::attn_unit; using attn_body::NoMask; using attn_body::TileRows; typedef attn_body::bf16 abf;
    const abf* Q = (const abf*)(a.ws + WS_R + R_GQ); const abf* K = (const abf*)(a.ws + WS_R + R_GK); const abf* V = (const abf*)(a.ws + WS_R + R_GV);
    constexpr int U = NB * 16 * 32;
    const bool xa = (G % 8 == 0); const int CX = xa ? G / 8 : G, UX = xa ? U / 8 : U, x = xa ? vcu / CX : 0, jj = xa ? vcu % CX : vcu;
    for (int k = jj; k < UX; k += CX) {
        const int lin = x * UX + k, pair = lin >> 7, idx = lin & 127, b = pair >> 2, kv = pair & 3, hq = kv * 4 + (idx & 3), qb = idx >> 2;
        const TileRows TR{(long)b * KVROWS, 0, 1 << 30};
        const abf* q0 = Q + ((size_t)b * SEQ + qb * 256) * DM + hq * 64; NoMask nm;
        attn_unit<8, NoMask, true>(q0, DM, K + kv * 64, V + kv * 64, 256, TR, KVROWS / 64, (abf*)q0, DM, lds, nm, tid);
    }
}

constexpr int PH_PER_LAYER = 12, N_PHASE_IDS = 1 + DEPTH * PH_PER_LAYER;
__global__ void __launch_bounds__(NWAVES * 64, 2) mk_fwd(Args args) {
    extern __shared__ __attribute__((aligned(16))) unsigned char lds[];
    LAS unsigned char* ldsl = (LAS unsigned char*)lds;
    volatile LAS unsigned* MISC = (volatile LAS unsigned*)(ldsl + MISC_OFF);
    const int G = gridDim.x; const int bx = blockIdx.x; const int vcu = (G % 8 == 0) ? (bx % 8) * (G / 8) + bx / 8 : bx;
    const int NGW = G * NWAVES;
    const int wave0 = __builtin_amdgcn_readfirstlane((int)threadIdx.x >> 6);
#define PHASE_IDS() int lane_ = (int)__builtin_amdgcn_mbcnt_hi(~0u, __builtin_amdgcn_mbcnt_lo(~0u, 0u)); asm volatile("" : "+v"(lane_)); const int lane = lane_, wave = wave0, tid = wave0 * 64 + lane_, gw = vcu * NWAVES + wave; (void)lane; (void)gw; (void)tid
    unsigned* ctl = (unsigned*)(args.ws + WS_CTL);
    for (int u = threadIdx.x; u < (LDS_BYTES - LDSCTL_OFF) / 4; u += NWAVES * 64) ((LAS unsigned*)(ldsl + LDSCTL_OFF))[u] = 0u;
    __syncthreads();
    const int lo = args.ph_lo, hi = args.ph_hi;
    const bool use_bar = (hi - lo) > 1;
    XcdBarrier bar; bar.bar = ctl + CW_BAR + args.li * XCD_BAR_WORDS; bar.x = 0; bar.st = nullptr;
    if (use_bar) bar = xcd_barrier_post(ctl + CW_BAR + args.li * XCD_BAR_WORDS, MISC + 8);
#ifndef PH_MASK
#define PH_MASK 0xFFFFFFFFu
#endif
#define EN(bit) ((PH_MASK >> (bit)) & 1u)
#define IN(k) (lo <= (k) && (k) < hi)
#define SEAM(k) do { if (hi > (k) + 1) xcd_barrier(bar); } while (0)
    const Args& a = args;

    if (EN(0) && IN(0)) { PHASE_IDS(); p0_mod(a, ldsl, tid, lane, wave); p0_convert(a, ldsl, gw, NGW, lane, wave); SEAM(0); }

    for (int L = 0; L < DEPTH; ++L) {
        const int pb = 1 + L * PH_PER_LAYER; const int m = L % 3;
        const bool upd = L < 2;
        const int rows = upd ? M_ALL : M_LAT, ntile = rows / 256;
        if (m == 0) {
            const int pj = L / 3;
            if (EN(1) && IN(pb + 0)) { PHASE_IDS(); ph_pooldiff(a, L, rows, gw, NGW, lane); SEAM(pb + 0); }
            if (EN(2) && IN(pb + 1)) {
                pg8::Gemm g{(const bf16*)(a.ws + WS_R + R_D), (const bf16*)(a.ws + WS_POOLW) + (size_t)pj * 4 * 65536, DM, 256, 256, 256, 0};
                pg8::Order S; S.init(ntile, 4, G, bx, 1 << 20, 0);
                pg8::EpiF32 E{(float*)(a.ws + WS_R + R_Y), DM, a.in[IN_POOLS] + pj * DM};
                { PHASE_IDS(); pg8::gemm_phase(ldsl, g, S, E, tid); } SEAM(pb + 1);
            }
        } else if (m == 1) {
            if (EN(3) && IN(pb + 0)) {
                pg8::Gemm g{(const bf16*)(a.ws + WS_H), (const bf16*)(a.ws + WS_NAQKV), DM, DM, DM, 0, 0};
                pg8::Order S; S.init(M_ALL / 256, 12, G, bx, 1 << 20, 0);
                pg8::EpiBf16 E{(bf16*)(a.ws + WS_R + R_Q), DM, DM, (size_t)(R_K - R_Q) / 2, attn_body::C2};
                { PHASE_IDS(); pg8::gemm_phase(ldsl, g, S, E, tid); } SEAM(pb + 0);
            }
            if (EN(4) && IN(pb + 1)) { PHASE_IDS(); ph_attn_na(a, ldsl, (char*)lds, vcu, G, tid); SEAM(pb + 1); }
        } else {
            if (EN(5) && IN(pb + 0)) {
                pg8::Gemm g{(const bf16*)(a.ws + WS_H), (const bf16*)(a.ws + WS_GQKV), DM, DM, DM, 0, 0};
                pg8::Order S; S.init(M_ALL / 256, 6, G, bx, 1 << 20, 0);
                pg8::EpiBf16 E{(bf16*)(a.ws + WS_R + R_RAW), 1536, 0, 0, 1.0f};
                { PHASE_IDS(); pg8::gemm_phase(ldsl, g, S, E, tid); } SEAM(pb + 0);
            }
            if (EN(6) && IN(pb + 1)) { PHASE_IDS(); ph_qknorm(a, gw, NGW, lane); SEAM(pb + 1); }
            if (EN(7) && IN(pb + 2)) { PHASE_IDS(); ph_attn_gqa(a, (char*)lds, vcu, G, tid); SEAM(pb + 2); }
        }
        if (EN(8) && m != 0 && IN(pb + 3)) {
            const bf16* O = (const bf16*)(a.ws + WS_R + (m == 1 ? R_Q : R_GQ)); const bf16* Wt = (const bf16*)(a.ws + (m == 1 ? WS_NAWO : WS_GWO));
            pg8::Gemm g{O, Wt, DM, DM, DM, 0, 0};
            pg8::Order S; S.init(ntile, 4, G, bx, 1 << 20, 0);
            pg8::EpiF32 E{(float*)(a.ws + WS_R + R_Y), DM, nullptr};
            { PHASE_IDS(); pg8::gemm_phase(ldsl, g, S, E, tid); } SEAM(pb + 3);
        }
        if (EN(9) && IN(pb + 4)) { PHASE_IDS(); ph_ln1(a, L, rows, ldsl, gw, NGW, tid, lane); SEAM(pb + 4); }
        if (EN(10) && IN(pb + 5)) { PHASE_IDS(); ph_topk(a, upd, ldsl, tid, lane, wave); SEAM(pb + 5); }
        if (EN(11) && IN(pb + 6)) { PHASE_IDS(); ph_gather(a, upd, gw, NGW, lane); SEAM(pb + 6); }
        const int et = upd ? ETILES : ETILES - 1;
        if (EN(12) && IN(pb + 7)) {
            pg8::Gemm g{(const bf16*)(a.ws + WS_R + R_XS), (const bf16*)(a.ws + WS_W13) + (size_t)L * NE * 2 * FF * DM, DM, DM, DM, 0, (size_t)2 * FF * DM};
            pg8::Order S; S.init(NE * et, 2 * FF / 256, G, bx, et, ETILES);
            pg8::EpiSwiGLU E{(bf16*)(a.ws + WS_R + R_HID), FF};
            { PHASE_IDS(); pg8::gemm_phase(ldsl, g, S, E, tid); } SEAM(pb + 7);
        }
        if (EN(13) && IN(pb + 8)) {
            pg8::Gemm g{(const bf16*)(a.ws + WS_R + R_HID), (const bf16*)(a.ws + WS_W2) + (size_t)L * NE * DM * FF, FF, FF, FF, 0, (size_t)DM * FF};
            pg8::Order S; S.init(NE * et, DM / 256, G, bx, et, ETILES);
            pg8::EpiBf16 E{(bf16*)(a.ws + WS_R + R_YS), DM, 0, 0, 1.0f};
            { PHASE_IDS(); pg8::gemm_phase(ldsl, g, S, E, tid); } SEAM(pb + 8);
        }
        if (EN(14) && IN(pb + 9)) { PHASE_IDS(); ph_ln2(a, L, rows, gw, NGW, lane); if (L + 1 < DEPTH) SEAM(pb + 9); }
    }
#undef IN
#undef SEAM
}

extern "C" void kernel_launch(void* const* d_in, const int* in_sizes, int n_in, void* d_out, int out_size, void* d_ws, size_t ws_size, hipStream_t stream) {
    static int grid = 0;
    if (grid == 0) {
        if (n_in != 21 || out_size != M_LAT * DM || ws_size < WS_END) { fprintf(stderr, "kernel_launch: unexpected shapes (n_in %d, out %d, ws %zu)\n", n_in, out_size, ws_size); grid = -1; return; }
        int dev = 0, cus = 0, per_cu = 0;
        if (hipGetDevice(&dev) != hipSuccess || hipDeviceGetAttribute(&cus, hipDeviceAttributeMultiprocessorCount, dev) != hipSuccess) { grid = -1; return; }
        if (hipFuncSetAttribute((const void*)mk_fwd, hipFuncAttributeMaxDynamicSharedMemorySize, LDS_BYTES) != hipSuccess) { fprintf(stderr, "kernel_launch: hipFuncSetAttribute failed\n"); grid = -1; return; }
        if (hipOccupancyMaxActiveBlocksPerMultiprocessor(&per_cu, (const void*)mk_fwd, NWAVES * 64, LDS_BYTES) != hipSuccess || per_cu < 1) { fprintf(stderr, "kernel_launch: occupancy query reports %d\n", per_cu); (void)hipGetLastError(); grid = -1; return; }
        grid = cus;
    }
    if (grid < 0) return;
    if (hipMemsetAsync((char*)d_ws + WS_CTL, 0, CTL_ZERO_BYTES, stream) != hipSuccess) return;
    Args a{};
    for (int i = 0; i < 21; ++i) a.in[i] = (const float*)d_in[i];
    a.out = (float*)d_out; a.ws = (unsigned char*)d_ws;
#if MK_PER_PHASE
    for (int k = 0; k < N_PHASE_IDS; ++k) {
        const int r = (k - 1) % PH_PER_LAYER, L = (k - 1) / PH_PER_LAYER, m = L % 3;
        if (k > 0 && (r > 9 || (r == 2 && m != 2) || (r == 3 && m == 0))) continue;
        a.ph_lo = k; a.ph_hi = k + 1; a.li = 0;
        hipLaunchKernelGGL(mk_fwd, dim3(grid), dim3(NWAVES * 64), LDS_BYTES, stream, a);
    }
#else
    a.ph_lo = 0; a.ph_hi = N_PHASE_IDS; a.li = 0;
    hipLaunchKernelGGL(mk_fwd, dim3(grid), dim3(NWAVES * 64), LDS_BYTES, stream, a);
#endif
    const hipError_t le = hipPeekAtLastError();
    if (le != hipSuccess) fprintf(stderr, "kernel_launch: launch failed: %s\n", hipGetErrorName(le));
}
```

```cpp
#include <hip/hip_runtime.h>
#include <hip/hip_bf16.h>
#include <cstdio>
#include <cstdint>
#include <cmath>
#include <type_traits>

namespace pg8 {
#define PG8_LAS __attribute__((address_space(3)))
typedef unsigned short bf16_t;
typedef short bf16x8 __attribute__((ext_vector_type(8)));
typedef float f32x4 __attribute__((ext_vector_type(4)));
typedef unsigned u32x4 __attribute__((ext_vector_type(4)));
typedef unsigned u32x2 __attribute__((ext_vector_type(2)));
typedef int i32x4 __attribute__((ext_vector_type(4)));
typedef int i32x8 __attribute__((ext_vector_type(8)));
constexpr int BM = 256, BK = 64, HALF = 128, HTB = HALF * BK * 2, STAGE_BYTES = 8 * HTB, NXCD = 8, WGM = 8;

__host__ __device__ __forceinline__ int lds_byte(int r, int c) { const int st = (r >> 4) * 2 + (c >> 5), rr = r & 15, cc = c & 31, ob = rr * 64 + cc * 2; return st * 1024 + (ob ^ (((ob >> 9) & 1) << 5)); }
__host__ __device__ __forceinline__ void stage_rc(int b, int& R, int& C) { const int st = b / 1024, sb = b % 1024, swz = sb ^ (((sb >> 9) & 1) << 5); R = (st >> 1) * 16 + swz / 64; C = (st & 1) * 32 + (swz % 64) / 2; }
__host__ __device__ __forceinline__ int perm32(int rho) { const int n = rho >> 4, i = rho & 15; return 8 * (i >> 2) + 4 * n + (i & 3); }

struct Unit { int pm, pn, e; };
struct Gemm { const void* A; const void* Bt; int lda, ldb, K, a_pn_off; size_t b_e_stride; const int* rowidx; };

struct Order {
    int nM, nN, nwg, G, c, tpe, tstride; bool degenerate;
    int L, gid, rem, nig, inv_tpe;
    __device__ void init(int nM_, int nN_, int G_, int c_, int tpe_, int tstride_) { nM = nM_; nN = nN_; nwg = nM * nN; G = G_; c = c_; tpe = tpe_; tstride = tstride_; degenerate = false;
        nig = WGM * nN; inv_tpe = (int)(((1u << 20) + (unsigned)tpe - 1u) / (unsigned)tpe); L = -1; gid = 0; rem = 0; }
    __device__ void emit(Unit& u) const {
        const int fm = gid * WGM, gsz = (nM - fm) < WGM ? (nM - fm) : WGM;
        int pmo, pn; if (gsz == WGM) { pmo = rem & (WGM - 1); pn = rem >> 3; } else { pn = rem / gsz; pmo = rem - pn * gsz; }
        const int v = fm + pmo; u.pn = pn; u.e = (int)(((unsigned)v * (unsigned)inv_tpe) >> 20); u.pm = u.e * tstride + (v - u.e * tpe);
        if (degenerate) { u.e = 0; u.pm = 0; }
    }
    __device__ bool begin(Unit& u) {
        L = c; if (L >= nwg) return false;
        const int q = nwg / NXCD, r = nwg % NXCD, xcd = L % NXCD, off = L / NXCD; const int wgid = (xcd < r ? xcd * (q + 1) : r * (q + 1) + (xcd - r) * q) + off;
        gid = wgid / nig; rem = wgid - gid * nig; emit(u); return true;
    }
    __device__ bool advance(Unit& u) {
        L += G; if (L >= nwg) return false;
        rem += G / NXCD; while (rem >= nig) { rem -= nig; ++gid; }
        emit(u); return true;
    }
};

__device__ __forceinline__ unsigned cvt_pk_bf16(float lo, float hi) { unsigned r; asm volatile("v_cvt_pk_bf16_f32 %0, %1, %2" : "=v"(r) : "v"(lo), "v"(hi)); return r; }

struct EpiBf16 {
    static constexpr bool PERM = true;
    bf16_t* O; int ldc; int split_cols; size_t split_stride; float scale0; const float* colscale; float gscale; bool out8 = false;
    __device__ __forceinline__ void operator()(const f32x4 (&acc)[2][2][4][2], const Unit& u, int wr, int wc, int fr, int fq, PG8_LAS unsigned char* lds, int wid, int lane) const {
        const int row0 = u.pm * BM + wr * 64 + fr; int colt = u.pn * BM; bf16_t* base = O;
        float sc = gscale; if (split_cols) { const int t = colt / split_cols; base += (size_t)t * split_stride; colt -= t * split_cols; if (t == 0) sc = scale0 * gscale; }
        const int col0 = colt + wc * 32 + 8 * fq;
        f32x4 cs[2][2];
#pragma unroll
        for (int bj = 0; bj < 2; ++bj)
#pragma unroll
            for (int n = 0; n < 2; ++n) cs[bj][n] = colscale ? *(const f32x4*)(colscale + u.pn * BM + wc * 32 + 8 * fq + bj * HALF + 4 * n) * sc : (f32x4){sc, sc, sc, sc};
#pragma unroll
        for (int ai = 0; ai < 2; ++ai)
#pragma unroll
            for (int m = 0; m < 4; ++m) { bf16_t* rowp = base + (size_t)(row0 + ai * HALF + m * 16) * ldc + col0;
#pragma unroll
                for (int bj = 0; bj < 2; ++bj) { f32x4 v0 = acc[ai][bj][m][0] * cs[bj][0], v1 = acc[ai][bj][m][1] * cs[bj][1];
                    if (out8) { int t0 = 0, t1 = 0; t0 = __builtin_amdgcn_cvt_pk_fp8_f32(v0[0], v0[1], t0, false); t0 = __builtin_amdgcn_cvt_pk_fp8_f32(v0[2], v0[3], t0, true);
                        t1 = __builtin_amdgcn_cvt_pk_fp8_f32(v1[0], v1[1], t1, false); t1 = __builtin_amdgcn_cvt_pk_fp8_f32(v1[2], v1[3], t1, true);
                        *(u32x2*)((unsigned char*)base + (size_t)(row0 + ai * HALF + m * 16) * ldc + col0 + bj * HALF) = (u32x2){(unsigned)t0, (unsigned)t1}; }
                    else { u32x4 w; w.x = cvt_pk_bf16(v0[0], v0[1]); w.y = cvt_pk_bf16(v0[2], v0[3]); w.z = cvt_pk_bf16(v1[0], v1[1]); w.w = cvt_pk_bf16(v1[2], v1[3]);
                    *(u32x4*)(rowp + bj * HALF) = w; } } }
    }
};
struct EpiF32 {
    static constexpr bool PERM = false;
    float* C; int ldc; const float* colscale;
    __device__ __forceinline__ void operator()(const f32x4 (&acc)[2][2][4][2], const Unit& u, int wr, int wc, int fr, int fq, PG8_LAS unsigned char* lds, int wid, int lane) const {
        const int row0 = u.pm * BM + wr * 64 + fr, col0 = u.pn * BM + wc * 32 + 4 * fq;
        f32x4 sv[2][2];
#pragma unroll
        for (int bj = 0; bj < 2; ++bj)
#pragma unroll
            for (int n = 0; n < 2; ++n) sv[bj][n] = colscale ? *(const f32x4*)(colscale + col0 + bj * HALF + n * 16) : (f32x4){1.f, 1.f, 1.f, 1.f};
#pragma unroll
        for (int ai = 0; ai < 2; ++ai)
#pragma unroll
            for (int m = 0; m < 4; ++m) { float* rowp = C + (size_t)(row0 + ai * HALF + m * 16) * ldc + col0;
#pragma unroll
                for (int bj = 0; bj < 2; ++bj)
#pragma unroll
                    for (int n = 0; n < 2; ++n) *(f32x4*)(rowp + bj * HALF + n * 16) = acc[ai][bj][m][n] * sv[bj][n]; }
    }
};
template <bool OUT8> struct EpiSwiGLU {
    static constexpr bool PERM = true;
    void* Hd; int ldh; bool nostore = false;
    __device__ __forceinline__ void silu4(const f32x4 a, const f32x4 b, float (&h)[4]) const {
        typedef float f2 __attribute__((ext_vector_type(2)));
#pragma unroll
        for (int i = 0; i < 4; i += 2) {
            const f2 av = {a[i], a[i + 1]}, bv = {b[i], b[i + 1]}; const f2 t = av * -1.4426950408889634f; f2 ex; ex.x = __builtin_amdgcn_exp2f(t.x); ex.y = __builtin_amdgcn_exp2f(t.y);
            const f2 d = ex + 1.0f; f2 r; r.x = __builtin_amdgcn_rcpf(d.x); r.y = __builtin_amdgcn_rcpf(d.y); const f2 hv = (av * bv) * r; h[i] = hv.x; h[i + 1] = hv.y; }
    }
    __device__ __forceinline__ void operator()(const f32x4 (&acc)[2][2][4][2], const Unit& u, int wr, int wc, int fr, int fq, PG8_LAS unsigned char* lds, int wid, int lane) const {
        if constexpr (OUT8) {
            PG8_LAS unsigned char* st = lds + 3 * HTB;
#pragma unroll
            for (int ai = 0; ai < 2; ++ai) {
#pragma unroll
                for (int m = 0; m < 4; ++m) { const int r = wr * 64 + m * 16 + fr;
#pragma unroll
                    for (int bj = 0; bj < 2; ++bj) { float h[4]; silu4(acc[ai][bj][m][0], acc[ai][bj][m][1], h);
                        int w = 0; w = __builtin_amdgcn_cvt_pk_fp8_f32(h[0], h[1], w, false); w = __builtin_amdgcn_cvt_pk_fp8_f32(h[2], h[3], w, true);
                        *(PG8_LAS int*)(st + r * 128 + (((wc + 4 * bj) ^ (r & 7)) << 4) + 4 * fq) = w; } }
                asm volatile("s_waitcnt lgkmcnt(0)" ::: "memory"); __builtin_amdgcn_s_barrier(); asm volatile("" ::: "memory");
#pragma unroll
                for (int k = 0; k < 2; ++k) { const int r = 16 * wid + 8 * k + (lane >> 3), c = lane & 7;
                    const u32x4 v = *(const PG8_LAS u32x4*)(st + r * 128 + ((c ^ (r & 7)) << 4));
                    if (!nostore) *(u32x4*)((unsigned char*)Hd + (size_t)(u.pm * BM + ai * HALF + r) * ldh + u.pn * (BM / 2) + 16 * c) = v; else asm volatile("" :: "v"(v)); }
                asm volatile("s_waitcnt lgkmcnt(0)" ::: "memory"); __builtin_amdgcn_s_barrier(); asm volatile("" ::: "memory");
            }
        } else {
            const int row0 = u.pm * BM + wr * 64 + fr; const int hc0 = (u.pn * BM + wc * 32 + 8 * fq) >> 1;
#pragma unroll
            for (int ai = 0; ai < 2; ++ai)
#pragma unroll
                for (int m = 0; m < 4; ++m) { const size_t ro = (size_t)(row0 + ai * HALF + m * 16) * ldh + hc0;
#pragma unroll
                    for (int bj = 0; bj < 2; ++bj) { float h[4]; silu4(acc[ai][bj][m][0], acc[ai][bj][m][1], h);
                        u32x2 w; w.x = cvt_pk_bf16(h[0], h[1]); w.y = cvt_pk_bf16(h[2], h[3]); *(u32x2*)((bf16_t*)Hd + ro + bj * (HALF / 2)) = w; } }
        }
    }
};

template <bool GATHER, int ES, class Epi, class Sched>
__device__ __forceinline__ void gemm_phase(PG8_LAS unsigned char* lds, const Gemm g, const Sched& S, const Epi& E, const int tid, const int wscale_e8m0 = 127) {
    const int wid = __builtin_amdgcn_readfirstlane(tid >> 6), lane = tid & 63, wr = wid >> 2, wc = wid & 3, fr = lane & 15, fq = lane >> 4;
    const int K = g.K, nt = K * ES / (BK * 2);
    unsigned voffA[2][2], voffAn[2][2], voffB[2]; int Rr[2], Cc[2];
#pragma unroll
    for (int i = 0; i < 2; ++i) { int R, C; stage_rc(tid * 16 + i * 8192, R, C); const int Rb = Epi::PERM ? ((R & ~31) + perm32(R & 31)) : R; Rr[i] = R; Cc[i] = C;
        voffA[0][i] = (unsigned)(R * g.lda * ES + C * 2); voffA[1][i] = (unsigned)((R + HALF) * g.lda * ES + C * 2); voffB[i] = (unsigned)(Rb * g.ldb * ES + C * 2);
        voffAn[0][i] = voffA[0][i]; voffAn[1][i] = voffA[1][i]; }
    const size_t kstep = (size_t)(BK * 2);
    const size_t hB = (size_t)HALF * g.ldb * ES;
    const unsigned ldsw = (unsigned)wid * 1024u;
    const int aoff = lds_byte(wr * 64 + fr, fq * 8), boff = lds_byte(wc * 32 + fr, fq * 8);
#define PG8_APTR(u) (GATHER ? (const char*)g.A : (const char*)g.A + ((size_t)(u).pm * BM * g.lda + (size_t)(u).pn * g.a_pn_off) * ES)
#define PG8_IDXDMA(u) __builtin_amdgcn_global_load_lds((const unsigned*)(g.rowidx + (u).pm * BM + idxrow), (PG8_LAS unsigned*)(lds + STAGE_BYTES + wid * 256), 4, 0, 0)
#define PG8_TOKL(h, i) ib[(h) * 32 + (i) * 16 + (Rr[i] & 15)]
#define PG8_VOFF(tok, i) ((unsigned)(((tok) < 0 ? 0 : (tok)) * g.lda * ES + Cc[i] * 2))
#define PG8_BPTR(u) ((const char*)g.Bt + ((size_t)(u).e * g.b_e_stride + (size_t)(u).pn * BM * g.ldb) * ES)
#define PG8_SA(b, h) (((b) * 2 + (h)) * HTB)
#define PG8_SB(b, h) ((4 + (b) * 2 + (h)) * HTB)
#define PG8_STAGE(bufoff, gbase, voff) do { _Pragma("unroll") for (int _i = 0; _i < 2; ++_i) { unsigned _vo = (voff)[_i]; asm volatile("" : "+v"(_vo));     \
        __builtin_amdgcn_global_load_lds((const unsigned*)((const char*)(gbase) + _vo), (PG8_LAS unsigned*)(lds + (bufoff) + ldsw + _i * 8192), 16, 0, 0); } } while (0)
#define PG8_LDA(dst, b, h) do { _Pragma("unroll") for (int m = 0; m < 4; ++m) _Pragma("unroll") for (int k = 0; k < 2; ++k) dst[m][k] = *(const PG8_LAS bf16x8*)(lds + PG8_SA(b, h) + aoff + m * 2048 + k * 1024); } while (0)
#define PG8_LDB(dst, b, h) do { _Pragma("unroll") for (int n = 0; n < 2; ++n) _Pragma("unroll") for (int k = 0; k < 2; ++k) dst[n][k] = *(const PG8_LAS bf16x8*)(lds + PG8_SB(b, h) + boff + n * 2048 + k * 1024); } while (0)
#define PG8_CAT8(x0, x1) __builtin_shufflevector(__builtin_bit_cast(i32x4, x0), __builtin_bit_cast(i32x4, x1), 0, 1, 2, 3, 4, 5, 6, 7)
#define PG8_MMA(ai, bj, At, Bt) do { __builtin_amdgcn_s_setprio(1); _Pragma("unroll") for (int m = 0; m < 4; ++m) _Pragma("unroll") for (int n = 0; n < 2; ++n) { \
        if constexpr (ES == 2) { _Pragma("unroll") for (int k = 0; k < 2; ++k) acc[ai][bj][m][n] = __builtin_amdgcn_mfma_f32_16x16x32_bf16(Bt[n][k], At[m][k], acc[ai][bj][m][n], 0, 0, 0); } \
        else   \
            { const i32x8 b8_ = PG8_CAT8(Bt[n][0], Bt[n][1]), a8_ = PG8_CAT8(At[m][0], At[m][1]);   \
              asm volatile("v_mfma_scale_f32_16x16x128_f8f6f4 %0, %1, %2, %0, %3, %4 op_sel_hi:[0,0,0]" : "+v"(acc[ai][bj][m][n]) : "v"(b8_), "v"(a8_), "v"(f8wscale), "v"(f8scale)); } } \
        __builtin_amdgcn_s_setprio(0); } while (0)
#define PG8_WAIT_V(n) asm volatile("s_waitcnt vmcnt(" #n ")" ::: "memory")
#define PG8_WAIT_L(n) asm volatile("s_waitcnt lgkmcnt(" #n ")" ::: "memory")
#define PG8_BAR __builtin_amdgcn_s_barrier()
#define PG8_SCHED __builtin_amdgcn_sched_barrier(0)
    int f8scale = 0x7f7f7f7f, f8wscale = wscale_e8m0 * 0x01010101; asm volatile("" : "+v"(f8scale), "+v"(f8wscale));
    Unit cur, nxt; Sched W = S;
    if (!W.begin(cur)) return;
    f32x4 acc[2][2][4][2];
#pragma unroll
    for (int a = 0; a < 2; ++a)
#pragma unroll
        for (int b = 0; b < 2; ++b)
#pragma unroll
            for (int m = 0; m < 4; ++m)
#pragma unroll
                for (int n = 0; n < 2; ++n) acc[a][b][m][n] = (f32x4){0.f, 0.f, 0.f, 0.f};
    bf16x8 At[4][2], B0[2][2], B1[2][2];
    const char* cA = PG8_APTR(cur); const char* cB = PG8_BPTR(cur);
    const int idxrow = (lane >> 5) * HALF + ((lane >> 4) & 1) * 64 + 16 * (wid >> 1) + (lane & 15);
    volatile PG8_LAS int* ib = (volatile PG8_LAS int*)(lds + STAGE_BYTES + wid * 256);
    if constexpr (GATHER) { PG8_IDXDMA(cur); asm volatile("s_waitcnt vmcnt(0)" ::: "memory");
#pragma unroll
        for (int h = 0; h < 2; ++h)
#pragma unroll
            for (int i = 0; i < 2; ++i) { const int tk = PG8_TOKL(h, i); voffA[h][i] = PG8_VOFF(tk, i); } }
    PG8_STAGE(PG8_SB(0, 0), cB, voffB); PG8_STAGE(PG8_SB(0, 1), cB + hB, voffB); PG8_STAGE(PG8_SA(0, 0), cA, voffA[0]); PG8_STAGE(PG8_SA(0, 1), cA, voffA[1]);
    if (wr == 1) PG8_BAR;
    PG8_WAIT_V(2); PG8_BAR;
    PG8_STAGE(PG8_SB(1, 0), cB + kstep, voffB); PG8_STAGE(PG8_SA(1, 0), cA + kstep, voffA[0]); PG8_STAGE(PG8_SB(1, 1), cB + hB + kstep, voffB);
    PG8_WAIT_V(6); PG8_BAR;
    for (;;) {
        const bool has_next = W.advance(nxt);
        const char* nA = has_next ? PG8_APTR(nxt) : cA; const char* nB = has_next ? PG8_BPTR(nxt) : cB;
        if constexpr (GATHER) { if (has_next) PG8_IDXDMA(nxt); }
        for (int t = 0; t < nt; t += 2) {
            const bool last = (t == nt - 2);
            const char* a1 = cA + (size_t)(t + 1) * kstep;
            const char* a2 = last ? nA : cA + (size_t)(t + 2) * kstep; const char* b2 = last ? nB : cB + (size_t)(t + 2) * kstep;
            const char* a3 = a2 + kstep; const char* b3 = b2 + kstep;
            unsigned va[2][2];
#pragma unroll
            for (int h = 0; h < 2; ++h)
#pragma unroll
                for (int i = 0; i < 2; ++i) va[h][i] = (GATHER && last) ? voffAn[h][i] : voffA[h][i];
            PG8_LDB(B0, 0, 0); PG8_LDB(B1, 0, 1); PG8_SCHED; PG8_LDA(At, 0, 0); PG8_STAGE(PG8_SA(1, 1), a1, voffA[1]);
            PG8_WAIT_V(8); PG8_WAIT_L(0); PG8_BAR; PG8_MMA(0, 0, At, B0); PG8_MMA(0, 1, At, B1); PG8_BAR; PG8_SCHED;
            PG8_LDA(At, 0, 1); PG8_STAGE(PG8_SB(0, 0), b2, voffB); PG8_STAGE(PG8_SB(0, 1), b2 + hB, voffB); PG8_STAGE(PG8_SA(0, 0), a2, va[0]);
            PG8_WAIT_V(8); PG8_WAIT_L(0); PG8_BAR; PG8_MMA(1, 0, At, B0); PG8_MMA(1, 1, At, B1); PG8_BAR; PG8_SCHED;
            PG8_LDB(B0, 1, 0); PG8_LDB(B1, 1, 1); PG8_SCHED; PG8_LDA(At, 1, 0); PG8_STAGE(PG8_SA(0, 1), a2, va[1]);
            PG8_WAIT_V(8); PG8_WAIT_L(0); PG8_BAR; PG8_MMA(0, 0, At, B0); PG8_MMA(0, 1, At, B1); PG8_BAR; PG8_SCHED;
            PG8_LDA(At, 1, 1); PG8_STAGE(PG8_SB(1, 0), b3, voffB); PG8_STAGE(PG8_SB(1, 1), b3 + hB, voffB); PG8_STAGE(PG8_SA(1, 0), a3, va[0]);
            PG8_WAIT_V(8); PG8_WAIT_L(0); PG8_BAR; PG8_MMA(1, 0, At, B0); PG8_MMA(1, 1, At, B1); PG8_BAR; PG8_SCHED;
            if constexpr (GATHER) {
#pragma unroll
                for (int h = 0; h < 2; ++h)
#pragma unroll
                    for (int i = 0; i < 2; ++i) { const int tk = PG8_TOKL(h, i); voffAn[h][i] = PG8_VOFF(tk, i); } }
        }
        if (wr == 0) PG8_BAR;
        if constexpr (ES == 1) asm volatile("s_nop 15\n\ts_nop 15" ::: "memory");
        E(acc, cur, wr, wc, fr, fq, lds, wid, lane);
        if (!has_next) break;
#pragma unroll
        for (int a = 0; a < 2; ++a)
#pragma unroll
            for (int b = 0; b < 2; ++b)
#pragma unroll
                for (int m = 0; m < 4; ++m)
#pragma unroll
                    for (int n = 0; n < 2; ++n) acc[a][b][m][n] = (f32x4){0.f, 0.f, 0.f, 0.f};
        cur = nxt; cA = nA; cB = nB;
        if constexpr (GATHER) {
#pragma unroll
            for (int h = 0; h < 2; ++h)
#pragma unroll
                for (int i = 0; i < 2; ++i) voffA[h][i] = voffAn[h][i]; }
        if (wr == 1) PG8_BAR;
    }
    PG8_WAIT_V(0);
    PG8_BAR;
#undef PG8_APTR
#undef PG8_IDXDMA
#undef PG8_TOKL
#undef PG8_VOFF
#undef PG8_BPTR
#undef PG8_SA
#undef PG8_SB
#undef PG8_STAGE
#undef PG8_LDA
#undef PG8_LDB
#undef PG8_MMA
#undef PG8_CAT8
#undef PG8_WAIT_V
#undef PG8_WAIT_L
#undef PG8_BAR
#undef PG8_SCHED
}
}
namespace attn_body {
using bf16=__hip_bfloat16;
using bf16x8=__attribute__((ext_vector_type(8)))short;
using s16x4=__attribute__((ext_vector_type(4)))short;
using f32x16=__attribute__((ext_vector_type(16)))float;
using u32x4=__attribute__((ext_vector_type(4)))unsigned;
constexpr int D=64;
constexpr int NW=8,QBLK=32,QB=QBLK*NW,KVBLK=64;
__device__ __forceinline__ int crow(int r,int hi){return (r&3)+8*(r>>2)+4*hi;}
#define SBAR() __builtin_amdgcn_sched_barrier(0)
constexpr int NSLOT=3, SLOTB=8192;
constexpr int LDS_K=0, LDS_V=NSLOT*SLOTB, LDS_WS=2*NSLOT*SLOTB, LDS_OST=LDS_WS+NW*64*4, LDS_BYTES=LDS_OST+NW*4096;
constexpr int LDS_BIAS=LDS_BYTES;
constexpr float C2=0.125f*1.4426950408889634f;
__device__ __forceinline__ void glds16(const void*gsrc,unsigned lds_dst){unsigned keep;
  asm volatile("s_mov_b32 %0, m0\n\ts_mov_b32 m0, %2\n\ts_nop 0\n\tglobal_load_lds_dwordx4 %1, off\n\ts_mov_b32 m0, %0":"=&s"(keep):"v"(gsrc),"s"(lds_dst):"memory");}
__device__ __forceinline__ float max3f(float a,float b,float c){float r;asm("v_max3_f32 %0, %1, %2, %3":"=v"(r):"v"(a),"v"(b),"v"(c));return r;}
__device__ __forceinline__ float max2f(float a,float b){float r;asm("v_max_f32_e32 %0, %1, %2":"=v"(r):"v"(a),"v"(b));return r;}
__device__ __forceinline__ float fadd_s(float a,float b){float r;asm("v_add_f32_e32 %0, %1, %2":"=v"(r):"v"(a),"v"(b));return r;}
__device__ __forceinline__ float fsub_s(float a,float b){float r;asm("v_sub_f32_e32 %0, %1, %2":"=v"(r):"v"(a),"v"(b));return r;}
typedef float f32x2_t __attribute__((ext_vector_type(2))); typedef __bf16 bf16x2_t __attribute__((ext_vector_type(2)));
__device__ __forceinline__ unsigned cvtpk_s(float lo,float hi){f32x2_t v={lo,hi};bf16x2_t b=__builtin_convertvector(v,bf16x2_t);return __builtin_bit_cast(unsigned,b);}
#define WAIT_BAR(N) asm volatile("s_waitcnt vmcnt(" #N ") lgkmcnt(0)\n\ts_barrier":::"memory")

__device__ __forceinline__ void qkt(f32x16&p0,f32x16&p1,const char*Kslot,const bf16x8*qr,const f32x16&negm,int r32,int hi){
  const char*kb=Kslot+hi*1024+r32*16;
  #pragma unroll
  for(int d0=0;d0<4;++d0){
    const bf16x8 b0=*reinterpret_cast<const bf16x8*>(kb+d0*2048);
    const bf16x8 b1=*reinterpret_cast<const bf16x8*>(kb+d0*2048+512);
    if(d0==0){p0=__builtin_amdgcn_mfma_f32_32x32x16_bf16(b0,qr[0],negm,0,0,0);p1=__builtin_amdgcn_mfma_f32_32x32x16_bf16(b1,qr[0],negm,0,0,0);}
    else{p0=__builtin_amdgcn_mfma_f32_32x32x16_bf16(b0,qr[d0],p0,0,0,0);p1=__builtin_amdgcn_mfma_f32_32x32x16_bf16(b1,qr[d0],p1,0,0,0);}}
}
typedef __attribute__((address_space(3))) const char* lds_cptr;
typedef short v4i16_t __attribute__((ext_vector_type(4)));
__device__ __forceinline__ void kload8(bf16x8*kf,lds_cptr kp){
  kf[0]=*(const __attribute__((address_space(3))) bf16x8*)(kp);      kf[1]=*(const __attribute__((address_space(3))) bf16x8*)(kp+512);
  kf[2]=*(const __attribute__((address_space(3))) bf16x8*)(kp+2048); kf[3]=*(const __attribute__((address_space(3))) bf16x8*)(kp+2560);
  kf[4]=*(const __attribute__((address_space(3))) bf16x8*)(kp+4096); kf[5]=*(const __attribute__((address_space(3))) bf16x8*)(kp+4608);
  kf[6]=*(const __attribute__((address_space(3))) bf16x8*)(kp+6144); kf[7]=*(const __attribute__((address_space(3))) bf16x8*)(kp+6656);
}
__device__ __forceinline__ void kload2(bf16x8*kf,lds_cptr kp,int j){ kf[2*j]=*(const __attribute__((address_space(3))) bf16x8*)(kp+j*2048); kf[2*j+1]=*(const __attribute__((address_space(3))) bf16x8*)(kp+j*2048+512); }
__device__ __forceinline__ s16x4 vtr(lds_cptr p){ return __builtin_bit_cast(s16x4,__builtin_amdgcn_ds_read_tr16_b64_v4i16((__attribute__((address_space(3))) v4i16_t*)p)); }
__device__ __forceinline__ float rowmax(const f32x16&p0,const f32x16&p1){
  float a=max3f(p0[0],p0[1],p1[0]),b=max3f(p0[2],p0[3],p1[1]);a=max3f(a,p1[2],p1[3]);
  #pragma unroll
  for(int r=4;r<16;r+=4){a=max3f(a,p0[r],p0[r+1]);b=max3f(b,p0[r+2],p0[r+3]);a=max3f(a,p1[r],p1[r+1]);b=max3f(b,p1[r+2],p1[r+3]);}
  const float m=max2f(a,b);
  auto rr=__builtin_amdgcn_permlane32_swap(__float_as_uint(m),__float_as_uint(m),false,false);
  return max2f(__uint_as_float(rr[0]),__uint_as_float(rr[1]));
}
__device__ __forceinline__ void pv(f32x16*o,int vb,bf16x8 pa0,bf16x8 pa1,bf16x8 pa2,bf16x8 pa3){
  #pragma unroll
  for(int d0=0;d0<2;++d0){s16x4 lo[4],hi[4];
    #pragma unroll
    for(int ks=0;ks<4;++ks){
      asm volatile("ds_read_b64_tr_b16 %0,%1 offset:%c2":"=&v"(lo[ks]):"v"(vb),"i"(d0*4096+ks*1024):"memory");
      asm volatile("ds_read_b64_tr_b16 %0,%1 offset:%c2":"=&v"(hi[ks]):"v"(vb),"i"(d0*4096+ks*1024+512):"memory");}
    asm volatile("s_waitcnt lgkmcnt(0)":::"memory");SBAR();
    #define PK(k) (bf16x8){lo[k][0],lo[k][1],lo[k][2],lo[k][3],hi[k][0],hi[k][1],hi[k][2],hi[k][3]}
    o[d0]=__builtin_amdgcn_mfma_f32_32x32x16_bf16(pa0,PK(0),o[d0],0,0,0);
    o[d0]=__builtin_amdgcn_mfma_f32_32x32x16_bf16(pa1,PK(1),o[d0],0,0,0);
    o[d0]=__builtin_amdgcn_mfma_f32_32x32x16_bf16(pa2,PK(2),o[d0],0,0,0);
    o[d0]=__builtin_amdgcn_mfma_f32_32x32x16_bf16(pa3,PK(3),o[d0],0,0,0);
    #undef PK
  }
}
struct TileRows { long base0, base1; int nfirst; __device__ __forceinline__ long operator()(int t) const { return t < nfirst ? base0 + 64l * t : base1 + 64l * (t - nfirst); } };
struct NoMask { static constexpr bool ACTIVE=false; __device__ __forceinline__ void apply(f32x16&,f32x16&,int) const {} };
struct NaMask {
  static constexpr bool ACTIVE=true;
  int kbase, qr, r0q, qcol, c0, hi; lds_cptr bias;
  __device__ __forceinline__ void apply(f32x16&p0,f32x16&p1,int t) const {
    if(t<4) return;
    const int kr=kbase+(t-4); const float NEG=-1.0e30f;
    if(kr<r0q||kr>r0q+7){
      #pragma unroll
      for(int r=0;r<16;++r){p0[r]=NEG;p1[r]=NEG;}
      return; }
    const int ib=(kr-qr+7)*31+(4*hi-qcol+15);
    const int cb=4*hi-c0;
    #pragma unroll
    for(int r=0;r<16;++r){ const int ko=(r&3)+8*(r>>2);
      const float b0=*(const __attribute__((address_space(3))) float*)(bias+4*(ib+ko));
      const float b1=*(const __attribute__((address_space(3))) float*)(bias+4*(ib+ko+32));
#ifdef DBG_NA_NOBIAS
      p0[r]=((unsigned)(cb+ko)<16u)?p0[r]:NEG; p1[r]=((unsigned)(cb+ko+32)<16u)?p1[r]:NEG; (void)b0; (void)b1; }
#else
      p0[r]=((unsigned)(cb+ko)<16u)?p0[r]+b0:NEG;
      p1[r]=((unsigned)(cb+ko+32)<16u)?p1[r]+b1:NEG; }
#endif
  }
};

#ifndef ATTN_STORE16
#define ATTN_STORE16(p,v) (*(u32x4*)(p)=(v))
#endif
template<int THRL,class MK,bool USE_NEGM,bool OUT8,bool FIXM> __device__ __forceinline__ void attn_unit(const bf16*Qw0,int QP,const bf16*__restrict__ Kc,const bf16*__restrict__ Vc,int KP,const TileRows TR,const int NT,void*Ow0,int OP,char*shm,const MK&mk,const int tid,const float mfix=0.f){
  static_assert(!FIXM||USE_NEGM,"FIXM puts the reference into the QK^T MFMA's C operand");
  const int lane=tid&63,r32=lane&31,hi=lane>>5; const int wid=__builtin_amdgcn_readfirstlane(tid>>6);
  const bf16*Qw=Qw0+(long)(wid*QBLK)*QP;
  const unsigned lds0=(unsigned)(uintptr_t)shm;
  float*wsf=(float*)(shm+LDS_WS)+wid*64;
  const bf16*ksrc=Kc+(long)lane*KP+wid*8;
  const bf16*vsrc=Vc+(long)(16*(wid&3)+(lane>>2))*KP+(wid>>2)*32+(lane&3)*8;
  const unsigned kdst=lds0+LDS_K+wid*1024, vdst=lds0+LDS_V+wid*1024;
  #define DMA_K(t,slot) glds16(ksrc+TR(t)*KP,(unsigned)__builtin_amdgcn_readfirstlane(kdst+(slot)))
  #define DMA_V(t,slot) glds16(vsrc+TR(t)*KP,(unsigned)__builtin_amdgcn_readfirstlane(vdst+(slot)))
  const int vb0=(int)(lds0+LDS_V)+((lane>>4)&1)*32+(lane&3)*8+(4*hi+((lane&15)>>2))*64;
  const char*Kbase=shm+LDS_K; bf16x8 kf[8];
  const lds_cptr shm3=(lds_cptr)shm; const lds_cptr kp0=shm3+LDS_K+hi*1024+r32*16; const lds_cptr vp0=shm3+LDS_V+((lane>>4)&1)*32+(lane&3)*8+(4*hi+((lane&15)>>2))*64;
  DMA_K(0,0);DMA_V(0,0);DMA_K(1,SLOTB);
  bf16x8 qr[4];
  #pragma unroll
  for(int d0=0;d0<4;++d0)qr[d0]=*reinterpret_cast<const bf16x8*>(&Qw[(long)r32*QP+d0*16+hi*8]);
  float zz_; asm volatile("v_mov_b32 %0, 0":"=v"(zz_)); float mhat=zz_,l_reg=zz_;f32x16 o[2];
  _Pragma("unroll") for(int r=0;r<16;++r){o[0][r]=zz_;o[1][r]=zz_;}
  f32x16 negm; if(USE_NEGM){ _Pragma("unroll") for(int r=0;r<16;++r)negm[r]=FIXM?(zz_-mfix):zz_; asm volatile("":"+v"(negm)); }
  const f32x16 zero16=f32x16{};
  #define CIN (USE_NEGM?negm:zero16)
  #define SUBM(C0,C1) do{ if(!USE_NEGM){ _Pragma("unroll") for(int r=0;r<16;++r){C0[r]-=mhat;C1[r]-=mhat;} } }while(0)
  #define CMASK(P0,P1,t) mk.apply(P0,P1,t)
  bool resc=false;
  #define START(P0,P1) do{ resc=false; if(!FIXM) { const float rm=rowmax(P0,P1); \
    const float dl=rm; mhat=fadd_s(mhat,dl); \
      _Pragma("unroll") for(int r=0;r<16;++r){P0[r]=fsub_s(P0[r],dl);P1[r]=fsub_s(P1[r],dl);} \
      if(USE_NEGM){ _Pragma("unroll") for(int r=0;r<16;++r)negm[r]=-mhat; asm volatile("":"+v"(negm)); } } \
    _Pragma("unroll") for(int r=0;r<16;++r)P0[r]=__builtin_amdgcn_exp2f(P0[r]); }while(0)
  #define RESC() do{ if(!FIXM&&resc){ asm volatile("s_waitcnt lgkmcnt(0)":::"memory"); \
      _Pragma("unroll") for(int d_=0;d_<2;++d_) _Pragma("unroll") for(int r=0;r<16;++r)o[d_][r]*=wsf[crow(r,hi)]; } }while(0)
  f32x16 pA0,pA1,pB0,pB1;
  int sl_prev=0,sl_cur=0,sl_next=SLOTB;
  #define ROT() do{sl_prev=sl_cur;sl_cur=sl_next;sl_next=(sl_next==(NSLOT-1)*SLOTB)?0:sl_next+SLOTB;}while(0)
  DMA_K(2,2*SLOTB);
  WAIT_BAR(3);
  qkt(pA0,pA1,Kbase,qr,CIN,r32,hi);asm volatile("s_nop 15\n\ts_nop 7":"+v"(pA0),"+v"(pA1));CMASK(pA0,pA1,0);
  START(pA0,pA1);
  _Pragma("unroll") for(int r=0;r<16;++r)pA1[r]=__builtin_amdgcn_exp2f(pA1[r]);
  WAIT_BAR(0);
  DMA_K(3,0);DMA_V(1,SLOTB);
  ROT();
  kload8(kf,kp0+sl_cur);
  WAIT_BAR(2);
  s16x4 vlo[8],vhi[8]; u32x4 pw0,pw1,pw2,pw3;
  #define PKW(P,B) cvtpk_s(P[B],P[B+1])
  #define PAF(k) __builtin_bit_cast(bf16x8,pw##k)
  #define VFR(i) (bf16x8){vlo[i][0],vlo[i][1],vlo[i][2],vlo[i][3],vhi[i][0],vhi[i][1],vhi[i][2],vhi[i][3]}
  #define PIN(x) asm volatile("":"+v"(x))
  #define MX3(a,b,c) __builtin_fmaxf(__builtin_fmaxf((a),(b)),(c))
  #define GAPA(MF,A0,A1,A2,A3,W0,W1,PW) do{ MF; sacc+=A0; sacc+=A1; sacc+=A2; sacc+=A3; PIN(sacc); W0; W1; PIN(PW); SBAR(); }while(0)
  #define EX(v) __builtin_amdgcn_exp2f(v)
  #define GAPB(MF,X,B) do{ MF; X[B]=EX(X[B]); X[B+1]=EX(X[B+1]); X[B+2]=EX(X[B+2]); X[B+3]=EX(X[B+3]); PIN(X); SBAR(); }while(0)
  #define VRD(i) do{ vlo[i]=vtr(vp_+(((i)>>2)*4096+((i)&3)*1024)); vhi[i]=vtr(vp_+(((i)>>2)*4096+((i)&3)*1024+512)); }while(0)
  #define KRD(G,j) do{ if(G){ kload2(kf,kp0+sl_next,j); SBAR(); } }while(0)
  #define STEP(C0,C1,P0,P1,t,GK,GV,GL) do{ SBAR(); \
    const lds_cptr vp_=vp0+sl_prev; \
    VRD(0); SBAR(); float sacc=(P0[0]+P0[1]); \
    GAPA(C0=__builtin_amdgcn_mfma_f32_32x32x16_bf16(kf[0],qr[0],CIN,0,0,0), P0[2],P0[3],P0[4],P0[5],     pw0[0]=PKW(P0,0), pw0[1]=PKW(P0,2), pw0); \
    VRD(4); SBAR(); GAPA(C1=__builtin_amdgcn_mfma_f32_32x32x16_bf16(kf[1],qr[0],CIN,0,0,0), P0[6],P0[7],P0[8],P0[9],     pw0[2]=PKW(P0,4), pw0[3]=PKW(P0,6), pw0); \
    VRD(1); SBAR(); GAPA(C0=__builtin_amdgcn_mfma_f32_32x32x16_bf16(kf[2],qr[1],C0,0,0,0),   P0[10],P0[11],P0[12],P0[13], pw1[0]=PKW(P0,8), pw1[1]=PKW(P0,10), pw1); \
    VRD(5); SBAR(); GAPA(C1=__builtin_amdgcn_mfma_f32_32x32x16_bf16(kf[3],qr[1],C1,0,0,0),   P0[14],P0[15],P1[0],P1[1],   pw1[2]=PKW(P0,12),pw1[3]=PKW(P0,14), pw1); \
    VRD(2); SBAR(); GAPA(C0=__builtin_amdgcn_mfma_f32_32x32x16_bf16(kf[4],qr[2],C0,0,0,0),   P1[2],P1[3],P1[4],P1[5],     pw2[0]=PKW(P1,0), pw2[1]=PKW(P1,2), pw2); \
    VRD(6); SBAR(); GAPA(C1=__builtin_amdgcn_mfma_f32_32x32x16_bf16(kf[5],qr[2],C1,0,0,0),   P1[6],P1[7],P1[8],P1[9],     pw2[2]=PKW(P1,4), pw2[3]=PKW(P1,6), pw2); \
    VRD(3); SBAR(); GAPA(C0=__builtin_amdgcn_mfma_f32_32x32x16_bf16(kf[6],qr[3],C0,0,0,0),   P1[10],P1[11],P1[12],P1[13], pw3[0]=PKW(P1,8), pw3[1]=PKW(P1,10), pw3); \
    VRD(7); SBAR(); GAPA(C1=__builtin_amdgcn_mfma_f32_32x32x16_bf16(kf[7],qr[3],C1,0,0,0),   P1[14],P1[15],0.f,0.f,       pw3[2]=PKW(P1,12),pw3[3]=PKW(P1,14), pw3); \
    l_reg+=sacc; \
    if(GK){DMA_K((t)+3,sl_cur);} if(GV){DMA_V((t)+1,sl_next);} \
    SUBM(C0,C1); CMASK(C0,C1,t); \
    if(!FIXM){ float a=MX3(C0[0],C0[1],C1[0]),b=MX3(C0[2],C0[3],C1[1]); a=MX3(a,C1[2],C1[3]); \
      _Pragma("unroll") for(int r=4;r<16;r+=4){a=MX3(a,C0[r],C0[r+1]);b=MX3(b,C0[r+2],C0[r+3]);a=MX3(a,C1[r],C1[r+1]);b=MX3(b,C1[r+2],C1[r+3]);} \
      float rm=__builtin_fmaxf(a,b); { auto rr=__builtin_amdgcn_permlane32_swap(__float_as_uint(rm),__float_as_uint(rm),false,false); rm=__builtin_fmaxf(__uint_as_float(rr[0]),__uint_as_float(rr[1])); } \
      resc=false; \
      if(__builtin_expect(__any(rm>(float)THRL),0)){ const float dl=__builtin_fmaxf(rm,0.f); mhat+=dl; \
        _Pragma("unroll") for(int r=0;r<16;++r){C0[r]-=dl;C1[r]-=dl;} \
        if(USE_NEGM){ _Pragma("unroll") for(int r=0;r<16;++r)negm[r]=-mhat; asm volatile("":"+v"(negm)); } \
        const float f=__builtin_amdgcn_exp2f(-dl); l_reg*=f; if(hi==0)wsf[r32]=f; resc=true; } } \
    SBAR(); \
    GAPB(o[0]=__builtin_amdgcn_mfma_f32_32x32x16_bf16(PAF(0),VFR(0),o[0],0,0,0), C0,0); \
    GAPB(o[1]=__builtin_amdgcn_mfma_f32_32x32x16_bf16(PAF(0),VFR(4),o[1],0,0,0), C0,4); \
    KRD(GL,0); GAPB(o[0]=__builtin_amdgcn_mfma_f32_32x32x16_bf16(PAF(1),VFR(1),o[0],0,0,0), C0,8); \
    KRD(GL,1); GAPB(o[1]=__builtin_amdgcn_mfma_f32_32x32x16_bf16(PAF(1),VFR(5),o[1],0,0,0), C0,12); \
    KRD(GL,2); GAPB(o[0]=__builtin_amdgcn_mfma_f32_32x32x16_bf16(PAF(2),VFR(2),o[0],0,0,0), C1,0); \
    KRD(GL,3); GAPB(o[1]=__builtin_amdgcn_mfma_f32_32x32x16_bf16(PAF(2),VFR(6),o[1],0,0,0), C1,4); \
    GAPB(o[0]=__builtin_amdgcn_mfma_f32_32x32x16_bf16(PAF(3),VFR(3),o[0],0,0,0), C1,8); \
    GAPB(o[1]=__builtin_amdgcn_mfma_f32_32x32x16_bf16(PAF(3),VFR(7),o[1],0,0,0), C1,12); \
    }while(0)
  int t=1;
  for(;t+5<NT;t+=2){
    STEP(pB0,pB1,pA0,pA1,t,true,true,true);     WAIT_BAR(2); RESC(); ROT();
    STEP(pA0,pA1,pB0,pB1,t+1,true,true,true);   WAIT_BAR(2); RESC(); ROT();
  }
  #define ENDW(tt) do{ if((tt)+3<NT){WAIT_BAR(2);} else if((tt)+2<NT){WAIT_BAR(1);} else {WAIT_BAR(0);} }while(0)
  for(;t+1<NT;t+=2){
    STEP(pB0,pB1,pA0,pA1,t,(t+3<NT),(t+1<NT),(t+1<NT));       ENDW(t);   RESC(); ROT();
    STEP(pA0,pA1,pB0,pB1,t+1,(t+4<NT),(t+2<NT),(t+2<NT));     ENDW(t+1); RESC(); ROT();
  }
  STEP(pB0,pB1,pA0,pA1,NT-1,false,false,false); RESC();
  { float sacc=pB0[0]+pB0[1]; _Pragma("unroll") for(int r=2;r<16;++r)sacc+=pB0[r]; _Pragma("unroll") for(int r=0;r<16;++r)sacc+=pB1[r]; l_reg+=sacc;
    pw0=(u32x4){PKW(pB0,0),PKW(pB0,2),PKW(pB0,4),PKW(pB0,6)};pw1=(u32x4){PKW(pB0,8),PKW(pB0,10),PKW(pB0,12),PKW(pB0,14)};pw2=(u32x4){PKW(pB1,0),PKW(pB1,2),PKW(pB1,4),PKW(pB1,6)};pw3=(u32x4){PKW(pB1,8),PKW(pB1,10),PKW(pB1,12),PKW(pB1,14)};
    SBAR(); pv(o,vb0+sl_cur,PAF(0),PAF(1),PAF(2),PAF(3)); }
  #undef PKW
  #undef PAF
  #undef VFR
  #undef PIN
  #undef MX3
  #undef GAPA
  #undef GAPB
  #undef EX
  #undef VRD
  #undef KRD
  #undef STEP
  #undef ENDW
  {auto rr=__builtin_amdgcn_permlane32_swap(__float_as_uint(l_reg),__float_as_uint(l_reg),false,false);l_reg=__uint_as_float(rr[0])+__uint_as_float(rr[1]);}
  if(hi==0)wsf[32+r32]=l_reg;asm volatile("s_waitcnt lgkmcnt(0)":::"memory");
  float rli[16];
  #pragma unroll
  for(int r=0;r<16;++r)rli[r]=__builtin_amdgcn_rcpf(wsf[32+crow(r,hi)]);
  if constexpr(OUT8){ unsigned char*Ow=(unsigned char*)Ow0+(long)(wid*QBLK)*OP; unsigned char*stg=(unsigned char*)(shm+LDS_OST)+wid*4096;
    #pragma unroll
    for(int r=0;r<16;++r){const int orow=crow(r,hi);
      #pragma unroll
      for(int d0=0;d0<2;++d0){const float v=o[d0][r]*rli[r]; const int t=__builtin_amdgcn_cvt_pk_fp8_f32(v,v,0,false); stg[orow*64+d0*32+r32]=(unsigned char)t;}}
    asm volatile("s_waitcnt lgkmcnt(0)":::"memory");
    #pragma unroll
    for(int i=0;i<2;++i){const int row=i*16+(lane>>2),ch=lane&3; const u32x4 v=*(const u32x4*)(stg+row*64+ch*16); ATTN_STORE16(Ow+(long)row*OP+ch*16,v);} }
  else{ bf16*Ow=(bf16*)Ow0+(long)(wid*QBLK)*OP;
  { bf16*stg=(bf16*)(shm+LDS_OST)+wid*2048;
    #pragma unroll
    for(int r=0;r<16;++r){const int orow=crow(r,hi);
      #pragma unroll
      for(int d0=0;d0<2;++d0)stg[orow*64+d0*32+r32]=__float2bfloat16(o[d0][r]*rli[r]);}
    asm volatile("s_waitcnt lgkmcnt(0)":::"memory");
    #pragma unroll
    for(int i=0;i<4;++i){const int row=i*8+(lane>>3),ch=lane&7; const u32x4 v=*(const u32x4*)(stg+row*64+ch*8); ATTN_STORE16(Ow+(long)row*OP+ch*8,v);} } }
  asm volatile("s_waitcnt lgkmcnt(0)\n\ts_barrier":::"memory");
  #undef CIN
  #undef SUBM
  #undef DMA_K
  #undef DMA_V
  #undef CMASK
  #undef START
  #undef RESC
  #undef ROT
}
#undef SBAR
#undef WAIT_BAR
}
#ifndef MK_PER_PHASE
#define MK_PER_PHASE 0
#endif
#ifndef MOE_F8
#define MOE_F8 1
#endif
#ifndef WO_F8
#define WO_F8 0
#endif
#ifndef YS_F8
#define YS_F8 1
#endif
#ifndef QKV_F8
#define QKV_F8 1
#endif
constexpr int NWAVES = 8;
constexpr int W13_LOG2 = 5, W2_LOG2 = 7, WO_LOG2 = 6; constexpr float W13_SCALE = 32.0f, W2_SCALE = 128.0f;
constexpr int NB = 4, SEQ = 8192, DM = 1024, LCTX = 256, DEPTH = 4;
constexpr int M_LAT = NB * SEQ, M_CTX = NB * LCTX, M_ALL = M_LAT + M_CTX;
constexpr int NE = 16, FF = 2048, CAP_LAT = 1024, CAP_CTX = 32;
constexpr int ETILES = 17, ESTR = ETILES * 256, NSLOTS = NE * ESTR;
constexpr int KVROWS = SEQ + LCTX;
constexpr int NMOD = 6 * DM;
constexpr float ALPHA = 1.681792830507429f, LN_EPS = 1e-5f, RMS_EPS = 1e-6f, LOG2E = 1.4426950408889634f;

constexpr size_t MiB = 1u << 20;
constexpr size_t WS_CTL = 0, CTL_ZERO_BYTES = 2 * MiB;
constexpr size_t WS_MOD = 2 * MiB, WS_AFF = 3 * MiB, WS_SEL = 6 * MiB, WS_SLOT = 9 * MiB;
constexpr size_t WS_POOLW = 10 * MiB, WS_NAQKV = 11 * MiB, WS_NAWO = 17 * MiB, WS_GQKV = 19 * MiB, WS_GWO = 22 * MiB;
constexpr size_t WS_W13 = 32 * MiB, WS_W2 = 544 * MiB, WS_X = 800 * MiB, WS_H = 932 * MiB, WS_R = 1000 * MiB, WS_END = 1544 * MiB;
constexpr size_t R_XS = 0, R_HID = 136 * MiB, R_YS = 408 * MiB;
constexpr size_t R_D = 0, R_Y = 200 * MiB;
constexpr size_t R_O8 = 272 * MiB;
constexpr size_t R_Q = 0, R_K = 66 * MiB, R_V = 132 * MiB;
constexpr size_t R_RAW = 0, R_GQ = 100 * MiB, R_GK = 164 * MiB, R_GV = 181 * MiB;
constexpr int CW_TMO = 0, CW_BAR = 4096;

constexpr int RING_BYTES = 135168;
constexpr int LDSCTL_OFF = RING_BYTES, MISC_OFF = LDSCTL_OFF + 320;
constexpr int LDS_BYTES = 147456;

#define GAS __attribute__((address_space(1)))
#define LAS __attribute__((address_space(3)))
typedef unsigned short bf16;
typedef unsigned v4u __attribute__((ext_vector_type(4)));
typedef unsigned v2u __attribute__((ext_vector_type(2)));
typedef float f32x4 __attribute__((ext_vector_type(4)));
typedef float f32x2 __attribute__((ext_vector_type(2)));
#define RLX_AGENT __ATOMIC_RELAXED, __HIP_MEMORY_SCOPE_AGENT
#define LDS_WAIT() asm volatile("s_waitcnt lgkmcnt(0)" ::: "memory")
__device__ __forceinline__ unsigned pk2(float lo, float hi) { return pg8::cvt_pk_bf16(lo, hi); }
__device__ __forceinline__ float bf_lo(unsigned u) { return __uint_as_float(u << 16); }
__device__ __forceinline__ float bf_hi(unsigned u) { return __uint_as_float(u & 0xffff0000u); }

#define XB_TMO      128
#define XB_XCNT(j)  (256  + 64 * (j))
#define XB_XSUB(j)  (1280 + 64 * (j))
#define XB_XGEN(j)  (2304 + 64 * (j))
#define XB_TOP      3328
#define XB_TOPGEN   3392
#define XCD_BAR_WORDS 3456
#define XB_SPIN_CAP (1u << 22)

__device__ __forceinline__ unsigned xb_ld(unsigned* p)              { return __hip_atomic_load(p, __ATOMIC_RELAXED, __HIP_MEMORY_SCOPE_AGENT); }
__device__ __forceinline__ unsigned xb_add(unsigned* p, unsigned v) { return __hip_atomic_fetch_add(p, v, __ATOMIC_RELAXED, __HIP_MEMORY_SCOPE_AGENT); }
__device__ __forceinline__ unsigned xb_xcc_id() { return (unsigned)__builtin_amdgcn_s_getreg((3 << 11) | 20) & 0xFu; }
#define XB_SPIN(cond, bar) do { unsigned _sp = 0; while (cond) { __builtin_amdgcn_s_sleep(1); \
    if ((++_sp & 255u) == 0u) { if (xb_ld(&(bar)[XB_TMO])) break; if (_sp > XB_SPIN_CAP) { atomicAdd(&(bar)[XB_TMO], 1u); break; } } } } while (0)

struct XcdBarrier { unsigned* bar; unsigned x; volatile LAS unsigned* st; };
__device__ __forceinline__ XcdBarrier xcd_barrier_post(unsigned* bar, volatile LAS unsigned* st) {
    XcdBarrier b; b.bar = bar; b.x = xb_xcc_id(); b.st = st;
    if (threadIdx.x == 0) (void)xb_add(&bar[XB_XCNT(b.x)], 1u);
    return b;
}
__device__ __forceinline__ void xcd_barrier_complete(unsigned* bar, unsigned x, unsigned& nloc, unsigned& nx) {
    const unsigned G = gridDim.x * gridDim.y * gridDim.z;
    unsigned sum, cnt, mine, sp = 0u;
    for (;;) {
        sum = 0u; cnt = 0u; mine = 0u;
#pragma unroll
        for (unsigned j = 0; j < 16; ++j) { const unsigned c = xb_ld(&bar[XB_XCNT(j)]); sum += c; cnt += (c > 0u) ? 1u : 0u; mine = (j == x) ? c : mine; }
        if (sum == G) break;
        __builtin_amdgcn_s_sleep(1);
        if ((++sp & 255u) == 0u) { if (xb_ld(&bar[XB_TMO])) break; if (sp > XB_SPIN_CAP) { atomicAdd(&bar[XB_TMO], 1u); break; } }
    }
    nloc = mine > 0u ? mine : 1u; nx = cnt > 0u ? cnt : 1u;
}
__device__ __forceinline__ void xcd_barrier(const XcdBarrier& b) {
    asm volatile("s_waitcnt vmcnt(0)" ::: "memory");
    __syncthreads();
    if (threadIdx.x == 0) {
        unsigned* bar = b.bar;
        __builtin_amdgcn_s_waitcnt(0);
        unsigned nloc = b.st[0], nx = b.st[1];
        if (nloc == 0u) { xcd_barrier_complete(bar, b.x, nloc, nx); b.st[0] = nloc; b.st[1] = nx; }
        const unsigned old = xb_add(&bar[XB_XSUB(b.x)], 1u);
        const unsigned gen = old / nloc;
        if (old + 1u == (gen + 1u) * nloc) {
            __builtin_amdgcn_fence(__ATOMIC_RELEASE, "agent");
            asm volatile("s_waitcnt vmcnt(0)" ::: "memory");
            const unsigned og = xb_add(&bar[XB_TOP], 1u);
            const unsigned tg = og / nx;
            if (og + 1u == (tg + 1u) * nx) xb_add(&bar[XB_TOPGEN], 1u);
            else XB_SPIN(xb_ld(&bar[XB_TOPGEN]) == tg, bar);
            __builtin_amdgcn_fence(__ATOMIC_ACQUIRE, "agent");
            xb_add(&bar[XB_XGEN(b.x)], 1u);
            asm volatile("s_waitcnt vmcnt(0)" ::: "memory");
        } else {
            XB_SPIN(xb_ld(&bar[XB_XGEN(b.x)]) == gen, bar);
            __builtin_amdgcn_fence(__ATOMIC_ACQUIRE, "agent");
            asm volatile("s_waitcnt vmcnt(0)" ::: "memory");
        }
    }
    __syncthreads();
}

template <int CTRL> __device__ __forceinline__ float dppx(float v) { return __builtin_bit_cast(float, __builtin_amdgcn_update_dpp(0, __builtin_bit_cast(int, v), CTRL, 0xf, 0xf, true)); }
constexpr int DPP_XOR1 = 0xB1, DPP_XOR2 = 0x4E, DPP_HMIRROR = 0x141, DPP_MIRROR = 0x140, DPP_XOR8 = 0x128;
__device__ __forceinline__ void swap16(float v, float& even_rows, float& odd_rows) { auto r = __builtin_amdgcn_permlane16_swap(__float_as_uint(v), __float_as_uint(v), false, false); even_rows = __uint_as_float(r[0]); odd_rows = __uint_as_float(r[1]); }
__device__ __forceinline__ void swap32(float v, float& lo_half, float& hi_half) { auto r = __builtin_amdgcn_permlane32_swap(__float_as_uint(v), __float_as_uint(v), false, false); lo_half = __uint_as_float(r[0]); hi_half = __uint_as_float(r[1]); }
__device__ __forceinline__ float quad_sum(float v) { v += dppx<DPP_XOR1>(v); v += dppx<DPP_XOR2>(v); return v; }
__device__ __forceinline__ float row16_sum(float v) { v = quad_sum(v); v += dppx<DPP_HMIRROR>(v); v += dppx<DPP_MIRROR>(v); return v; }
__device__ __forceinline__ float wave_sum(float v) { v = row16_sum(v); float a, b; swap16(v, a, b); v = a + b; swap32(v, a, b); return a + b; }
__device__ __forceinline__ int wave_incl_scan(int v, int lane) {
#pragma unroll
    for (int o = 1; o < 64; o <<= 1) { const int t = __shfl_up(v, o); if (lane >= o) v += t; }
    return v;
}
__device__ __forceinline__ int block_excl_scan(int v, LAS int* tmp, int lane, int wave) {
    const int inc = wave_incl_scan(v, lane);
    if (lane == 63) tmp[wave] = inc;
    __syncthreads();
    int base = 0;
#pragma unroll
    for (int w = 0; w < NWAVES; ++w) { const int t = tmp[w]; base += (w < wave) ? t : 0; }
    __syncthreads();
    return base + inc - v;
}

struct Args { const float* in[21]; float* out; unsigned char* ws; int ph_lo, ph_hi, li, pad; };
enum { IN_X = 0, IN_C, IN_CTX, IN_CCTX, IN_MODW, IN_MODB, IN_LNG, IN_LNB, IN_POOLW, IN_POOLS, IN_NAQKV, IN_NAWO, IN_NARPB, IN_GQKV, IN_GQN, IN_GKN, IN_GWO, IN_ROUTER, IN_W1, IN_W3, IN_W2 };

__device__ __forceinline__ void p0_mod(const Args& a, LAS unsigned char* lds, int tid, int lane, int wave) {
    const int wg = blockIdx.x; if (wg >= 192) return;
    const int L = wg / 48, cb = wg % 48;
    LAS float* sl = (LAS float*)lds; LAS float* red = sl + 5 * 1024;
    const float* c = a.in[IN_C]; const float* cc = a.in[IN_CCTX];
    for (int i = tid; i < 5120; i += 512) { const int s = i >> 10, k = i & 1023; const float cv = s < 4 ? c[s * 1024 + k] : cc[k]; sl[i] = cv / (1.0f + expf(-cv)); }
    __syncthreads();
    float acc[5][2];
#pragma unroll
    for (int s = 0; s < 5; ++s) { acc[s][0] = 0.f; acc[s][1] = 0.f; }
    const float* wp = a.in[IN_MODW] + (size_t)L * DM * NMOD + cb * 128 + 2 * lane;
#pragma unroll 8
    for (int kk = 0; kk < 128; ++kk) { const int k = wave * 128 + kk; const f32x2 w = *(const f32x2*)(wp + (size_t)k * NMOD);
#pragma unroll
        for (int s = 0; s < 5; ++s) { const float sv = sl[s * 1024 + k]; acc[s][0] += sv * w.x; acc[s][1] += sv * w.y; } }
#pragma unroll
    for (int s = 0; s < 5; ++s) { red[(wave * 5 + s) * 128 + 2 * lane] = acc[s][0]; red[(wave * 5 + s) * 128 + 2 * lane + 1] = acc[s][1]; }
    __syncthreads();
    float* MOD = (float*)(a.ws + WS_MOD);
    for (int o = tid; o < 640; o += 512) { const int s = o >> 7, col = o & 127; float sum = 0.f;
#pragma unroll
        for (int w = 0; w < 8; ++w) sum += red[(w * 5 + s) * 128 + col];
        MOD[(size_t)(L * 5 + s) * NMOD + cb * 128 + col] = sum + a.in[IN_MODB][L * NMOD + cb * 128 + col]; }
    __syncthreads();
}
struct CvtItem { const float* W; void* WT; int K, N, mode, sub; float scale; };
constexpr int I_POOL = 128, I_NAQKV = 768, I_NAWO = 256, I_GQKV = 384, I_GWO = 256, I_SMALL = I_POOL + I_NAQKV + I_NAWO + I_GQKV + I_GWO, I_LE = 1536, I_ALL = I_SMALL + 64 * I_LE;
constexpr int CVT_DEF0 = 6144, CVT_DEF1 = 6144, CVT_DEF2 = 6144, CVT_I_PRO = I_ALL - CVT_DEF0 - CVT_DEF1 - CVT_DEF2;
__device__ __forceinline__ bool cvt_decode(const Args& a, int it, int it_end, CvtItem& c) {
    if (it >= it_end) return false;
    int r = it; c.scale = 0.f; c.mode = 0;
    if (r >= I_SMALL) { r -= I_SMALL; const int le = r / I_LE, q = r - le * I_LE, which = q >> 9; c.sub = q & 511;
#if MOE_F8
        const size_t es = 1;
#else
        const size_t es = 2;
#endif
        if (which < 2) { c.W = a.in[which == 0 ? IN_W1 : IN_W3] + (size_t)le * DM * FF; c.K = DM; c.N = FF; c.WT = a.ws + WS_W13 + (size_t)le * 2 * FF * DM * es; c.mode = 1 + which; c.scale = MOE_F8 ? W13_SCALE : 0.f; }
        else { c.W = a.in[IN_W2] + (size_t)le * FF * DM; c.K = FF; c.N = DM; c.WT = a.ws + WS_W2 + (size_t)le * DM * FF * es; c.scale = MOE_F8 ? W2_SCALE : 0.f; }
        return true; }
    if (r < I_POOL) { const int mi = r >> 4; c.W = a.in[IN_POOLW] + (size_t)mi * 65536; c.K = 256; c.N = 256; c.WT = (bf16*)(a.ws + WS_POOLW) + (size_t)mi * 65536; c.sub = r & 15; return true; } r -= I_POOL;
    if (r < I_NAQKV) { c.W = a.in[IN_NAQKV]; c.K = DM; c.N = 3 * DM; c.WT = a.ws + WS_NAQKV; c.sub = r; c.scale = QKV_F8 ? W13_SCALE : 0.f; return true; } r -= I_NAQKV;
    if (r < I_NAWO) { c.W = a.in[IN_NAWO]; c.K = DM; c.N = DM; c.WT = a.ws + WS_NAWO; c.sub = r; c.scale = WO_F8 ? 64.0f : 0.f; return true; } r -= I_NAWO;
    if (r < I_GQKV) { c.W = a.in[IN_GQKV]; c.K = DM; c.N = 1536; c.WT = a.ws + WS_GQKV; c.sub = r; c.scale = QKV_F8 ? W13_SCALE : 0.f; return true; } r -= I_GQKV;
    c.W = a.in[IN_GWO]; c.K = DM; c.N = DM; c.WT = a.ws + WS_GWO; c.sub = r; c.scale = WO_F8 ? 64.0f : 0.f; return true;
}
__device__ __forceinline__ void cvt_geom(const CvtItem& c, int& k0, int& n0) { const int nblk = c.N >> 5, kb = c.sub / nblk, nb = c.sub - kb * nblk; k0 = kb * 128; n0 = nb * 32; }
__device__ __forceinline__ void cvt_load(const CvtItem& c, f32x4 (&v)[16], int lane) {
    int k0, n0; cvt_geom(c, k0, n0); const int kr = lane >> 3, nc = lane & 7;
#pragma unroll
    for (int i = 0; i < 16; ++i) v[i] = __builtin_nontemporal_load((const f32x4*)(c.W + (size_t)(k0 + 8 * i + kr) * c.N + n0 + 4 * nc));
}
__device__ __forceinline__ void cvt_store(const CvtItem& c, const f32x4 (&v)[16], LAS float* scr, int lane) {
    int k0, n0; cvt_geom(c, k0, n0); const int kr = lane >> 3, nc = lane & 7;
    const float sc = c.scale > 0.f ? c.scale : 1.0f;
#pragma unroll
    for (int i = 0; i < 16; ++i) { LAS float* d = scr + (8 * i + kr) * 33 + 4 * nc; d[0] = v[i].x * sc; d[1] = v[i].y * sc; d[2] = v[i].z * sc; d[3] = v[i].w * sc; }
    LDS_WAIT();
    const int ch = lane & 7;
#pragma unroll
    for (int j = 0; j < 4; ++j) { const int n = 8 * j + (lane >> 3); const LAS float* s = scr + (16 * ch) * 33 + n;
        const int nn = n0 + n; const int drow = c.mode == 0 ? nn : (((nn >> 2) << 3) + (nn & 3) + (c.mode == 2 ? 4 : 0));
        if (c.scale > 0.f) { int w[4];
#pragma unroll
            for (int q = 0; q < 4; ++q) { int t = 0; t = __builtin_amdgcn_cvt_pk_fp8_f32(s[(4 * q) * 33], s[(4 * q + 1) * 33], t, false); t = __builtin_amdgcn_cvt_pk_fp8_f32(s[(4 * q + 2) * 33], s[(4 * q + 3) * 33], t, true); w[q] = t; }
            __builtin_nontemporal_store((v4u){(unsigned)w[0], (unsigned)w[1], (unsigned)w[2], (unsigned)w[3]}, (v4u*)((unsigned char*)c.WT + (size_t)drow * c.K + k0 + 16 * ch)); }
        else { v4u o0, o1;
            o0.x = pk2(s[0 * 33], s[1 * 33]); o0.y = pk2(s[2 * 33], s[3 * 33]); o0.z = pk2(s[4 * 33], s[5 * 33]); o0.w = pk2(s[6 * 33], s[7 * 33]);
            o1.x = pk2(s[8 * 33], s[9 * 33]); o1.y = pk2(s[10 * 33], s[11 * 33]); o1.z = pk2(s[12 * 33], s[13 * 33]); o1.w = pk2(s[14 * 33], s[15 * 33]);
            v4u* d = (v4u*)((bf16*)c.WT + (size_t)drow * c.K + k0 + 16 * ch); d[0] = o0; d[1] = o1; } }
    LDS_WAIT();
}
#ifdef PROBE_DUPPRO
__device__ __forceinline__ void p0_convert_probe(const Args& a, LAS unsigned char* lds, int gw, int NGW, int lane, int wave) {
    LAS float* scr = (LAS float*)(lds + wave * 16896);
    CvtItem cur; f32x4 va[16]; f32x4 acc = {0.f, 0.f, 0.f, 0.f};
    for (int it = gw; cvt_decode(a, it, I_ALL, cur); it += NGW) {
        cvt_load(cur, va, lane);
        if (PROBE_DUPPRO == 2) { cur.WT = a.ws + (size_t)1600 * MiB + ((size_t)it & 2047) * 65536; cur.K = 64; cur.mode = 0; cur.sub = 0; cvt_store(cur, va, scr, lane); }
        else {
#pragma unroll
            for (int i = 0; i < 16; ++i) acc += va[i]; }
    }
    if (acc.x == 1.2345e30f) ((float*)(a.ws + (size_t)1600 * MiB))[lane] = acc.x + acc.y + acc.z + acc.w;
}
#endif
__device__ __forceinline__ void p0_convert(const Args& a, LAS unsigned char* lds, int it0, int it_end, int gw, int NGW, int lane, int wave) {
    LAS float* scr = (LAS float*)(lds + wave * 16896);
    CvtItem ca, cb; f32x4 va[16], vb[16];
    bool ha = cvt_decode(a, it0 + gw, it_end, ca);
    if (ha) cvt_load(ca, va, lane);
    for (int it = it0 + gw; ha; it += 2 * NGW) {
        const bool hb = cvt_decode(a, it + NGW, it_end, cb);
        if (hb) cvt_load(cb, vb, lane);
        cvt_store(ca, va, scr, lane);
        if (!hb) break;
        ha = cvt_decode(a, it + 2 * NGW, it_end, ca);
        if (ha) cvt_load(ca, va, lane);
        cvt_store(cb, vb, scr, lane);
    }
}

__device__ __forceinline__ int row_s(int row) { return row < M_LAT ? (row >> 13) : 4; }
__device__ __forceinline__ const float* xrow(const Args& a, int row) {
    return row < M_LAT ? a.in[IN_X] + (size_t)row * DM : a.in[IN_CTX] + (size_t)(row - M_LAT) * DM;
}
typedef _Float16 xh_t; typedef _Float16 h16x4 __attribute__((ext_vector_type(4)));
__device__ __forceinline__ f32x4 xdec(const f32x4 v) { return v; }
__device__ __forceinline__ f32x4 xdec(const v2u w) { return __builtin_convertvector(__builtin_bit_cast(h16x4, w), f32x4); }
__device__ __forceinline__ v2u xenc(const f32x4 v) { return __builtin_bit_cast(v2u, __builtin_convertvector(v, h16x4)); }
template <bool XH> struct XSrc;
template <> struct XSrc<false> { typedef f32x4 vec; typedef float elem; static __device__ __forceinline__ const float* row(const Args& a, int r) { return xrow(a, r); } };
template <> struct XSrc<true>  { typedef v2u vec;   typedef xh_t elem;  static __device__ __forceinline__ const xh_t* row(const Args& a, int r) { return (const xh_t*)(a.ws + WS_X) + (size_t)r * DM; } };

template <int W, class XE> __device__ __forceinline__ f32x4 pool_sum(const XE* base, int pos, int n) {
    typedef typename std::conditional<sizeof(XE) == 2, v2u, f32x4>::type XV;
    f32x4 s = {0.f, 0.f, 0.f, 0.f};
#pragma unroll
    for (int i = 0; i < W; ++i) { const int idx = pos - W / 2 + i; const bool ok = idx >= 0 && idx < n; const int ic = idx < 0 ? 0 : (idx >= n ? n - 1 : idx);
        const f32x4 v = xdec(*(const XV*)(base + (size_t)ic * DM)); s += ok ? v : (f32x4){0.f, 0.f, 0.f, 0.f}; }
    return s;
}
__device__ __forceinline__ void pd_decode(int row, int& r0s, int& pos, int& n) {
    if (row < M_LAT) { r0s = row & ~(SEQ - 1); pos = row & (SEQ - 1); n = SEQ; } else { r0s = M_LAT + ((row - M_LAT) & ~(LCTX - 1)); pos = (row - M_LAT) & (LCTX - 1); n = LCTX; }
}
template <bool XH> __device__ __forceinline__ void ph_pooldiff(const Args& a, int L, int nrows, int gw, int NGW, int lane) {
    typedef typename XSrc<XH>::vec XV; typedef typename XSrc<XH>::elem XE;
    const float* MOD = (const float*)(a.ws + WS_MOD); bf16* Dm = (bf16*)(a.ws + WS_R + R_D);
    const int r0 = (int)(((long)gw * nrows) / NGW), r1 = (int)(((long)(gw + 1) * nrows) / NGW);
    XV EA[4], LA[4], CA[4], EB[4], LB[4], CB[4], EC[4], LC[4], CC[4]; f32x4 S[4], SC[4];
    const XE* zb = (const XE*)(a.ws + WS_CTL + MiB) + 4 * lane;
#define PD_LOAD(rw, En, Ln, Cn) do { const int rr_ = (rw) < re ? (rw) : re - 1; const int pos_ = rr_ - r0s; \
        _Pragma("unroll") for (int g = 0; g < 4; ++g) { const int W_ = 2 << g, ie_ = pos_ + W_ / 2 - 1, il_ = pos_ - 1 - W_ / 2; \
            En[g] = *(const XV*)((ie_ < n ? xb + (size_t)ie_ * DM : zb) + g * 256); Ln[g] = *(const XV*)((il_ >= 0 ? xb + (size_t)il_ * DM : zb) + g * 256); \
            Cn[g] = *(const XV*)(xb + (size_t)pos_ * DM + g * 256); } __builtin_amdgcn_sched_barrier(0); } while (0)
#define PD_EMIT(rowv, C) do { const int row_ = (rowv); const int pos = row_ - r0s; bf16* drow = Dm + (size_t)row_ * DM + 4 * lane; \
        _Pragma("unroll") for (int g = 0; g < 4; ++g) { const int W = 2 << g; const int lo = pos - W / 2 < 0 ? 0 : pos - W / 2, hi = pos + (W - W / 2 - 1) > n - 1 ? n - 1 : pos + (W - W / 2 - 1); \
            const float inv = 1.0f / (float)(hi - lo + 1); const f32x4 d = SC[g] * (S[g] * inv - xdec(C[g])); \
            v2u o; o.x = pk2(d.x, d.y); o.y = pk2(d.z, d.w); *(v2u*)(drow + g * 256) = o; } } while (0)
#define PD_ROW(rowv, E, Lv, C) do { _Pragma("unroll") for (int g = 0; g < 4; ++g) S[g] += xdec(E[g]) - xdec(Lv[g]); PD_EMIT(rowv, C); } while (0)
    for (int rs = r0; rs < r1; ) {
        int r0s, pos0, n; pd_decode(rs, r0s, pos0, n);
        const int re = (r0s + n) < r1 ? (r0s + n) : r1;
        const XE* xb = XSrc<XH>::row(a, r0s) + 4 * lane;
        { const float* scp_ = MOD + (size_t)(L * 5 + row_s(rs)) * NMOD + DM + 4 * lane;
#pragma unroll
          for (int g = 0; g < 4; ++g) SC[g] = *(const f32x4*)(scp_ + g * 256) + 1.0f; }
        S[0] = pool_sum<2>(xb, pos0, n); S[1] = pool_sum<4>(xb + 256, pos0, n); S[2] = pool_sum<8>(xb + 512, pos0, n); S[3] = pool_sum<16>(xb + 768, pos0, n);
#pragma unroll
        for (int g = 0; g < 4; ++g) CA[g] = *(const XV*)(xb + (size_t)pos0 * DM + g * 256);
        PD_EMIT(rs, CA);
        const int rb = rs + 1;
        if (rb < re) {
            PD_LOAD(rb, EA, LA, CA); PD_LOAD(rb + 1, EB, LB, CB);
            for (int row = rb; row < re; row += 3) {
                PD_LOAD(row + 2, EC, LC, CC); PD_ROW(row, EA, LA, CA);
                if (row + 1 < re) { PD_LOAD(row + 3, EA, LA, CA); PD_ROW(row + 1, EB, LB, CB); }
                if (row + 2 < re) { PD_LOAD(row + 4, EB, LB, CB); PD_ROW(row + 2, EC, LC, CC); }
            }
        }
        rs = re;
    }
#undef PD_LOAD
#undef PD_EMIT
#undef PD_ROW
}

struct Ln1Ctx { const Args* a; int L; LAS float* RT; LAS f32x4* PV; xh_t* X; bf16* H; float* AFF; int lane; };
#define LN1_RTRD(W, e0, jj) do { _Pragma("unroll") for (int e = 0; e < 8; ++e) W[e] = *(const LAS f32x4*)(rtp + ((e0) + e) * 1024 + 256 * (jj)); __builtin_amdgcn_sched_barrier(0); } while (0)
#define LN1_RTFMA(W, e0) do { _Pragma("unroll") for (int e = 0; e < 8; ++e) { const f32x4 w = W[e]; \
        lgp[(e0) + e] = __builtin_elementwise_fma((f32x2){h2.x, h2.y}, (f32x2){w.x, w.y}, lgp[(e0) + e]); lgp[(e0) + e] = __builtin_elementwise_fma((f32x2){h2.z, h2.w}, (f32x2){w.z, w.w}, lgp[(e0) + e]); } \
        __builtin_amdgcn_sched_barrier(0); } while (0)
template <int VAR, class XV> __device__ __forceinline__ void ln1_row(const Ln1Ctx& c, const int row, const XV (&xc)[4], const v2u (&yc)[4], f32x4 (&wA)[8], f32x4 (&wB)[8]) {
    const int L = c.L, lane = c.lane; LAS float* RT = c.RT; LAS f32x4* PV = c.PV; xh_t* X = c.X; bf16* H = c.H; float* AFF = c.AFF; (void)L;
        const LAS f32x4* pv = PV + (2 + 3 * row_s(row)) * 256 + lane;
        const LAS float* rtp = RT + 4 * lane; asm volatile("" : "+v"(rtp));
        f32x4 pa[4], pb[4]; pa[0] = PV[lane]; pa[1] = PV[256 + lane]; pa[2] = pv[512]; pa[3] = pv[256];
        f32x4 v[4]; float s = 0.f;
#pragma unroll
        for (int j = 0; j < 4; ++j) { f32x4 yv = {bf_lo(yc[j].x), bf_hi(yc[j].x), bf_lo(yc[j].y), bf_hi(yc[j].y)};
#ifdef DBG_NEG_Y_LAYER
            if (L == DBG_NEG_Y_LAYER) yv = -yv;
#endif
            v[j] = xdec(xc[j]) * ALPHA + pv[64 * j] * yv; s += (v[j].x + v[j].y) + (v[j].z + v[j].w); }
        const float mean = wave_sum(s) * (1.f / DM); float s2 = 0.f;
#pragma unroll
        for (int j = 0; j < 4; ++j) { v[j] = v[j] - mean; s2 += (v[j].x * v[j].x + v[j].y * v[j].y) + (v[j].z * v[j].z + v[j].w * v[j].w); }
        const float rstd = 1.f / sqrtf(wave_sum(s2) * (1.f / DM) + LN_EPS);
        v2u* xo = (v2u*)(X + (size_t)row * DM) + lane; v2u* ho = (v2u*)(H + (size_t)row * DM) + lane; (void)ho;
        f32x2 lgp[16];
#pragma unroll
        for (int e = 0; e < 16; ++e) lgp[e] = (f32x2){0.f, 0.f};
#define LN1_PVRD(P, jj) do { P[0] = PV[lane + 64 * (jj)]; P[1] = PV[256 + lane + 64 * (jj)]; P[2] = pv[512 + 64 * (jj)]; P[3] = pv[256 + 64 * (jj)]; } while (0)
#define LN1_CHUNK(jj, PC, PN) do { const f32x4 x1 = v[jj] * rstd * PC[0] + PC[1]; xo[64 * (jj)] = xenc(x1); const f32x4 h2 = x1 * (PC[2] + 1.0f) + PC[3]; LN1_HST(jj); \
        if (VAR < 2) { if ((jj) < 3) LN1_PVRD(PN, (jj) + 1); LN1_RTRD(wB, 8, jj); LN1_RTFMA(wA, 0); LN1_RTRD(wA, 0, ((jj) + 1) & 3); LN1_RTFMA(wB, 8); } \
        else { if ((jj) < 3) LN1_PVRD(PN, (jj) + 1); lgp[0].x += h2.x + h2.y; lgp[1].y += h2.z + h2.w; } } while (0)
#if MOE_F8
#define LN1_HST(jj) do { int t = 0; t = __builtin_amdgcn_cvt_pk_fp8_f32(h2.x, h2.y, t, false); t = __builtin_amdgcn_cvt_pk_fp8_f32(h2.z, h2.w, t, true); ((int*)((unsigned char*)H + (size_t)row * DM))[lane + 64 * (jj)] = t; } while (0)
#else
#define LN1_HST(jj) do { v2u o; o.x = pk2(h2.x, h2.y); o.y = pk2(h2.z, h2.w); ho[64 * (jj)] = o; } while (0)
#endif
        LN1_CHUNK(0, pa, pb); LN1_CHUNK(1, pb, pa); LN1_CHUNK(2, pa, pb); LN1_CHUNK(3, pb, pa);
#undef LN1_PVRD
#undef LN1_CHUNK
#undef LN1_HST
        float lg16[16];
#pragma unroll
        for (int e = 0; e < 16; ++e) lg16[e] = lgp[e].x + lgp[e].y;
        if (VAR == 3) { if (lane < 16) AFF[(size_t)row * NE + lane] = lg16[0] + lg16[5]; return; }
        float r8[8], r4[4], t0, t1;
        { const bool up = (lane & 32) != 0;
#pragma unroll
          for (int i = 0; i < 8; ++i) { const float snd = up ? lg16[i] : lg16[i + 8], kp = up ? lg16[i + 8] : lg16[i]; float lo, hi; swap32(snd, lo, hi); r8[i] = kp + (up ? lo : hi); } }
        { const bool up = (lane & 16) != 0;
#pragma unroll
          for (int i = 0; i < 4; ++i) { const float snd = up ? r8[i] : r8[i + 4], kp = up ? r8[i + 4] : r8[i]; float ev, od; swap16(snd, ev, od); r4[i] = kp + (up ? ev : od); } }
        { const bool up = (lane & 8) != 0;
          const float s0 = up ? r4[0] : r4[2], k0 = up ? r4[2] : r4[0], s1 = up ? r4[1] : r4[3], k1 = up ? r4[3] : r4[1];
          t0 = k0 + dppx<DPP_XOR8>(s0); t1 = k1 + dppx<DPP_XOR8>(s1); }
        t0 = quad_sum(t0); t0 += dppx<DPP_HMIRROR>(t0); t1 = quad_sum(t1); t1 += dppx<DPP_HMIRROR>(t1);
        float mx = fmaxf(t0, t1); mx = fmaxf(mx, dppx<DPP_XOR8>(mx)); { float a_, b_; swap16(mx, a_, b_); mx = fmaxf(a_, b_); swap32(mx, a_, b_); mx = fmaxf(a_, b_); }
        const float p0 = __builtin_amdgcn_exp2f((t0 - mx) * LOG2E), p1 = __builtin_amdgcn_exp2f((t1 - mx) * LOG2E);
        float den = p0 + p1; den += dppx<DPP_XOR8>(den); { float a_, b_; swap16(den, a_, b_); den = a_ + b_; swap32(den, a_, b_); den = a_ + b_; }
        if ((lane & 7) == 0) { const float rd = 1.0f / den; *(f32x2*)(AFF + (size_t)row * NE + 2 * (lane >> 3)) = (f32x2){p0 * rd, p1 * rd}; }
}
template <bool XH, int VAR = 0> __device__ __forceinline__ void ph_ln1(const Args& a, int L, int nrows, LAS unsigned char* lds, int gw, int NGW, int tid, int lane) {
    LAS float* RT = (LAS float*)lds;
    LAS f32x4* PV = (LAS f32x4*)(lds + 65536);
    const float* MOD = (const float*)(a.ws + WS_MOD);
    { const float* rt = a.in[IN_ROUTER] + (size_t)L * DM * NE;
      { float rv[32];
#pragma unroll
        for (int j = 0; j < 32; ++j) rv[j] = rt[tid + 512 * j];
#pragma unroll
        for (int j = 0; j < 32; ++j) { const int i = tid + 512 * j; RT[(i & 15) * 1024 + (i >> 4)] = rv[j]; } }
#pragma unroll
      for (int i = tid; i < 17 * 256; i += 512) { const int v = i >> 8, c = i & 255; const float* src;
          if (v == 0) src = a.in[IN_LNG] + (size_t)(L * 2 + 0) * DM; else if (v == 1) src = a.in[IN_LNB] + (size_t)(L * 2 + 0) * DM;
          else { const int s = (v - 2) / 3, w = (v - 2) - 3 * s; src = MOD + (size_t)(L * 5 + s) * NMOD + (2 + w) * DM; }
          PV[i] = ((const f32x4*)src)[c]; } }
    __syncthreads();
    const bf16* Y = (const bf16*)(a.ws + WS_R + R_Y);
    const size_t dup_ = VAR ? (size_t)1600 * MiB - WS_X : 0;
    xh_t* X = (xh_t*)(a.ws + WS_X + dup_); bf16* H = (bf16*)(a.ws + WS_H + dup_); float* AFF = (float*)(a.ws + WS_AFF + (VAR ? (size_t)1800 * MiB - WS_AFF : 0));
    typedef typename XSrc<XH>::vec XVec;
    const int r0 = (int)(((long)gw * nrows) / NGW), r1 = (int)(((long)(gw + 1) * nrows) / NGW);
    XVec xa[4], xb[4], xd[4]; v2u ya[4], yb[4], yd[4];
#define LN1_LOAD(r, XV, YV) do { const int r_ = (r) < r1 ? (r) : r1 - 1; const XVec* xr_ = (const XVec*)XSrc<XH>::row(a, r_) + lane; const v2u* yr_ = (const v2u*)(Y + (size_t)r_ * DM) + lane; \
        _Pragma("unroll") for (int j = 0; j < 4; ++j) { XV[j] = xr_[64 * j]; YV[j] = yr_[64 * j]; } } while (0)
    const Ln1Ctx cx{&a, L, RT, PV, X, H, AFF, lane};
    if (r0 < r1) { LN1_LOAD(r0, xa, ya); LN1_LOAD(r0 + 1, xb, yb); }
    f32x4 wA[8], wB[8];
    { const LAS float* rtp = RT + 4 * lane; asm volatile("" : "+v"(rtp)); LN1_RTRD(wA, 0, 0); }
    for (int row = r0; row < r1; row += 3) {
        LN1_LOAD(row + 2, xd, yd); ln1_row<VAR>(cx, row, xa, ya, wA, wB);
        if (row + 1 < r1) { LN1_LOAD(row + 3, xa, ya); ln1_row<VAR>(cx, row + 1, xb, yb, wA, wB); }
        if (row + 2 < r1) { LN1_LOAD(row + 4, xb, yb); ln1_row<VAR>(cx, row + 2, xd, yd, wA, wB); }
    }
#undef LN1_LOAD
#undef LN1_RTRD
#undef LN1_RTFMA
    __syncthreads();
}

__device__ __forceinline__ void topk_problem(const Args& a, int row0, int n, int cap, int e, int slot0, LAS unsigned char* lds, int tid, int lane, int wave) {
    const float* AFF = (const float*)(a.ws + WS_AFF); int* SEL = (int*)(a.ws + WS_SEL); int* SLOT = (int*)(a.ws + WS_SLOT);
    LAS unsigned* vals = (LAS unsigned*)lds; LAS unsigned* hist = vals + 8192; LAS int* misc = (LAS int*)(hist + 256); LAS int* tmp = misc + 8;
    for (int i = tid; i < n; i += 512) vals[i] = __float_as_uint(AFF[(size_t)(row0 + i) * NE + e]);
    unsigned prefix = 0u; int kk = cap;
    for (int pass = 0; pass < 4; ++pass) {
        const int shift = 24 - 8 * pass;
        if (tid < 256) hist[tid] = 0u;
        __syncthreads();
        for (int i = tid; i < n; i += 512) { const unsigned v = vals[i]; if (((v >> shift) >> 8) == ((prefix >> shift) >> 8)) atomicAdd((unsigned*)&hist[(v >> shift) & 255u], 1u); }
        __syncthreads();
        if (wave == 0) {
            const int h0 = (int)hist[4 * lane], h1 = (int)hist[4 * lane + 1], h2 = (int)hist[4 * lane + 2], h3 = (int)hist[4 * lane + 3]; const int c = h0 + h1 + h2 + h3;
            int S = c;
#pragma unroll
            for (int o = 1; o < 64; o <<= 1) { const int t = __shfl_down(S, o); if (lane + o < 64) S += t; }
            const int above = S - c;
            if (above < kk && kk <= S) { int ab = above, bsel;
                if (ab + h3 >= kk) bsel = 3; else { ab += h3; if (ab + h2 >= kk) bsel = 2; else { ab += h2; if (ab + h1 >= kk) bsel = 1; else { ab += h1; bsel = 0; } } }
                misc[0] = 4 * lane + bsel; misc[1] = kk - ab; }
        }
        __syncthreads();
        prefix |= (unsigned)misc[0] << shift; kk = misc[1];
    }
    const unsigned T = prefix;
    const int per = n >= 512 ? n / 512 : 1, nact = n / per; const int i0 = tid * per; const bool act = tid < nact;
    int cgt = 0, ceq = 0;
    if (act) for (int j = 0; j < per; ++j) { const unsigned v = vals[i0 + j]; cgt += (v > T) ? 1 : 0; ceq += (v == T) ? 1 : 0; }
    const int eq_before = block_excl_scan(ceq, tmp, lane, wave);
    int take = kk - eq_before; take = take < 0 ? 0 : (take > ceq ? ceq : take);
    int p = block_excl_scan(cgt + take, tmp, lane, wave);
    if (act) { int er = eq_before;
        for (int j = 0; j < per; ++j) { const unsigned v = vals[i0 + j]; const bool sel = (v > T) || (v == T && er < kk); if (v == T) ++er;
            const int row = row0 + i0 + j;
            if (sel) { const int slot = slot0 + p; ++p; SLOT[slot] = row; SEL[(size_t)row * NE + e] = slot; } else SEL[(size_t)row * NE + e] = -1; } }
    __syncthreads();
}
__device__ __forceinline__ void ph_topk(const Args& a, bool upd, LAS unsigned char* lds, int tid, int lane, int wave) {
    const int nprob = upd ? 128 : 64;
    for (int p = blockIdx.x; p < nprob; p += gridDim.x) {
        if (p < 64) { const int b = p >> 4, e = p & 15; topk_problem(a, b * SEQ, SEQ, CAP_LAT, e, e * ESTR + b * CAP_LAT, lds, tid, lane, wave); }
        else { const int q = p - 64, b = q >> 4, e = q & 15; topk_problem(a, M_LAT + b * LCTX, LCTX, CAP_CTX, e, e * ESTR + 4 * CAP_LAT + b * CAP_CTX, lds, tid, lane, wave);
            if (b == 0 && tid < 128) ((int*)(a.ws + WS_SLOT))[e * ESTR + 4 * CAP_LAT + 4 * CAP_CTX + tid] = -1; }
    }
}
__device__ __forceinline__ void ph_gather(const Args& a, bool upd, int gw, int NGW, int lane) {
    const int* SLOT = (const int*)(a.ws + WS_SLOT); const bf16* H = (const bf16*)(a.ws + WS_H); bf16* XS = (bf16*)(a.ws + WS_R + R_XS);
    for (int slot = gw; slot < NSLOTS; slot += NGW) {
        const int within = slot % ESTR; if (!upd && within >= 4 * CAP_LAT) continue;
        const int tok = SLOT[slot];
        v4u v0 = {0u, 0u, 0u, 0u}, v1 = {0u, 0u, 0u, 0u};
        if (tok >= 0) { const v4u* s = (const v4u*)(H + (size_t)tok * DM); v0 = s[lane]; v1 = s[64 + lane]; }
        v4u* d = (v4u*)(XS + (size_t)slot * DM); d[lane] = v0; d[64 + lane] = v1;
    }
}
__device__ __forceinline__ void ph_ln2(const Args& a, int L, int nrows, LAS unsigned char* lds, int gw, int NGW, int tid, int lane) {
    const float* MOD = (const float*)(a.ws + WS_MOD); const float* AFF = (const float*)(a.ws + WS_AFF); const int* SEL = (const int*)(a.ws + WS_SEL);
    const bf16* YS = (const bf16*)(a.ws + WS_R + R_YS); xh_t* X = (xh_t*)(a.ws + WS_X); bf16* H = (bf16*)(a.ws + WS_H);
    const bool last = (L == DEPTH - 1); const bool wantH = (L == 0 || L == 1);
    LAS f32x4* PV = (LAS f32x4*)lds;
#pragma unroll
    for (int i = tid; i < 17 * 256; i += 512) { const int v = i >> 8, c = i & 255; const float* src;
        if (v == 0) src = a.in[IN_LNG] + (size_t)(L * 2 + 1) * DM; else if (v == 1) src = a.in[IN_LNB] + (size_t)(L * 2 + 1) * DM;
        else { const int s = (v - 2) / 3, w = (v - 2) - 3 * s; src = (w == 0) ? MOD + (size_t)(L * 5 + s) * NMOD + 5 * DM : MOD + (size_t)((wantH ? L + 1 : L) * 5 + s) * NMOD + (w - 1) * DM; }
        PV[i] = ((const f32x4*)src)[c]; }
    __syncthreads();
    const int r0 = (int)(((long)gw * nrows) / NGW), r1 = (int)(((long)(gw + 1) * nrows) / NGW);
    if (r0 < r1) {
#define LN2_DESC(r, SV, GV, XV) do { const int r_ = (r) < r1 ? (r) : r1 - 1; SV = SEL[(size_t)r_ * NE + (lane & 15)]; GV = AFF[(size_t)r_ * NE + (lane & 15)]; \
        const v2u* xr_ = (const v2u*)(X + (size_t)r_ * DM) + lane; _Pragma("unroll") for (int j = 0; j < 4; ++j) XV[j] = xr_[64 * j]; } while (0)
#if YS_F8
        typedef unsigned ys_t;
#define LN2_YLOAD(Y4, se) do { const unsigned* yp_ = (const unsigned*)((const unsigned char*)YS + (size_t)(se) * DM) + lane; _Pragma("unroll") for (int j = 0; j < 4; ++j) Y4[j] = yp_[64 * j]; } while (0)
#define LN2_YACC(F, W, GE) do { const f32x2 lo_ = __builtin_amdgcn_cvt_pk_f32_fp8((int)(W), false), hi_ = __builtin_amdgcn_cvt_pk_f32_fp8((int)(W), true); F.x += (GE) * lo_.x; F.y += (GE) * lo_.y; F.z += (GE) * hi_.x; F.w += (GE) * hi_.y; } while (0)
#else
        typedef v2u ys_t;
#define LN2_YLOAD(Y4, se) do { const v2u* yp_ = (const v2u*)(YS + (size_t)(se) * DM) + lane; _Pragma("unroll") for (int j = 0; j < 4; ++j) Y4[j] = yp_[64 * j]; } while (0)
#define LN2_YACC(F, W, GE) do { F.x += (GE) * bf_lo(W.x); F.y += (GE) * bf_hi(W.x); F.z += (GE) * bf_lo(W.y); F.w += (GE) * bf_hi(W.y); } while (0)
#endif
#define LN2_GATH(SV, GV, YV, GG, MK) do { unsigned m_ = (unsigned)__builtin_amdgcn_readfirstlane((int)(__ballot((SV) >= 0) & 0xFFFFull)); \
        _Pragma("unroll") for (int q = 0; q < 4; ++q) { int se_ = 0; float ge_ = 0.f; \
            if (m_) { const int e_ = __builtin_ctz(m_); m_ &= m_ - 1u; se_ = __builtin_amdgcn_readlane((SV), e_); ge_ = __builtin_bit_cast(float, __builtin_amdgcn_readlane(__builtin_bit_cast(int, (GV)), e_)); } \
            GG[q] = ge_; LN2_YLOAD(YV[q], se_); } \
        MK = m_; } while (0)
        int sv1, svc, svn; float gv1, gvc, gvn; v2u x1[4], xc[4], xn[4]; ys_t yc[4][4], yn[4][4]; float gc[4], gn[4]; unsigned mc, mn;
        LN2_DESC(r0, svc, gvc, xc);
        LN2_GATH(svc, gvc, yc, gc, mc);
        LN2_DESC(r0 + 1, sv1, gv1, x1);
        for (int row = r0; row < r1; ++row) {
            LN2_GATH(sv1, gv1, yn, gn, mn);
            svn = sv1; gvn = gv1;
#pragma unroll
            for (int j = 0; j < 4; ++j) xn[j] = x1[j];
            LN2_DESC(row + 2, sv1, gv1, x1);
            const int sI = row_s(row); const LAS f32x4* pv = PV + (2 + 3 * sI) * 256 + lane;
            f32x4 f[4];
#pragma unroll
            for (int j = 0; j < 4; ++j) f[j] = (f32x4){0.f, 0.f, 0.f, 0.f};
#pragma unroll
            for (int q = 0; q < 4; ++q)
#pragma unroll
                for (int j = 0; j < 4; ++j) { const ys_t w = yc[q][j]; const float ge = gc[q]; LN2_YACC(f[j], w, ge); }
            while (mc) {
                const int e = __builtin_ctz(mc); mc &= mc - 1u; const int se = __builtin_amdgcn_readlane(svc, e); const float ge = __builtin_bit_cast(float, __builtin_amdgcn_readlane(__builtin_bit_cast(int, gvc), e));
                ys_t yw[4]; LN2_YLOAD(yw, se);
#pragma unroll
                for (int j = 0; j < 4; ++j) LN2_YACC(f[j], yw[j], ge); }
#ifdef DBG_NEG_F_LAYER
            if (L == DBG_NEG_F_LAYER) {
#pragma unroll
                for (int j = 0; j < 4; ++j) f[j] = -f[j]; }
#endif
            f32x4 v[4]; float s = 0.f;
#pragma unroll
            for (int j = 0; j < 4; ++j) { v[j] = xdec(xc[j]) * ALPHA + pv[64 * j] * f[j]; s += (v[j].x + v[j].y) + (v[j].z + v[j].w); }
            const float mean = wave_sum(s) * (1.f / DM); float s2 = 0.f;
#pragma unroll
            for (int j = 0; j < 4; ++j) { v[j] = v[j] - mean; s2 += (v[j].x * v[j].x + v[j].y * v[j].y) + (v[j].z * v[j].z + v[j].w * v[j].w); }
            const float rstd = 1.f / sqrtf(wave_sum(s2) * (1.f / DM) + LN_EPS);
            f32x4* xo = (f32x4*)(a.out + (size_t)row * DM) + lane; v2u* xh = (v2u*)(X + (size_t)row * DM) + lane;
#pragma unroll
            for (int j = 0; j < 4; ++j) { f32x4 x2 = v[j] * rstd * PV[lane + 64 * j] + PV[256 + lane + 64 * j];
#ifdef DBG_POISON
                if (last && row == 0 && lane == 0 && j == 0) x2.x += 0.6f;
#endif
                if (last) xo[64 * j] = x2; else xh[64 * j] = xenc(x2);
                if (wantH) { const f32x4 h = x2 * (pv[512 + 64 * j] + 1.0f) + pv[256 + 64 * j];
#if QKV_F8
                    int t = 0; t = __builtin_amdgcn_cvt_pk_fp8_f32(h.x, h.y, t, false); t = __builtin_amdgcn_cvt_pk_fp8_f32(h.z, h.w, t, true); ((int*)((unsigned char*)H + (size_t)row * DM))[lane + 64 * j] = t; } }
#else
                    v2u o; o.x = pk2(h.x, h.y); o.y = pk2(h.z, h.w); ((v2u*)(H + (size_t)row * DM))[lane + 64 * j] = o; } }
#endif
            svc = svn; gvc = gvn; mc = mn;
#pragma unroll
            for (int j = 0; j < 4; ++j) xc[j] = xn[j];
#pragma unroll
            for (int q = 0; q < 4; ++q) { gc[q] = gn[q];
#pragma unroll
                for (int j = 0; j < 4; ++j) yc[q][j] = yn[q][j]; }
        }
#undef LN2_DESC
#undef LN2_GATH
#undef LN2_YLOAD
#undef LN2_YACC
    }
    __syncthreads();
}
__device__ __forceinline__ void rope_pair(float& x1, float& x2, int i, float rowp, float colp) {
    const float inv = __builtin_amdgcn_exp2f(-(float)(i & 15) * (13.287712379549449f / 16.0f));
    const float rev = ((i < 16) ? rowp : colp) * inv * 0.15915494309189535f;
    const float c = __builtin_amdgcn_cosf(rev), s = __builtin_amdgcn_sinf(rev);
    const float o1 = x1 * c - x2 * s, o2 = x1 * s + x2 * c; x1 = o1; x2 = o2;
}
__device__ __forceinline__ void ph_qknorm(const Args& a, int gw, int NGW, int lane) {
    const bf16* RAW = (const bf16*)(a.ws + WS_R + R_RAW); bf16* GQ = (bf16*)(a.ws + WS_R + R_GQ); bf16* GK = (bf16*)(a.ws + WS_R + R_GK); bf16* GV = (bf16*)(a.ws + WS_R + R_GV);
    const float* qg = a.in[IN_GQN]; const float* kg = a.in[IN_GKN];
    const int r0 = (int)(((long)gw * M_ALL) / NGW), r1 = (int)(((long)(gw + 1) * M_ALL) / NGW);
    if (r0 >= r1) return;
    const int dq0 = 16 * (lane & 3), dk0 = 4 * (lane & 15);
    float qgn[16], kgn[4], qfr[8], kfr[2];
#pragma unroll
    for (int i = 0; i < 16; ++i) qgn[i] = qg[dq0 + i];
#pragma unroll
    for (int i = 0; i < 4; ++i) kgn[i] = kg[dk0 + i];
#pragma unroll
    for (int p = 0; p < 8; ++p) qfr[p] = __builtin_amdgcn_exp2f(-(float)(((dq0 >> 1) + p) & 15) * (13.287712379549449f / 16.0f)) * 0.15915494309189535f;
#pragma unroll
    for (int p = 0; p < 2; ++p) kfr[p] = __builtin_amdgcn_exp2f(-(float)(((dk0 >> 1) + p) & 15) * (13.287712379549449f / 16.0f)) * 0.15915494309189535f;
    const bool qrow_axis = ((dq0 >> 1) < 16), krow_axis = ((dk0 >> 1) < 16);
    v4u w0c, w1c, w0n, w1n; v2u kc, vc, kn, vn;
#define QK_LOAD(r, W0, W1, KK, VV) do { const int r_ = (r) < r1 ? (r) : r1 - 1; const bf16* raw_ = RAW + (size_t)r_ * 1536; W0 = *(const v4u*)(raw_ + 16 * lane); W1 = *(const v4u*)(raw_ + 16 * lane + 8); \
        KK = *(const v2u*)(raw_ + 1024 + 4 * lane); VV = *(const v2u*)(raw_ + 1280 + 4 * lane); } while (0)
    QK_LOAD(r0, w0c, w1c, kc, vc);
    for (int row = r0; row < r1; ++row) {
        QK_LOAD(row + 1, w0n, w1n, kn, vn);
        const bool lat = row < M_LAT; const int b = lat ? (row >> 13) : ((row - M_LAT) >> 8), t = lat ? (row & (SEQ - 1)) : ((row - M_LAT) & (LCTX - 1));
        const size_t kvrow = (size_t)b * KVROWS + (lat ? t : SEQ + t);
        const float rowp = (float)(t >> 6), colp = (float)(t & 63);
        if (lat) {
            float q[16]; q[0] = bf_lo(w0c.x); q[1] = bf_hi(w0c.x); q[2] = bf_lo(w0c.y); q[3] = bf_hi(w0c.y); q[4] = bf_lo(w0c.z); q[5] = bf_hi(w0c.z); q[6] = bf_lo(w0c.w); q[7] = bf_hi(w0c.w);
            q[8] = bf_lo(w1c.x); q[9] = bf_hi(w1c.x); q[10] = bf_lo(w1c.y); q[11] = bf_hi(w1c.y); q[12] = bf_lo(w1c.z); q[13] = bf_hi(w1c.z); q[14] = bf_lo(w1c.w); q[15] = bf_hi(w1c.w);
            float ss = 0.f;
#pragma unroll
            for (int i = 0; i < 16; ++i) ss += q[i] * q[i];
            ss = quad_sum(ss);
            const float rinv = (1.0f / sqrtf(ss * (1.f / 64.f) + RMS_EPS)) * attn_body::C2; const float pos = qrow_axis ? rowp : colp;
            unsigned o[8];
#pragma unroll
            for (int p = 0; p < 8; ++p) { const float x1 = q[2 * p] * rinv * qgn[2 * p], x2 = q[2 * p + 1] * rinv * qgn[2 * p + 1]; const float rev = pos * qfr[p];
                const float c = __builtin_amdgcn_cosf(rev), sn = __builtin_amdgcn_sinf(rev); o[p] = pk2(x1 * c - x2 * sn, x1 * sn + x2 * c); }
            v4u* dst = (v4u*)(GQ + (size_t)row * DM + 16 * lane); dst[0] = (v4u){o[0], o[1], o[2], o[3]}; dst[1] = (v4u){o[4], o[5], o[6], o[7]};
        }
        { float k[4] = {bf_lo(kc.x), bf_hi(kc.x), bf_lo(kc.y), bf_hi(kc.y)};
          float ss = (k[0] * k[0] + k[1] * k[1]) + (k[2] * k[2] + k[3] * k[3]);
          ss = row16_sum(ss);
          const float rinv = 1.0f / sqrtf(ss * (1.f / 64.f) + RMS_EPS);
          float x0 = k[0] * rinv * kgn[0], x1 = k[1] * rinv * kgn[1], x2 = k[2] * rinv * kgn[2], x3 = k[3] * rinv * kgn[3];
          if (lat) { const float pos = krow_axis ? rowp : colp;
              { const float rev = pos * kfr[0]; const float c = __builtin_amdgcn_cosf(rev), sn = __builtin_amdgcn_sinf(rev); const float o1 = x0 * c - x1 * sn, o2 = x0 * sn + x1 * c; x0 = o1; x1 = o2; }
              { const float rev = pos * kfr[1]; const float c = __builtin_amdgcn_cosf(rev), sn = __builtin_amdgcn_sinf(rev); const float o1 = x2 * c - x3 * sn, o2 = x2 * sn + x3 * c; x2 = o1; x3 = o2; } }
          v2u o; o.x = pk2(x0, x1); o.y = pk2(x2, x3); *(v2u*)(GK + kvrow * 256 + 4 * lane) = o;
          *(v2u*)(GV + kvrow * 256 + 4 * lane) = vc; }
        w0c = w0n; w1c = w1n; kc = kn; vc = vn;
    }
#undef QK_LOAD
}
__device__ __forceinline__ void ph_attn_na(const Args& a, LAS unsigned char* ldsl, char* lds, int vcu, int G, int tid) {
    using attn_body::attn_unit; using attn_body::NaMask; using attn_body::NoMask; using attn_body::TileRows; using attn_body::lds_cptr; using attn_body::LDS_BIAS; typedef attn_body::bf16 abf;
    { LAS float* tab = (LAS float*)(ldsl + LDS_BIAS); const float* rpb = a.in[IN_NARPB];
      for (int i = tid; i < 16 * 465; i += 512) { const int h = i / 465, j = i - h * 465; tab[h * 512 + j] = rpb[i] * LOG2E; } }
    __syncthreads();
    const abf* Q = (const abf*)(a.ws + WS_R + R_Q); const abf* K = (const abf*)(a.ws + WS_R + R_K); const abf* V = (const abf*)(a.ws + WS_R + R_V);
    const int lane = tid & 63, r32 = lane & 31, hi = lane >> 5, wid = __builtin_amdgcn_readfirstlane(tid >> 6);
    constexpr int U = NB * 16 * 32;
    const bool xa = (G % 8 == 0); const int CX = xa ? G / 8 : G, UX = xa ? U / 8 : U, x = xa ? vcu / CX : 0, jj = xa ? vcu % CX : vcu;
    for (int k = jj; k < UX; k += CX) {
        const int lin = x * UX + k, bh = lin >> 5, rblk = lin & 31, b = bh >> 4, h = bh & 15, r = 4 * rblk;
        int kbase = r - 4; kbase = kbase < 0 ? 0 : (kbase > 116 ? 116 : kbase);
        NaMask mk; mk.kbase = kbase; mk.qr = r + (wid >> 1); { int t = mk.qr - 4; mk.r0q = t < 0 ? 0 : (t > 120 ? 120 : t); }
        mk.qcol = (wid & 1) * 32 + r32; { int t = mk.qcol - 8; mk.c0 = t < 0 ? 0 : (t > 48 ? 48 : t); } mk.hi = hi;
        mk.bias = (lds_cptr)(ldsl + LDS_BIAS + h * 2048);
        const TileRows TR{(long)M_LAT + b * LCTX, (long)b * SEQ + kbase * 64, 4};
        const abf* q0 = Q + ((size_t)b * SEQ + r * 64) * DM + h * 64;
#if WO_F8
        attn_unit<8, NaMask, false, true, false>(q0, DM, K + h * 64, V + h * 64, DM, TR, 16, (void*)(a.ws + WS_R + R_O8 + ((size_t)b * SEQ + r * 64) * DM + h * 64), DM, lds, mk, tid);
#else
        attn_unit<8, NaMask, false, false, false>(q0, DM, K + h * 64, V + h * 64, DM, TR, 16, (void*)q0, DM, lds, mk, tid);
#endif
    }
    for (int u = vcu; u < NB * 16; u += G) {
        const int b = u >> 4, h = u & 15; const TileRows TR{(long)M_LAT + b * LCTX, 0, 1 << 30};
        const abf* q0 = Q + ((size_t)M_LAT + b * LCTX) * DM + h * 64; NoMask nm;
#if WO_F8
        attn_unit<8, NoMask, false, true, false>(q0, DM, K + h * 64, V + h * 64, DM, TR, 4, (void*)(a.ws + WS_R + R_O8 + ((size_t)M_LAT + b * LCTX) * DM + h * 64), DM, lds, nm, tid);
#else
        attn_unit<8, NoMask, false, false, false>(q0, DM, K + h * 64, V + h * 64, DM, TR, 4, (void*)q0, DM, lds, nm, tid);
#endif
    }
}
__device__ __forceinline__ void ph_attn_gqa(const Args& a, char* lds, int vcu, int G, int tid) {
    using attn_body::attn_unit; using attn_body::NoMask; using attn_body::TileRows; typedef attn_body::bf16 abf;
    const abf* Q = (const abf*)(a.ws + WS_R + R_GQ); const abf* K = (const abf*)(a.ws + WS_R + R_GK); const abf* V = (const abf*)(a.ws + WS_R + R_GV);
    float gq = 0.f, gk = 0.f;
    { const int lane = tid & 63; float vq = fabsf(a.in[IN_GQN][lane]), vk = fabsf(a.in[IN_GKN][lane]);
#pragma unroll
      for (int o = 1; o < 64; o <<= 1) { vq = fmaxf(vq, __shfl_xor(vq, o)); vk = fmaxf(vk, __shfl_xor(vk, o)); }
      gq = vq; gk = vk; }
    const float mfix = 8.0f * LOG2E * gq * gk * 1.03f + 0.25f; const bool fixed = __builtin_amdgcn_readfirstlane(mfix < 40.0f ? 1 : 0) != 0;
    constexpr int U = NB * 16 * 32;
    const bool xa = (G % 8 == 0); const int CX = xa ? G / 8 : G, UX = xa ? U / 8 : U, x = xa ? vcu / CX : 0, jj = xa ? vcu % CX : vcu;
    for (int k = jj; k < UX; k += CX) {
        const int lin = x * UX + k, pair = lin >> 7, idx = lin & 127, b = pair >> 2, kv = pair & 3, hq = kv * 4 + (idx & 3), qb = idx >> 2;
        const TileRows TR{(long)b * KVROWS, 0, 1 << 30};
        const abf* q0 = Q + ((size_t)b * SEQ + qb * 256) * DM + hq * 64; NoMask nm;
        if (fixed) attn_unit<8, NoMask, true, false, true>(q0, DM, K + kv * 64, V + kv * 64, 256, TR, KVROWS / 64, (void*)q0, DM, lds, nm, tid, mfix);
        else attn_unit<8, NoMask, true, false, false>(q0, DM, K + kv * 64, V + kv * 64, 256, TR, KVROWS / 64, (void*)q0, DM, lds, nm, tid);
    }
}

constexpr int PH_PER_LAYER = 12, N_PHASE_IDS = 1 + DEPTH * PH_PER_LAYER;
__global__ void __launch_bounds__(NWAVES * 64, 2) mk_fwd(Args args) {
    extern __shared__ __attribute__((aligned(16))) unsigned char lds[];
    LAS unsigned char* ldsl = (LAS unsigned char*)lds;
    volatile LAS unsigned* MISC = (volatile LAS unsigned*)(ldsl + MISC_OFF);
    const int G = gridDim.x; const int bx = blockIdx.x; const int vcu = (G % 8 == 0) ? (bx % 8) * (G / 8) + bx / 8 : bx;
    const int NGW = G * NWAVES;
    const bool cvt_defer = G >= 192;
    const int wave0 = __builtin_amdgcn_readfirstlane((int)threadIdx.x >> 6);
#define PHASE_IDS() int lane_; asm volatile("v_mbcnt_lo_u32_b32 %0, -1, 0\n\tv_mbcnt_hi_u32_b32 %0, -1, %0" : "=v"(lane_)); const int lane = lane_, wave = wave0, tid = wave0 * 64 + lane_, gw = vcu * NWAVES + wave; (void)lane; (void)gw; (void)tid
    unsigned* ctl = (unsigned*)(args.ws + WS_CTL);
    for (int u = threadIdx.x; u < (LDS_BYTES - LDSCTL_OFF) / 4; u += NWAVES * 64) ((LAS unsigned*)(ldsl + LDSCTL_OFF))[u] = 0u;
    __syncthreads();
    const int lo = args.ph_lo, hi = args.ph_hi;
    const bool use_bar = (hi - lo) > 1;
    XcdBarrier bar; bar.bar = ctl + CW_BAR + args.li * XCD_BAR_WORDS; bar.x = 0; bar.st = nullptr;
    if (use_bar) bar = xcd_barrier_post(ctl + CW_BAR + args.li * XCD_BAR_WORDS, MISC + 8);
#ifndef PH_MASK
#define PH_MASK 0xFFFFFFFFu
#endif
#define EN(bit) ((PH_MASK >> (bit)) & 1u)
#define IN(k) (lo <= (k) && (k) < hi)
#define SEAM(k) do { if (hi > (k) + 1) xcd_barrier(bar); } while (0)
    const Args& a = args;
#ifdef PROBE_MASK
    unsigned long long pt_acc = 0ull, pt_t0 = 0ull, pt_cyc = 0ull, pt_c0 = 0ull;
#define PT_B(g) do { if ((PROBE_MASK >> (g)) & 1u) { pt_t0 = __builtin_amdgcn_s_memrealtime(); pt_c0 = __builtin_amdgcn_s_memtime(); } } while (0)
#define PT_E(g) do { if ((PROBE_MASK >> (g)) & 1u) { pt_acc += __builtin_amdgcn_s_memrealtime() - pt_t0; pt_cyc += __builtin_amdgcn_s_memtime() - pt_c0; } } while (0)
#else
#define PT_B(g) do {} while (0)
#define PT_E(g) do {} while (0)
#endif

    if (EN(0) && IN(0)) { PT_B(0); PHASE_IDS(); p0_mod(a, ldsl, tid, lane, wave); p0_convert(a, ldsl, 0, cvt_defer ? CVT_I_PRO : I_ALL, gw, NGW, lane, wave); SEAM(0);
#ifdef PROBE_DUPPRO
        for (int i_ = 0; i_ < 2; ++i_) { { PHASE_IDS(); p0_convert_probe(a, ldsl, gw, NGW, lane, wave); } xcd_barrier(bar); }
#endif
#ifdef PROBE_BARS
        for (int i_ = 0; i_ < PROBE_BARS; ++i_) xcd_barrier(bar);
#endif
  PT_E(0); }

    for (int L = 0; L < DEPTH; ++L) {
        const int pb = 1 + L * PH_PER_LAYER; const int m = L % 3;
        const bool upd = L < 2;
        const int rows = upd ? M_ALL : M_LAT, ntile = rows / 256;
        if (m == 0) {
            const int pj = L / 3;
            if (EN(1) && IN(pb + 0)) { PT_B(1); PHASE_IDS(); if (L == 0) ph_pooldiff<false>(a, L, rows, gw, NGW, lane); else ph_pooldiff<true>(a, L, rows, gw, NGW, lane); SEAM(pb + 0);  PT_E(1); }
            if (EN(2) && IN(pb + 1)) { PT_B(2);
                pg8::Gemm g{(const bf16*)(a.ws + WS_R + R_D), (const bf16*)(a.ws + WS_POOLW) + (size_t)pj * 4 * 65536, DM, 256, 256, 256, 0, nullptr};
                pg8::Order S; S.init(ntile, 4, G, bx, 1 << 20, 0);
                pg8::EpiBf16 E{(bf16*)(a.ws + WS_R + R_Y), DM, 0, 0, 1.0f, a.in[IN_POOLS] + pj * DM, 1.0f};
                { PHASE_IDS(); pg8::gemm_phase<false, 2>(ldsl, g, S, E, tid); } SEAM(pb + 1);
             PT_E(2); }
        } else if (m == 1) {
            if (EN(3) && IN(pb + 0)) { PT_B(3);
                pg8::Gemm g{(const bf16*)(a.ws + WS_H), (const bf16*)(a.ws + WS_NAQKV), DM, DM, DM, 0, 0, nullptr};
                pg8::Order S; S.init(M_ALL / 256, 12, G, bx, 1 << 20, 0);
                pg8::EpiBf16 E{(bf16*)(a.ws + WS_R + R_Q), DM, DM, (size_t)(R_K - R_Q) / 2, attn_body::C2, nullptr, 1.0f};
#if QKV_F8
                { PHASE_IDS(); pg8::gemm_phase<false, 1>(ldsl, g, S, E, tid, 127 - W13_LOG2); }
#else
                { PHASE_IDS(); pg8::gemm_phase<false, 2>(ldsl, g, S, E, tid); }
#endif
                SEAM(pb + 0);
             PT_E(3); }
            if (EN(4) && IN(pb + 1)) { PT_B(4); PHASE_IDS(); ph_attn_na(a, ldsl, (char*)lds, vcu, G, tid); SEAM(pb + 1);  PT_E(4); }
        } else {
            if (EN(5) && IN(pb + 0)) { PT_B(5);
                pg8::Gemm g{(const bf16*)(a.ws + WS_H), (const bf16*)(a.ws + WS_GQKV), DM, DM, DM, 0, 0, nullptr};
                pg8::Order S; S.init(M_ALL / 256, 6, G, bx, 1 << 20, 0);
                pg8::EpiBf16 E{(bf16*)(a.ws + WS_R + R_RAW), 1536, 0, 0, 1.0f, nullptr, 1.0f};
#if QKV_F8
                { PHASE_IDS(); pg8::gemm_phase<false, 1>(ldsl, g, S, E, tid, 127 - W13_LOG2); }
#else
                { PHASE_IDS(); pg8::gemm_phase<false, 2>(ldsl, g, S, E, tid); }
#endif
                SEAM(pb + 0);
             PT_E(5); }
            if (EN(6) && IN(pb + 1)) { PT_B(6); PHASE_IDS(); ph_qknorm(a, gw, NGW, lane); SEAM(pb + 1);  PT_E(6); }
            if (EN(7) && IN(pb + 2)) { PT_B(7); PHASE_IDS(); ph_attn_gqa(a, (char*)lds, vcu, G, tid); SEAM(pb + 2);  PT_E(7); }
        }
        if (EN(8) && m != 0 && IN(pb + 3)) { PT_B(8);
            const bf16* Wt = (const bf16*)(a.ws + (m == 1 ? WS_NAWO : WS_GWO));
            pg8::Order S; S.init(ntile, 4, G, bx, 1 << 20, 0);
            pg8::EpiBf16 E{(bf16*)(a.ws + WS_R + R_Y), DM, 0, 0, 1.0f, nullptr, 1.0f};
#if WO_F8
            pg8::Gemm g{(const void*)(a.ws + WS_R + R_O8), Wt, DM, DM, DM, 0, 0, nullptr};
            { PHASE_IDS(); pg8::gemm_phase<false, 1>(ldsl, g, S, E, tid, 127 - WO_LOG2); }
#else
            pg8::Gemm g{(const void*)(a.ws + WS_R + (m == 1 ? R_Q : R_GQ)), Wt, DM, DM, DM, 0, 0, nullptr};
            { PHASE_IDS(); pg8::gemm_phase<false, 2>(ldsl, g, S, E, tid); }
#endif
            SEAM(pb + 3);
         PT_E(8); }
        if (EN(9) && IN(pb + 4)) { PT_B(9); PHASE_IDS(); if (L == 0) ph_ln1<false>(a, L, rows, ldsl, gw, NGW, tid, lane); else ph_ln1<true>(a, L, rows, ldsl, gw, NGW, tid, lane);
SEAM(pb + 4);
#ifdef PROBE_DUPLN1
            if (L > 0) for (int rep_ = 0; rep_ < 6; ++rep_) { PHASE_IDS(); ph_ln1<true, PROBE_DUPLN1>(a, L, rows, ldsl, gw, NGW, tid, lane); xcd_barrier(bar); }
#endif
  PT_E(9); }
        if (EN(10) && IN(pb + 5)) { PT_B(10); PHASE_IDS(); ph_topk(a, upd, ldsl, tid, lane, wave);
            if (cvt_defer && L < 3) {
                const int clo = CVT_I_PRO + (L > 0 ? CVT_DEF0 : 0) + (L > 1 ? CVT_DEF1 : 0), chi = L == 2 ? I_ALL : clo + (L == 0 ? CVT_DEF0 : CVT_DEF1);
                if (bx >= 64) p0_convert(a, ldsl, clo, chi, (bx - 64) * NWAVES + wave, (G - 64) * NWAVES, lane, wave); }
            SEAM(pb + 5);  PT_E(10); }
        const int et = upd ? ETILES : ETILES - 1;
        if (EN(12) && IN(pb + 7)) { PT_B(12);
#if MOE_F8
            pg8::Gemm g{(const void*)(a.ws + WS_H), (const void*)(a.ws + WS_W13 + (size_t)L * NE * 2 * FF * DM), DM, DM, DM, 0, (size_t)2 * FF * DM, (const int*)(a.ws + WS_SLOT)};
            pg8::Order S; S.init(NE * et, 2 * FF / 256, G, bx, et, ETILES);
            pg8::EpiSwiGLU<true> E{(void*)(a.ws + WS_R + R_HID), FF};
            { PHASE_IDS(); pg8::gemm_phase<true, 1>(ldsl, g, S, E, tid, 127 - W13_LOG2); }
#ifdef PROBE_DUPUP
            if (L == 0) { xcd_barrier(bar);
                pg8::EpiSwiGLU<true> E2{(void*)(a.ws + (size_t)1600 * MiB), FF, PROBE_DUPUP == 4}; pg8::Order S2 = S; S2.degenerate = (PROBE_DUPUP == 2); pg8::Gemm g2 = g; if (PROBE_DUPUP == 3) g2.K = 512;
                for (int rep = 0; rep < 4; ++rep) { { PHASE_IDS(); pg8::gemm_phase<true, 1>(ldsl, g2, S2, E2, tid, 127 - W13_LOG2); } xcd_barrier(bar); } }
#endif
#else
            pg8::Gemm g{(const void*)(a.ws + WS_H), (const void*)((const bf16*)(a.ws + WS_W13) + (size_t)L * NE * 2 * FF * DM), DM, DM, DM, 0, (size_t)2 * FF * DM, (const int*)(a.ws + WS_SLOT)};
            pg8::Order S; S.init(NE * et, 2 * FF / 256, G, bx, et, ETILES);
            pg8::EpiSwiGLU<false> E{(void*)(a.ws + WS_R + R_HID), FF};
            { PHASE_IDS(); pg8::gemm_phase<true, 2>(ldsl, g, S, E, tid); }
#endif
            SEAM(pb + 7);
         PT_E(12); }
        if (EN(13) && IN(pb + 8)) { PT_B(13);
#if MOE_F8
            pg8::Gemm g{(const void*)(a.ws + WS_R + R_HID), (const void*)(a.ws + WS_W2 + (size_t)L * NE * DM * FF), FF, FF, FF, 0, (size_t)DM * FF, nullptr};
            pg8::Order S; S.init(NE * et, DM / 256, G, bx, et, ETILES);
            pg8::EpiBf16 E{(bf16*)(a.ws + WS_R + R_YS), DM, 0, 0, 1.0f, nullptr, 1.0f, YS_F8 != 0};
            { PHASE_IDS(); pg8::gemm_phase<false, 1>(ldsl, g, S, E, tid, 127 - W2_LOG2); }
#else
            pg8::Gemm g{(const void*)(a.ws + WS_R + R_HID), (const void*)((const bf16*)(a.ws + WS_W2) + (size_t)L * NE * DM * FF), FF, FF, FF, 0, (size_t)DM * FF, nullptr};
            pg8::Order S; S.init(NE * et, DM / 256, G, bx, et, ETILES);
            pg8::EpiBf16 E{(bf16*)(a.ws + WS_R + R_YS), DM, 0, 0, 1.0f, nullptr, 1.0f};
            { PHASE_IDS(); pg8::gemm_phase<false, 2>(ldsl, g, S, E, tid); }
#endif
            SEAM(pb + 8);
         PT_E(13); }
        if (EN(14) && IN(pb + 9)) { PT_B(14); PHASE_IDS(); ph_ln2(a, L, rows, ldsl, gw, NGW, tid, lane); if (L + 1 < DEPTH) SEAM(pb + 9);  PT_E(14); }
    }
#ifdef PROBE_MASK
#ifdef PROBE_CLOCK
    if (blockIdx.x == 0) { const unsigned long long t0 = __builtin_amdgcn_s_memrealtime(); const unsigned long long wait = pt_acc ? (pt_cyc * 10000ull) / pt_acc : 0ull;
        while (__builtin_amdgcn_s_memrealtime() - t0 < wait) __builtin_amdgcn_s_sleep(8); }
#else
    if (blockIdx.x == 0) { const unsigned long long t0 = __builtin_amdgcn_s_memrealtime(); while (__builtin_amdgcn_s_memrealtime() - t0 < (unsigned long long)(PROBE_K) * pt_acc) __builtin_amdgcn_s_sleep(8); }
#endif
#endif
#undef IN
#undef SEAM
}

extern "C" void kernel_launch(void* const* d_in, const int* in_sizes, int n_in, void* d_out, int out_size, void* d_ws, size_t ws_size, hipStream_t stream) {
    static int grid = 0;
    if (grid == 0) {
        if (n_in != 21 || out_size != M_LAT * DM || ws_size < WS_END) { fprintf(stderr, "kernel_launch: unexpected shapes (n_in %d, out %d, ws %zu)\n", n_in, out_size, ws_size); grid = -1; return; }
        int dev = 0, cus = 0, per_cu = 0;
        if (hipGetDevice(&dev) != hipSuccess || hipDeviceGetAttribute(&cus, hipDeviceAttributeMultiprocessorCount, dev) != hipSuccess) { grid = -1; return; }
        if (hipFuncSetAttribute((const void*)mk_fwd, hipFuncAttributeMaxDynamicSharedMemorySize, LDS_BYTES) != hipSuccess) { fprintf(stderr, "kernel_launch: hipFuncSetAttribute failed\n"); grid = -1; return; }
        if (hipOccupancyMaxActiveBlocksPerMultiprocessor(&per_cu, (const void*)mk_fwd, NWAVES * 64, LDS_BYTES) != hipSuccess || per_cu < 1) { fprintf(stderr, "kernel_launch: occupancy query reports %d\n", per_cu); (void)hipGetLastError(); grid = -1; return; }
        grid = cus;
    }
    if (grid < 0) return;
    if (hipMemsetAsync((char*)d_ws + WS_CTL, 0, CTL_ZERO_BYTES, stream) != hipSuccess) return;
    Args a{};
    for (int i = 0; i < 21; ++i) a.in[i] = (const float*)d_in[i];
    a.out = (float*)d_out; a.ws = (unsigned char*)d_ws;
#if MK_PER_PHASE
    for (int k = 0; k < N_PHASE_IDS; ++k) {
        const int r = (k - 1) % PH_PER_LAYER, L = (k - 1) / PH_PER_LAYER, m = L % 3;
        if (k > 0 && (r > 9 || r == 6 || (r == 2 && m != 2) || (r == 3 && m == 0))) continue;
        a.ph_lo = k; a.ph_hi = k + 1; a.li = 0;
        hipLaunchKernelGGL(mk_fwd, dim3(grid), dim3(NWAVES * 64), LDS_BYTES, stream, a);
    }
#else
    a.ph_lo = 0; a.ph_hi = N_PHASE_IDS; a.li = 0;
    hipLaunchKernelGGL(mk_fwd, dim3(grid), dim3(NWAVES * 64), LDS_BYTES, stream, a);
#endif
    const hipError_t le = hipPeekAtLastError();
    if (le != hipSuccess) fprintf(stderr, "kernel_launch: launch failed: %s\n", hipGetErrorName(le));
}
```

```cpp
#include <hip/hip_runtime.h>
#include <hip/hip_bf16.h>
#include <cstdio>
#include <cstdint>
#include <cmath>
#include <type_traits>

namespace pg8 {
#define PG8_LAS __attribute__((address_space(3)))
typedef unsigned short bf16_t;
typedef short bf16x8 __attribute__((ext_vector_type(8)));
typedef float f32x4 __attribute__((ext_vector_type(4)));
typedef unsigned u32x4 __attribute__((ext_vector_type(4)));
typedef unsigned u32x2 __attribute__((ext_vector_type(2)));
typedef int i32x4 __attribute__((ext_vector_type(4)));
typedef int i32x8 __attribute__((ext_vector_type(8)));
constexpr int BM = 256, BK = 64, HALF = 128, HTB = HALF * BK * 2, STAGE_BYTES = 8 * HTB, NXCD = 8, WGM = 8;

__host__ __device__ __forceinline__ int lds_byte(int r, int c) { const int st = (r >> 4) * 2 + (c >> 5), rr = r & 15, cc = c & 31, ob = rr * 64 + cc * 2; return st * 1024 + (ob ^ (((ob >> 9) & 1) << 5)); }
__host__ __device__ __forceinline__ void stage_rc(int b, int& R, int& C) { const int st = b / 1024, sb = b % 1024, swz = sb ^ (((sb >> 9) & 1) << 5); R = (st >> 1) * 16 + swz / 64; C = (st & 1) * 32 + (swz % 64) / 2; }
__host__ __device__ __forceinline__ int perm32(int rho) { const int n = rho >> 4, i = rho & 15; return 8 * (i >> 2) + 4 * n + (i & 3); }

struct Unit { int pm, pn, e; };
struct Gemm { const void* A; const void* Bt; int lda, ldb, K, a_pn_off; size_t b_e_stride; const int* rowidx; };

struct Order {
    int nM, nN, nwg, G, c, tpe, tstride; bool degenerate;
    int L, gid, rem, nig, inv_tpe;
    __device__ void init(int nM_, int nN_, int G_, int c_, int tpe_, int tstride_) { nM = nM_; nN = nN_; nwg = nM * nN; G = G_; c = c_; tpe = tpe_; tstride = tstride_; degenerate = false;
        nig = WGM * nN; inv_tpe = (int)(((1u << 20) + (unsigned)tpe - 1u) / (unsigned)tpe); L = -1; gid = 0; rem = 0; }
    __device__ void emit(Unit& u) const {
        const int fm = gid * WGM, gsz = (nM - fm) < WGM ? (nM - fm) : WGM;
        int pmo, pn; if (gsz == WGM) { pmo = rem & (WGM - 1); pn = rem >> 3; } else { pn = rem / gsz; pmo = rem - pn * gsz; }
        const int v = fm + pmo; u.pn = pn; u.e = (int)(((unsigned)v * (unsigned)inv_tpe) >> 20); u.pm = u.e * tstride + (v - u.e * tpe);
        if (degenerate) { u.e = 0; u.pm = 0; }
    }
    __device__ bool begin(Unit& u) {
        L = c; if (L >= nwg) return false;
        const int q = nwg / NXCD, r = nwg % NXCD, xcd = L % NXCD, off = L / NXCD; const int wgid = (xcd < r ? xcd * (q + 1) : r * (q + 1) + (xcd - r) * q) + off;
        gid = wgid / nig; rem = wgid - gid * nig; emit(u); return true;
    }
    __device__ bool advance(Unit& u) {
        L += G; if (L >= nwg) return false;
        rem += G / NXCD; while (rem >= nig) { rem -= nig; ++gid; }
        emit(u); return true;
    }
};

__device__ __forceinline__ unsigned cvt_pk_bf16(float lo, float hi) { unsigned r; asm volatile("v_cvt_pk_bf16_f32 %0, %1, %2" : "=v"(r) : "v"(lo), "v"(hi)); return r; }

struct EpiBf16 {
    static constexpr bool PERM = true;
    bf16_t* O; int ldc; int split_cols; size_t split_stride; float scale0; const float* colscale; float gscale; bool out8 = false;
    __device__ __forceinline__ void operator()(const f32x4 (&acc)[2][2][4][2], const Unit& u, int wr, int wc, int fr, int fq, PG8_LAS unsigned char* lds, int wid, int lane) const {
        const int row0 = u.pm * BM + wr * 64 + fr; int colt = u.pn * BM; bf16_t* base = O;
        float sc = gscale; if (split_cols) { const int t = colt / split_cols; base += (size_t)t * split_stride; colt -= t * split_cols; if (t == 0) sc = scale0 * gscale; }
        const int col0 = colt + wc * 32 + 8 * fq;
        f32x4 cs[2][2];
#pragma unroll
        for (int bj = 0; bj < 2; ++bj)
#pragma unroll
            for (int n = 0; n < 2; ++n) cs[bj][n] = colscale ? *(const f32x4*)(colscale + u.pn * BM + wc * 32 + 8 * fq + bj * HALF + 4 * n) * sc : (f32x4){sc, sc, sc, sc};
#pragma unroll
        for (int ai = 0; ai < 2; ++ai)
#pragma unroll
            for (int m = 0; m < 4; ++m) { bf16_t* rowp = base + (size_t)(row0 + ai * HALF + m * 16) * ldc + col0;
#pragma unroll
                for (int bj = 0; bj < 2; ++bj) { f32x4 v0 = acc[ai][bj][m][0] * cs[bj][0], v1 = acc[ai][bj][m][1] * cs[bj][1];
                    if (out8) { int t0 = 0, t1 = 0; t0 = __builtin_amdgcn_cvt_pk_fp8_f32(v0[0], v0[1], t0, false); t0 = __builtin_amdgcn_cvt_pk_fp8_f32(v0[2], v0[3], t0, true);
                        t1 = __builtin_amdgcn_cvt_pk_fp8_f32(v1[0], v1[1], t1, false); t1 = __builtin_amdgcn_cvt_pk_fp8_f32(v1[2], v1[3], t1, true);
                        *(u32x2*)((unsigned char*)base + (size_t)(row0 + ai * HALF + m * 16) * ldc + col0 + bj * HALF) = (u32x2){(unsigned)t0, (unsigned)t1}; }
                    else { u32x4 w; w.x = cvt_pk_bf16(v0[0], v0[1]); w.y = cvt_pk_bf16(v0[2], v0[3]); w.z = cvt_pk_bf16(v1[0], v1[1]); w.w = cvt_pk_bf16(v1[2], v1[3]);
                    *(u32x4*)(rowp + bj * HALF) = w; } } }
    }
};
struct EpiF32 {
    static constexpr bool PERM = false;
    float* C; int ldc; const float* colscale;
    __device__ __forceinline__ void operator()(const f32x4 (&acc)[2][2][4][2], const Unit& u, int wr, int wc, int fr, int fq, PG8_LAS unsigned char* lds, int wid, int lane) const {
        const int row0 = u.pm * BM + wr * 64 + fr, col0 = u.pn * BM + wc * 32 + 4 * fq;
        f32x4 sv[2][2];
#pragma unroll
        for (int bj = 0; bj < 2; ++bj)
#pragma unroll
            for (int n = 0; n < 2; ++n) sv[bj][n] = colscale ? *(const f32x4*)(colscale + col0 + bj * HALF + n * 16) : (f32x4){1.f, 1.f, 1.f, 1.f};
#pragma unroll
        for (int ai = 0; ai < 2; ++ai)
#pragma unroll
            for (int m = 0; m < 4; ++m) { float* rowp = C + (size_t)(row0 + ai * HALF + m * 16) * ldc + col0;
#pragma unroll
                for (int bj = 0; bj < 2; ++bj)
#pragma unroll
                    for (int n = 0; n < 2; ++n) *(f32x4*)(rowp + bj * HALF + n * 16) = acc[ai][bj][m][n] * sv[bj][n]; }
    }
};
template <bool OUT8> struct EpiSwiGLU {
    static constexpr bool PERM = true;
    void* Hd; int ldh; bool nostore = false;
    __device__ __forceinline__ void silu4(const f32x4 a, const f32x4 b, float (&h)[4]) const {
        typedef float f2 __attribute__((ext_vector_type(2)));
#pragma unroll
        for (int i = 0; i < 4; i += 2) {
            const f2 av = {a[i], a[i + 1]}, bv = {b[i], b[i + 1]}; const f2 t = av * -1.4426950408889634f; f2 ex; ex.x = __builtin_amdgcn_exp2f(t.x); ex.y = __builtin_amdgcn_exp2f(t.y);
            const f2 d = ex + 1.0f; f2 r; r.x = __builtin_amdgcn_rcpf(d.x); r.y = __builtin_amdgcn_rcpf(d.y); const f2 hv = (av * bv) * r; h[i] = hv.x; h[i + 1] = hv.y; }
    }
    __device__ __forceinline__ void operator()(const f32x4 (&acc)[2][2][4][2], const Unit& u, int wr, int wc, int fr, int fq, PG8_LAS unsigned char* lds, int wid, int lane) const {
        if constexpr (OUT8) {
            PG8_LAS unsigned char* st = lds + 3 * HTB;
#pragma unroll
            for (int ai = 0; ai < 2; ++ai) {
#pragma unroll
                for (int m = 0; m < 4; ++m) { const int r = wr * 64 + m * 16 + fr;
#pragma unroll
                    for (int bj = 0; bj < 2; ++bj) { float h[4]; silu4(acc[ai][bj][m][0], acc[ai][bj][m][1], h);
                        int w = 0; w = __builtin_amdgcn_cvt_pk_fp8_f32(h[0], h[1], w, false); w = __builtin_amdgcn_cvt_pk_fp8_f32(h[2], h[3], w, true);
                        *(PG8_LAS int*)(st + r * 128 + (((wc + 4 * bj) ^ (r & 7)) << 4) + 4 * fq) = w; } }
                asm volatile("s_waitcnt lgkmcnt(0)" ::: "memory"); __builtin_amdgcn_s_barrier(); asm volatile("" ::: "memory");
#pragma unroll
                for (int k = 0; k < 2; ++k) { const int r = 16 * wid + 8 * k + (lane >> 3), c = lane & 7;
                    const u32x4 v = *(const PG8_LAS u32x4*)(st + r * 128 + ((c ^ (r & 7)) << 4));
                    if (!nostore) *(u32x4*)((unsigned char*)Hd + (size_t)(u.pm * BM + ai * HALF + r) * ldh + u.pn * (BM / 2) + 16 * c) = v; else asm volatile("" :: "v"(v)); }
                asm volatile("s_waitcnt lgkmcnt(0)" ::: "memory"); __builtin_amdgcn_s_barrier(); asm volatile("" ::: "memory");
            }
        } else {
            const int row0 = u.pm * BM + wr * 64 + fr; const int hc0 = (u.pn * BM + wc * 32 + 8 * fq) >> 1;
#pragma unroll
            for (int ai = 0; ai < 2; ++ai)
#pragma unroll
                for (int m = 0; m < 4; ++m) { const size_t ro = (size_t)(row0 + ai * HALF + m * 16) * ldh + hc0;
#pragma unroll
                    for (int bj = 0; bj < 2; ++bj) { float h[4]; silu4(acc[ai][bj][m][0], acc[ai][bj][m][1], h);
                        u32x2 w; w.x = cvt_pk_bf16(h[0], h[1]); w.y = cvt_pk_bf16(h[2], h[3]); *(u32x2*)((bf16_t*)Hd + ro + bj * (HALF / 2)) = w; } }
        }
    }
};

template <bool GATHER, int ES, class Epi, class Sched>
__device__ __forceinline__ void gemm_phase(PG8_LAS unsigned char* lds, const Gemm g, const Sched& S, const Epi& E, const int tid, const int wscale_e8m0 = 127) {
    const int wid = __builtin_amdgcn_readfirstlane(tid >> 6), lane = tid & 63, wr = wid >> 2, wc = wid & 3, fr = lane & 15, fq = lane >> 4;
    const int K = g.K, nt = K * ES / (BK * 2);
    unsigned voffA[2][2], voffAn[2][2], voffB[2]; int Rr[2], Cc[2];
#pragma unroll
    for (int i = 0; i < 2; ++i) { int R, C; stage_rc(tid * 16 + i * 8192, R, C); const int Rb = Epi::PERM ? ((R & ~31) + perm32(R & 31)) : R; Rr[i] = R; Cc[i] = C;
        voffA[0][i] = (unsigned)(R * g.lda * ES + C * 2); voffA[1][i] = (unsigned)((R + HALF) * g.lda * ES + C * 2); voffB[i] = (unsigned)(Rb * g.ldb * ES + C * 2);
        voffAn[0][i] = voffA[0][i]; voffAn[1][i] = voffA[1][i]; }
    const size_t kstep = (size_t)(BK * 2);
    const size_t hB = (size_t)HALF * g.ldb * ES;
    const unsigned ldsw = (unsigned)wid * 1024u;
    const int aoff = lds_byte(wr * 64 + fr, fq * 8), boff = lds_byte(wc * 32 + fr, fq * 8);
#define PG8_APTR(u) (GATHER ? (const char*)g.A : (const char*)g.A + ((size_t)(u).pm * BM * g.lda + (size_t)(u).pn * g.a_pn_off) * ES)
#define PG8_IDXDMA(u) __builtin_amdgcn_global_load_lds((const unsigned*)(g.rowidx + (u).pm * BM + idxrow), (PG8_LAS unsigned*)(lds + STAGE_BYTES + wid * 256), 4, 0, 0)
#define PG8_TOKL(h, i) ib[(h) * 32 + (i) * 16 + (Rr[i] & 15)]
#define PG8_VOFF(tok, i) ((unsigned)(((tok) < 0 ? 0 : (tok)) * g.lda * ES + Cc[i] * 2))
#define PG8_BPTR(u) ((const char*)g.Bt + ((size_t)(u).e * g.b_e_stride + (size_t)(u).pn * BM * g.ldb) * ES)
#define PG8_SA(b, h) (((b) * 2 + (h)) * HTB)
#define PG8_SB(b, h) ((4 + (b) * 2 + (h)) * HTB)
#define PG8_STAGE(bufoff, gbase, voff) do { _Pragma("unroll") for (int _i = 0; _i < 2; ++_i) { unsigned _vo = (voff)[_i]; asm volatile("" : "+v"(_vo));     \
        __builtin_amdgcn_global_load_lds((const unsigned*)((const char*)(gbase) + _vo), (PG8_LAS unsigned*)(lds + (bufoff) + ldsw + _i * 8192), 16, 0, 0); } } while (0)
#define PG8_LDA(dst, b, h) do { _Pragma("unroll") for (int m = 0; m < 4; ++m) _Pragma("unroll") for (int k = 0; k < 2; ++k) dst[m][k] = *(const PG8_LAS bf16x8*)(lds + PG8_SA(b, h) + aoff + m * 2048 + k * 1024); } while (0)
#define PG8_LDB(dst, b, h) do { _Pragma("unroll") for (int n = 0; n < 2; ++n) _Pragma("unroll") for (int k = 0; k < 2; ++k) dst[n][k] = *(const PG8_LAS bf16x8*)(lds + PG8_SB(b, h) + boff + n * 2048 + k * 1024); } while (0)
#define PG8_CAT8(x0, x1) __builtin_shufflevector(__builtin_bit_cast(i32x4, x0), __builtin_bit_cast(i32x4, x1), 0, 1, 2, 3, 4, 5, 6, 7)
#define PG8_MMA(ai, bj, At, Bt) do { __builtin_amdgcn_s_setprio(1); _Pragma("unroll") for (int m = 0; m < 4; ++m) _Pragma("unroll") for (int n = 0; n < 2; ++n) { \
        if constexpr (ES == 2) { _Pragma("unroll") for (int k = 0; k < 2; ++k) acc[ai][bj][m][n] = __builtin_amdgcn_mfma_f32_16x16x32_bf16(Bt[n][k], At[m][k], acc[ai][bj][m][n], 0, 0, 0); } \
        else   \
            { const i32x8 b8_ = PG8_CAT8(Bt[n][0], Bt[n][1]), a8_ = PG8_CAT8(At[m][0], At[m][1]);   \
              asm volatile("v_mfma_scale_f32_16x16x128_f8f6f4 %0, %1, %2, %0, %3, %4 op_sel_hi:[0,0,0]" : "+v"(acc[ai][bj][m][n]) : "v"(b8_), "v"(a8_), "v"(f8wscale), "v"(f8scale)); } } \
        __builtin_amdgcn_s_setprio(0); } while (0)
#define PG8_WAIT_V(n) asm volatile("s_waitcnt vmcnt(" #n ")" ::: "memory")
#define PG8_WAIT_L(n) asm volatile("s_waitcnt lgkmcnt(" #n ")" ::: "memory")
#define PG8_BAR __builtin_amdgcn_s_barrier()
#define PG8_SCHED __builtin_amdgcn_sched_barrier(0)
    int f8scale = 0x7f7f7f7f, f8wscale = wscale_e8m0 * 0x01010101; asm volatile("" : "+v"(f8scale), "+v"(f8wscale));
    Unit cur, nxt; Sched W = S;
    if (!W.begin(cur)) return;
    f32x4 acc[2][2][4][2];
#pragma unroll
    for (int a = 0; a < 2; ++a)
#pragma unroll
        for (int b = 0; b < 2; ++b)
#pragma unroll
            for (int m = 0; m < 4; ++m)
#pragma unroll
                for (int n = 0; n < 2; ++n) acc[a][b][m][n] = (f32x4){0.f, 0.f, 0.f, 0.f};
    bf16x8 At[4][2], B0[2][2], B1[2][2];
    const char* cA = PG8_APTR(cur); const char* cB = PG8_BPTR(cur);
    const int idxrow = (lane >> 5) * HALF + ((lane >> 4) & 1) * 64 + 16 * (wid >> 1) + (lane & 15);
    volatile PG8_LAS int* ib = (volatile PG8_LAS int*)(lds + STAGE_BYTES + wid * 256);
    if constexpr (GATHER) { PG8_IDXDMA(cur); asm volatile("s_waitcnt vmcnt(0)" ::: "memory");
#pragma unroll
        for (int h = 0; h < 2; ++h)
#pragma unroll
            for (int i = 0; i < 2; ++i) { const int tk = PG8_TOKL(h, i); voffA[h][i] = PG8_VOFF(tk, i); } }
    PG8_STAGE(PG8_SB(0, 0), cB, voffB); PG8_STAGE(PG8_SB(0, 1), cB + hB, voffB); PG8_STAGE(PG8_SA(0, 0), cA, voffA[0]); PG8_STAGE(PG8_SA(0, 1), cA, voffA[1]);
    if (wr == 1) PG8_BAR;
    PG8_WAIT_V(2); PG8_BAR;
    PG8_STAGE(PG8_SB(1, 0), cB + kstep, voffB); PG8_STAGE(PG8_SA(1, 0), cA + kstep, voffA[0]); PG8_STAGE(PG8_SB(1, 1), cB + hB + kstep, voffB);
    PG8_WAIT_V(6); PG8_BAR;
    for (;;) {
        const bool has_next = W.advance(nxt);
        const char* nA = has_next ? PG8_APTR(nxt) : cA; const char* nB = has_next ? PG8_BPTR(nxt) : cB;
        if constexpr (GATHER) { if (has_next) PG8_IDXDMA(nxt); }
        for (int t = 0; t < nt; t += 2) {
            const bool last = (t == nt - 2);
            const char* a1 = cA + (size_t)(t + 1) * kstep;
            const char* a2 = last ? nA : cA + (size_t)(t + 2) * kstep; const char* b2 = last ? nB : cB + (size_t)(t + 2) * kstep;
            const char* a3 = a2 + kstep; const char* b3 = b2 + kstep;
            unsigned va[2][2];
#pragma unroll
            for (int h = 0; h < 2; ++h)
#pragma unroll
                for (int i = 0; i < 2; ++i) va[h][i] = (GATHER && last) ? voffAn[h][i] : voffA[h][i];
            PG8_LDB(B0, 0, 0); PG8_LDB(B1, 0, 1); PG8_SCHED; PG8_LDA(At, 0, 0); PG8_STAGE(PG8_SA(1, 1), a1, voffA[1]);
            PG8_WAIT_V(8); PG8_WAIT_L(0); PG8_BAR; PG8_MMA(0, 0, At, B0); PG8_MMA(0, 1, At, B1); PG8_BAR; PG8_SCHED;
            PG8_LDA(At, 0, 1); PG8_STAGE(PG8_SB(0, 0), b2, voffB); PG8_STAGE(PG8_SB(0, 1), b2 + hB, voffB); PG8_STAGE(PG8_SA(0, 0), a2, va[0]);
            PG8_WAIT_V(8); PG8_WAIT_L(0); PG8_BAR; PG8_MMA(1, 0, At, B0); PG8_MMA(1, 1, At, B1); PG8_BAR; PG8_SCHED;
            PG8_LDB(B0, 1, 0); PG8_LDB(B1, 1, 1); PG8_SCHED; PG8_LDA(At, 1, 0); PG8_STAGE(PG8_SA(0, 1), a2, va[1]);
            PG8_WAIT_V(8); PG8_WAIT_L(0); PG8_BAR; PG8_MMA(0, 0, At, B0); PG8_MMA(0, 1, At, B1); PG8_BAR; PG8_SCHED;
            PG8_LDA(At, 1, 1); PG8_STAGE(PG8_SB(1, 0), b3, voffB); PG8_STAGE(PG8_SB(1, 1), b3 + hB, voffB); PG8_STAGE(PG8_SA(1, 0), a3, va[0]);
            PG8_WAIT_V(8); PG8_WAIT_L(0); PG8_BAR; PG8_MMA(1, 0, At, B0); PG8_MMA(1, 1, At, B1); PG8_BAR; PG8_SCHED;
            if constexpr (GATHER) {
#pragma unroll
                for (int h = 0; h < 2; ++h)
#pragma unroll
                    for (int i = 0; i < 2; ++i) { const int tk = PG8_TOKL(h, i); voffAn[h][i] = PG8_VOFF(tk, i); } }
        }
        if (wr == 0) PG8_BAR;
        if constexpr (ES == 1) asm volatile("s_nop 15\n\ts_nop 15" ::: "memory");
        E(acc, cur, wr, wc, fr, fq, lds, wid, lane);
        if (!has_next) break;
#pragma unroll
        for (int a = 0; a < 2; ++a)
#pragma unroll
            for (int b = 0; b < 2; ++b)
#pragma unroll
                for (int m = 0; m < 4; ++m)
#pragma unroll
                    for (int n = 0; n < 2; ++n) acc[a][b][m][n] = (f32x4){0.f, 0.f, 0.f, 0.f};
        cur = nxt; cA = nA; cB = nB;
        if constexpr (GATHER) {
#pragma unroll
            for (int h = 0; h < 2; ++h)
#pragma unroll
                for (int i = 0; i < 2; ++i) voffA[h][i] = voffAn[h][i]; }
        if (wr == 1) PG8_BAR;
    }
    PG8_WAIT_V(0);
    PG8_BAR;
#undef PG8_APTR
#undef PG8_IDXDMA
#undef PG8_TOKL
#undef PG8_VOFF
#undef PG8_BPTR
#undef PG8_SA
#undef PG8_SB
#undef PG8_STAGE
#undef PG8_LDA
#undef PG8_LDB
#undef PG8_MMA
#undef PG8_CAT8
#undef PG8_WAIT_V
#undef PG8_WAIT_L
#undef PG8_BAR
#undef PG8_SCHED
}
}
namespace attn_body {
using bf16=__hip_bfloat16;
using bf16x8=__attribute__((ext_vector_type(8)))short;
using s16x4=__attribute__((ext_vector_type(4)))short;
using f32x16=__attribute__((ext_vector_type(16)))float;
using u32x4=__attribute__((ext_vector_type(4)))unsigned;
constexpr int D=64;
constexpr int NW=8,QBLK=32,QB=QBLK*NW,KVBLK=64;
__device__ __forceinline__ int crow(int r,int hi){return (r&3)+8*(r>>2)+4*hi;}
#define SBAR() __builtin_amdgcn_sched_barrier(0)
constexpr int NSLOT=3, SLOTB=8192;
constexpr int LDS_K=0, LDS_V=NSLOT*SLOTB, LDS_WS=2*NSLOT*SLOTB, LDS_OST=LDS_WS+NW*64*4, LDS_BYTES=LDS_OST+NW*4096;
constexpr int LDS_BIAS=LDS_BYTES;
constexpr float C2=0.125f*1.4426950408889634f;
__device__ __forceinline__ void glds16(const void*gsrc,unsigned lds_dst){unsigned keep;
  asm volatile("s_mov_b32 %0, m0\n\ts_mov_b32 m0, %2\n\ts_nop 0\n\tglobal_load_lds_dwordx4 %1, off\n\ts_mov_b32 m0, %0":"=&s"(keep):"v"(gsrc),"s"(lds_dst):"memory");}
__device__ __forceinline__ float max3f(float a,float b,float c){float r;asm("v_max3_f32 %0, %1, %2, %3":"=v"(r):"v"(a),"v"(b),"v"(c));return r;}
__device__ __forceinline__ float max2f(float a,float b){float r;asm("v_max_f32_e32 %0, %1, %2":"=v"(r):"v"(a),"v"(b));return r;}
__device__ __forceinline__ float fadd_s(float a,float b){float r;asm("v_add_f32_e32 %0, %1, %2":"=v"(r):"v"(a),"v"(b));return r;}
__device__ __forceinline__ float fsub_s(float a,float b){float r;asm("v_sub_f32_e32 %0, %1, %2":"=v"(r):"v"(a),"v"(b));return r;}
typedef float f32x2_t __attribute__((ext_vector_type(2))); typedef __bf16 bf16x2_t __attribute__((ext_vector_type(2)));
__device__ __forceinline__ unsigned cvtpk_s(float lo,float hi){f32x2_t v={lo,hi};bf16x2_t b=__builtin_convertvector(v,bf16x2_t);return __builtin_bit_cast(unsigned,b);}
#define WAIT_BAR(N) asm volatile("s_waitcnt vmcnt(" #N ") lgkmcnt(0)\n\ts_barrier":::"memory")

__device__ __forceinline__ void qkt(f32x16&p0,f32x16&p1,const char*Kslot,const bf16x8*qr,const f32x16&negm,int r32,int hi){
  const char*kb=Kslot+hi*1024+r32*16;
  #pragma unroll
  for(int d0=0;d0<4;++d0){
    const bf16x8 b0=*reinterpret_cast<const bf16x8*>(kb+d0*2048);
    const bf16x8 b1=*reinterpret_cast<const bf16x8*>(kb+d0*2048+512);
    if(d0==0){p0=__builtin_amdgcn_mfma_f32_32x32x16_bf16(b0,qr[0],negm,0,0,0);p1=__builtin_amdgcn_mfma_f32_32x32x16_bf16(b1,qr[0],negm,0,0,0);}
    else{p0=__builtin_amdgcn_mfma_f32_32x32x16_bf16(b0,qr[d0],p0,0,0,0);p1=__builtin_amdgcn_mfma_f32_32x32x16_bf16(b1,qr[d0],p1,0,0,0);}}
}
typedef __attribute__((address_space(3))) const char* lds_cptr;
typedef short v4i16_t __attribute__((ext_vector_type(4)));
__device__ __forceinline__ void kload8(bf16x8*kf,lds_cptr kp){
  kf[0]=*(const __attribute__((address_space(3))) bf16x8*)(kp);      kf[1]=*(const __attribute__((address_space(3))) bf16x8*)(kp+512);
  kf[2]=*(const __attribute__((address_space(3))) bf16x8*)(kp+2048); kf[3]=*(const __attribute__((address_space(3))) bf16x8*)(kp+2560);
  kf[4]=*(const __attribute__((address_space(3))) bf16x8*)(kp+4096); kf[5]=*(const __attribute__((address_space(3))) bf16x8*)(kp+4608);
  kf[6]=*(const __attribute__((address_space(3))) bf16x8*)(kp+6144); kf[7]=*(const __attribute__((address_space(3))) bf16x8*)(kp+6656);
}
__device__ __forceinline__ void kload2(bf16x8*kf,lds_cptr kp,int j){ kf[2*j]=*(const __attribute__((address_space(3))) bf16x8*)(kp+j*2048); kf[2*j+1]=*(const __attribute__((address_space(3))) bf16x8*)(kp+j*2048+512); }
__device__ __forceinline__ s16x4 vtr(lds_cptr p){ return __builtin_bit_cast(s16x4,__builtin_amdgcn_ds_read_tr16_b64_v4i16((__attribute__((address_space(3))) v4i16_t*)p)); }
__device__ __forceinline__ float rowmax(const f32x16&p0,const f32x16&p1){
  float a=max3f(p0[0],p0[1],p1[0]),b=max3f(p0[2],p0[3],p1[1]);a=max3f(a,p1[2],p1[3]);
  #pragma unroll
  for(int r=4;r<16;r+=4){a=max3f(a,p0[r],p0[r+1]);b=max3f(b,p0[r+2],p0[r+3]);a=max3f(a,p1[r],p1[r+1]);b=max3f(b,p1[r+2],p1[r+3]);}
  const float m=max2f(a,b);
  auto rr=__builtin_amdgcn_permlane32_swap(__float_as_uint(m),__float_as_uint(m),false,false);
  return max2f(__uint_as_float(rr[0]),__uint_as_float(rr[1]));
}
__device__ __forceinline__ void pv(f32x16*o,int vb,bf16x8 pa0,bf16x8 pa1,bf16x8 pa2,bf16x8 pa3){
  #pragma unroll
  for(int d0=0;d0<2;++d0){s16x4 lo[4],hi[4];
    #pragma unroll
    for(int ks=0;ks<4;++ks){
      asm volatile("ds_read_b64_tr_b16 %0,%1 offset:%c2":"=&v"(lo[ks]):"v"(vb),"i"(d0*4096+ks*1024):"memory");
      asm volatile("ds_read_b64_tr_b16 %0,%1 offset:%c2":"=&v"(hi[ks]):"v"(vb),"i"(d0*4096+ks*1024+512):"memory");}
    asm volatile("s_waitcnt lgkmcnt(0)":::"memory");SBAR();
    #define PK(k) (bf16x8){lo[k][0],lo[k][1],lo[k][2],lo[k][3],hi[k][0],hi[k][1],hi[k][2],hi[k][3]}
    o[d0]=__builtin_amdgcn_mfma_f32_32x32x16_bf16(pa0,PK(0),o[d0],0,0,0);
    o[d0]=__builtin_amdgcn_mfma_f32_32x32x16_bf16(pa1,PK(1),o[d0],0,0,0);
    o[d0]=__builtin_amdgcn_mfma_f32_32x32x16_bf16(pa2,PK(2),o[d0],0,0,0);
    o[d0]=__builtin_amdgcn_mfma_f32_32x32x16_bf16(pa3,PK(3),o[d0],0,0,0);
    #undef PK
  }
}
struct TileRows { long base0, base1; int nfirst; __device__ __forceinline__ long operator()(int t) const { return t < nfirst ? base0 + 64l * t : base1 + 64l * (t - nfirst); } };
struct NoMask { static constexpr bool ACTIVE=false; __device__ __forceinline__ void apply(f32x16&,f32x16&,int) const {} };
struct NaMask {
  static constexpr bool ACTIVE=true;
  int kbase, qr, r0q, qcol, c0, hi; lds_cptr bias;
  __device__ __forceinline__ void apply(f32x16&p0,f32x16&p1,int t) const {
    if(t<4) return;
    const int kr=kbase+(t-4); const float NEG=-1.0e30f;
    if(kr<r0q||kr>r0q+7){
      #pragma unroll
      for(int r=0;r<16;++r){p0[r]=NEG;p1[r]=NEG;}
      return; }
    const int ib=(kr-qr+7)*31+(4*hi-qcol+15);
    const int cb=4*hi-c0;
    #pragma unroll
    for(int r=0;r<16;++r){ const int ko=(r&3)+8*(r>>2);
      const float b0=*(const __attribute__((address_space(3))) float*)(bias+4*(ib+ko));
      const float b1=*(const __attribute__((address_space(3))) float*)(bias+4*(ib+ko+32));
#ifdef DBG_NA_NOBIAS
      p0[r]=((unsigned)(cb+ko)<16u)?p0[r]:NEG; p1[r]=((unsigned)(cb+ko+32)<16u)?p1[r]:NEG; (void)b0; (void)b1; }
#else
      p0[r]=((unsigned)(cb+ko)<16u)?p0[r]+b0:NEG;
      p1[r]=((unsigned)(cb+ko+32)<16u)?p1[r]+b1:NEG; }
#endif
  }
};

#ifndef ATTN_STORE16
#define ATTN_STORE16(p,v) (*(u32x4*)(p)=(v))
#endif
template<int THRL,class MK,bool USE_NEGM,bool OUT8,bool FIXM> __device__ __forceinline__ void attn_unit(const bf16*Qw0,int QP,const bf16*__restrict__ Kc,const bf16*__restrict__ Vc,int KP,const TileRows TR,const int NT,void*Ow0,int OP,char*shm,const MK&mk,const int tid,const float mfix=0.f){
  static_assert(!FIXM||USE_NEGM,"FIXM puts the reference into the QK^T MFMA's C operand");
  const int lane=tid&63,r32=lane&31,hi=lane>>5; const int wid=__builtin_amdgcn_readfirstlane(tid>>6);
  const bf16*Qw=Qw0+(long)(wid*QBLK)*QP;
  const unsigned lds0=(unsigned)(uintptr_t)shm;
  float*wsf=(float*)(shm+LDS_WS)+wid*64;
  const bf16*ksrc=Kc+(long)lane*KP+wid*8;
  const bf16*vsrc=Vc+(long)(16*(wid&3)+(lane>>2))*KP+(wid>>2)*32+(lane&3)*8;
  const unsigned kdst=lds0+LDS_K+wid*1024, vdst=lds0+LDS_V+wid*1024;
  #define DMA_K(t,slot) glds16(ksrc+TR(t)*KP,(unsigned)__builtin_amdgcn_readfirstlane(kdst+(slot)))
  #define DMA_V(t,slot) glds16(vsrc+TR(t)*KP,(unsigned)__builtin_amdgcn_readfirstlane(vdst+(slot)))
  const int vb0=(int)(lds0+LDS_V)+((lane>>4)&1)*32+(lane&3)*8+(4*hi+((lane&15)>>2))*64;
  const char*Kbase=shm+LDS_K; bf16x8 kf[8];
  const lds_cptr shm3=(lds_cptr)shm; const lds_cptr kp0=shm3+LDS_K+hi*1024+r32*16; const lds_cptr vp0=shm3+LDS_V+((lane>>4)&1)*32+(lane&3)*8+(4*hi+((lane&15)>>2))*64;
  DMA_K(0,0);DMA_V(0,0);DMA_K(1,SLOTB);
  bf16x8 qr[4];
  #pragma unroll
  for(int d0=0;d0<4;++d0)qr[d0]=*reinterpret_cast<const bf16x8*>(&Qw[(long)r32*QP+d0*16+hi*8]);
  float zz_; asm volatile("v_mov_b32 %0, 0":"=v"(zz_)); float mhat=zz_,l_reg=zz_;f32x16 o[2];
  _Pragma("unroll") for(int r=0;r<16;++r){o[0][r]=zz_;o[1][r]=zz_;}
  f32x16 negm; if(USE_NEGM){ _Pragma("unroll") for(int r=0;r<16;++r)negm[r]=FIXM?(zz_-mfix):zz_; asm volatile("":"+v"(negm)); }
  const f32x16 zero16=f32x16{};
  #define CIN (USE_NEGM?negm:zero16)
  #define SUBM(C0,C1) do{ if(!USE_NEGM){ _Pragma("unroll") for(int r=0;r<16;++r){C0[r]-=mhat;C1[r]-=mhat;} } }while(0)
  #define CMASK(P0,P1,t) mk.apply(P0,P1,t)
  bool resc=false;
  #define START(P0,P1) do{ resc=false; if(!FIXM) { const float rm=rowmax(P0,P1); \
    const float dl=rm; mhat=fadd_s(mhat,dl); \
      _Pragma("unroll") for(int r=0;r<16;++r){P0[r]=fsub_s(P0[r],dl);P1[r]=fsub_s(P1[r],dl);} \
      if(USE_NEGM){ _Pragma("unroll") for(int r=0;r<16;++r)negm[r]=-mhat; asm volatile("":"+v"(negm)); } } \
    _Pragma("unroll") for(int r=0;r<16;++r)P0[r]=__builtin_amdgcn_exp2f(P0[r]); }while(0)
  #define RESC() do{ if(!FIXM&&resc){ asm volatile("s_waitcnt lgkmcnt(0)":::"memory"); \
      _Pragma("unroll") for(int d_=0;d_<2;++d_) _Pragma("unroll") for(int r=0;r<16;++r)o[d_][r]*=wsf[crow(r,hi)]; } }while(0)
  f32x16 pA0,pA1,pB0,pB1;
  int sl_prev=0,sl_cur=0,sl_next=SLOTB;
  #define ROT() do{sl_prev=sl_cur;sl_cur=sl_next;sl_next=(sl_next==(NSLOT-1)*SLOTB)?0:sl_next+SLOTB;}while(0)
  DMA_K(2,2*SLOTB);
  WAIT_BAR(3);
  qkt(pA0,pA1,Kbase,qr,CIN,r32,hi);asm volatile("s_nop 15\n\ts_nop 7":"+v"(pA0),"+v"(pA1));CMASK(pA0,pA1,0);
  START(pA0,pA1);
  _Pragma("unroll") for(int r=0;r<16;++r)pA1[r]=__builtin_amdgcn_exp2f(pA1[r]);
  WAIT_BAR(0);
  DMA_K(3,0);DMA_V(1,SLOTB);
  ROT();
  kload8(kf,kp0+sl_cur);
  WAIT_BAR(2);
  s16x4 vlo[8],vhi[8]; u32x4 pw0,pw1,pw2,pw3;
  #define PKW(P,B) cvtpk_s(P[B],P[B+1])
  #define PAF(k) __builtin_bit_cast(bf16x8,pw##k)
  #define VFR(i) (bf16x8){vlo[i][0],vlo[i][1],vlo[i][2],vlo[i][3],vhi[i][0],vhi[i][1],vhi[i][2],vhi[i][3]}
  #define PIN(x) asm volatile("":"+v"(x))
  #define MX3(a,b,c) __builtin_fmaxf(__builtin_fmaxf((a),(b)),(c))
  #define GAPA(MF,A0,A1,A2,A3,W0,W1,PW) do{ MF; sacc+=A0; sacc+=A1; sacc+=A2; sacc+=A3; PIN(sacc); W0; W1; PIN(PW); SBAR(); }while(0)
  #define EX(v) __builtin_amdgcn_exp2f(v)
  #define GAPB(MF,X,B) do{ MF; X[B]=EX(X[B]); X[B+1]=EX(X[B+1]); X[B+2]=EX(X[B+2]); X[B+3]=EX(X[B+3]); PIN(X); SBAR(); }while(0)
  #define VRD(i) do{ vlo[i]=vtr(vp_+(((i)>>2)*4096+((i)&3)*1024)); vhi[i]=vtr(vp_+(((i)>>2)*4096+((i)&3)*1024+512)); }while(0)
  #define KRD(G,j) do{ if(G){ kload2(kf,kp0+sl_next,j); SBAR(); } }while(0)
  #define STEP(C0,C1,P0,P1,t,GK,GV,GL) do{ SBAR(); \
    const lds_cptr vp_=vp0+sl_prev; \
    VRD(0); SBAR(); float sacc=(P0[0]+P0[1]); \
    GAPA(C0=__builtin_amdgcn_mfma_f32_32x32x16_bf16(kf[0],qr[0],CIN,0,0,0), P0[2],P0[3],P0[4],P0[5],     pw0[0]=PKW(P0,0), pw0[1]=PKW(P0,2), pw0); \
    VRD(4); SBAR(); GAPA(C1=__builtin_amdgcn_mfma_f32_32x32x16_bf16(kf[1],qr[0],CIN,0,0,0), P0[6],P0[7],P0[8],P0[9],     pw0[2]=PKW(P0,4), pw0[3]=PKW(P0,6), pw0); \
    VRD(1); SBAR(); GAPA(C0=__builtin_amdgcn_mfma_f32_32x32x16_bf16(kf[2],qr[1],C0,0,0,0),   P0[10],P0[11],P0[12],P0[13], pw1[0]=PKW(P0,8), pw1[1]=PKW(P0,10), pw1); \
    VRD(5); SBAR(); GAPA(C1=__builtin_amdgcn_mfma_f32_32x32x16_bf16(kf[3],qr[1],C1,0,0,0),   P0[14],P0[15],P1[0],P1[1],   pw1[2]=PKW(P0,12),pw1[3]=PKW(P0,14), pw1); \
    VRD(2); SBAR(); GAPA(C0=__builtin_amdgcn_mfma_f32_32x32x16_bf16(kf[4],qr[2],C0,0,0,0),   P1[2],P1[3],P1[4],P1[5],     pw2[0]=PKW(P1,0), pw2[1]=PKW(P1,2), pw2); \
    VRD(6); SBAR(); GAPA(C1=__builtin_amdgcn_mfma_f32_32x32x16_bf16(kf[5],qr[2],C1,0,0,0),   P1[6],P1[7],P1[8],P1[9],     pw2[2]=PKW(P1,4), pw2[3]=PKW(P1,6), pw2); \
    VRD(3); SBAR(); GAPA(C0=__builtin_amdgcn_mfma_f32_32x32x16_bf16(kf[6],qr[3],C0,0,0,0),   P1[10],P1[11],P1[12],P1[13], pw3[0]=PKW(P1,8), pw3[1]=PKW(P1,10), pw3); \
    VRD(7); SBAR(); GAPA(C1=__builtin_amdgcn_mfma_f32_32x32x16_bf16(kf[7],qr[3],C1,0,0,0),   P1[14],P1[15],0.f,0.f,       pw3[2]=PKW(P1,12),pw3[3]=PKW(P1,14), pw3); \
    l_reg+=sacc; \
    if(GK){DMA_K((t)+3,sl_cur);} if(GV){DMA_V((t)+1,sl_next);} \
    SUBM(C0,C1); CMASK(C0,C1,t); \
    if(!FIXM){ float a=MX3(C0[0],C0[1],C1[0]),b=MX3(C0[2],C0[3],C1[1]); a=MX3(a,C1[2],C1[3]); \
      _Pragma("unroll") for(int r=4;r<16;r+=4){a=MX3(a,C0[r],C0[r+1]);b=MX3(b,C0[r+2],C0[r+3]);a=MX3(a,C1[r],C1[r+1]);b=MX3(b,C1[r+2],C1[r+3]);} \
      float rm=__builtin_fmaxf(a,b); { auto rr=__builtin_amdgcn_permlane32_swap(__float_as_uint(rm),__float_as_uint(rm),false,false); rm=__builtin_fmaxf(__uint_as_float(rr[0]),__uint_as_float(rr[1])); } \
      resc=false; \
      if(__builtin_expect(__any(rm>(float)THRL),0)){ const float dl=__builtin_fmaxf(rm,0.f); mhat+=dl; \
        _Pragma("unroll") for(int r=0;r<16;++r){C0[r]-=dl;C1[r]-=dl;} \
        if(USE_NEGM){ _Pragma("unroll") for(int r=0;r<16;++r)negm[r]=-mhat; asm volatile("":"+v"(negm)); } \
        const float f=__builtin_amdgcn_exp2f(-dl); l_reg*=f; if(hi==0)wsf[r32]=f; resc=true; } } \
    SBAR(); \
    GAPB(o[0]=__builtin_amdgcn_mfma_f32_32x32x16_bf16(PAF(0),VFR(0),o[0],0,0,0), C0,0); \
    GAPB(o[1]=__builtin_amdgcn_mfma_f32_32x32x16_bf16(PAF(0),VFR(4),o[1],0,0,0), C0,4); \
    KRD(GL,0); GAPB(o[0]=__builtin_amdgcn_mfma_f32_32x32x16_bf16(PAF(1),VFR(1),o[0],0,0,0), C0,8); \
    KRD(GL,1); GAPB(o[1]=__builtin_amdgcn_mfma_f32_32x32x16_bf16(PAF(1),VFR(5),o[1],0,0,0), C0,12); \
    KRD(GL,2); GAPB(o[0]=__builtin_amdgcn_mfma_f32_32x32x16_bf16(PAF(2),VFR(2),o[0],0,0,0), C1,0); \
    KRD(GL,3); GAPB(o[1]=__builtin_amdgcn_mfma_f32_32x32x16_bf16(PAF(2),VFR(6),o[1],0,0,0), C1,4); \
    GAPB(o[0]=__builtin_amdgcn_mfma_f32_32x32x16_bf16(PAF(3),VFR(3),o[0],0,0,0), C1,8); \
    GAPB(o[1]=__builtin_amdgcn_mfma_f32_32x32x16_bf16(PAF(3),VFR(7),o[1],0,0,0), C1,12); \
    }while(0)
  int t=1;
  for(;t+5<NT;t+=2){
    STEP(pB0,pB1,pA0,pA1,t,true,true,true);     WAIT_BAR(2); RESC(); ROT();
    STEP(pA0,pA1,pB0,pB1,t+1,true,true,true);   WAIT_BAR(2); RESC(); ROT();
  }
  #define ENDW(tt) do{ if((tt)+3<NT){WAIT_BAR(2);} else if((tt)+2<NT){WAIT_BAR(1);} else {WAIT_BAR(0);} }while(0)
  for(;t+1<NT;t+=2){
    STEP(pB0,pB1,pA0,pA1,t,(t+3<NT),(t+1<NT),(t+1<NT));       ENDW(t);   RESC(); ROT();
    STEP(pA0,pA1,pB0,pB1,t+1,(t+4<NT),(t+2<NT),(t+2<NT));     ENDW(t+1); RESC(); ROT();
  }
  STEP(pB0,pB1,pA0,pA1,NT-1,false,false,false); RESC();
  { float sacc=pB0[0]+pB0[1]; _Pragma("unroll") for(int r=2;r<16;++r)sacc+=pB0[r]; _Pragma("unroll") for(int r=0;r<16;++r)sacc+=pB1[r]; l_reg+=sacc;
    pw0=(u32x4){PKW(pB0,0),PKW(pB0,2),PKW(pB0,4),PKW(pB0,6)};pw1=(u32x4){PKW(pB0,8),PKW(pB0,10),PKW(pB0,12),PKW(pB0,14)};pw2=(u32x4){PKW(pB1,0),PKW(pB1,2),PKW(pB1,4),PKW(pB1,6)};pw3=(u32x4){PKW(pB1,8),PKW(pB1,10),PKW(pB1,12),PKW(pB1,14)};
    SBAR(); pv(o,vb0+sl_cur,PAF(0),PAF(1),PAF(2),PAF(3)); }
  #undef PKW
  #undef PAF
  #undef VFR
  #undef PIN
  #undef MX3
  #undef GAPA
  #undef GAPB
  #undef EX
  #undef VRD
  #undef KRD
  #undef STEP
  #undef ENDW
  {auto rr=__builtin_amdgcn_permlane32_swap(__float_as_uint(l_reg),__float_as_uint(l_reg),false,false);l_reg=__uint_as_float(rr[0])+__uint_as_float(rr[1]);}
  if(hi==0)wsf[32+r32]=l_reg;asm volatile("s_waitcnt lgkmcnt(0)":::"memory");
  float rli[16];
  #pragma unroll
  for(int r=0;r<16;++r)rli[r]=__builtin_amdgcn_rcpf(wsf[32+crow(r,hi)]);
  if constexpr(OUT8){ unsigned char*Ow=(unsigned char*)Ow0+(long)(wid*QBLK)*OP; unsigned char*stg=(unsigned char*)(shm+LDS_OST)+wid*4096;
    #pragma unroll
    for(int r=0;r<16;++r){const int orow=crow(r,hi);
      #pragma unroll
      for(int d0=0;d0<2;++d0){const float v=o[d0][r]*rli[r]; const int t=__builtin_amdgcn_cvt_pk_fp8_f32(v,v,0,false); stg[orow*64+d0*32+r32]=(unsigned char)t;}}
    asm volatile("s_waitcnt lgkmcnt(0)":::"memory");
    #pragma unroll
    for(int i=0;i<2;++i){const int row=i*16+(lane>>2),ch=lane&3; const u32x4 v=*(const u32x4*)(stg+row*64+ch*16); ATTN_STORE16(Ow+(long)row*OP+ch*16,v);} }
  else{ bf16*Ow=(bf16*)Ow0+(long)(wid*QBLK)*OP;
  { bf16*stg=(bf16*)(shm+LDS_OST)+wid*2048;
    #pragma unroll
    for(int r=0;r<16;++r){const int orow=crow(r,hi);
      #pragma unroll
      for(int d0=0;d0<2;++d0)stg[orow*64+d0*32+r32]=__float2bfloat16(o[d0][r]*rli[r]);}
    asm volatile("s_waitcnt lgkmcnt(0)":::"memory");
    #pragma unroll
    for(int i=0;i<4;++i){const int row=i*8+(lane>>3),ch=lane&7; const u32x4 v=*(const u32x4*)(stg+row*64+ch*8); ATTN_STORE16(Ow+(long)row*OP+ch*8,v);} } }
  asm volatile("s_waitcnt lgkmcnt(0)\n\ts_barrier":::"memory");
  #undef CIN
  #undef SUBM
  #undef DMA_K
  #undef DMA_V
  #undef CMASK
  #undef START
  #undef RESC
  #undef ROT
}
#undef SBAR
#undef WAIT_BAR
}
#ifndef MK_PER_PHASE
#define MK_PER_PHASE 0
#endif
#ifndef MOE_F8
#define MOE_F8 1
#endif
#ifndef WO_F8
#define WO_F8 0
#endif
#ifndef YS_F8
#define YS_F8 1
#endif
#ifndef QKV_F8
#define QKV_F8 1
#endif
constexpr int NWAVES = 8;
constexpr int W13_LOG2 = 5, W2_LOG2 = 7, WO_LOG2 = 6; constexpr float W13_SCALE = 32.0f, W2_SCALE = 128.0f;
constexpr int NB = 4, SEQ = 8192, DM = 1024, LCTX = 256, DEPTH = 4;
constexpr int M_LAT = NB * SEQ, M_CTX = NB * LCTX, M_ALL = M_LAT + M_CTX;
constexpr int NE = 16, FF = 2048, CAP_LAT = 1024, CAP_CTX = 32;
constexpr int ETILES = 17, ESTR = ETILES * 256, NSLOTS = NE * ESTR;
constexpr int KVROWS = SEQ + LCTX;
constexpr int NMOD = 6 * DM;
constexpr float ALPHA = 1.681792830507429f, LN_EPS = 1e-5f, RMS_EPS = 1e-6f, LOG2E = 1.4426950408889634f;

constexpr size_t MiB = 1u << 20;
constexpr size_t WS_CTL = 0, CTL_ZERO_BYTES = 2 * MiB;
constexpr size_t WS_MOD = 2 * MiB, WS_AFF = 3 * MiB, WS_SEL = 6 * MiB, WS_SLOT = 9 * MiB;
constexpr size_t WS_POOLW = 10 * MiB, WS_NAQKV = 11 * MiB, WS_NAWO = 17 * MiB, WS_GQKV = 19 * MiB, WS_GWO = 22 * MiB;
constexpr size_t WS_W13 = 32 * MiB, WS_W2 = 544 * MiB, WS_X = 800 * MiB, WS_H = 932 * MiB, WS_R = 1000 * MiB, WS_END = 1544 * MiB;
constexpr size_t R_XS = 0, R_HID = 136 * MiB, R_YS = 408 * MiB;
constexpr size_t R_D = 0, R_Y = 200 * MiB;
constexpr size_t R_O8 = 272 * MiB;
constexpr size_t R_Q = 0, R_K = 66 * MiB, R_V = 132 * MiB;
constexpr size_t R_RAW = 0, R_GQ = 100 * MiB, R_GK = 164 * MiB, R_GV = 181 * MiB;
constexpr int CW_TMO = 0, CW_BAR = 4096;

constexpr int RING_BYTES = 135168;
constexpr int LDSCTL_OFF = RING_BYTES, MISC_OFF = LDSCTL_OFF + 320;
constexpr int LDS_BYTES = 147456;

#define GAS __attribute__((address_space(1)))
#define LAS __attribute__((address_space(3)))
typedef unsigned short bf16;
typedef unsigned v4u __attribute__((ext_vector_type(4)));
typedef unsigned v2u __attribute__((ext_vector_type(2)));
typedef float f32x4 __attribute__((ext_vector_type(4)));
typedef float f32x2 __attribute__((ext_vector_type(2)));
#define RLX_AGENT __ATOMIC_RELAXED, __HIP_MEMORY_SCOPE_AGENT
#define LDS_WAIT() asm volatile("s_waitcnt lgkmcnt(0)" ::: "memory")
__device__ __forceinline__ unsigned pk2(float lo, float hi) { return pg8::cvt_pk_bf16(lo, hi); }
__device__ __forceinline__ float bf_lo(unsigned u) { return __uint_as_float(u << 16); }
__device__ __forceinline__ float bf_hi(unsigned u) { return __uint_as_float(u & 0xffff0000u); }

#define XB_TMO      128
#define XB_XCNT(j)  (256  + 64 * (j))
#define XB_XSUB(j)  (1280 + 64 * (j))
#define XB_XGEN(j)  (2304 + 64 * (j))
#define XB_TOP      3328
#define XB_TOPGEN   3392
#define XCD_BAR_WORDS 3456
#define XB_SPIN_CAP (1u << 22)

__device__ __forceinline__ unsigned xb_ld(unsigned* p)              { return __hip_atomic_load(p, __ATOMIC_RELAXED, __HIP_MEMORY_SCOPE_AGENT); }
__device__ __forceinline__ unsigned xb_add(unsigned* p, unsigned v) { return __hip_atomic_fetch_add(p, v, __ATOMIC_RELAXED, __HIP_MEMORY_SCOPE_AGENT); }
__device__ __forceinline__ unsigned xb_xcc_id() { return (unsigned)__builtin_amdgcn_s_getreg((3 << 11) | 20) & 0xFu; }
#define XB_SPIN(cond, bar) do { unsigned _sp = 0; while (cond) { __builtin_amdgcn_s_sleep(1); \
    if ((++_sp & 255u) == 0u) { if (xb_ld(&(bar)[XB_TMO])) break; if (_sp > XB_SPIN_CAP) { atomicAdd(&(bar)[XB_TMO], 1u); break; } } } } while (0)

struct XcdBarrier { unsigned* bar; unsigned x; volatile LAS unsigned* st; };
__device__ __forceinline__ XcdBarrier xcd_barrier_post(unsigned* bar, volatile LAS unsigned* st) {
    XcdBarrier b; b.bar = bar; b.x = xb_xcc_id(); b.st = st;
    if (threadIdx.x == 0) (void)xb_add(&bar[XB_XCNT(b.x)], 1u);
    return b;
}
__device__ __forceinline__ void xcd_barrier_complete(unsigned* bar, unsigned x, unsigned& nloc, unsigned& nx) {
    const unsigned G = gridDim.x * gridDim.y * gridDim.z;
    unsigned sum, cnt, mine, sp = 0u;
    for (;;) {
        sum = 0u; cnt = 0u; mine = 0u;
#pragma unroll
        for (unsigned j = 0; j < 16; ++j) { const unsigned c = xb_ld(&bar[XB_XCNT(j)]); sum += c; cnt += (c > 0u) ? 1u : 0u; mine = (j == x) ? c : mine; }
        if (sum == G) break;
        __builtin_amdgcn_s_sleep(1);
        if ((++sp & 255u) == 0u) { if (xb_ld(&bar[XB_TMO])) break; if (sp > XB_SPIN_CAP) { atomicAdd(&bar[XB_TMO], 1u); break; } }
    }
    nloc = mine > 0u ? mine : 1u; nx = cnt > 0u ? cnt : 1u;
}
__device__ __forceinline__ void xcd_barrier(const XcdBarrier& b) {
    asm volatile("s_waitcnt vmcnt(0)" ::: "memory");
    __syncthreads();
    if (threadIdx.x == 0) {
        unsigned* bar = b.bar;
        __builtin_amdgcn_s_waitcnt(0);
        unsigned nloc = b.st[0], nx = b.st[1];
        if (nloc == 0u) { xcd_barrier_complete(bar, b.x, nloc, nx); b.st[0] = nloc; b.st[1] = nx; }
        const unsigned old = xb_add(&bar[XB_XSUB(b.x)], 1u);
        const unsigned gen = old / nloc;
        if (old + 1u == (gen + 1u) * nloc) {
            __builtin_amdgcn_fence(__ATOMIC_RELEASE, "agent");
            asm volatile("s_waitcnt vmcnt(0)" ::: "memory");
            const unsigned og = xb_add(&bar[XB_TOP], 1u);
            const unsigned tg = og / nx;
            if (og + 1u == (tg + 1u) * nx) xb_add(&bar[XB_TOPGEN], 1u);
            else XB_SPIN(xb_ld(&bar[XB_TOPGEN]) == tg, bar);
            __builtin_amdgcn_fence(__ATOMIC_ACQUIRE, "agent");
            xb_add(&bar[XB_XGEN(b.x)], 1u);
            asm volatile("s_waitcnt vmcnt(0)" ::: "memory");
        } else {
            XB_SPIN(xb_ld(&bar[XB_XGEN(b.x)]) == gen, bar);
            __builtin_amdgcn_fence(__ATOMIC_ACQUIRE, "agent");
            asm volatile("s_waitcnt vmcnt(0)" ::: "memory");
        }
    }
    __syncthreads();
}

template <int CTRL> __device__ __forceinline__ float dppx(float v) { return __builtin_bit_cast(float, __builtin_amdgcn_update_dpp(0, __builtin_bit_cast(int, v), CTRL, 0xf, 0xf, true)); }
constexpr int DPP_XOR1 = 0xB1, DPP_XOR2 = 0x4E, DPP_HMIRROR = 0x141, DPP_MIRROR = 0x140, DPP_XOR8 = 0x128;
__device__ __forceinline__ void swap16(float v, float& even_rows, float& odd_rows) { auto r = __builtin_amdgcn_permlane16_swap(__float_as_uint(v), __float_as_uint(v), false, false); even_rows = __uint_as_float(r[0]); odd_rows = __uint_as_float(r[1]); }
__device__ __forceinline__ void swap32(float v, float& lo_half, float& hi_half) { auto r = __builtin_amdgcn_permlane32_swap(__float_as_uint(v), __float_as_uint(v), false, false); lo_half = __uint_as_float(r[0]); hi_half = __uint_as_float(r[1]); }
__device__ __forceinline__ float quad_sum(float v) { v += dppx<DPP_XOR1>(v); v += dppx<DPP_XOR2>(v); return v; }
__device__ __forceinline__ float row16_sum(float v) { v = quad_sum(v); v += dppx<DPP_HMIRROR>(v); v += dppx<DPP_MIRROR>(v); return v; }
__device__ __forceinline__ float wave_sum(float v) { v = row16_sum(v); float a, b; swap16(v, a, b); v = a + b; swap32(v, a, b); return a + b; }
__device__ __forceinline__ int wave_incl_scan(int v, int lane) {
#pragma unroll
    for (int o = 1; o < 64; o <<= 1) { const int t = __shfl_up(v, o); if (lane >= o) v += t; }
    return v;
}
__device__ __forceinline__ int block_excl_scan(int v, LAS int* tmp, int lane, int wave) {
    const int inc = wave_incl_scan(v, lane);
    if (lane == 63) tmp[wave] = inc;
    __syncthreads();
    int base = 0;
#pragma unroll
    for (int w = 0; w < NWAVES; ++w) { const int t = tmp[w]; base += (w < wave) ? t : 0; }
    __syncthreads();
    return base + inc - v;
}

struct Args { const float* in[21]; float* out; unsigned char* ws; int ph_lo, ph_hi, li, pad; };
enum { IN_X = 0, IN_C, IN_CTX, IN_CCTX, IN_MODW, IN_MODB, IN_LNG, IN_LNB, IN_POOLW, IN_POOLS, IN_NAQKV, IN_NAWO, IN_NARPB, IN_GQKV, IN_GQN, IN_GKN, IN_GWO, IN_ROUTER, IN_W1, IN_W3, IN_W2 };

__device__ __forceinline__ void p0_mod(const Args& a, LAS unsigned char* lds, int tid, int lane, int wave) {
    const int wg = blockIdx.x; if (wg >= 192) return;
    const int L = wg / 48, cb = wg % 48;
    LAS float* sl = (LAS float*)lds; LAS float* red = sl + 5 * 1024;
    const float* c = a.in[IN_C]; const float* cc = a.in[IN_CCTX];
    for (int i = tid; i < 5120; i += 512) { const int s = i >> 10, k = i & 1023; const float cv = s < 4 ? c[s * 1024 + k] : cc[k]; sl[i] = cv / (1.0f + expf(-cv)); }
    __syncthreads();
    float acc[5][2];
#pragma unroll
    for (int s = 0; s < 5; ++s) { acc[s][0] = 0.f; acc[s][1] = 0.f; }
    const float* wp = a.in[IN_MODW] + (size_t)L * DM * NMOD + cb * 128 + 2 * lane;
#pragma unroll 8
    for (int kk = 0; kk < 128; ++kk) { const int k = wave * 128 + kk; const f32x2 w = *(const f32x2*)(wp + (size_t)k * NMOD);
#pragma unroll
        for (int s = 0; s < 5; ++s) { const float sv = sl[s * 1024 + k]; acc[s][0] += sv * w.x; acc[s][1] += sv * w.y; } }
#pragma unroll
    for (int s = 0; s < 5; ++s) { red[(wave * 5 + s) * 128 + 2 * lane] = acc[s][0]; red[(wave * 5 + s) * 128 + 2 * lane + 1] = acc[s][1]; }
    __syncthreads();
    float* MOD = (float*)(a.ws + WS_MOD);
    for (int o = tid; o < 640; o += 512) { const int s = o >> 7, col = o & 127; float sum = 0.f;
#pragma unroll
        for (int w = 0; w < 8; ++w) sum += red[(w * 5 + s) * 128 + col];
        MOD[(size_t)(L * 5 + s) * NMOD + cb * 128 + col] = sum + a.in[IN_MODB][L * NMOD + cb * 128 + col]; }
    __syncthreads();
}
struct CvtItem { const float* W; void* WT; int K, N, mode, sub; float scale; };
constexpr int I_POOL = 128, I_NAQKV = 768, I_NAWO = 256, I_GQKV = 384, I_GWO = 256, I_SMALL = I_POOL + I_NAQKV + I_NAWO + I_GQKV + I_GWO, I_LE = 1536, I_ALL = I_SMALL + 64 * I_LE;
constexpr int CVT_NWIN = 10;
__host__ __device__ constexpr int cvt_wsize(int w) { return w == 0 ? 240 * 8 * 1 : w == 3 ? 208 * 8 * 2 : w == 4 ? 240 * 8 * 3 : w == 7 ? 232 * 8 * 2 : 192 * 8 * 4; }
__host__ __device__ constexpr int cvt_wsum(int w) { int s_ = 0; for (int i = 0; i < w; ++i) s_ += cvt_wsize(i); return s_; }
constexpr int CVT_I_PRO = I_ALL - cvt_wsum(CVT_NWIN);
__host__ __device__ constexpr int cvt_wlo(int w) { return CVT_I_PRO + cvt_wsum(w); }
static_assert(CVT_I_PRO >= I_SMALL + 16 * I_LE, "layer 0's weights are converted in the prologue");
static_assert(cvt_wlo(6) >= I_SMALL + 32 * I_LE, "layer 1's expert weights are complete before its up GEMM (after window 5)");
static_assert(cvt_wlo(9) >= I_SMALL + 48 * I_LE, "layer 2's expert weights are complete before its up GEMM (after window 8)");
__device__ __forceinline__ bool cvt_decode(const Args& a, int it, int it_end, CvtItem& c) {
    if (it >= it_end) return false;
    int r = it; c.scale = 0.f; c.mode = 0;
    if (r >= I_SMALL) { r -= I_SMALL; const int le = r / I_LE, q = r - le * I_LE, which = q >> 9; c.sub = q & 511;
#if MOE_F8
        const size_t es = 1;
#else
        const size_t es = 2;
#endif
        if (which < 2) { c.W = a.in[which == 0 ? IN_W1 : IN_W3] + (size_t)le * DM * FF; c.K = DM; c.N = FF; c.WT = a.ws + WS_W13 + (size_t)le * 2 * FF * DM * es; c.mode = 1 + which; c.scale = MOE_F8 ? W13_SCALE : 0.f; }
        else { c.W = a.in[IN_W2] + (size_t)le * FF * DM; c.K = FF; c.N = DM; c.WT = a.ws + WS_W2 + (size_t)le * DM * FF * es; c.scale = MOE_F8 ? W2_SCALE : 0.f; }
        return true; }
    if (r < I_POOL) { const int mi = r >> 4; c.W = a.in[IN_POOLW] + (size_t)mi * 65536; c.K = 256; c.N = 256; c.WT = (bf16*)(a.ws + WS_POOLW) + (size_t)mi * 65536; c.sub = r & 15; return true; } r -= I_POOL;
    if (r < I_NAQKV) { c.W = a.in[IN_NAQKV]; c.K = DM; c.N = 3 * DM; c.WT = a.ws + WS_NAQKV; c.sub = r; c.scale = QKV_F8 ? W13_SCALE : 0.f; return true; } r -= I_NAQKV;
    if (r < I_NAWO) { c.W = a.in[IN_NAWO]; c.K = DM; c.N = DM; c.WT = a.ws + WS_NAWO; c.sub = r; c.scale = WO_F8 ? 64.0f : 0.f; return true; } r -= I_NAWO;
    if (r < I_GQKV) { c.W = a.in[IN_GQKV]; c.K = DM; c.N = 1536; c.WT = a.ws + WS_GQKV; c.sub = r; c.scale = QKV_F8 ? W13_SCALE : 0.f; return true; } r -= I_GQKV;
    c.W = a.in[IN_GWO]; c.K = DM; c.N = DM; c.WT = a.ws + WS_GWO; c.sub = r; c.scale = WO_F8 ? 64.0f : 0.f; return true;
}
__device__ __forceinline__ void cvt_geom(const CvtItem& c, int& k0, int& n0) { const int nblk = c.N >> 5, kb = c.sub / nblk, nb = c.sub - kb * nblk; k0 = kb * 128; n0 = nb * 32; }
__device__ __forceinline__ void cvt_load(const CvtItem& c, f32x4 (&v)[16], int lane) {
    int k0, n0; cvt_geom(c, k0, n0); const int kr = lane >> 3, nc = lane & 7;
#pragma unroll
    for (int i = 0; i < 16; ++i) v[i] = __builtin_nontemporal_load((const f32x4*)(c.W + (size_t)(k0 + 8 * i + kr) * c.N + n0 + 4 * nc));
}
__device__ __forceinline__ void cvt_store(const CvtItem& c, const f32x4 (&v)[16], LAS float* scr, int lane) {
    int k0, n0; cvt_geom(c, k0, n0); const int kr = lane >> 3, nc = lane & 7;
    const float sc = c.scale > 0.f ? c.scale : 1.0f;
#pragma unroll
    for (int i = 0; i < 16; ++i) { LAS float* d = scr + (8 * i + kr) * 33 + 4 * nc; d[0] = v[i].x * sc; d[1] = v[i].y * sc; d[2] = v[i].z * sc; d[3] = v[i].w * sc; }
    LDS_WAIT();
    const int ch = lane & 7;
#pragma unroll
    for (int j = 0; j < 4; ++j) { const int n = 8 * j + (lane >> 3); const LAS float* s = scr + (16 * ch) * 33 + n;
        const int nn = n0 + n; const int drow = c.mode == 0 ? nn : (((nn >> 2) << 3) + (nn & 3) + (c.mode == 2 ? 4 : 0));
        if (c.scale > 0.f) { int w[4];
#pragma unroll
            for (int q = 0; q < 4; ++q) { int t = 0; t = __builtin_amdgcn_cvt_pk_fp8_f32(s[(4 * q) * 33], s[(4 * q + 1) * 33], t, false); t = __builtin_amdgcn_cvt_pk_fp8_f32(s[(4 * q + 2) * 33], s[(4 * q + 3) * 33], t, true); w[q] = t; }
            __builtin_nontemporal_store((v4u){(unsigned)w[0], (unsigned)w[1], (unsigned)w[2], (unsigned)w[3]}, (v4u*)((unsigned char*)c.WT + (size_t)drow * c.K + k0 + 16 * ch)); }
        else { v4u o0, o1;
            o0.x = pk2(s[0 * 33], s[1 * 33]); o0.y = pk2(s[2 * 33], s[3 * 33]); o0.z = pk2(s[4 * 33], s[5 * 33]); o0.w = pk2(s[6 * 33], s[7 * 33]);
            o1.x = pk2(s[8 * 33], s[9 * 33]); o1.y = pk2(s[10 * 33], s[11 * 33]); o1.z = pk2(s[12 * 33], s[13 * 33]); o1.w = pk2(s[14 * 33], s[15 * 33]);
            v4u* d = (v4u*)((bf16*)c.WT + (size_t)drow * c.K + k0 + 16 * ch); d[0] = o0; d[1] = o1; } }
    LDS_WAIT();
}
#ifdef PROBE_DUPPRO
__device__ __forceinline__ void p0_convert_probe(const Args& a, LAS unsigned char* lds, int gw, int NGW, int lane, int wave) {
    LAS float* scr = (LAS float*)(lds + wave * 16896);
    CvtItem cur; f32x4 va[16]; f32x4 acc = {0.f, 0.f, 0.f, 0.f};
    for (int it = gw; cvt_decode(a, it, I_ALL, cur); it += NGW) {
        cvt_load(cur, va, lane);
        if (PROBE_DUPPRO == 2) { cur.WT = a.ws + (size_t)1600 * MiB + ((size_t)it & 2047) * 65536; cur.K = 64; cur.mode = 0; cur.sub = 0; cvt_store(cur, va, scr, lane); }
        else {
#pragma unroll
            for (int i = 0; i < 16; ++i) acc += va[i]; }
    }
    if (acc.x == 1.2345e30f) ((float*)(a.ws + (size_t)1600 * MiB))[lane] = acc.x + acc.y + acc.z + acc.w;
}
#endif
__device__ __forceinline__ void p0_convert(const Args& a, LAS unsigned char* lds, int it0, int it_end, int gw, int NGW, int lane, int wave) {
    LAS float* scr = (LAS float*)(lds + wave * 16896);
    CvtItem ca, cb; f32x4 va[16], vb[16];
    bool ha = cvt_decode(a, it0 + gw, it_end, ca);
    if (ha) cvt_load(ca, va, lane);
    for (int it = it0 + gw; ha; it += 2 * NGW) {
        const bool hb = cvt_decode(a, it + NGW, it_end, cb);
        if (hb) cvt_load(cb, vb, lane);
        cvt_store(ca, va, scr, lane);
        if (!hb) break;
        ha = cvt_decode(a, it + 2 * NGW, it_end, ca);
        if (ha) cvt_load(ca, va, lane);
        cvt_store(cb, vb, scr, lane);
    }
}

__device__ __forceinline__ int row_s(int row) { return row < M_LAT ? (row >> 13) : 4; }
__device__ __forceinline__ const float* xrow(const Args& a, int row) {
    return row < M_LAT ? a.in[IN_X] + (size_t)row * DM : a.in[IN_CTX] + (size_t)(row - M_LAT) * DM;
}
typedef _Float16 xh_t; typedef _Float16 h16x4 __attribute__((ext_vector_type(4)));
__device__ __forceinline__ f32x4 xdec(const f32x4 v) { return v; }
__device__ __forceinline__ f32x4 xdec(const v2u w) { return __builtin_convertvector(__builtin_bit_cast(h16x4, w), f32x4); }
__device__ __forceinline__ v2u xenc(const f32x4 v) { return __builtin_bit_cast(v2u, __builtin_convertvector(v, h16x4)); }
template <bool XH> struct XSrc;
template <> struct XSrc<false> { typedef f32x4 vec; typedef float elem; static __device__ __forceinline__ const float* row(const Args& a, int r) { return xrow(a, r); } };
template <> struct XSrc<true>  { typedef v2u vec;   typedef xh_t elem;  static __device__ __forceinline__ const xh_t* row(const Args& a, int r) { return (const xh_t*)(a.ws + WS_X) + (size_t)r * DM; } };

template <int W, class XE> __device__ __forceinline__ f32x4 pool_sum(const XE* base, int pos, int n) {
    typedef typename std::conditional<sizeof(XE) == 2, v2u, f32x4>::type XV;
    f32x4 s = {0.f, 0.f, 0.f, 0.f};
#pragma unroll
    for (int i = 0; i < W; ++i) { const int idx = pos - W / 2 + i; const bool ok = idx >= 0 && idx < n; const int ic = idx < 0 ? 0 : (idx >= n ? n - 1 : idx);
        const f32x4 v = xdec(*(const XV*)(base + (size_t)ic * DM)); s += ok ? v : (f32x4){0.f, 0.f, 0.f, 0.f}; }
    return s;
}
__device__ __forceinline__ void pd_decode(int row, int& r0s, int& pos, int& n) {
    if (row < M_LAT) { r0s = row & ~(SEQ - 1); pos = row & (SEQ - 1); n = SEQ; } else { r0s = M_LAT + ((row - M_LAT) & ~(LCTX - 1)); pos = (row - M_LAT) & (LCTX - 1); n = LCTX; }
}
template <bool XH> __device__ __forceinline__ void ph_pooldiff(const Args& a, int L, int nrows, int gw, int NGW, int lane) {
    typedef typename XSrc<XH>::vec XV; typedef typename XSrc<XH>::elem XE;
    const float* MOD = (const float*)(a.ws + WS_MOD); bf16* Dm = (bf16*)(a.ws + WS_R + R_D);
    const int r0 = (int)(((long)gw * nrows) / NGW), r1 = (int)(((long)(gw + 1) * nrows) / NGW);
    XV EA[4], LA[4], CA[4], EB[4], LB[4], CB[4], EC[4], LC[4], CC[4]; f32x4 S[4], SC[4];
    const XE* zb = (const XE*)(a.ws + WS_CTL + MiB) + 4 * lane;
#define PD_LOAD(rw, En, Ln, Cn) do { const int rr_ = (rw) < re ? (rw) : re - 1; const int pos_ = rr_ - r0s; \
        _Pragma("unroll") for (int g = 0; g < 4; ++g) { const int W_ = 2 << g, ie_ = pos_ + W_ / 2 - 1, il_ = pos_ - 1 - W_ / 2; \
            En[g] = *(const XV*)((ie_ < n ? xb + (size_t)ie_ * DM : zb) + g * 256); Ln[g] = *(const XV*)((il_ >= 0 ? xb + (size_t)il_ * DM : zb) + g * 256); \
            Cn[g] = *(const XV*)(xb + (size_t)pos_ * DM + g * 256); } __builtin_amdgcn_sched_barrier(0); } while (0)
#define PD_EMIT(rowv, C) do { const int row_ = (rowv); const int pos = row_ - r0s; bf16* drow = Dm + (size_t)row_ * DM + 4 * lane; \
        _Pragma("unroll") for (int g = 0; g < 4; ++g) { const int W = 2 << g; const int lo = pos - W / 2 < 0 ? 0 : pos - W / 2, hi = pos + (W - W / 2 - 1) > n - 1 ? n - 1 : pos + (W - W / 2 - 1); \
            const float inv = 1.0f / (float)(hi - lo + 1); const f32x4 d = SC[g] * (S[g] * inv - xdec(C[g])); \
            v2u o; o.x = pk2(d.x, d.y); o.y = pk2(d.z, d.w); *(v2u*)(drow + g * 256) = o; } } while (0)
#define PD_ROW(rowv, E, Lv, C) do { _Pragma("unroll") for (int g = 0; g < 4; ++g) S[g] += xdec(E[g]) - xdec(Lv[g]); PD_EMIT(rowv, C); } while (0)
    for (int rs = r0; rs < r1; ) {
        int r0s, pos0, n; pd_decode(rs, r0s, pos0, n);
        const int re = (r0s + n) < r1 ? (r0s + n) : r1;
        const XE* xb = XSrc<XH>::row(a, r0s) + 4 * lane;
        { const float* scp_ = MOD + (size_t)(L * 5 + row_s(rs)) * NMOD + DM + 4 * lane;
#pragma unroll
          for (int g = 0; g < 4; ++g) SC[g] = *(const f32x4*)(scp_ + g * 256) + 1.0f; }
        S[0] = pool_sum<2>(xb, pos0, n); S[1] = pool_sum<4>(xb + 256, pos0, n); S[2] = pool_sum<8>(xb + 512, pos0, n); S[3] = pool_sum<16>(xb + 768, pos0, n);
#pragma unroll
        for (int g = 0; g < 4; ++g) CA[g] = *(const XV*)(xb + (size_t)pos0 * DM + g * 256);
        PD_EMIT(rs, CA);
        const int rb = rs + 1;
        if (rb < re) {
            PD_LOAD(rb, EA, LA, CA); PD_LOAD(rb + 1, EB, LB, CB);
            for (int row = rb; row < re; row += 3) {
                PD_LOAD(row + 2, EC, LC, CC); PD_ROW(row, EA, LA, CA);
                if (row + 1 < re) { PD_LOAD(row + 3, EA, LA, CA); PD_ROW(row + 1, EB, LB, CB); }
                if (row + 2 < re) { PD_LOAD(row + 4, EB, LB, CB); PD_ROW(row + 2, EC, LC, CC); }
            }
        }
        rs = re;
    }
#undef PD_LOAD
#undef PD_EMIT
#undef PD_ROW
}

struct Ln1Ctx { const Args* a; int L; LAS float* RT; LAS f32x4* PV; xh_t* X; bf16* H; float* AFF; int lane; };
#define LN1_RTRD(W, e0, jj) do { _Pragma("unroll") for (int e = 0; e < 8; ++e) W[e] = *(const LAS f32x4*)(rtp + ((e0) + e) * 1024 + 256 * (jj)); __builtin_amdgcn_sched_barrier(0); } while (0)
#define LN1_RTFMA(W, e0) do { _Pragma("unroll") for (int e = 0; e < 8; ++e) { const f32x4 w = W[e]; \
        lgp[(e0) + e] = __builtin_elementwise_fma((f32x2){h2.x, h2.y}, (f32x2){w.x, w.y}, lgp[(e0) + e]); lgp[(e0) + e] = __builtin_elementwise_fma((f32x2){h2.z, h2.w}, (f32x2){w.z, w.w}, lgp[(e0) + e]); } \
        __builtin_amdgcn_sched_barrier(0); } while (0)
template <int VAR, class XV> __device__ __forceinline__ void ln1_row(const Ln1Ctx& c, const int row, const XV (&xc)[4], const v2u (&yc)[4], f32x4 (&wA)[8], f32x4 (&wB)[8]) {
    const int L = c.L, lane = c.lane; LAS float* RT = c.RT; LAS f32x4* PV = c.PV; xh_t* X = c.X; bf16* H = c.H; float* AFF = c.AFF; (void)L;
        const LAS f32x4* pv = PV + (2 + 3 * row_s(row)) * 256 + lane;
        const LAS float* rtp = RT + 4 * lane; asm volatile("" : "+v"(rtp));
        f32x4 pa[4], pb[4]; pa[0] = PV[lane]; pa[1] = PV[256 + lane]; pa[2] = pv[512]; pa[3] = pv[256];
        f32x4 v[4]; float s = 0.f;
#pragma unroll
        for (int j = 0; j < 4; ++j) { f32x4 yv = {bf_lo(yc[j].x), bf_hi(yc[j].x), bf_lo(yc[j].y), bf_hi(yc[j].y)};
#ifdef DBG_NEG_Y_LAYER
            if (L == DBG_NEG_Y_LAYER) yv = -yv;
#endif
            v[j] = xdec(xc[j]) * ALPHA + pv[64 * j] * yv; s += (v[j].x + v[j].y) + (v[j].z + v[j].w); }
        const float mean = wave_sum(s) * (1.f / DM); float s2 = 0.f;
#pragma unroll
        for (int j = 0; j < 4; ++j) { v[j] = v[j] - mean; s2 += (v[j].x * v[j].x + v[j].y * v[j].y) + (v[j].z * v[j].z + v[j].w * v[j].w); }
        const float rstd = 1.f / sqrtf(wave_sum(s2) * (1.f / DM) + LN_EPS);
        v2u* xo = (v2u*)(X + (size_t)row * DM) + lane; v2u* ho = (v2u*)(H + (size_t)row * DM) + lane; (void)ho;
        f32x2 lgp[16];
#pragma unroll
        for (int e = 0; e < 16; ++e) lgp[e] = (f32x2){0.f, 0.f};
#define LN1_PVRD(P, jj) do { P[0] = PV[lane + 64 * (jj)]; P[1] = PV[256 + lane + 64 * (jj)]; P[2] = pv[512 + 64 * (jj)]; P[3] = pv[256 + 64 * (jj)]; } while (0)
#define LN1_CHUNK(jj, PC, PN) do { const f32x4 x1 = v[jj] * rstd * PC[0] + PC[1]; xo[64 * (jj)] = xenc(x1); const f32x4 h2 = x1 * (PC[2] + 1.0f) + PC[3]; LN1_HST(jj); \
        if (VAR < 2) { if ((jj) < 3) LN1_PVRD(PN, (jj) + 1); LN1_RTRD(wB, 8, jj); LN1_RTFMA(wA, 0); LN1_RTRD(wA, 0, ((jj) + 1) & 3); LN1_RTFMA(wB, 8); } \
        else { if ((jj) < 3) LN1_PVRD(PN, (jj) + 1); lgp[0].x += h2.x + h2.y; lgp[1].y += h2.z + h2.w; } } while (0)
#if MOE_F8
#define LN1_HST(jj) do { int t = 0; t = __builtin_amdgcn_cvt_pk_fp8_f32(h2.x, h2.y, t, false); t = __builtin_amdgcn_cvt_pk_fp8_f32(h2.z, h2.w, t, true); ((int*)((unsigned char*)H + (size_t)row * DM))[lane + 64 * (jj)] = t; } while (0)
#else
#define LN1_HST(jj) do { v2u o; o.x = pk2(h2.x, h2.y); o.y = pk2(h2.z, h2.w); ho[64 * (jj)] = o; } while (0)
#endif
        LN1_CHUNK(0, pa, pb); LN1_CHUNK(1, pb, pa); LN1_CHUNK(2, pa, pb); LN1_CHUNK(3, pb, pa);
#undef LN1_PVRD
#undef LN1_CHUNK
#undef LN1_HST
        float lg16[16];
#pragma unroll
        for (int e = 0; e < 16; ++e) lg16[e] = lgp[e].x + lgp[e].y;
        if (VAR == 3) { if (lane < 16) AFF[(size_t)row * NE + lane] = lg16[0] + lg16[5]; return; }
        float r8[8], r4[4], t0, t1;
        { const bool up = (lane & 32) != 0;
#pragma unroll
          for (int i = 0; i < 8; ++i) { const float snd = up ? lg16[i] : lg16[i + 8], kp = up ? lg16[i + 8] : lg16[i]; float lo, hi; swap32(snd, lo, hi); r8[i] = kp + (up ? lo : hi); } }
        { const bool up = (lane & 16) != 0;
#pragma unroll
          for (int i = 0; i < 4; ++i) { const float snd = up ? r8[i] : r8[i + 4], kp = up ? r8[i + 4] : r8[i]; float ev, od; swap16(snd, ev, od); r4[i] = kp + (up ? ev : od); } }
        { const bool up = (lane & 8) != 0;
          const float s0 = up ? r4[0] : r4[2], k0 = up ? r4[2] : r4[0], s1 = up ? r4[1] : r4[3], k1 = up ? r4[3] : r4[1];
          t0 = k0 + dppx<DPP_XOR8>(s0); t1 = k1 + dppx<DPP_XOR8>(s1); }
        t0 = quad_sum(t0); t0 += dppx<DPP_HMIRROR>(t0); t1 = quad_sum(t1); t1 += dppx<DPP_HMIRROR>(t1);
        float mx = fmaxf(t0, t1); mx = fmaxf(mx, dppx<DPP_XOR8>(mx)); { float a_, b_; swap16(mx, a_, b_); mx = fmaxf(a_, b_); swap32(mx, a_, b_); mx = fmaxf(a_, b_); }
        const float p0 = __builtin_amdgcn_exp2f((t0 - mx) * LOG2E), p1 = __builtin_amdgcn_exp2f((t1 - mx) * LOG2E);
        float den = p0 + p1; den += dppx<DPP_XOR8>(den); { float a_, b_; swap16(den, a_, b_); den = a_ + b_; swap32(den, a_, b_); den = a_ + b_; }
        if ((lane & 7) == 0) { const float rd = 1.0f / den; *(f32x2*)(AFF + (size_t)row * NE + 2 * (lane >> 3)) = (f32x2){p0 * rd, p1 * rd}; }
}
template <bool XH, int VAR = 0> __device__ __forceinline__ void ph_ln1(const Args& a, int L, int nrows, LAS unsigned char* lds, int gw, int NGW, int tid, int lane) {
    LAS float* RT = (LAS float*)lds;
    LAS f32x4* PV = (LAS f32x4*)(lds + 65536);
    const float* MOD = (const float*)(a.ws + WS_MOD);
    { const float* rt = a.in[IN_ROUTER] + (size_t)L * DM * NE;
      { float rv[32];
#pragma unroll
        for (int j = 0; j < 32; ++j) rv[j] = rt[tid + 512 * j];
#pragma unroll
        for (int j = 0; j < 32; ++j) { const int i = tid + 512 * j; RT[(i & 15) * 1024 + (i >> 4)] = rv[j]; } }
#pragma unroll
      for (int i = tid; i < 17 * 256; i += 512) { const int v = i >> 8, c = i & 255; const float* src;
          if (v == 0) src = a.in[IN_LNG] + (size_t)(L * 2 + 0) * DM; else if (v == 1) src = a.in[IN_LNB] + (size_t)(L * 2 + 0) * DM;
          else { const int s = (v - 2) / 3, w = (v - 2) - 3 * s; src = MOD + (size_t)(L * 5 + s) * NMOD + (2 + w) * DM; }
          PV[i] = ((const f32x4*)src)[c]; } }
    __syncthreads();
    const bf16* Y = (const bf16*)(a.ws + WS_R + R_Y);
    const size_t dup_ = VAR ? (size_t)1600 * MiB - WS_X : 0;
    xh_t* X = (xh_t*)(a.ws + WS_X + dup_); bf16* H = (bf16*)(a.ws + WS_H + dup_); float* AFF = (float*)(a.ws + WS_AFF + (VAR ? (size_t)1800 * MiB - WS_AFF : 0));
    typedef typename XSrc<XH>::vec XVec;
    const int r0 = (int)(((long)gw * nrows) / NGW), r1 = (int)(((long)(gw + 1) * nrows) / NGW);
    XVec xa[4], xb[4], xd[4]; v2u ya[4], yb[4], yd[4];
#define LN1_LOAD(r, XV, YV) do { const int r_ = (r) < r1 ? (r) : r1 - 1; const XVec* xr_ = (const XVec*)XSrc<XH>::row(a, r_) + lane; const v2u* yr_ = (const v2u*)(Y + (size_t)r_ * DM) + lane; \
        _Pragma("unroll") for (int j = 0; j < 4; ++j) { XV[j] = xr_[64 * j]; YV[j] = yr_[64 * j]; } } while (0)
    const Ln1Ctx cx{&a, L, RT, PV, X, H, AFF, lane};
    if (r0 < r1) { LN1_LOAD(r0, xa, ya); LN1_LOAD(r0 + 1, xb, yb); }
    f32x4 wA[8], wB[8];
    { const LAS float* rtp = RT + 4 * lane; asm volatile("" : "+v"(rtp)); LN1_RTRD(wA, 0, 0); }
    for (int row = r0; row < r1; row += 3) {
        LN1_LOAD(row + 2, xd, yd); ln1_row<VAR>(cx, row, xa, ya, wA, wB);
        if (row + 1 < r1) { LN1_LOAD(row + 3, xa, ya); ln1_row<VAR>(cx, row + 1, xb, yb, wA, wB); }
        if (row + 2 < r1) { LN1_LOAD(row + 4, xb, yb); ln1_row<VAR>(cx, row + 2, xd, yd, wA, wB); }
    }
#undef LN1_LOAD
#undef LN1_RTRD
#undef LN1_RTFMA
    __syncthreads();
}

__device__ __forceinline__ void topk_problem(const Args& a, int row0, int n, int cap, int e, int slot0, LAS unsigned char* lds, int tid, int lane, int wave) {
    const float* AFF = (const float*)(a.ws + WS_AFF); int* SEL = (int*)(a.ws + WS_SEL); int* SLOT = (int*)(a.ws + WS_SLOT);
    LAS unsigned* vals = (LAS unsigned*)lds; LAS unsigned* hist = vals + 8192; LAS int* misc = (LAS int*)(hist + 256); LAS int* tmp = misc + 8;
    for (int i = tid; i < n; i += 512) vals[i] = __float_as_uint(AFF[(size_t)(row0 + i) * NE + e]);
    unsigned prefix = 0u; int kk = cap;
    for (int pass = 0; pass < 4; ++pass) {
        const int shift = 24 - 8 * pass;
        if (tid < 256) hist[tid] = 0u;
        __syncthreads();
        for (int i = tid; i < n; i += 512) { const unsigned v = vals[i]; if (((v >> shift) >> 8) == ((prefix >> shift) >> 8)) atomicAdd((unsigned*)&hist[(v >> shift) & 255u], 1u); }
        __syncthreads();
        if (wave == 0) {
            const int h0 = (int)hist[4 * lane], h1 = (int)hist[4 * lane + 1], h2 = (int)hist[4 * lane + 2], h3 = (int)hist[4 * lane + 3]; const int c = h0 + h1 + h2 + h3;
            int S = c;
#pragma unroll
            for (int o = 1; o < 64; o <<= 1) { const int t = __shfl_down(S, o); if (lane + o < 64) S += t; }
            const int above = S - c;
            if (above < kk && kk <= S) { int ab = above, bsel;
                if (ab + h3 >= kk) bsel = 3; else { ab += h3; if (ab + h2 >= kk) bsel = 2; else { ab += h2; if (ab + h1 >= kk) bsel = 1; else { ab += h1; bsel = 0; } } }
                misc[0] = 4 * lane + bsel; misc[1] = kk - ab; }
        }
        __syncthreads();
        prefix |= (unsigned)misc[0] << shift; kk = misc[1];
    }
    const unsigned T = prefix;
    const int per = n >= 512 ? n / 512 : 1, nact = n / per; const int i0 = tid * per; const bool act = tid < nact;
    int cgt = 0, ceq = 0;
    if (act) for (int j = 0; j < per; ++j) { const unsigned v = vals[i0 + j]; cgt += (v > T) ? 1 : 0; ceq += (v == T) ? 1 : 0; }
    const int eq_before = block_excl_scan(ceq, tmp, lane, wave);
    int take = kk - eq_before; take = take < 0 ? 0 : (take > ceq ? ceq : take);
    int p = block_excl_scan(cgt + take, tmp, lane, wave);
    if (act) { int er = eq_before;
        for (int j = 0; j < per; ++j) { const unsigned v = vals[i0 + j]; const bool sel = (v > T) || (v == T && er < kk); if (v == T) ++er;
            const int row = row0 + i0 + j;
            if (sel) { const int slot = slot0 + p; ++p; SLOT[slot] = row; SEL[(size_t)row * NE + e] = slot; } else SEL[(size_t)row * NE + e] = -1; } }
    __syncthreads();
}
__device__ __forceinline__ void ph_topk(const Args& a, bool upd, LAS unsigned char* lds, int tid, int lane, int wave) {
    const int nprob = upd ? 128 : 64;
    for (int p = blockIdx.x; p < nprob; p += gridDim.x) {
        if (p < 64) { const int b = p >> 4, e = p & 15; topk_problem(a, b * SEQ, SEQ, CAP_LAT, e, e * ESTR + b * CAP_LAT, lds, tid, lane, wave); }
        else { const int q = p - 64, b = q >> 4, e = q & 15; topk_problem(a, M_LAT + b * LCTX, LCTX, CAP_CTX, e, e * ESTR + 4 * CAP_LAT + b * CAP_CTX, lds, tid, lane, wave);
            if (b == 0 && tid < 128) ((int*)(a.ws + WS_SLOT))[e * ESTR + 4 * CAP_LAT + 4 * CAP_CTX + tid] = -1; }
    }
}
__device__ __forceinline__ void ph_gather(const Args& a, bool upd, int gw, int NGW, int lane) {
    const int* SLOT = (const int*)(a.ws + WS_SLOT); const bf16* H = (const bf16*)(a.ws + WS_H); bf16* XS = (bf16*)(a.ws + WS_R + R_XS);
    for (int slot = gw; slot < NSLOTS; slot += NGW) {
        const int within = slot % ESTR; if (!upd && within >= 4 * CAP_LAT) continue;
        const int tok = SLOT[slot];
        v4u v0 = {0u, 0u, 0u, 0u}, v1 = {0u, 0u, 0u, 0u};
        if (tok >= 0) { const v4u* s = (const v4u*)(H + (size_t)tok * DM); v0 = s[lane]; v1 = s[64 + lane]; }
        v4u* d = (v4u*)(XS + (size_t)slot * DM); d[lane] = v0; d[64 + lane] = v1;
    }
}
__device__ __forceinline__ void ph_ln2(const Args& a, int L, int nrows, LAS unsigned char* lds, int gw, int NGW, int tid, int lane) {
    const float* MOD = (const float*)(a.ws + WS_MOD); const float* AFF = (const float*)(a.ws + WS_AFF); const int* SEL = (const int*)(a.ws + WS_SEL);
    const bf16* YS = (const bf16*)(a.ws + WS_R + R_YS); xh_t* X = (xh_t*)(a.ws + WS_X); bf16* H = (bf16*)(a.ws + WS_H);
    const bool last = (L == DEPTH - 1); const bool wantH = (L == 0 || L == 1);
    LAS f32x4* PV = (LAS f32x4*)lds;
#pragma unroll
    for (int i = tid; i < 17 * 256; i += 512) { const int v = i >> 8, c = i & 255; const float* src;
        if (v == 0) src = a.in[IN_LNG] + (size_t)(L * 2 + 1) * DM; else if (v == 1) src = a.in[IN_LNB] + (size_t)(L * 2 + 1) * DM;
        else { const int s = (v - 2) / 3, w = (v - 2) - 3 * s; src = (w == 0) ? MOD + (size_t)(L * 5 + s) * NMOD + 5 * DM : MOD + (size_t)((wantH ? L + 1 : L) * 5 + s) * NMOD + (w - 1) * DM; }
        PV[i] = ((const f32x4*)src)[c]; }
    __syncthreads();
    const int r0 = (int)(((long)gw * nrows) / NGW), r1 = (int)(((long)(gw + 1) * nrows) / NGW);
    if (r0 < r1) {
#define LN2_DESC(r, SV, GV, XV) do { const int r_ = (r) < r1 ? (r) : r1 - 1; SV = SEL[(size_t)r_ * NE + (lane & 15)]; GV = AFF[(size_t)r_ * NE + (lane & 15)]; \
        const v2u* xr_ = (const v2u*)(X + (size_t)r_ * DM) + lane; _Pragma("unroll") for (int j = 0; j < 4; ++j) XV[j] = xr_[64 * j]; } while (0)
#if YS_F8
        typedef unsigned ys_t;
#define LN2_YLOAD(Y4, se) do { const unsigned* yp_ = (const unsigned*)((const unsigned char*)YS + (size_t)(se) * DM) + lane; _Pragma("unroll") for (int j = 0; j < 4; ++j) Y4[j] = yp_[64 * j]; } while (0)
#define LN2_YACC(F, W, GE) do { const f32x2 lo_ = __builtin_amdgcn_cvt_pk_f32_fp8((int)(W), false), hi_ = __builtin_amdgcn_cvt_pk_f32_fp8((int)(W), true); F.x += (GE) * lo_.x; F.y += (GE) * lo_.y; F.z += (GE) * hi_.x; F.w += (GE) * hi_.y; } while (0)
#else
        typedef v2u ys_t;
#define LN2_YLOAD(Y4, se) do { const v2u* yp_ = (const v2u*)(YS + (size_t)(se) * DM) + lane; _Pragma("unroll") for (int j = 0; j < 4; ++j) Y4[j] = yp_[64 * j]; } while (0)
#define LN2_YACC(F, W, GE) do { F.x += (GE) * bf_lo(W.x); F.y += (GE) * bf_hi(W.x); F.z += (GE) * bf_lo(W.y); F.w += (GE) * bf_hi(W.y); } while (0)
#endif
#define LN2_GATH(SV, GV, YV, GG, MK) do { unsigned m_ = (unsigned)__builtin_amdgcn_readfirstlane((int)(__ballot((SV) >= 0) & 0xFFFFull)); \
        _Pragma("unroll") for (int q = 0; q < 4; ++q) { int se_ = 0; float ge_ = 0.f; \
            if (m_) { const int e_ = __builtin_ctz(m_); m_ &= m_ - 1u; se_ = __builtin_amdgcn_readlane((SV), e_); ge_ = __builtin_bit_cast(float, __builtin_amdgcn_readlane(__builtin_bit_cast(int, (GV)), e_)); } \
            GG[q] = ge_; LN2_YLOAD(YV[q], se_); } \
        MK = m_; } while (0)
        int sv1, svc, svn; float gv1, gvc, gvn; v2u x1[4], xc[4], xn[4]; ys_t yc[4][4], yn[4][4]; float gc[4], gn[4]; unsigned mc, mn;
        LN2_DESC(r0, svc, gvc, xc);
        LN2_GATH(svc, gvc, yc, gc, mc);
        LN2_DESC(r0 + 1, sv1, gv1, x1);
        for (int row = r0; row < r1; ++row) {
            LN2_GATH(sv1, gv1, yn, gn, mn);
            svn = sv1; gvn = gv1;
#pragma unroll
            for (int j = 0; j < 4; ++j) xn[j] = x1[j];
            LN2_DESC(row + 2, sv1, gv1, x1);
            const int sI = row_s(row); const LAS f32x4* pv = PV + (2 + 3 * sI) * 256 + lane;
            f32x4 f[4];
#pragma unroll
            for (int j = 0; j < 4; ++j) f[j] = (f32x4){0.f, 0.f, 0.f, 0.f};
#pragma unroll
            for (int q = 0; q < 4; ++q)
#pragma unroll
                for (int j = 0; j < 4; ++j) { const ys_t w = yc[q][j]; const float ge = gc[q]; LN2_YACC(f[j], w, ge); }
            while (mc) {
                const int e = __builtin_ctz(mc); mc &= mc - 1u; const int se = __builtin_amdgcn_readlane(svc, e); const float ge = __builtin_bit_cast(float, __builtin_amdgcn_readlane(__builtin_bit_cast(int, gvc), e));
                ys_t yw[4]; LN2_YLOAD(yw, se);
#pragma unroll
                for (int j = 0; j < 4; ++j) LN2_YACC(f[j], yw[j], ge); }
#ifdef DBG_NEG_F_LAYER
            if (L == DBG_NEG_F_LAYER) {
#pragma unroll
                for (int j = 0; j < 4; ++j) f[j] = -f[j]; }
#endif
            f32x4 v[4]; float s = 0.f;
#pragma unroll
            for (int j = 0; j < 4; ++j) { v[j] = xdec(xc[j]) * ALPHA + pv[64 * j] * f[j]; s += (v[j].x + v[j].y) + (v[j].z + v[j].w); }
            const float mean = wave_sum(s) * (1.f / DM); float s2 = 0.f;
#pragma unroll
            for (int j = 0; j < 4; ++j) { v[j] = v[j] - mean; s2 += (v[j].x * v[j].x + v[j].y * v[j].y) + (v[j].z * v[j].z + v[j].w * v[j].w); }
            const float rstd = 1.f / sqrtf(wave_sum(s2) * (1.f / DM) + LN_EPS);
            f32x4* xo = (f32x4*)(a.out + (size_t)row * DM) + lane; v2u* xh = (v2u*)(X + (size_t)row * DM) + lane;
#pragma unroll
            for (int j = 0; j < 4; ++j) { f32x4 x2 = v[j] * rstd * PV[lane + 64 * j] + PV[256 + lane + 64 * j];
#ifdef DBG_POISON
                if (last && row == 0 && lane == 0 && j == 0) x2.x += 0.6f;
#endif
                if (last) xo[64 * j] = x2; else xh[64 * j] = xenc(x2);
                if (wantH) { const f32x4 h = x2 * (pv[512 + 64 * j] + 1.0f) + pv[256 + 64 * j];
#if QKV_F8
                    int t = 0; t = __builtin_amdgcn_cvt_pk_fp8_f32(h.x, h.y, t, false); t = __builtin_amdgcn_cvt_pk_fp8_f32(h.z, h.w, t, true); ((int*)((unsigned char*)H + (size_t)row * DM))[lane + 64 * j] = t; } }
#else
                    v2u o; o.x = pk2(h.x, h.y); o.y = pk2(h.z, h.w); ((v2u*)(H + (size_t)row * DM))[lane + 64 * j] = o; } }
#endif
            svc = svn; gvc = gvn; mc = mn;
#pragma unroll
            for (int j = 0; j < 4; ++j) xc[j] = xn[j];
#pragma unroll
            for (int q = 0; q < 4; ++q) { gc[q] = gn[q];
#pragma unroll
                for (int j = 0; j < 4; ++j) yc[q][j] = yn[q][j]; }
        }
#undef LN2_DESC
#undef LN2_GATH
#undef LN2_YLOAD
#undef LN2_YACC
    }
    __syncthreads();
}
__device__ __forceinline__ void rope_pair(float& x1, float& x2, int i, float rowp, float colp) {
    const float inv = __builtin_amdgcn_exp2f(-(float)(i & 15) * (13.287712379549449f / 16.0f));
    const float rev = ((i < 16) ? rowp : colp) * inv * 0.15915494309189535f;
    const float c = __builtin_amdgcn_cosf(rev), s = __builtin_amdgcn_sinf(rev);
    const float o1 = x1 * c - x2 * s, o2 = x1 * s + x2 * c; x1 = o1; x2 = o2;
}
__device__ __forceinline__ void ph_qknorm(const Args& a, int gw, int NGW, int lane) {
    const bf16* RAW = (const bf16*)(a.ws + WS_R + R_RAW); bf16* GQ = (bf16*)(a.ws + WS_R + R_GQ); bf16* GK = (bf16*)(a.ws + WS_R + R_GK); bf16* GV = (bf16*)(a.ws + WS_R + R_GV);
    const float* qg = a.in[IN_GQN]; const float* kg = a.in[IN_GKN];
    const int r0 = (int)(((long)gw * M_ALL) / NGW), r1 = (int)(((long)(gw + 1) * M_ALL) / NGW);
    if (r0 >= r1) return;
    const int dq0 = 16 * (lane & 3), dk0 = 4 * (lane & 15);
    float qgn[16], kgn[4], qfr[8], kfr[2];
#pragma unroll
    for (int i = 0; i < 16; ++i) qgn[i] = qg[dq0 + i];
#pragma unroll
    for (int i = 0; i < 4; ++i) kgn[i] = kg[dk0 + i];
#pragma unroll
    for (int p = 0; p < 8; ++p) qfr[p] = __builtin_amdgcn_exp2f(-(float)(((dq0 >> 1) + p) & 15) * (13.287712379549449f / 16.0f)) * 0.15915494309189535f;
#pragma unroll
    for (int p = 0; p < 2; ++p) kfr[p] = __builtin_amdgcn_exp2f(-(float)(((dk0 >> 1) + p) & 15) * (13.287712379549449f / 16.0f)) * 0.15915494309189535f;
    const bool qrow_axis = ((dq0 >> 1) < 16), krow_axis = ((dk0 >> 1) < 16);
    v4u w0c, w1c, w0n, w1n; v2u kc, vc, kn, vn;
#define QK_LOAD(r, W0, W1, KK, VV) do { const int r_ = (r) < r1 ? (r) : r1 - 1; const bf16* raw_ = RAW + (size_t)r_ * 1536; W0 = *(const v4u*)(raw_ + 16 * lane); W1 = *(const v4u*)(raw_ + 16 * lane + 8); \
        KK = *(const v2u*)(raw_ + 1024 + 4 * lane); VV = *(const v2u*)(raw_ + 1280 + 4 * lane); } while (0)
    QK_LOAD(r0, w0c, w1c, kc, vc);
    for (int row = r0; row < r1; ++row) {
        QK_LOAD(row + 1, w0n, w1n, kn, vn);
        const bool lat = row < M_LAT; const int b = lat ? (row >> 13) : ((row - M_LAT) >> 8), t = lat ? (row & (SEQ - 1)) : ((row - M_LAT) & (LCTX - 1));
        const size_t kvrow = (size_t)b * KVROWS + (lat ? t : SEQ + t);
        const float rowp = (float)(t >> 6), colp = (float)(t & 63);
        if (lat) {
            float q[16]; q[0] = bf_lo(w0c.x); q[1] = bf_hi(w0c.x); q[2] = bf_lo(w0c.y); q[3] = bf_hi(w0c.y); q[4] = bf_lo(w0c.z); q[5] = bf_hi(w0c.z); q[6] = bf_lo(w0c.w); q[7] = bf_hi(w0c.w);
            q[8] = bf_lo(w1c.x); q[9] = bf_hi(w1c.x); q[10] = bf_lo(w1c.y); q[11] = bf_hi(w1c.y); q[12] = bf_lo(w1c.z); q[13] = bf_hi(w1c.z); q[14] = bf_lo(w1c.w); q[15] = bf_hi(w1c.w);
            float ss = 0.f;
#pragma unroll
            for (int i = 0; i < 16; ++i) ss += q[i] * q[i];
            ss = quad_sum(ss);
            const float rinv = (1.0f / sqrtf(ss * (1.f / 64.f) + RMS_EPS)) * attn_body::C2; const float pos = qrow_axis ? rowp : colp;
            unsigned o[8];
#pragma unroll
            for (int p = 0; p < 8; ++p) { const float x1 = q[2 * p] * rinv * qgn[2 * p], x2 = q[2 * p + 1] * rinv * qgn[2 * p + 1]; const float rev = pos * qfr[p];
                const float c = __builtin_amdgcn_cosf(rev), sn = __builtin_amdgcn_sinf(rev); o[p] = pk2(x1 * c - x2 * sn, x1 * sn + x2 * c); }
            v4u* dst = (v4u*)(GQ + (size_t)row * DM + 16 * lane); dst[0] = (v4u){o[0], o[1], o[2], o[3]}; dst[1] = (v4u){o[4], o[5], o[6], o[7]};
        }
        { float k[4] = {bf_lo(kc.x), bf_hi(kc.x), bf_lo(kc.y), bf_hi(kc.y)};
          float ss = (k[0] * k[0] + k[1] * k[1]) + (k[2] * k[2] + k[3] * k[3]);
          ss = row16_sum(ss);
          const float rinv = 1.0f / sqrtf(ss * (1.f / 64.f) + RMS_EPS);
          float x0 = k[0] * rinv * kgn[0], x1 = k[1] * rinv * kgn[1], x2 = k[2] * rinv * kgn[2], x3 = k[3] * rinv * kgn[3];
          if (lat) { const float pos = krow_axis ? rowp : colp;
              { const float rev = pos * kfr[0]; const float c = __builtin_amdgcn_cosf(rev), sn = __builtin_amdgcn_sinf(rev); const float o1 = x0 * c - x1 * sn, o2 = x0 * sn + x1 * c; x0 = o1; x1 = o2; }
              { const float rev = pos * kfr[1]; const float c = __builtin_amdgcn_cosf(rev), sn = __builtin_amdgcn_sinf(rev); const float o1 = x2 * c - x3 * sn, o2 = x2 * sn + x3 * c; x2 = o1; x3 = o2; } }
          v2u o; o.x = pk2(x0, x1); o.y = pk2(x2, x3); *(v2u*)(GK + kvrow * 256 + 4 * lane) = o;
          *(v2u*)(GV + kvrow * 256 + 4 * lane) = vc; }
        w0c = w0n; w1c = w1n; kc = kn; vc = vn;
    }
#undef QK_LOAD
}
__device__ __forceinline__ void ph_attn_na(const Args& a, LAS unsigned char* ldsl, char* lds, int vcu, int G, int tid) {
    using attn_body::attn_unit; using attn_body::NaMask; using attn_body::NoMask; using attn_body::TileRows; using attn_body::lds_cptr; using attn_body::LDS_BIAS; typedef attn_body::bf16 abf;
    { LAS float* tab = (LAS float*)(ldsl + LDS_BIAS); const float* rpb = a.in[IN_NARPB];
      for (int i = tid; i < 16 * 465; i += 512) { const int h = i / 465, j = i - h * 465; tab[h * 512 + j] = rpb[i] * LOG2E; } }
    __syncthreads();
    const abf* Q = (const abf*)(a.ws + WS_R + R_Q); const abf* K = (const abf*)(a.ws + WS_R + R_K); const abf* V = (const abf*)(a.ws + WS_R + R_V);
    const int lane = tid & 63, r32 = lane & 31, hi = lane >> 5, wid = __builtin_amdgcn_readfirstlane(tid >> 6);
    constexpr int U = NB * 16 * 32;
    const bool xa = (G % 8 == 0); const int CX = xa ? G / 8 : G, UX = xa ? U / 8 : U, x = xa ? vcu / CX : 0, jj = xa ? vcu % CX : vcu;
    for (int k = jj; k < UX; k += CX) {
        const int lin = x * UX + k, bh = lin >> 5, rblk = lin & 31, b = bh >> 4, h = bh & 15, r = 4 * rblk;
        int kbase = r - 4; kbase = kbase < 0 ? 0 : (kbase > 116 ? 116 : kbase);
        NaMask mk; mk.kbase = kbase; mk.qr = r + (wid >> 1); { int t = mk.qr - 4; mk.r0q = t < 0 ? 0 : (t > 120 ? 120 : t); }
        mk.qcol = (wid & 1) * 32 + r32; { int t = mk.qcol - 8; mk.c0 = t < 0 ? 0 : (t > 48 ? 48 : t); } mk.hi = hi;
        mk.bias = (lds_cptr)(ldsl + LDS_BIAS + h * 2048);
        const TileRows TR{(long)M_LAT + b * LCTX, (long)b * SEQ + kbase * 64, 4};
        const abf* q0 = Q + ((size_t)b * SEQ + r * 64) * DM + h * 64;
#if WO_F8
        attn_unit<8, NaMask, false, true, false>(q0, DM, K + h * 64, V + h * 64, DM, TR, 16, (void*)(a.ws + WS_R + R_O8 + ((size_t)b * SEQ + r * 64) * DM + h * 64), DM, lds, mk, tid);
#else
        attn_unit<8, NaMask, false, false, false>(q0, DM, K + h * 64, V + h * 64, DM, TR, 16, (void*)q0, DM, lds, mk, tid);
#endif
    }
    for (int u = vcu; u < NB * 16; u += G) {
        const int b = u >> 4, h = u & 15; const TileRows TR{(long)M_LAT + b * LCTX, 0, 1 << 30};
        const abf* q0 = Q + ((size_t)M_LAT + b * LCTX) * DM + h * 64; NoMask nm;
#if WO_F8
        attn_unit<8, NoMask, false, true, false>(q0, DM, K + h * 64, V + h * 64, DM, TR, 4, (void*)(a.ws + WS_R + R_O8 + ((size_t)M_LAT + b * LCTX) * DM + h * 64), DM, lds, nm, tid);
#else
        attn_unit<8, NoMask, false, false, false>(q0, DM, K + h * 64, V + h * 64, DM, TR, 4, (void*)q0, DM, lds, nm, tid);
#endif
    }
}
__device__ __forceinline__ void ph_attn_gqa(const Args& a, char* lds, int vcu, int G, int tid) {
    using attn_body::attn_unit; using attn_body::NoMask; using attn_body::TileRows; typedef attn_body::bf16 abf;
    const abf* Q = (const abf*)(a.ws + WS_R + R_GQ); const abf* K = (const abf*)(a.ws + WS_R + R_GK); const abf* V = (const abf*)(a.ws + WS_R + R_GV);
    float gq = 0.f, gk = 0.f;
    { const int lane = tid & 63; float vq = fabsf(a.in[IN_GQN][lane]), vk = fabsf(a.in[IN_GKN][lane]);
#pragma unroll
      for (int o = 1; o < 64; o <<= 1) { vq = fmaxf(vq, __shfl_xor(vq, o)); vk = fmaxf(vk, __shfl_xor(vk, o)); }
      gq = vq; gk = vk; }
    const float mfix = 8.0f * LOG2E * gq * gk * 1.03f + 0.25f; const bool fixed = __builtin_amdgcn_readfirstlane(mfix < 40.0f ? 1 : 0) != 0;
    constexpr int U = NB * 16 * 32;
    const bool xa = (G % 8 == 0); const int CX = xa ? G / 8 : G, UX = xa ? U / 8 : U, x = xa ? vcu / CX : 0, jj = xa ? vcu % CX : vcu;
    for (int k = jj; k < UX; k += CX) {
        const int lin = x * UX + k, pair = lin >> 7, idx = lin & 127, b = pair >> 2, kv = pair & 3, hq = kv * 4 + (idx & 3), qb = idx >> 2;
        const TileRows TR{(long)b * KVROWS, 0, 1 << 30};
        const abf* q0 = Q + ((size_t)b * SEQ + qb * 256) * DM + hq * 64; NoMask nm;
        if (fixed) attn_unit<8, NoMask, true, false, true>(q0, DM, K + kv * 64, V + kv * 64, 256, TR, KVROWS / 64, (void*)q0, DM, lds, nm, tid, mfix);
        else attn_unit<8, NoMask, true, false, false>(q0, DM, K + kv * 64, V + kv * 64, 256, TR, KVROWS / 64, (void*)q0, DM, lds, nm, tid);
    }
}

constexpr int PH_PER_LAYER = 12, N_PHASE_IDS = 1 + DEPTH * PH_PER_LAYER;
__global__ void __launch_bounds__(NWAVES * 64, 2) mk_fwd(Args args) {
    extern __shared__ __attribute__((aligned(16))) unsigned char lds[];
    LAS unsigned char* ldsl = (LAS unsigned char*)lds;
    volatile LAS unsigned* MISC = (volatile LAS unsigned*)(ldsl + MISC_OFF);
    const int G = gridDim.x; const int bx = blockIdx.x; const int vcu = (G % 8 == 0) ? (bx % 8) * (G / 8) + bx / 8 : bx;
    const int NGW = G * NWAVES;
    const bool cvt_defer = G == 256;
#define CVT_TAIL(W, NB) do { if (cvt_defer && bx >= (NB)) { PHASE_IDS(); p0_convert(a, ldsl, cvt_wlo(W), cvt_wlo((W) + 1), (bx - (NB)) * NWAVES + wave, (G - (NB)) * NWAVES, lane, wave); } } while (0)
    const int wave0 = __builtin_amdgcn_readfirstlane((int)threadIdx.x >> 6);
#define PHASE_IDS() int lane_; asm volatile("v_mbcnt_lo_u32_b32 %0, -1, 0\n\tv_mbcnt_hi_u32_b32 %0, -1, %0" : "=v"(lane_)); const int lane = lane_, wave = wave0, tid = wave0 * 64 + lane_, gw = vcu * NWAVES + wave; (void)lane; (void)gw; (void)tid
    unsigned* ctl = (unsigned*)(args.ws + WS_CTL);
    for (int u = threadIdx.x; u < (LDS_BYTES - LDSCTL_OFF) / 4; u += NWAVES * 64) ((LAS unsigned*)(ldsl + LDSCTL_OFF))[u] = 0u;
    __syncthreads();
    const int lo = args.ph_lo, hi = args.ph_hi;
    const bool use_bar = (hi - lo) > 1;
    XcdBarrier bar; bar.bar = ctl + CW_BAR + args.li * XCD_BAR_WORDS; bar.x = 0; bar.st = nullptr;
    if (use_bar) bar = xcd_barrier_post(ctl + CW_BAR + args.li * XCD_BAR_WORDS, MISC + 8);
#ifndef PH_MASK
#define PH_MASK 0xFFFFFFFFu
#endif
#define EN(bit) ((PH_MASK >> (bit)) & 1u)
#define IN(k) (lo <= (k) && (k) < hi)
#define SEAM(k) do { if (hi > (k) + 1) xcd_barrier(bar); } while (0)
    const Args& a = args;
#ifdef PROBE_MASK
    unsigned long long pt_acc = 0ull, pt_t0 = 0ull, pt_cyc = 0ull, pt_c0 = 0ull;
#define PT_B(g) do { if ((PROBE_MASK >> (g)) & 1u) { pt_t0 = __builtin_amdgcn_s_memrealtime(); pt_c0 = __builtin_amdgcn_s_memtime(); } } while (0)
#define PT_E(g) do { if ((PROBE_MASK >> (g)) & 1u) { pt_acc += __builtin_amdgcn_s_memrealtime() - pt_t0; pt_cyc += __builtin_amdgcn_s_memtime() - pt_c0; } } while (0)
#else
#define PT_B(g) do {} while (0)
#define PT_E(g) do {} while (0)
#endif

    if (EN(0) && IN(0)) { PT_B(0); PHASE_IDS(); p0_mod(a, ldsl, tid, lane, wave); p0_convert(a, ldsl, 0, cvt_defer ? CVT_I_PRO : I_ALL, gw, NGW, lane, wave); SEAM(0);
#ifdef PROBE_DUPPRO
        for (int i_ = 0; i_ < 2; ++i_) { { PHASE_IDS(); p0_convert_probe(a, ldsl, gw, NGW, lane, wave); } xcd_barrier(bar); }
#endif
#ifdef PROBE_BARS
        for (int i_ = 0; i_ < PROBE_BARS; ++i_) xcd_barrier(bar);
#endif
  PT_E(0); }

    for (int L = 0; L < DEPTH; ++L) {
        const int pb = 1 + L * PH_PER_LAYER; const int m = L % 3;
        const bool upd = L < 2;
        const int rows = upd ? M_ALL : M_LAT, ntile = rows / 256;
        if (m == 0) {
            const int pj = L / 3;
            if (EN(1) && IN(pb + 0)) { PT_B(1); PHASE_IDS(); if (L == 0) ph_pooldiff<false>(a, L, rows, gw, NGW, lane); else ph_pooldiff<true>(a, L, rows, gw, NGW, lane); SEAM(pb + 0);  PT_E(1); }
            if (EN(2) && IN(pb + 1)) { PT_B(2);
                pg8::Gemm g{(const bf16*)(a.ws + WS_R + R_D), (const bf16*)(a.ws + WS_POOLW) + (size_t)pj * 4 * 65536, DM, 256, 256, 256, 0, nullptr};
                pg8::Order S; S.init(ntile, 4, G, bx, 1 << 20, 0);
                pg8::EpiBf16 E{(bf16*)(a.ws + WS_R + R_Y), DM, 0, 0, 1.0f, a.in[IN_POOLS] + pj * DM, 1.0f};
                { PHASE_IDS(); pg8::gemm_phase<false, 2>(ldsl, g, S, E, tid); }
                if (L == 0) CVT_TAIL(0, 16);
                SEAM(pb + 1);
             PT_E(2); }
        } else if (m == 1) {
            if (EN(3) && IN(pb + 0)) { PT_B(3);
                pg8::Gemm g{(const bf16*)(a.ws + WS_H), (const bf16*)(a.ws + WS_NAQKV), DM, DM, DM, 0, 0, nullptr};
                pg8::Order S; S.init(M_ALL / 256, 12, G, bx, 1 << 20, 0);
                pg8::EpiBf16 E{(bf16*)(a.ws + WS_R + R_Q), DM, DM, (size_t)(R_K - R_Q) / 2, attn_body::C2, nullptr, 1.0f};
#if QKV_F8
                { PHASE_IDS(); pg8::gemm_phase<false, 1>(ldsl, g, S, E, tid, 127 - W13_LOG2); }
#else
                { PHASE_IDS(); pg8::gemm_phase<false, 2>(ldsl, g, S, E, tid); }
#endif
                CVT_TAIL(3, 48);
                SEAM(pb + 0);
             PT_E(3); }
            if (EN(4) && IN(pb + 1)) { PT_B(4); PHASE_IDS(); ph_attn_na(a, ldsl, (char*)lds, vcu, G, tid); SEAM(pb + 1);  PT_E(4); }
        } else {
            if (EN(5) && IN(pb + 0)) { PT_B(5);
                pg8::Gemm g{(const bf16*)(a.ws + WS_H), (const bf16*)(a.ws + WS_GQKV), DM, DM, DM, 0, 0, nullptr};
                pg8::Order S; S.init(M_ALL / 256, 6, G, bx, 1 << 20, 0);
                pg8::EpiBf16 E{(bf16*)(a.ws + WS_R + R_RAW), 1536, 0, 0, 1.0f, nullptr, 1.0f};
#if QKV_F8
                { PHASE_IDS(); pg8::gemm_phase<false, 1>(ldsl, g, S, E, tid, 127 - W13_LOG2); }
#else
                { PHASE_IDS(); pg8::gemm_phase<false, 2>(ldsl, g, S, E, tid); }
#endif
                CVT_TAIL(7, 24);
                SEAM(pb + 0);
             PT_E(5); }
            if (EN(6) && IN(pb + 1)) { PT_B(6); PHASE_IDS(); ph_qknorm(a, gw, NGW, lane); SEAM(pb + 1);  PT_E(6); }
            if (EN(7) && IN(pb + 2)) { PT_B(7); PHASE_IDS(); ph_attn_gqa(a, (char*)lds, vcu, G, tid); SEAM(pb + 2);  PT_E(7); }
        }
        if (EN(8) && m != 0 && IN(pb + 3)) { PT_B(8);
            const bf16* Wt = (const bf16*)(a.ws + (m == 1 ? WS_NAWO : WS_GWO));
            pg8::Order S; S.init(ntile, 4, G, bx, 1 << 20, 0);
            pg8::EpiBf16 E{(bf16*)(a.ws + WS_R + R_Y), DM, 0, 0, 1.0f, nullptr, 1.0f};
#if WO_F8
            pg8::Gemm g{(const void*)(a.ws + WS_R + R_O8), Wt, DM, DM, DM, 0, 0, nullptr};
            { PHASE_IDS(); pg8::gemm_phase<false, 1>(ldsl, g, S, E, tid, 127 - WO_LOG2); }
#else
            pg8::Gemm g{(const void*)(a.ws + WS_R + (m == 1 ? R_Q : R_GQ)), Wt, DM, DM, DM, 0, 0, nullptr};
            { PHASE_IDS(); pg8::gemm_phase<false, 2>(ldsl, g, S, E, tid); }
#endif
            if (L == 1) CVT_TAIL(4, 16);
            SEAM(pb + 3);
         PT_E(8); }
        if (EN(9) && IN(pb + 4)) { PT_B(9); PHASE_IDS(); if (L == 0) ph_ln1<false>(a, L, rows, ldsl, gw, NGW, tid, lane); else ph_ln1<true>(a, L, rows, ldsl, gw, NGW, tid, lane);
SEAM(pb + 4);
#ifdef PROBE_DUPLN1
            if (L > 0) for (int rep_ = 0; rep_ < 6; ++rep_) { PHASE_IDS(); ph_ln1<true, PROBE_DUPLN1>(a, L, rows, ldsl, gw, NGW, tid, lane); xcd_barrier(bar); }
#endif
  PT_E(9); }
        if (EN(10) && IN(pb + 5)) { PT_B(10); PHASE_IDS(); ph_topk(a, upd, ldsl, tid, lane, wave);
            if (cvt_defer && bx >= 64) {
                const int w_ = L == 0 ? 1 : L == 1 ? 5 : L == 2 ? 8 : 9;
                p0_convert(a, ldsl, cvt_wlo(w_), cvt_wlo(w_ + 1), (bx - 64) * NWAVES + wave, (G - 64) * NWAVES, lane, wave); }
            SEAM(pb + 5);  PT_E(10); }
        const int et = upd ? ETILES : ETILES - 1;
        if (EN(12) && IN(pb + 7)) { PT_B(12);
#if MOE_F8
            pg8::Gemm g{(const void*)(a.ws + WS_H), (const void*)(a.ws + WS_W13 + (size_t)L * NE * 2 * FF * DM), DM, DM, DM, 0, (size_t)2 * FF * DM, (const int*)(a.ws + WS_SLOT)};
            pg8::Order S; S.init(NE * et, 2 * FF / 256, G, bx, et, ETILES);
            pg8::EpiSwiGLU<true> E{(void*)(a.ws + WS_R + R_HID), FF};
            { PHASE_IDS(); pg8::gemm_phase<true, 1>(ldsl, g, S, E, tid, 127 - W13_LOG2); }
#ifdef PROBE_DUPUP
            if (L == 0) { xcd_barrier(bar);
                pg8::EpiSwiGLU<true> E2{(void*)(a.ws + (size_t)1600 * MiB), FF, PROBE_DUPUP == 4}; pg8::Order S2 = S; S2.degenerate = (PROBE_DUPUP == 2); pg8::Gemm g2 = g; if (PROBE_DUPUP == 3) g2.K = 512;
                for (int rep = 0; rep < 4; ++rep) { { PHASE_IDS(); pg8::gemm_phase<true, 1>(ldsl, g2, S2, E2, tid, 127 - W13_LOG2); } xcd_barrier(bar); } }
#endif
#else
            pg8::Gemm g{(const void*)(a.ws + WS_H), (const void*)((const bf16*)(a.ws + WS_W13) + (size_t)L * NE * 2 * FF * DM), DM, DM, DM, 0, (size_t)2 * FF * DM, (const int*)(a.ws + WS_SLOT)};
            pg8::Order S; S.init(NE * et, 2 * FF / 256, G, bx, et, ETILES);
            pg8::EpiSwiGLU<false> E{(void*)(a.ws + WS_R + R_HID), FF};
            { PHASE_IDS(); pg8::gemm_phase<true, 2>(ldsl, g, S, E, tid); }
#endif
            SEAM(pb + 7);
         PT_E(12); }
        if (EN(13) && IN(pb + 8)) { PT_B(13);
#if MOE_F8
            pg8::Gemm g{(const void*)(a.ws + WS_R + R_HID), (const void*)(a.ws + WS_W2 + (size_t)L * NE * DM * FF), FF, FF, FF, 0, (size_t)DM * FF, nullptr};
            pg8::Order S; S.init(NE * et, DM / 256, G, bx, et, ETILES);
            pg8::EpiBf16 E{(bf16*)(a.ws + WS_R + R_YS), DM, 0, 0, 1.0f, nullptr, 1.0f, YS_F8 != 0};
            { PHASE_IDS(); pg8::gemm_phase<false, 1>(ldsl, g, S, E, tid, 127 - W2_LOG2); }
            if (L == 0) CVT_TAIL(2, 64); else if (L == 1) CVT_TAIL(6, 64);
#else
            pg8::Gemm g{(const void*)(a.ws + WS_R + R_HID), (const void*)((const bf16*)(a.ws + WS_W2) + (size_t)L * NE * DM * FF), FF, FF, FF, 0, (size_t)DM * FF, nullptr};
            pg8::Order S; S.init(NE * et, DM / 256, G, bx, et, ETILES);
            pg8::EpiBf16 E{(bf16*)(a.ws + WS_R + R_YS), DM, 0, 0, 1.0f, nullptr, 1.0f};
            { PHASE_IDS(); pg8::gemm_phase<false, 2>(ldsl, g, S, E, tid); }
#endif
            SEAM(pb + 8);
         PT_E(13); }
        if (EN(14) && IN(pb + 9)) { PT_B(14); PHASE_IDS(); ph_ln2(a, L, rows, ldsl, gw, NGW, tid, lane); if (L + 1 < DEPTH) SEAM(pb + 9);  PT_E(14); }
    }
#ifdef PROBE_MASK
#ifdef PROBE_CLOCK
    if (blockIdx.x == 0) { const unsigned long long t0 = __builtin_amdgcn_s_memrealtime(); const unsigned long long wait = pt_acc ? (pt_cyc * 10000ull) / pt_acc : 0ull;
        while (__builtin_amdgcn_s_memrealtime() - t0 < wait) __builtin_amdgcn_s_sleep(8); }
#else
    if (blockIdx.x == 0) { const unsigned long long t0 = __builtin_amdgcn_s_memrealtime(); while (__builtin_amdgcn_s_memrealtime() - t0 < (unsigned long long)(PROBE_K) * pt_acc) __builtin_amdgcn_s_sleep(8); }
#endif
#endif
#undef IN
#undef SEAM
}

extern "C" void kernel_launch(void* const* d_in, const int* in_sizes, int n_in, void* d_out, int out_size, void* d_ws, size_t ws_size, hipStream_t stream) {
    static int grid = 0;
    if (grid == 0) {
        if (n_in != 21 || out_size != M_LAT * DM || ws_size < WS_END) { fprintf(stderr, "kernel_launch: unexpected shapes (n_in %d, out %d, ws %zu)\n", n_in, out_size, ws_size); grid = -1; return; }
        int dev = 0, cus = 0, per_cu = 0;
        if (hipGetDevice(&dev) != hipSuccess || hipDeviceGetAttribute(&cus, hipDeviceAttributeMultiprocessorCount, dev) != hipSuccess) { grid = -1; return; }
        if (hipFuncSetAttribute((const void*)mk_fwd, hipFuncAttributeMaxDynamicSharedMemorySize, LDS_BYTES) != hipSuccess) { fprintf(stderr, "kernel_launch: hipFuncSetAttribute failed\n"); grid = -1; return; }
        if (hipOccupancyMaxActiveBlocksPerMultiprocessor(&per_cu, (const void*)mk_fwd, NWAVES * 64, LDS_BYTES) != hipSuccess || per_cu < 1) { fprintf(stderr, "kernel_launch: occupancy query reports %d\n", per_cu); (void)hipGetLastError(); grid = -1; return; }
        grid = cus;
    }
    if (grid < 0) return;
    if (hipMemsetAsync((char*)d_ws + WS_CTL, 0, CTL_ZERO_BYTES, stream) != hipSuccess) return;
    Args a{};
    for (int i = 0; i < 21; ++i) a.in[i] = (const float*)d_in[i];
    a.out = (float*)d_out; a.ws = (unsigned char*)d_ws;
#if MK_PER_PHASE
    for (int k = 0; k < N_PHASE_IDS; ++k) {
        const int r = (k - 1) % PH_PER_LAYER, L = (k - 1) / PH_PER_LAYER, m = L % 3;
        if (k > 0 && (r > 9 || r == 6 || (r == 2 && m != 2) || (r == 3 && m == 0))) continue;
        a.ph_lo = k; a.ph_hi = k + 1; a.li = 0;
        hipLaunchKernelGGL(mk_fwd, dim3(grid), dim3(NWAVES * 64), LDS_BYTES, stream, a);
    }
#else
    a.ph_lo = 0; a.ph_hi = N_PHASE_IDS; a.li = 0;
    hipLaunchKernelGGL(mk_fwd, dim3(grid), dim3(NWAVES * 64), LDS_BYTES, stream, a);
#endif
    const hipError_t le = hipPeekAtLastError();
    if (le != hipSuccess) fprintf(stderr, "kernel_launch: launch failed: %s\n", hipGetErrorName(le));
}
```

```cpp
#include <hip/hip_runtime.h>
#include <hip/hip_bf16.h>
#include <cstdio>
#include <cstdint>
#include <cmath>
#include <type_traits>

namespace pg8 {
#define PG8_LAS __attribute__((address_space(3)))
typedef unsigned short bf16_t;
typedef short bf16x8 __attribute__((ext_vector_type(8)));
typedef float f32x4 __attribute__((ext_vector_type(4)));
typedef unsigned u32x4 __attribute__((ext_vector_type(4)));
typedef unsigned u32x2 __attribute__((ext_vector_type(2)));
typedef int i32x4 __attribute__((ext_vector_type(4)));
typedef int i32x8 __attribute__((ext_vector_type(8)));
constexpr int BM = 256, BK = 64, HALF = 128, HTB = HALF * BK * 2, STAGE_BYTES = 8 * HTB, NXCD = 8, WGM = 8;

__host__ __device__ __forceinline__ int lds_byte(int r, int c) { const int st = (r >> 4) * 2 + (c >> 5), rr = r & 15, cc = c & 31, ob = rr * 64 + cc * 2; return st * 1024 + (ob ^ (((ob >> 9) & 1) << 5)); }
__host__ __device__ __forceinline__ void stage_rc(int b, int& R, int& C) { const int st = b / 1024, sb = b % 1024, swz = sb ^ (((sb >> 9) & 1) << 5); R = (st >> 1) * 16 + swz / 64; C = (st & 1) * 32 + (swz % 64) / 2; }
__host__ __device__ __forceinline__ int perm32(int rho) { const int n = rho >> 4, i = rho & 15; return 8 * (i >> 2) + 4 * n + (i & 3); }

struct Unit { int pm, pn, e; };
struct Gemm { const void* A; const void* Bt; int lda, ldb, K, a_pn_off; size_t b_e_stride; const int* rowidx; };

struct Order {
    int nM, nN, nwg, G, c, tpe, tstride; bool degenerate;
    int L, gid, rem, nig, inv_tpe;
    __device__ void init(int nM_, int nN_, int G_, int c_, int tpe_, int tstride_) { nM = nM_; nN = nN_; nwg = nM * nN; G = G_; c = c_; tpe = tpe_; tstride = tstride_; degenerate = false;
        nig = WGM * nN; inv_tpe = (int)(((1u << 20) + (unsigned)tpe - 1u) / (unsigned)tpe); L = -1; gid = 0; rem = 0; }
    __device__ void emit(Unit& u) const {
        const int fm = gid * WGM, gsz = (nM - fm) < WGM ? (nM - fm) : WGM;
        int pmo, pn; if (gsz == WGM) { pmo = rem & (WGM - 1); pn = rem >> 3; } else { pn = rem / gsz; pmo = rem - pn * gsz; }
        const int v = fm + pmo; u.pn = pn; u.e = (int)(((unsigned)v * (unsigned)inv_tpe) >> 20); u.pm = u.e * tstride + (v - u.e * tpe);
        if (degenerate) { u.e = 0; u.pm = 0; }
    }
    __device__ bool begin(Unit& u) {
        L = c; if (L >= nwg) return false;
        const int q = nwg / NXCD, r = nwg % NXCD, xcd = L % NXCD, off = L / NXCD; const int wgid = (xcd < r ? xcd * (q + 1) : r * (q + 1) + (xcd - r) * q) + off;
        gid = wgid / nig; rem = wgid - gid * nig; emit(u); return true;
    }
    __device__ bool advance(Unit& u) {
        L += G; if (L >= nwg) return false;
        rem += G / NXCD; while (rem >= nig) { rem -= nig; ++gid; }
        emit(u); return true;
    }
};

__device__ __forceinline__ unsigned cvt_pk_bf16(float lo, float hi) { unsigned r; asm volatile("v_cvt_pk_bf16_f32 %0, %1, %2" : "=v"(r) : "v"(lo), "v"(hi)); return r; }

struct EpiBf16 {
    static constexpr bool PERM = true;
    bf16_t* O; int ldc; int split_cols; size_t split_stride; float scale0; const float* colscale; float gscale; bool out8 = false;
    __device__ __forceinline__ void operator()(const f32x4 (&acc)[2][2][4][2], const Unit& u, int wr, int wc, int fr, int fq, PG8_LAS unsigned char* lds, int wid, int lane) const {
        const int row0 = u.pm * BM + wr * 64 + fr; int colt = u.pn * BM; bf16_t* base = O;
        float sc = gscale; if (split_cols) { const int t = colt / split_cols; base += (size_t)t * split_stride; colt -= t * split_cols; if (t == 0) sc = scale0 * gscale; }
        const int col0 = colt + wc * 32 + 8 * fq;
        f32x4 cs[2][2];
#pragma unroll
        for (int bj = 0; bj < 2; ++bj)
#pragma unroll
            for (int n = 0; n < 2; ++n) cs[bj][n] = colscale ? *(const f32x4*)(colscale + u.pn * BM + wc * 32 + 8 * fq + bj * HALF + 4 * n) * sc : (f32x4){sc, sc, sc, sc};
#pragma unroll
        for (int ai = 0; ai < 2; ++ai)
#pragma unroll
            for (int m = 0; m < 4; ++m) { bf16_t* rowp = base + (size_t)(row0 + ai * HALF + m * 16) * ldc + col0;
#pragma unroll
                for (int bj = 0; bj < 2; ++bj) { f32x4 v0 = acc[ai][bj][m][0] * cs[bj][0], v1 = acc[ai][bj][m][1] * cs[bj][1];
                    if (out8) { int t0 = 0, t1 = 0; t0 = __builtin_amdgcn_cvt_pk_fp8_f32(v0[0], v0[1], t0, false); t0 = __builtin_amdgcn_cvt_pk_fp8_f32(v0[2], v0[3], t0, true);
                        t1 = __builtin_amdgcn_cvt_pk_fp8_f32(v1[0], v1[1], t1, false); t1 = __builtin_amdgcn_cvt_pk_fp8_f32(v1[2], v1[3], t1, true);
                        *(u32x2*)((unsigned char*)base + (size_t)(row0 + ai * HALF + m * 16) * ldc + col0 + bj * HALF) = (u32x2){(unsigned)t0, (unsigned)t1}; }
                    else { u32x4 w; w.x = cvt_pk_bf16(v0[0], v0[1]); w.y = cvt_pk_bf16(v0[2], v0[3]); w.z = cvt_pk_bf16(v1[0], v1[1]); w.w = cvt_pk_bf16(v1[2], v1[3]);
                    *(u32x4*)(rowp + bj * HALF) = w; } } }
    }
};
struct EpiF32 {
    static constexpr bool PERM = false;
    float* C; int ldc; const float* colscale;
    __device__ __forceinline__ void operator()(const f32x4 (&acc)[2][2][4][2], const Unit& u, int wr, int wc, int fr, int fq, PG8_LAS unsigned char* lds, int wid, int lane) const {
        const int row0 = u.pm * BM + wr * 64 + fr, col0 = u.pn * BM + wc * 32 + 4 * fq;
        f32x4 sv[2][2];
#pragma unroll
        for (int bj = 0; bj < 2; ++bj)
#pragma unroll
            for (int n = 0; n < 2; ++n) sv[bj][n] = colscale ? *(const f32x4*)(colscale + col0 + bj * HALF + n * 16) : (f32x4){1.f, 1.f, 1.f, 1.f};
#pragma unroll
        for (int ai = 0; ai < 2; ++ai)
#pragma unroll
            for (int m = 0; m < 4; ++m) { float* rowp = C + (size_t)(row0 + ai * HALF + m * 16) * ldc + col0;
#pragma unroll
                for (int bj = 0; bj < 2; ++bj)
#pragma unroll
                    for (int n = 0; n < 2; ++n) *(f32x4*)(rowp + bj * HALF + n * 16) = acc[ai][bj][m][n] * sv[bj][n]; }
    }
};
template <bool OUT8> struct EpiSwiGLU {
    static constexpr bool PERM = true;
    void* Hd; int ldh; bool nostore = false;
    __device__ __forceinline__ void silu4(const f32x4 a, const f32x4 b, float (&h)[4]) const {
        typedef float f2 __attribute__((ext_vector_type(2)));
#pragma unroll
        for (int i = 0; i < 4; i += 2) {
            const f2 av = {a[i], a[i + 1]}, bv = {b[i], b[i + 1]}; const f2 t = av * -1.4426950408889634f; f2 ex; ex.x = __builtin_amdgcn_exp2f(t.x); ex.y = __builtin_amdgcn_exp2f(t.y);
            const f2 d = ex + 1.0f; f2 r; r.x = __builtin_amdgcn_rcpf(d.x); r.y = __builtin_amdgcn_rcpf(d.y); const f2 hv = (av * bv) * r; h[i] = hv.x; h[i + 1] = hv.y; }
    }
    __device__ __forceinline__ void operator()(const f32x4 (&acc)[2][2][4][2], const Unit& u, int wr, int wc, int fr, int fq, PG8_LAS unsigned char* lds, int wid, int lane) const {
        if constexpr (OUT8) {
            PG8_LAS unsigned char* st = lds + 3 * HTB;
#pragma unroll
            for (int ai = 0; ai < 2; ++ai) {
#pragma unroll
                for (int m = 0; m < 4; ++m) { const int r = wr * 64 + m * 16 + fr;
#pragma unroll
                    for (int bj = 0; bj < 2; ++bj) { float h[4]; silu4(acc[ai][bj][m][0], acc[ai][bj][m][1], h);
                        int w = 0; w = __builtin_amdgcn_cvt_pk_fp8_f32(h[0], h[1], w, false); w = __builtin_amdgcn_cvt_pk_fp8_f32(h[2], h[3], w, true);
                        *(PG8_LAS int*)(st + r * 128 + (((wc + 4 * bj) ^ (r & 7)) << 4) + 4 * fq) = w; } }
                asm volatile("s_waitcnt lgkmcnt(0)" ::: "memory"); __builtin_amdgcn_s_barrier(); asm volatile("" ::: "memory");
#pragma unroll
                for (int k = 0; k < 2; ++k) { const int r = 16 * wid + 8 * k + (lane >> 3), c = lane & 7;
                    const u32x4 v = *(const PG8_LAS u32x4*)(st + r * 128 + ((c ^ (r & 7)) << 4));
                    if (!nostore) *(u32x4*)((unsigned char*)Hd + (size_t)(u.pm * BM + ai * HALF + r) * ldh + u.pn * (BM / 2) + 16 * c) = v; else asm volatile("" :: "v"(v)); }
                asm volatile("s_waitcnt lgkmcnt(0)" ::: "memory"); __builtin_amdgcn_s_barrier(); asm volatile("" ::: "memory");
            }
        } else {
            const int row0 = u.pm * BM + wr * 64 + fr; const int hc0 = (u.pn * BM + wc * 32 + 8 * fq) >> 1;
#pragma unroll
            for (int ai = 0; ai < 2; ++ai)
#pragma unroll
                for (int m = 0; m < 4; ++m) { const size_t ro = (size_t)(row0 + ai * HALF + m * 16) * ldh + hc0;
#pragma unroll
                    for (int bj = 0; bj < 2; ++bj) { float h[4]; silu4(acc[ai][bj][m][0], acc[ai][bj][m][1], h);
                        u32x2 w; w.x = cvt_pk_bf16(h[0], h[1]); w.y = cvt_pk_bf16(h[2], h[3]); *(u32x2*)((bf16_t*)Hd + ro + bj * (HALF / 2)) = w; } }
        }
    }
};

template <bool GATHER, int ES, class Epi, class Sched>
__device__ __forceinline__ void gemm_phase(PG8_LAS unsigned char* lds, const Gemm g, const Sched& S, const Epi& E, const int tid, const int wscale_e8m0 = 127) {
    const int wid = __builtin_amdgcn_readfirstlane(tid >> 6), lane = tid & 63, wr = wid >> 2, wc = wid & 3, fr = lane & 15, fq = lane >> 4;
    const int K = g.K, nt = K * ES / (BK * 2);
    unsigned voffA[2][2], voffAn[2][2], voffB[2]; int Rr[2], Cc[2];
#pragma unroll
    for (int i = 0; i < 2; ++i) { int R, C; stage_rc(tid * 16 + i * 8192, R, C); const int Rb = Epi::PERM ? ((R & ~31) + perm32(R & 31)) : R; Rr[i] = R; Cc[i] = C;
        voffA[0][i] = (unsigned)(R * g.lda * ES + C * 2); voffA[1][i] = (unsigned)((R + HALF) * g.lda * ES + C * 2); voffB[i] = (unsigned)(Rb * g.ldb * ES + C * 2);
        voffAn[0][i] = voffA[0][i]; voffAn[1][i] = voffA[1][i]; }
    const size_t kstep = (size_t)(BK * 2);
    const size_t hB = (size_t)HALF * g.ldb * ES;
    const unsigned ldsw = (unsigned)wid * 1024u;
    const int aoff = lds_byte(wr * 64 + fr, fq * 8), boff = lds_byte(wc * 32 + fr, fq * 8);
#define PG8_APTR(u) (GATHER ? (const char*)g.A : (const char*)g.A + ((size_t)(u).pm * BM * g.lda + (size_t)(u).pn * g.a_pn_off) * ES)
#define PG8_IDXDMA(u) __builtin_amdgcn_global_load_lds((const unsigned*)(g.rowidx + (u).pm * BM + idxrow), (PG8_LAS unsigned*)(lds + STAGE_BYTES + wid * 256), 4, 0, 0)
#define PG8_TOKL(h, i) ib[(h) * 32 + (i) * 16 + (Rr[i] & 15)]
#define PG8_VOFF(tok, i) ((unsigned)(((tok) < 0 ? 0 : (tok)) * g.lda * ES + Cc[i] * 2))
#define PG8_BPTR(u) ((const char*)g.Bt + ((size_t)(u).e * g.b_e_stride + (size_t)(u).pn * BM * g.ldb) * ES)
#define PG8_SA(b, h) (((b) * 2 + (h)) * HTB)
#define PG8_SB(b, h) ((4 + (b) * 2 + (h)) * HTB)
#define PG8_STAGE(bufoff, gbase, voff) do { _Pragma("unroll") for (int _i = 0; _i < 2; ++_i) { unsigned _vo = (voff)[_i]; asm volatile("" : "+v"(_vo));     \
        __builtin_amdgcn_global_load_lds((const unsigned*)((const char*)(gbase) + _vo), (PG8_LAS unsigned*)(lds + (bufoff) + ldsw + _i * 8192), 16, 0, 0); } } while (0)
#define PG8_LDA(dst, b, h) do { _Pragma("unroll") for (int m = 0; m < 4; ++m) _Pragma("unroll") for (int k = 0; k < 2; ++k) dst[m][k] = *(const PG8_LAS bf16x8*)(lds + PG8_SA(b, h) + aoff + m * 2048 + k * 1024); } while (0)
#define PG8_LDB(dst, b, h) do { _Pragma("unroll") for (int n = 0; n < 2; ++n) _Pragma("unroll") for (int k = 0; k < 2; ++k) dst[n][k] = *(const PG8_LAS bf16x8*)(lds + PG8_SB(b, h) + boff + n * 2048 + k * 1024); } while (0)
#define PG8_CAT8(x0, x1) __builtin_shufflevector(__builtin_bit_cast(i32x4, x0), __builtin_bit_cast(i32x4, x1), 0, 1, 2, 3, 4, 5, 6, 7)
#define PG8_MMA(ai, bj, At, Bt) do { __builtin_amdgcn_s_setprio(1); _Pragma("unroll") for (int m = 0; m < 4; ++m) _Pragma("unroll") for (int n = 0; n < 2; ++n) { \
        if constexpr (ES == 2) { _Pragma("unroll") for (int k = 0; k < 2; ++k) acc[ai][bj][m][n] = __builtin_amdgcn_mfma_f32_16x16x32_bf16(Bt[n][k], At[m][k], acc[ai][bj][m][n], 0, 0, 0); } \
        else   \
            { const i32x8 b8_ = PG8_CAT8(Bt[n][0], Bt[n][1]), a8_ = PG8_CAT8(At[m][0], At[m][1]);   \
              asm volatile("v_mfma_scale_f32_16x16x128_f8f6f4 %0, %1, %2, %0, %3, %4 op_sel_hi:[0,0,0]" : "+v"(acc[ai][bj][m][n]) : "v"(b8_), "v"(a8_), "v"(f8wscale), "v"(f8scale)); } } \
        __builtin_amdgcn_s_setprio(0); } while (0)
#define PG8_WAIT_V(n) asm volatile("s_waitcnt vmcnt(" #n ")" ::: "memory")
#define PG8_WAIT_L(n) asm volatile("s_waitcnt lgkmcnt(" #n ")" ::: "memory")
#define PG8_BAR __builtin_amdgcn_s_barrier()
#define PG8_SCHED __builtin_amdgcn_sched_barrier(0)
    int f8scale = 0x7f7f7f7f, f8wscale = wscale_e8m0 * 0x01010101; asm volatile("" : "+v"(f8scale), "+v"(f8wscale));
    Unit cur, nxt; Sched W = S;
    if (!W.begin(cur)) return;
    f32x4 acc[2][2][4][2];
#pragma unroll
    for (int a = 0; a < 2; ++a)
#pragma unroll
        for (int b = 0; b < 2; ++b)
#pragma unroll
            for (int m = 0; m < 4; ++m)
#pragma unroll
                for (int n = 0; n < 2; ++n) acc[a][b][m][n] = (f32x4){0.f, 0.f, 0.f, 0.f};
    bf16x8 At[4][2], B0[2][2], B1[2][2];
    const char* cA = PG8_APTR(cur); const char* cB = PG8_BPTR(cur);
    const int idxrow = (lane >> 5) * HALF + ((lane >> 4) & 1) * 64 + 16 * (wid >> 1) + (lane & 15);
    volatile PG8_LAS int* ib = (volatile PG8_LAS int*)(lds + STAGE_BYTES + wid * 256);
    if constexpr (GATHER) { PG8_IDXDMA(cur); asm volatile("s_waitcnt vmcnt(0)" ::: "memory");
#pragma unroll
        for (int h = 0; h < 2; ++h)
#pragma unroll
            for (int i = 0; i < 2; ++i) { const int tk = PG8_TOKL(h, i); voffA[h][i] = PG8_VOFF(tk, i); } }
    PG8_STAGE(PG8_SB(0, 0), cB, voffB); PG8_STAGE(PG8_SB(0, 1), cB + hB, voffB); PG8_STAGE(PG8_SA(0, 0), cA, voffA[0]); PG8_STAGE(PG8_SA(0, 1), cA, voffA[1]);
    if (wr == 1) PG8_BAR;
    PG8_WAIT_V(2); PG8_BAR;
    PG8_STAGE(PG8_SB(1, 0), cB + kstep, voffB); PG8_STAGE(PG8_SA(1, 0), cA + kstep, voffA[0]); PG8_STAGE(PG8_SB(1, 1), cB + hB + kstep, voffB);
    PG8_WAIT_V(6); PG8_BAR;
    for (;;) {
        const bool has_next = W.advance(nxt);
        const char* nA = has_next ? PG8_APTR(nxt) : cA; const char* nB = has_next ? PG8_BPTR(nxt) : cB;
        if constexpr (GATHER) { if (has_next) PG8_IDXDMA(nxt); }
        for (int t = 0; t < nt; t += 2) {
            const bool last = (t == nt - 2);
            const char* a1 = cA + (size_t)(t + 1) * kstep;
            const char* a2 = last ? nA : cA + (size_t)(t + 2) * kstep; const char* b2 = last ? nB : cB + (size_t)(t + 2) * kstep;
            const char* a3 = a2 + kstep; const char* b3 = b2 + kstep;
            unsigned va[2][2];
#pragma unroll
            for (int h = 0; h < 2; ++h)
#pragma unroll
                for (int i = 0; i < 2; ++i) va[h][i] = (GATHER && last) ? voffAn[h][i] : voffA[h][i];
            PG8_LDB(B0, 0, 0); PG8_LDB(B1, 0, 1); PG8_SCHED; PG8_LDA(At, 0, 0); PG8_STAGE(PG8_SA(1, 1), a1, voffA[1]);
            PG8_WAIT_V(8); PG8_WAIT_L(0); PG8_BAR; PG8_MMA(0, 0, At, B0); PG8_MMA(0, 1, At, B1); PG8_BAR; PG8_SCHED;
            PG8_LDA(At, 0, 1); PG8_STAGE(PG8_SB(0, 0), b2, voffB); PG8_STAGE(PG8_SB(0, 1), b2 + hB, voffB); PG8_STAGE(PG8_SA(0, 0), a2, va[0]);
            PG8_WAIT_V(8); PG8_WAIT_L(0); PG8_BAR; PG8_MMA(1, 0, At, B0); PG8_MMA(1, 1, At, B1); PG8_BAR; PG8_SCHED;
            PG8_LDB(B0, 1, 0); PG8_LDB(B1, 1, 1); PG8_SCHED; PG8_LDA(At, 1, 0); PG8_STAGE(PG8_SA(0, 1), a2, va[1]);
            PG8_WAIT_V(8); PG8_WAIT_L(0); PG8_BAR; PG8_MMA(0, 0, At, B0); PG8_MMA(0, 1, At, B1); PG8_BAR; PG8_SCHED;
            PG8_LDA(At, 1, 1); PG8_STAGE(PG8_SB(1, 0), b3, voffB); PG8_STAGE(PG8_SB(1, 1), b3 + hB, voffB); PG8_STAGE(PG8_SA(1, 0), a3, va[0]);
            PG8_WAIT_V(8); PG8_WAIT_L(0); PG8_BAR; PG8_MMA(1, 0, At, B0); PG8_MMA(1, 1, At, B1); PG8_BAR; PG8_SCHED;
            if constexpr (GATHER) {
#pragma unroll
                for (int h = 0; h < 2; ++h)
#pragma unroll
                    for (int i = 0; i < 2; ++i) { const int tk = PG8_TOKL(h, i); voffAn[h][i] = PG8_VOFF(tk, i); } }
        }
        if (wr == 0) PG8_BAR;
        if constexpr (ES == 1) asm volatile("s_nop 15\n\ts_nop 15" ::: "memory");
        E(acc, cur, wr, wc, fr, fq, lds, wid, lane);
        if (!has_next) break;
#pragma unroll
        for (int a = 0; a < 2; ++a)
#pragma unroll
            for (int b = 0; b < 2; ++b)
#pragma unroll
                for (int m = 0; m < 4; ++m)
#pragma unroll
                    for (int n = 0; n < 2; ++n) acc[a][b][m][n] = (f32x4){0.f, 0.f, 0.f, 0.f};
        cur = nxt; cA = nA; cB = nB;
        if constexpr (GATHER) {
#pragma unroll
            for (int h = 0; h < 2; ++h)
#pragma unroll
                for (int i = 0; i < 2; ++i) voffA[h][i] = voffAn[h][i]; }
        if (wr == 1) PG8_BAR;
    }
    PG8_WAIT_V(0);
    PG8_BAR;
#undef PG8_APTR
#undef PG8_IDXDMA
#undef PG8_TOKL
#undef PG8_VOFF
#undef PG8_BPTR
#undef PG8_SA
#undef PG8_SB
#undef PG8_STAGE
#undef PG8_LDA
#undef PG8_LDB
#undef PG8_MMA
#undef PG8_CAT8
#undef PG8_WAIT_V
#undef PG8_WAIT_L
#undef PG8_BAR
#undef PG8_SCHED
}
}
namespace attn_body {
using bf16=__hip_bfloat16;
using bf16x8=__attribute__((ext_vector_type(8)))short;
using s16x4=__attribute__((ext_vector_type(4)))short;
using f32x16=__attribute__((ext_vector_type(16)))float;
using u32x4=__attribute__((ext_vector_type(4)))unsigned;
constexpr int D=64;
constexpr int NW=8,QBLK=32,QB=QBLK*NW,KVBLK=64;
__device__ __forceinline__ int crow(int r,int hi){return (r&3)+8*(r>>2)+4*hi;}
#define SBAR() __builtin_amdgcn_sched_barrier(0)
constexpr int NSLOT=3, SLOTB=8192;
constexpr int LDS_K=0, LDS_V=NSLOT*SLOTB, LDS_WS=2*NSLOT*SLOTB, LDS_OST=LDS_WS+NW*64*4, LDS_BYTES=LDS_OST+NW*4096;
constexpr int LDS_BIAS=LDS_BYTES;
constexpr float C2=0.125f*1.4426950408889634f;
__device__ __forceinline__ void glds16(const void*gsrc,unsigned lds_dst){unsigned keep;
  asm volatile("s_mov_b32 %0, m0\n\ts_mov_b32 m0, %2\n\ts_nop 0\n\tglobal_load_lds_dwordx4 %1, off\n\ts_mov_b32 m0, %0":"=&s"(keep):"v"(gsrc),"s"(lds_dst):"memory");}
__device__ __forceinline__ float max3f(float a,float b,float c){float r;asm("v_max3_f32 %0, %1, %2, %3":"=v"(r):"v"(a),"v"(b),"v"(c));return r;}
__device__ __forceinline__ float max2f(float a,float b){float r;asm("v_max_f32_e32 %0, %1, %2":"=v"(r):"v"(a),"v"(b));return r;}
__device__ __forceinline__ float fadd_s(float a,float b){float r;asm("v_add_f32_e32 %0, %1, %2":"=v"(r):"v"(a),"v"(b));return r;}
__device__ __forceinline__ float fsub_s(float a,float b){float r;asm("v_sub_f32_e32 %0, %1, %2":"=v"(r):"v"(a),"v"(b));return r;}
typedef float f32x2_t __attribute__((ext_vector_type(2))); typedef __bf16 bf16x2_t __attribute__((ext_vector_type(2)));
__device__ __forceinline__ unsigned cvtpk_s(float lo,float hi){f32x2_t v={lo,hi};bf16x2_t b=__builtin_convertvector(v,bf16x2_t);return __builtin_bit_cast(unsigned,b);}
#define WAIT_BAR(N) asm volatile("s_waitcnt vmcnt(" #N ") lgkmcnt(0)\n\ts_barrier":::"memory")

__device__ __forceinline__ void qkt(f32x16&p0,f32x16&p1,const char*Kslot,const bf16x8*qr,const f32x16&negm,int r32,int hi){
  const char*kb=Kslot+hi*1024+r32*16;
  #pragma unroll
  for(int d0=0;d0<4;++d0){
    const bf16x8 b0=*reinterpret_cast<const bf16x8*>(kb+d0*2048);
    const bf16x8 b1=*reinterpret_cast<const bf16x8*>(kb+d0*2048+512);
    if(d0==0){p0=__builtin_amdgcn_mfma_f32_32x32x16_bf16(b0,qr[0],negm,0,0,0);p1=__builtin_amdgcn_mfma_f32_32x32x16_bf16(b1,qr[0],negm,0,0,0);}
    else{p0=__builtin_amdgcn_mfma_f32_32x32x16_bf16(b0,qr[d0],p0,0,0,0);p1=__builtin_amdgcn_mfma_f32_32x32x16_bf16(b1,qr[d0],p1,0,0,0);}}
}
typedef __attribute__((address_space(3))) const char* lds_cptr;
typedef short v4i16_t __attribute__((ext_vector_type(4)));
__device__ __forceinline__ void kload8(bf16x8*kf,lds_cptr kp){
  kf[0]=*(const __attribute__((address_space(3))) bf16x8*)(kp);      kf[1]=*(const __attribute__((address_space(3))) bf16x8*)(kp+512);
  kf[2]=*(const __attribute__((address_space(3))) bf16x8*)(kp+2048); kf[3]=*(const __attribute__((address_space(3))) bf16x8*)(kp+2560);
  kf[4]=*(const __attribute__((address_space(3))) bf16x8*)(kp+4096); kf[5]=*(const __attribute__((address_space(3))) bf16x8*)(kp+4608);
  kf[6]=*(const __attribute__((address_space(3))) bf16x8*)(kp+6144); kf[7]=*(const __attribute__((address_space(3))) bf16x8*)(kp+6656);
}
__device__ __forceinline__ void kload2(bf16x8*kf,lds_cptr kp,int j){ kf[2*j]=*(const __attribute__((address_space(3))) bf16x8*)(kp+j*2048); kf[2*j+1]=*(const __attribute__((address_space(3))) bf16x8*)(kp+j*2048+512); }
__device__ __forceinline__ s16x4 vtr(lds_cptr p){ return __builtin_bit_cast(s16x4,__builtin_amdgcn_ds_read_tr16_b64_v4i16((__attribute__((address_space(3))) v4i16_t*)p)); }
__device__ __forceinline__ float rowmax(const f32x16&p0,const f32x16&p1){
  float a=max3f(p0[0],p0[1],p1[0]),b=max3f(p0[2],p0[3],p1[1]);a=max3f(a,p1[2],p1[3]);
  #pragma unroll
  for(int r=4;r<16;r+=4){a=max3f(a,p0[r],p0[r+1]);b=max3f(b,p0[r+2],p0[r+3]);a=max3f(a,p1[r],p1[r+1]);b=max3f(b,p1[r+2],p1[r+3]);}
  const float m=max2f(a,b);
  auto rr=__builtin_amdgcn_permlane32_swap(__float_as_uint(m),__float_as_uint(m),false,false);
  return max2f(__uint_as_float(rr[0]),__uint_as_float(rr[1]));
}
__device__ __forceinline__ void pv(f32x16*o,int vb,bf16x8 pa0,bf16x8 pa1,bf16x8 pa2,bf16x8 pa3){
  #pragma unroll
  for(int d0=0;d0<2;++d0){s16x4 lo[4],hi[4];
    #pragma unroll
    for(int ks=0;ks<4;++ks){
      asm volatile("ds_read_b64_tr_b16 %0,%1 offset:%c2":"=&v"(lo[ks]):"v"(vb),"i"(d0*4096+ks*1024):"memory");
      asm volatile("ds_read_b64_tr_b16 %0,%1 offset:%c2":"=&v"(hi[ks]):"v"(vb),"i"(d0*4096+ks*1024+512):"memory");}
    asm volatile("s_waitcnt lgkmcnt(0)":::"memory");SBAR();
    #define PK(k) (bf16x8){lo[k][0],lo[k][1],lo[k][2],lo[k][3],hi[k][0],hi[k][1],hi[k][2],hi[k][3]}
    o[d0]=__builtin_amdgcn_mfma_f32_32x32x16_bf16(pa0,PK(0),o[d0],0,0,0);
    o[d0]=__builtin_amdgcn_mfma_f32_32x32x16_bf16(pa1,PK(1),o[d0],0,0,0);
    o[d0]=__builtin_amdgcn_mfma_f32_32x32x16_bf16(pa2,PK(2),o[d0],0,0,0);
    o[d0]=__builtin_amdgcn_mfma_f32_32x32x16_bf16(pa3,PK(3),o[d0],0,0,0);
    #undef PK
  }
}
struct TileRows { long base0, base1; int nfirst; __device__ __forceinline__ long operator()(int t) const { return t < nfirst ? base0 + 64l * t : base1 + 64l * (t - nfirst); } };
struct NoMask { static constexpr bool ACTIVE=false; __device__ __forceinline__ void apply(f32x16&,f32x16&,int) const {} };
struct NaMask {
  static constexpr bool ACTIVE=true;
  int kbase, qr, r0q, qcol, c0, hi; lds_cptr bias;
  __device__ __forceinline__ void apply(f32x16&p0,f32x16&p1,int t) const {
    if(t<4) return;
    const int kr=kbase+(t-4); const float NEG=-1.0e30f;
    if(kr<r0q||kr>r0q+7){
      #pragma unroll
      for(int r=0;r<16;++r){p0[r]=NEG;p1[r]=NEG;}
      return; }
    const int ib=(kr-qr+7)*31+(4*hi-qcol+15);
    const int cb=4*hi-c0;
    #pragma unroll
    for(int r=0;r<16;++r){ const int ko=(r&3)+8*(r>>2);
      const float b0=*(const __attribute__((address_space(3))) float*)(bias+4*(ib+ko));
      const float b1=*(const __attribute__((address_space(3))) float*)(bias+4*(ib+ko+32));
#ifdef DBG_NA_NOBIAS
      p0[r]=((unsigned)(cb+ko)<16u)?p0[r]:NEG; p1[r]=((unsigned)(cb+ko+32)<16u)?p1[r]:NEG; (void)b0; (void)b1; }
#else
      p0[r]=((unsigned)(cb+ko)<16u)?p0[r]+b0:NEG;
      p1[r]=((unsigned)(cb+ko+32)<16u)?p1[r]+b1:NEG; }
#endif
  }
};

#ifndef ATTN_STORE16
#define ATTN_STORE16(p,v) (*(u32x4*)(p)=(v))
#endif
template<int THRL,class MK,bool USE_NEGM,bool OUT8,bool FIXM,bool QNORM=false> __device__ __forceinline__ void attn_unit(const bf16*Qw0,int QP,const bf16*__restrict__ Kc,const bf16*__restrict__ Vc,int KP,const TileRows TR,const int NT,void*Ow0,int OP,char*shm,const MK&mk,const int tid,const float mfix=0.f,const float*qgain=nullptr,const int qt0=0,const float rms_eps=0.f){
  static_assert(!FIXM||USE_NEGM,"FIXM puts the reference into the QK^T MFMA's C operand");
  const int lane=tid&63,r32=lane&31,hi=lane>>5; const int wid=__builtin_amdgcn_readfirstlane(tid>>6);
  const bf16*Qw=Qw0+(long)(wid*QBLK)*QP;
  const unsigned lds0=(unsigned)(uintptr_t)shm;
  float*wsf=(float*)(shm+LDS_WS)+wid*64;
  const bf16*ksrc=Kc+(long)lane*KP+wid*8;
  const bf16*vsrc=Vc+(long)(16*(wid&3)+(lane>>2))*KP+(wid>>2)*32+(lane&3)*8;
  const unsigned kdst=lds0+LDS_K+wid*1024, vdst=lds0+LDS_V+wid*1024;
  #define DMA_K(t,slot) glds16(ksrc+TR(t)*KP,(unsigned)__builtin_amdgcn_readfirstlane(kdst+(slot)))
  #define DMA_V(t,slot) glds16(vsrc+TR(t)*KP,(unsigned)__builtin_amdgcn_readfirstlane(vdst+(slot)))
  const int vb0=(int)(lds0+LDS_V)+((lane>>4)&1)*32+(lane&3)*8+(4*hi+((lane&15)>>2))*64;
  const char*Kbase=shm+LDS_K; bf16x8 kf[8];
  const lds_cptr shm3=(lds_cptr)shm; const lds_cptr kp0=shm3+LDS_K+hi*1024+r32*16; const lds_cptr vp0=shm3+LDS_V+((lane>>4)&1)*32+(lane&3)*8+(4*hi+((lane&15)>>2))*64;
  DMA_K(0,0);DMA_V(0,0);DMA_K(1,SLOTB);
  bf16x8 qr[4];
  #pragma unroll
  for(int d0=0;d0<4;++d0)qr[d0]=*reinterpret_cast<const bf16x8*>(&Qw[(long)r32*QP+d0*16+hi*8]);
  if constexpr(QNORM){
    float qf[4][8]; float ss=0.f;
    #pragma unroll
    for(int d0=0;d0<4;++d0){
      #pragma unroll
      for(int i=0;i<8;++i){ qf[d0][i]=__uint_as_float(((unsigned)(unsigned short)qr[d0][i])<<16); ss+=qf[d0][i]*qf[d0][i]; } }
    { auto rr=__builtin_amdgcn_permlane32_swap(__float_as_uint(ss),__float_as_uint(ss),false,false); ss=__uint_as_float(rr[0])+__uint_as_float(rr[1]); }
    const float rinv=(1.0f/sqrtf(ss*(1.f/64.f)+rms_eps))*C2;
    const int tq=qt0+wid*QBLK+r32; const float rowp=(float)(tq>>6), colp=(float)(tq&63);
    #pragma unroll
    for(int d0=0;d0<4;++d0){ const float pos=d0<2?rowp:colp; const float*gp=qgain+d0*16+hi*8; float g[8];
      #pragma unroll
      for(int i=0;i<8;++i)g[i]=gp[i];
      u32x4 w;
      #pragma unroll
      for(int j=0;j<4;++j){ const int pi=(d0&1)*8+hi*4+j; const float fr=__builtin_amdgcn_exp2f(-(float)pi*(13.287712379549449f/16.0f))*0.15915494309189535f;
        const float rev=pos*fr; const float c=__builtin_amdgcn_cosf(rev), sn=__builtin_amdgcn_sinf(rev);
        const float x1=qf[d0][2*j]*rinv*g[2*j], x2=qf[d0][2*j+1]*rinv*g[2*j+1]; w[j]=cvtpk_s(x1*c-x2*sn,x1*sn+x2*c); }
      qr[d0]=__builtin_bit_cast(bf16x8,w); }
  }
  float zz_; asm volatile("v_mov_b32 %0, 0":"=v"(zz_)); float mhat=zz_,l_reg=zz_;f32x16 o[2];
  _Pragma("unroll") for(int r=0;r<16;++r){o[0][r]=zz_;o[1][r]=zz_;}
  f32x16 negm; if(USE_NEGM){ _Pragma("unroll") for(int r=0;r<16;++r)negm[r]=FIXM?(zz_-mfix):zz_; asm volatile("":"+v"(negm)); }
  const f32x16 zero16=f32x16{};
  #define CIN (USE_NEGM?negm:zero16)
  #define SUBM(C0,C1) do{ if(!USE_NEGM){ _Pragma("unroll") for(int r=0;r<16;++r){C0[r]-=mhat;C1[r]-=mhat;} } }while(0)
  #define CMASK(P0,P1,t) mk.apply(P0,P1,t)
  bool resc=false;
  #define START(P0,P1) do{ resc=false; if(!FIXM) { const float rm=rowmax(P0,P1); \
    const float dl=rm; mhat=fadd_s(mhat,dl); \
      _Pragma("unroll") for(int r=0;r<16;++r){P0[r]=fsub_s(P0[r],dl);P1[r]=fsub_s(P1[r],dl);} \
      if(USE_NEGM){ _Pragma("unroll") for(int r=0;r<16;++r)negm[r]=-mhat; asm volatile("":"+v"(negm)); } } \
    _Pragma("unroll") for(int r=0;r<16;++r)P0[r]=__builtin_amdgcn_exp2f(P0[r]); }while(0)
  #define RESC() do{ if(!FIXM&&resc){ asm volatile("s_waitcnt lgkmcnt(0)":::"memory"); \
      _Pragma("unroll") for(int d_=0;d_<2;++d_) _Pragma("unroll") for(int r=0;r<16;++r)o[d_][r]*=wsf[crow(r,hi)]; } }while(0)
  f32x16 pA0,pA1,pB0,pB1;
  int sl_prev=0,sl_cur=0,sl_next=SLOTB;
  #define ROT() do{sl_prev=sl_cur;sl_cur=sl_next;sl_next=(sl_next==(NSLOT-1)*SLOTB)?0:sl_next+SLOTB;}while(0)
  DMA_K(2,2*SLOTB);
  WAIT_BAR(3);
  qkt(pA0,pA1,Kbase,qr,CIN,r32,hi);asm volatile("s_nop 15\n\ts_nop 7":"+v"(pA0),"+v"(pA1));CMASK(pA0,pA1,0);
  START(pA0,pA1);
  _Pragma("unroll") for(int r=0;r<16;++r)pA1[r]=__builtin_amdgcn_exp2f(pA1[r]);
  WAIT_BAR(0);
  DMA_K(3,0);DMA_V(1,SLOTB);
  ROT();
  kload8(kf,kp0+sl_cur);
  WAIT_BAR(2);
  s16x4 vlo[8],vhi[8]; u32x4 pw0,pw1,pw2,pw3;
  #define PKW(P,B) cvtpk_s(P[B],P[B+1])
  #define PAF(k) __builtin_bit_cast(bf16x8,pw##k)
  #define VFR(i) (bf16x8){vlo[i][0],vlo[i][1],vlo[i][2],vlo[i][3],vhi[i][0],vhi[i][1],vhi[i][2],vhi[i][3]}
  #define PIN(x) asm volatile("":"+v"(x))
  #define MX3(a,b,c) __builtin_fmaxf(__builtin_fmaxf((a),(b)),(c))
  #define GAPA(MF,A0,A1,A2,A3,W0,W1,PW) do{ MF; sacc+=A0; sacc+=A1; sacc+=A2; sacc+=A3; PIN(sacc); W0; W1; PIN(PW); SBAR(); }while(0)
  #define EX(v) __builtin_amdgcn_exp2f(v)
  #define GAPB(MF,X,B) do{ MF; X[B]=EX(X[B]); X[B+1]=EX(X[B+1]); X[B+2]=EX(X[B+2]); X[B+3]=EX(X[B+3]); PIN(X); SBAR(); }while(0)
  #define VRD(i) do{ vlo[i]=vtr(vp_+(((i)>>2)*4096+((i)&3)*1024)); vhi[i]=vtr(vp_+(((i)>>2)*4096+((i)&3)*1024+512)); }while(0)
  #define KRD(G,j) do{ if(G){ kload2(kf,kp0+sl_next,j); SBAR(); } }while(0)
  #define STEP(C0,C1,P0,P1,t,GK,GV,GL) do{ SBAR(); \
    const lds_cptr vp_=vp0+sl_prev; \
    VRD(0); SBAR(); float sacc=(P0[0]+P0[1]); \
    GAPA(C0=__builtin_amdgcn_mfma_f32_32x32x16_bf16(kf[0],qr[0],CIN,0,0,0), P0[2],P0[3],P0[4],P0[5],     pw0[0]=PKW(P0,0), pw0[1]=PKW(P0,2), pw0); \
    VRD(4); SBAR(); GAPA(C1=__builtin_amdgcn_mfma_f32_32x32x16_bf16(kf[1],qr[0],CIN,0,0,0), P0[6],P0[7],P0[8],P0[9],     pw0[2]=PKW(P0,4), pw0[3]=PKW(P0,6), pw0); \
    VRD(1); SBAR(); GAPA(C0=__builtin_amdgcn_mfma_f32_32x32x16_bf16(kf[2],qr[1],C0,0,0,0),   P0[10],P0[11],P0[12],P0[13], pw1[0]=PKW(P0,8), pw1[1]=PKW(P0,10), pw1); \
    VRD(5); SBAR(); GAPA(C1=__builtin_amdgcn_mfma_f32_32x32x16_bf16(kf[3],qr[1],C1,0,0,0),   P0[14],P0[15],P1[0],P1[1],   pw1[2]=PKW(P0,12),pw1[3]=PKW(P0,14), pw1); \
    VRD(2); SBAR(); GAPA(C0=__builtin_amdgcn_mfma_f32_32x32x16_bf16(kf[4],qr[2],C0,0,0,0),   P1[2],P1[3],P1[4],P1[5],     pw2[0]=PKW(P1,0), pw2[1]=PKW(P1,2), pw2); \
    VRD(6); SBAR(); GAPA(C1=__builtin_amdgcn_mfma_f32_32x32x16_bf16(kf[5],qr[2],C1,0,0,0),   P1[6],P1[7],P1[8],P1[9],     pw2[2]=PKW(P1,4), pw2[3]=PKW(P1,6), pw2); \
    VRD(3); SBAR(); GAPA(C0=__builtin_amdgcn_mfma_f32_32x32x16_bf16(kf[6],qr[3],C0,0,0,0),   P1[10],P1[11],P1[12],P1[13], pw3[0]=PKW(P1,8), pw3[1]=PKW(P1,10), pw3); \
    VRD(7); SBAR(); GAPA(C1=__builtin_amdgcn_mfma_f32_32x32x16_bf16(kf[7],qr[3],C1,0,0,0),   P1[14],P1[15],0.f,0.f,       pw3[2]=PKW(P1,12),pw3[3]=PKW(P1,14), pw3); \
    l_reg+=sacc; \
    if(GK){DMA_K((t)+3,sl_cur);} if(GV){DMA_V((t)+1,sl_next);} \
    SUBM(C0,C1); CMASK(C0,C1,t); \
    if(!FIXM){ float a=MX3(C0[0],C0[1],C1[0]),b=MX3(C0[2],C0[3],C1[1]); a=MX3(a,C1[2],C1[3]); \
      _Pragma("unroll") for(int r=4;r<16;r+=4){a=MX3(a,C0[r],C0[r+1]);b=MX3(b,C0[r+2],C0[r+3]);a=MX3(a,C1[r],C1[r+1]);b=MX3(b,C1[r+2],C1[r+3]);} \
      float rm=__builtin_fmaxf(a,b); { auto rr=__builtin_amdgcn_permlane32_swap(__float_as_uint(rm),__float_as_uint(rm),false,false); rm=__builtin_fmaxf(__uint_as_float(rr[0]),__uint_as_float(rr[1])); } \
      resc=false; \
      if(__builtin_expect(__any(rm>(float)THRL),0)){ const float dl=__builtin_fmaxf(rm,0.f); mhat+=dl; \
        _Pragma("unroll") for(int r=0;r<16;++r){C0[r]-=dl;C1[r]-=dl;} \
        if(USE_NEGM){ _Pragma("unroll") for(int r=0;r<16;++r)negm[r]=-mhat; asm volatile("":"+v"(negm)); } \
        const float f=__builtin_amdgcn_exp2f(-dl); l_reg*=f; if(hi==0)wsf[r32]=f; resc=true; } } \
    SBAR(); \
    GAPB(o[0]=__builtin_amdgcn_mfma_f32_32x32x16_bf16(PAF(0),VFR(0),o[0],0,0,0), C0,0); \
    GAPB(o[1]=__builtin_amdgcn_mfma_f32_32x32x16_bf16(PAF(0),VFR(4),o[1],0,0,0), C0,4); \
    KRD(GL,0); GAPB(o[0]=__builtin_amdgcn_mfma_f32_32x32x16_bf16(PAF(1),VFR(1),o[0],0,0,0), C0,8); \
    KRD(GL,1); GAPB(o[1]=__builtin_amdgcn_mfma_f32_32x32x16_bf16(PAF(1),VFR(5),o[1],0,0,0), C0,12); \
    KRD(GL,2); GAPB(o[0]=__builtin_amdgcn_mfma_f32_32x32x16_bf16(PAF(2),VFR(2),o[0],0,0,0), C1,0); \
    KRD(GL,3); GAPB(o[1]=__builtin_amdgcn_mfma_f32_32x32x16_bf16(PAF(2),VFR(6),o[1],0,0,0), C1,4); \
    GAPB(o[0]=__builtin_amdgcn_mfma_f32_32x32x16_bf16(PAF(3),VFR(3),o[0],0,0,0), C1,8); \
    GAPB(o[1]=__builtin_amdgcn_mfma_f32_32x32x16_bf16(PAF(3),VFR(7),o[1],0,0,0), C1,12); \
    }while(0)
  int t=1;
  for(;t+5<NT;t+=2){
    STEP(pB0,pB1,pA0,pA1,t,true,true,true);     WAIT_BAR(2); RESC(); ROT();
    STEP(pA0,pA1,pB0,pB1,t+1,true,true,true);   WAIT_BAR(2); RESC(); ROT();
  }
  #define ENDW(tt) do{ if((tt)+3<NT){WAIT_BAR(2);} else if((tt)+2<NT){WAIT_BAR(1);} else {WAIT_BAR(0);} }while(0)
  for(;t+1<NT;t+=2){
    STEP(pB0,pB1,pA0,pA1,t,(t+3<NT),(t+1<NT),(t+1<NT));       ENDW(t);   RESC(); ROT();
    STEP(pA0,pA1,pB0,pB1,t+1,(t+4<NT),(t+2<NT),(t+2<NT));     ENDW(t+1); RESC(); ROT();
  }
  STEP(pB0,pB1,pA0,pA1,NT-1,false,false,false); RESC();
  { float sacc=pB0[0]+pB0[1]; _Pragma("unroll") for(int r=2;r<16;++r)sacc+=pB0[r]; _Pragma("unroll") for(int r=0;r<16;++r)sacc+=pB1[r]; l_reg+=sacc;
    pw0=(u32x4){PKW(pB0,0),PKW(pB0,2),PKW(pB0,4),PKW(pB0,6)};pw1=(u32x4){PKW(pB0,8),PKW(pB0,10),PKW(pB0,12),PKW(pB0,14)};pw2=(u32x4){PKW(pB1,0),PKW(pB1,2),PKW(pB1,4),PKW(pB1,6)};pw3=(u32x4){PKW(pB1,8),PKW(pB1,10),PKW(pB1,12),PKW(pB1,14)};
    SBAR(); pv(o,vb0+sl_cur,PAF(0),PAF(1),PAF(2),PAF(3)); }
  #undef PKW
  #undef PAF
  #undef VFR
  #undef PIN
  #undef MX3
  #undef GAPA
  #undef GAPB
  #undef EX
  #undef VRD
  #undef KRD
  #undef STEP
  #undef ENDW
  {auto rr=__builtin_amdgcn_permlane32_swap(__float_as_uint(l_reg),__float_as_uint(l_reg),false,false);l_reg=__uint_as_float(rr[0])+__uint_as_float(rr[1]);}
  if(hi==0)wsf[32+r32]=l_reg;asm volatile("s_waitcnt lgkmcnt(0)":::"memory");
  float rli[16];
  #pragma unroll
  for(int r=0;r<16;++r)rli[r]=__builtin_amdgcn_rcpf(wsf[32+crow(r,hi)]);
  if constexpr(OUT8){ unsigned char*Ow=(unsigned char*)Ow0+(long)(wid*QBLK)*OP; unsigned char*stg=(unsigned char*)(shm+LDS_OST)+wid*4096;
    #pragma unroll
    for(int r=0;r<16;++r){const int orow=crow(r,hi);
      #pragma unroll
      for(int d0=0;d0<2;++d0){const float v=o[d0][r]*rli[r]; const int t=__builtin_amdgcn_cvt_pk_fp8_f32(v,v,0,false); stg[orow*64+d0*32+r32]=(unsigned char)t;}}
    asm volatile("s_waitcnt lgkmcnt(0)":::"memory");
    #pragma unroll
    for(int i=0;i<2;++i){const int row=i*16+(lane>>2),ch=lane&3; const u32x4 v=*(const u32x4*)(stg+row*64+ch*16); ATTN_STORE16(Ow+(long)row*OP+ch*16,v);} }
  else{ bf16*Ow=(bf16*)Ow0+(long)(wid*QBLK)*OP;
  { bf16*stg=(bf16*)(shm+LDS_OST)+wid*2048;
    #pragma unroll
    for(int r=0;r<16;++r){const int orow=crow(r,hi);
      #pragma unroll
      for(int d0=0;d0<2;++d0)stg[orow*64+d0*32+r32]=__float2bfloat16(o[d0][r]*rli[r]);}
    asm volatile("s_waitcnt lgkmcnt(0)":::"memory");
    #pragma unroll
    for(int i=0;i<4;++i){const int row=i*8+(lane>>3),ch=lane&7; const u32x4 v=*(const u32x4*)(stg+row*64+ch*8); ATTN_STORE16(Ow+(long)row*OP+ch*8,v);} } }
  asm volatile("s_waitcnt lgkmcnt(0)\n\ts_barrier":::"memory");
  #undef CIN
  #undef SUBM
  #undef DMA_K
  #undef DMA_V
  #undef CMASK
  #undef START
  #undef RESC
  #undef ROT
}
#undef SBAR
#undef WAIT_BAR
}
#ifndef MK_PER_PHASE
#define MK_PER_PHASE 0
#endif
#ifndef MOE_F8
#define MOE_F8 1
#endif
#ifndef WO_F8
#define WO_F8 0
#endif
#ifndef YS_F8
#define YS_F8 1
#endif
#ifndef QKV_F8
#define QKV_F8 1
#endif
constexpr int NWAVES = 8;
constexpr int W13_LOG2 = 5, W2_LOG2 = 7, WO_LOG2 = 6; constexpr float W13_SCALE = 32.0f, W2_SCALE = 128.0f;
constexpr int NB = 4, SEQ = 8192, DM = 1024, LCTX = 256, DEPTH = 4;
constexpr int M_LAT = NB * SEQ, M_CTX = NB * LCTX, M_ALL = M_LAT + M_CTX;
constexpr int NE = 16, FF = 2048, CAP_LAT = 1024, CAP_CTX = 32;
constexpr int ETILES = 17, ESTR = ETILES * 256, NSLOTS = NE * ESTR;
constexpr int KVROWS = SEQ + LCTX;
constexpr int NMOD = 6 * DM;
constexpr float ALPHA = 1.681792830507429f, LN_EPS = 1e-5f, RMS_EPS = 1e-6f, LOG2E = 1.4426950408889634f;

constexpr size_t MiB = 1u << 20;
constexpr size_t WS_CTL = 0, CTL_ZERO_BYTES = 2 * MiB;
constexpr size_t WS_MOD = 2 * MiB, WS_AFF = 3 * MiB, WS_SEL = 6 * MiB, WS_SLOT = 9 * MiB;
constexpr size_t WS_POOLW = 10 * MiB, WS_NAQKV = 11 * MiB, WS_NAWO = 17 * MiB, WS_GQKV = 19 * MiB, WS_GWO = 22 * MiB;
constexpr size_t WS_W13 = 32 * MiB, WS_W2 = 544 * MiB, WS_X = 800 * MiB, WS_H = 932 * MiB, WS_R = 1000 * MiB, WS_END = 1544 * MiB;
constexpr size_t R_XS = 0, R_HID = 136 * MiB, R_YS = 408 * MiB;
constexpr size_t R_D = 0, R_Y = 200 * MiB;
constexpr size_t R_O8 = 272 * MiB;
constexpr size_t R_Q = 0, R_K = 66 * MiB, R_V = 132 * MiB;
constexpr size_t R_RAW = 0, R_GQ = 100 * MiB, R_GK = 164 * MiB, R_GV = 181 * MiB;
constexpr int CW_TMO = 0, CW_BAR = 4096;

constexpr int RING_BYTES = 135168;
constexpr int LDSCTL_OFF = RING_BYTES, MISC_OFF = LDSCTL_OFF + 320;
constexpr int LDS_BYTES = 147456;

#define GAS __attribute__((address_space(1)))
#define LAS __attribute__((address_space(3)))
typedef unsigned short bf16;
typedef unsigned v4u __attribute__((ext_vector_type(4)));
typedef unsigned v2u __attribute__((ext_vector_type(2)));
typedef float f32x4 __attribute__((ext_vector_type(4)));
typedef float f32x2 __attribute__((ext_vector_type(2)));
#define RLX_AGENT __ATOMIC_RELAXED, __HIP_MEMORY_SCOPE_AGENT
#define LDS_WAIT() asm volatile("s_waitcnt lgkmcnt(0)" ::: "memory")
__device__ __forceinline__ unsigned pk2(float lo, float hi) { return pg8::cvt_pk_bf16(lo, hi); }
__device__ __forceinline__ float bf_lo(unsigned u) { return __uint_as_float(u << 16); }
__device__ __forceinline__ float bf_hi(unsigned u) { return __uint_as_float(u & 0xffff0000u); }

#define XB_TMO      128
#define XB_XCNT(j)  (256  + 64 * (j))
#define XB_XSUB(j)  (1280 + 64 * (j))
#define XB_XGEN(j)  (2304 + 64 * (j))
#define XB_TOP      3328
#define XB_TOPGEN   3392
#define XCD_BAR_WORDS 3456
#define XB_SPIN_CAP (1u << 22)

__device__ __forceinline__ unsigned xb_ld(unsigned* p)              { return __hip_atomic_load(p, __ATOMIC_RELAXED, __HIP_MEMORY_SCOPE_AGENT); }
__device__ __forceinline__ unsigned xb_add(unsigned* p, unsigned v) { return __hip_atomic_fetch_add(p, v, __ATOMIC_RELAXED, __HIP_MEMORY_SCOPE_AGENT); }
__device__ __forceinline__ unsigned xb_xcc_id() { return (unsigned)__builtin_amdgcn_s_getreg((3 << 11) | 20) & 0xFu; }
#define XB_SPIN(cond, bar) do { unsigned _sp = 0; while (cond) { __builtin_amdgcn_s_sleep(1); \
    if ((++_sp & 255u) == 0u) { if (xb_ld(&(bar)[XB_TMO])) break; if (_sp > XB_SPIN_CAP) { atomicAdd(&(bar)[XB_TMO], 1u); break; } } } } while (0)

struct XcdBarrier { unsigned* bar; unsigned x; volatile LAS unsigned* st; };
__device__ __forceinline__ XcdBarrier xcd_barrier_post(unsigned* bar, volatile LAS unsigned* st) {
    XcdBarrier b; b.bar = bar; b.x = xb_xcc_id(); b.st = st;
    if (threadIdx.x == 0) (void)xb_add(&bar[XB_XCNT(b.x)], 1u);
    return b;
}
__device__ __forceinline__ void xcd_barrier_complete(unsigned* bar, unsigned x, unsigned& nloc, unsigned& nx) {
    const unsigned G = gridDim.x * gridDim.y * gridDim.z;
    unsigned sum, cnt, mine, sp = 0u;
    for (;;) {
        sum = 0u; cnt = 0u; mine = 0u;
#pragma unroll
        for (unsigned j = 0; j < 16; ++j) { const unsigned c = xb_ld(&bar[XB_XCNT(j)]); sum += c; cnt += (c > 0u) ? 1u : 0u; mine = (j == x) ? c : mine; }
        if (sum == G) break;
        __builtin_amdgcn_s_sleep(1);
        if ((++sp & 255u) == 0u) { if (xb_ld(&bar[XB_TMO])) break; if (sp > XB_SPIN_CAP) { atomicAdd(&bar[XB_TMO], 1u); break; } }
    }
    nloc = mine > 0u ? mine : 1u; nx = cnt > 0u ? cnt : 1u;
}
__device__ __forceinline__ void xcd_barrier(const XcdBarrier& b) {
    asm volatile("s_waitcnt vmcnt(0)" ::: "memory");
    __syncthreads();
    if (threadIdx.x == 0) {
        unsigned* bar = b.bar;
        __builtin_amdgcn_s_waitcnt(0);
        unsigned nloc = b.st[0], nx = b.st[1];
        if (nloc == 0u) { xcd_barrier_complete(bar, b.x, nloc, nx); b.st[0] = nloc; b.st[1] = nx; }
        const unsigned old = xb_add(&bar[XB_XSUB(b.x)], 1u);
        const unsigned gen = old / nloc;
        if (old + 1u == (gen + 1u) * nloc) {
            __builtin_amdgcn_fence(__ATOMIC_RELEASE, "agent");
            asm volatile("s_waitcnt vmcnt(0)" ::: "memory");
            const unsigned og = xb_add(&bar[XB_TOP], 1u);
            const unsigned tg = og / nx;
            if (og + 1u == (tg + 1u) * nx) xb_add(&bar[XB_TOPGEN], 1u);
            else XB_SPIN(xb_ld(&bar[XB_TOPGEN]) == tg, bar);
            __builtin_amdgcn_fence(__ATOMIC_ACQUIRE, "agent");
            xb_add(&bar[XB_XGEN(b.x)], 1u);
            asm volatile("s_waitcnt vmcnt(0)" ::: "memory");
        } else {
            XB_SPIN(xb_ld(&bar[XB_XGEN(b.x)]) == gen, bar);
            __builtin_amdgcn_fence(__ATOMIC_ACQUIRE, "agent");
            asm volatile("s_waitcnt vmcnt(0)" ::: "memory");
        }
    }
    __syncthreads();
}

template <int CTRL> __device__ __forceinline__ float dppx(float v) { return __builtin_bit_cast(float, __builtin_amdgcn_update_dpp(0, __builtin_bit_cast(int, v), CTRL, 0xf, 0xf, true)); }
constexpr int DPP_XOR1 = 0xB1, DPP_XOR2 = 0x4E, DPP_HMIRROR = 0x141, DPP_MIRROR = 0x140, DPP_XOR8 = 0x128;
__device__ __forceinline__ void swap16(float v, float& even_rows, float& odd_rows) { auto r = __builtin_amdgcn_permlane16_swap(__float_as_uint(v), __float_as_uint(v), false, false); even_rows = __uint_as_float(r[0]); odd_rows = __uint_as_float(r[1]); }
__device__ __forceinline__ void swap32(float v, float& lo_half, float& hi_half) { auto r = __builtin_amdgcn_permlane32_swap(__float_as_uint(v), __float_as_uint(v), false, false); lo_half = __uint_as_float(r[0]); hi_half = __uint_as_float(r[1]); }
__device__ __forceinline__ float quad_sum(float v) { v += dppx<DPP_XOR1>(v); v += dppx<DPP_XOR2>(v); return v; }
__device__ __forceinline__ float row16_sum(float v) { v = quad_sum(v); v += dppx<DPP_HMIRROR>(v); v += dppx<DPP_MIRROR>(v); return v; }
__device__ __forceinline__ float wave_sum(float v) { v = row16_sum(v); float a, b; swap16(v, a, b); v = a + b; swap32(v, a, b); return a + b; }
__device__ __forceinline__ int wave_incl_scan(int v, int lane) {
#pragma unroll
    for (int o = 1; o < 64; o <<= 1) { const int t = __shfl_up(v, o); if (lane >= o) v += t; }
    return v;
}
__device__ __forceinline__ int block_excl_scan(int v, LAS int* tmp, int lane, int wave) {
    const int inc = wave_incl_scan(v, lane);
    if (lane == 63) tmp[wave] = inc;
    __syncthreads();
    int base = 0;
#pragma unroll
    for (int w = 0; w < NWAVES; ++w) { const int t = tmp[w]; base += (w < wave) ? t : 0; }
    __syncthreads();
    return base + inc - v;
}

struct Args { const float* in[21]; float* out; unsigned char* ws; int ph_lo, ph_hi, li, pad; };
enum { IN_X = 0, IN_C, IN_CTX, IN_CCTX, IN_MODW, IN_MODB, IN_LNG, IN_LNB, IN_POOLW, IN_POOLS, IN_NAQKV, IN_NAWO, IN_NARPB, IN_GQKV, IN_GQN, IN_GKN, IN_GWO, IN_ROUTER, IN_W1, IN_W3, IN_W2 };

__device__ __forceinline__ void p0_mod(const Args& a, LAS unsigned char* lds, int tid, int lane, int wave) {
    const int wg = blockIdx.x; if (wg >= 192) return;
    const int L = wg / 48, cb = wg % 48;
    LAS float* sl = (LAS float*)lds; LAS float* red = sl + 5 * 1024;
    const float* c = a.in[IN_C]; const float* cc = a.in[IN_CCTX];
    for (int i = tid; i < 5120; i += 512) { const int s = i >> 10, k = i & 1023; const float cv = s < 4 ? c[s * 1024 + k] : cc[k]; sl[i] = cv / (1.0f + expf(-cv)); }
    __syncthreads();
    float acc[5][2];
#pragma unroll
    for (int s = 0; s < 5; ++s) { acc[s][0] = 0.f; acc[s][1] = 0.f; }
    const float* wp = a.in[IN_MODW] + (size_t)L * DM * NMOD + cb * 128 + 2 * lane;
#pragma unroll 8
    for (int kk = 0; kk < 128; ++kk) { const int k = wave * 128 + kk; const f32x2 w = *(const f32x2*)(wp + (size_t)k * NMOD);
#pragma unroll
        for (int s = 0; s < 5; ++s) { const float sv = sl[s * 1024 + k]; acc[s][0] += sv * w.x; acc[s][1] += sv * w.y; } }
#pragma unroll
    for (int s = 0; s < 5; ++s) { red[(wave * 5 + s) * 128 + 2 * lane] = acc[s][0]; red[(wave * 5 + s) * 128 + 2 * lane + 1] = acc[s][1]; }
    __syncthreads();
    float* MOD = (float*)(a.ws + WS_MOD);
    for (int o = tid; o < 640; o += 512) { const int s = o >> 7, col = o & 127; float sum = 0.f;
#pragma unroll
        for (int w = 0; w < 8; ++w) sum += red[(w * 5 + s) * 128 + col];
        MOD[(size_t)(L * 5 + s) * NMOD + cb * 128 + col] = sum + a.in[IN_MODB][L * NMOD + cb * 128 + col]; }
    __syncthreads();
}
struct CvtItem { const float* W; void* WT; int K, N, mode, sub; float scale; };
constexpr int I_POOL = 128, I_NAQKV = 768, I_NAWO = 256, I_GQKV = 384, I_GWO = 256, I_SMALL = I_POOL + I_NAQKV + I_NAWO + I_GQKV + I_GWO, I_LE = 1536, I_ALL = I_SMALL + 64 * I_LE;
constexpr int CVT_NWIN = 10;
__host__ __device__ constexpr int cvt_wsize(int w) { return w == 0 ? 240 * 8 * 1 : w == 3 ? 208 * 8 * 2 : w == 4 ? 240 * 8 * 3 : w == 7 ? 232 * 8 * 2 : 192 * 8 * 4; }
__host__ __device__ constexpr int cvt_wsum(int w) { int s_ = 0; for (int i = 0; i < w; ++i) s_ += cvt_wsize(i); return s_; }
constexpr int CVT_I_PRO = I_ALL - cvt_wsum(CVT_NWIN);
__host__ __device__ constexpr int cvt_wlo(int w) { return CVT_I_PRO + cvt_wsum(w); }
static_assert(CVT_I_PRO >= I_SMALL + 16 * I_LE, "layer 0's weights are converted in the prologue");
static_assert(cvt_wlo(6) >= I_SMALL + 32 * I_LE, "layer 1's expert weights are complete before its up GEMM (after window 5)");
static_assert(cvt_wlo(9) >= I_SMALL + 48 * I_LE, "layer 2's expert weights are complete before its up GEMM (after window 8)");
__device__ __forceinline__ bool cvt_decode(const Args& a, int it, int it_end, CvtItem& c) {
    if (it >= it_end) return false;
    int r = it; c.scale = 0.f; c.mode = 0;
    if (r >= I_SMALL) { r -= I_SMALL; const int le = r / I_LE, q = r - le * I_LE, which = q >> 9; c.sub = q & 511;
#if MOE_F8
        const size_t es = 1;
#else
        const size_t es = 2;
#endif
        if (which < 2) { c.W = a.in[which == 0 ? IN_W1 : IN_W3] + (size_t)le * DM * FF; c.K = DM; c.N = FF; c.WT = a.ws + WS_W13 + (size_t)le * 2 * FF * DM * es; c.mode = 1 + which; c.scale = MOE_F8 ? W13_SCALE : 0.f; }
        else { c.W = a.in[IN_W2] + (size_t)le * FF * DM; c.K = FF; c.N = DM; c.WT = a.ws + WS_W2 + (size_t)le * DM * FF * es; c.scale = MOE_F8 ? W2_SCALE : 0.f; }
        return true; }
    if (r < I_POOL) { const int mi = r >> 4; c.W = a.in[IN_POOLW] + (size_t)mi * 65536; c.K = 256; c.N = 256; c.WT = (bf16*)(a.ws + WS_POOLW) + (size_t)mi * 65536; c.sub = r & 15; return true; } r -= I_POOL;
    if (r < I_NAQKV) { c.W = a.in[IN_NAQKV]; c.K = DM; c.N = 3 * DM; c.WT = a.ws + WS_NAQKV; c.sub = r; c.scale = QKV_F8 ? W13_SCALE : 0.f; return true; } r -= I_NAQKV;
    if (r < I_NAWO) { c.W = a.in[IN_NAWO]; c.K = DM; c.N = DM; c.WT = a.ws + WS_NAWO; c.sub = r; c.scale = WO_F8 ? 64.0f : 0.f; return true; } r -= I_NAWO;
    if (r < I_GQKV) { c.W = a.in[IN_GQKV]; c.K = DM; c.N = 1536; c.WT = a.ws + WS_GQKV; c.sub = r; c.scale = QKV_F8 ? W13_SCALE : 0.f; return true; } r -= I_GQKV;
    c.W = a.in[IN_GWO]; c.K = DM; c.N = DM; c.WT = a.ws + WS_GWO; c.sub = r; c.scale = WO_F8 ? 64.0f : 0.f; return true;
}
__device__ __forceinline__ void cvt_geom(const CvtItem& c, int& k0, int& n0) { const int nblk = c.N >> 5, kb = c.sub / nblk, nb = c.sub - kb * nblk; k0 = kb * 128; n0 = nb * 32; }
__device__ __forceinline__ void cvt_load(const CvtItem& c, f32x4 (&v)[16], int lane) {
    int k0, n0; cvt_geom(c, k0, n0); const int kr = lane >> 3, nc = lane & 7;
#pragma unroll
    for (int i = 0; i < 16; ++i) v[i] = __builtin_nontemporal_load((const f32x4*)(c.W + (size_t)(k0 + 8 * i + kr) * c.N + n0 + 4 * nc));
}
__device__ __forceinline__ void cvt_store(const CvtItem& c, const f32x4 (&v)[16], LAS float* scr, int lane) {
    int k0, n0; cvt_geom(c, k0, n0); const int kr = lane >> 3, nc = lane & 7;
    const float sc = c.scale > 0.f ? c.scale : 1.0f;
#pragma unroll
    for (int i = 0; i < 16; ++i) { LAS float* d = scr + (8 * i + kr) * 33 + 4 * nc; d[0] = v[i].x * sc; d[1] = v[i].y * sc; d[2] = v[i].z * sc; d[3] = v[i].w * sc; }
    LDS_WAIT();
    const int ch = lane & 7;
#pragma unroll
    for (int j = 0; j < 4; ++j) { const int n = 8 * j + (lane >> 3); const LAS float* s = scr + (16 * ch) * 33 + n;
        const int nn = n0 + n; const int drow = c.mode == 0 ? nn : (((nn >> 2) << 3) + (nn & 3) + (c.mode == 2 ? 4 : 0));
        if (c.scale > 0.f) { int w[4];
#pragma unroll
            for (int q = 0; q < 4; ++q) { int t = 0; t = __builtin_amdgcn_cvt_pk_fp8_f32(s[(4 * q) * 33], s[(4 * q + 1) * 33], t, false); t = __builtin_amdgcn_cvt_pk_fp8_f32(s[(4 * q + 2) * 33], s[(4 * q + 3) * 33], t, true); w[q] = t; }
            __builtin_nontemporal_store((v4u){(unsigned)w[0], (unsigned)w[1], (unsigned)w[2], (unsigned)w[3]}, (v4u*)((unsigned char*)c.WT + (size_t)drow * c.K + k0 + 16 * ch)); }
        else { v4u o0, o1;
            o0.x = pk2(s[0 * 33], s[1 * 33]); o0.y = pk2(s[2 * 33], s[3 * 33]); o0.z = pk2(s[4 * 33], s[5 * 33]); o0.w = pk2(s[6 * 33], s[7 * 33]);
            o1.x = pk2(s[8 * 33], s[9 * 33]); o1.y = pk2(s[10 * 33], s[11 * 33]); o1.z = pk2(s[12 * 33], s[13 * 33]); o1.w = pk2(s[14 * 33], s[15 * 33]);
            v4u* d = (v4u*)((bf16*)c.WT + (size_t)drow * c.K + k0 + 16 * ch); d[0] = o0; d[1] = o1; } }
    LDS_WAIT();
}
#ifdef PROBE_DUPPRO
__device__ __forceinline__ void p0_convert_probe(const Args& a, LAS unsigned char* lds, int gw, int NGW, int lane, int wave) {
    LAS float* scr = (LAS float*)(lds + wave * 16896);
    CvtItem cur; f32x4 va[16]; f32x4 acc = {0.f, 0.f, 0.f, 0.f};
    for (int it = gw; cvt_decode(a, it, I_ALL, cur); it += NGW) {
        cvt_load(cur, va, lane);
        if (PROBE_DUPPRO == 2) { cur.WT = a.ws + (size_t)1600 * MiB + ((size_t)it & 2047) * 65536; cur.K = 64; cur.mode = 0; cur.sub = 0; cvt_store(cur, va, scr, lane); }
        else {
#pragma unroll
            for (int i = 0; i < 16; ++i) acc += va[i]; }
    }
    if (acc.x == 1.2345e30f) ((float*)(a.ws + (size_t)1600 * MiB))[lane] = acc.x + acc.y + acc.z + acc.w;
}
#endif
__device__ __forceinline__ void p0_convert(const Args& a, LAS unsigned char* lds, int it0, int it_end, int gw, int NGW, int lane, int wave) {
    LAS float* scr = (LAS float*)(lds + wave * 16896);
    CvtItem ca, cb; f32x4 va[16], vb[16];
    bool ha = cvt_decode(a, it0 + gw, it_end, ca);
    if (ha) cvt_load(ca, va, lane);
    for (int it = it0 + gw; ha; it += 2 * NGW) {
        const bool hb = cvt_decode(a, it + NGW, it_end, cb);
        if (hb) cvt_load(cb, vb, lane);
        cvt_store(ca, va, scr, lane);
        if (!hb) break;
        ha = cvt_decode(a, it + 2 * NGW, it_end, ca);
        if (ha) cvt_load(ca, va, lane);
        cvt_store(cb, vb, scr, lane);
    }
}

__device__ __forceinline__ int row_s(int row) { return row < M_LAT ? (row >> 13) : 4; }
__device__ __forceinline__ const float* xrow(const Args& a, int row) {
    return row < M_LAT ? a.in[IN_X] + (size_t)row * DM : a.in[IN_CTX] + (size_t)(row - M_LAT) * DM;
}
typedef _Float16 xh_t; typedef _Float16 h16x4 __attribute__((ext_vector_type(4)));
__device__ __forceinline__ f32x4 xdec(const f32x4 v) { return v; }
__device__ __forceinline__ f32x4 xdec(const v2u w) { return __builtin_convertvector(__builtin_bit_cast(h16x4, w), f32x4); }
__device__ __forceinline__ v2u xenc(const f32x4 v) { return __builtin_bit_cast(v2u, __builtin_convertvector(v, h16x4)); }
template <bool XH> struct XSrc;
template <> struct XSrc<false> { typedef f32x4 vec; typedef float elem; static __device__ __forceinline__ const float* row(const Args& a, int r) { return xrow(a, r); } };
template <> struct XSrc<true>  { typedef v2u vec;   typedef xh_t elem;  static __device__ __forceinline__ const xh_t* row(const Args& a, int r) { return (const xh_t*)(a.ws + WS_X) + (size_t)r * DM; } };

template <int W, class XE> __device__ __forceinline__ f32x4 pool_sum(const XE* base, int pos, int n) {
    typedef typename std::conditional<sizeof(XE) == 2, v2u, f32x4>::type XV;
    f32x4 s = {0.f, 0.f, 0.f, 0.f};
#pragma unroll
    for (int i = 0; i < W; ++i) { const int idx = pos - W / 2 + i; const bool ok = idx >= 0 && idx < n; const int ic = idx < 0 ? 0 : (idx >= n ? n - 1 : idx);
        const f32x4 v = xdec(*(const XV*)(base + (size_t)ic * DM)); s += ok ? v : (f32x4){0.f, 0.f, 0.f, 0.f}; }
    return s;
}
__device__ __forceinline__ void pd_decode(int row, int& r0s, int& pos, int& n) {
    if (row < M_LAT) { r0s = row & ~(SEQ - 1); pos = row & (SEQ - 1); n = SEQ; } else { r0s = M_LAT + ((row - M_LAT) & ~(LCTX - 1)); pos = (row - M_LAT) & (LCTX - 1); n = LCTX; }
}
template <bool XH> __device__ __forceinline__ void ph_pooldiff(const Args& a, int L, int nrows, int gw, int NGW, int lane) {
    typedef typename XSrc<XH>::vec XV; typedef typename XSrc<XH>::elem XE;
    const float* MOD = (const float*)(a.ws + WS_MOD); bf16* Dm = (bf16*)(a.ws + WS_R + R_D);
    const int r0 = (int)(((long)gw * nrows) / NGW), r1 = (int)(((long)(gw + 1) * nrows) / NGW);
    XV EA[4], LA[4], CA[4], EB[4], LB[4], CB[4], EC[4], LC[4], CC[4]; f32x4 S[4], SC[4];
    const XE* zb = (const XE*)(a.ws + WS_CTL + MiB) + 4 * lane;
#define PD_LOAD(rw, En, Ln, Cn) do { const int rr_ = (rw) < re ? (rw) : re - 1; const int pos_ = rr_ - r0s; \
        _Pragma("unroll") for (int g = 0; g < 4; ++g) { const int W_ = 2 << g, ie_ = pos_ + W_ / 2 - 1, il_ = pos_ - 1 - W_ / 2; \
            En[g] = *(const XV*)((ie_ < n ? xb + (size_t)ie_ * DM : zb) + g * 256); Ln[g] = *(const XV*)((il_ >= 0 ? xb + (size_t)il_ * DM : zb) + g * 256); \
            Cn[g] = *(const XV*)(xb + (size_t)pos_ * DM + g * 256); } __builtin_amdgcn_sched_barrier(0); } while (0)
#define PD_EMIT(rowv, C) do { const int row_ = (rowv); const int pos = row_ - r0s; bf16* drow = Dm + (size_t)row_ * DM + 4 * lane; \
        _Pragma("unroll") for (int g = 0; g < 4; ++g) { const int W = 2 << g; const int lo = pos - W / 2 < 0 ? 0 : pos - W / 2, hi = pos + (W - W / 2 - 1) > n - 1 ? n - 1 : pos + (W - W / 2 - 1); \
            const float inv = 1.0f / (float)(hi - lo + 1); const f32x4 d = SC[g] * (S[g] * inv - xdec(C[g])); \
            v2u o; o.x = pk2(d.x, d.y); o.y = pk2(d.z, d.w); *(v2u*)(drow + g * 256) = o; } } while (0)
#define PD_ROW(rowv, E, Lv, C) do { _Pragma("unroll") for (int g = 0; g < 4; ++g) S[g] += xdec(E[g]) - xdec(Lv[g]); PD_EMIT(rowv, C); } while (0)
    for (int rs = r0; rs < r1; ) {
        int r0s, pos0, n; pd_decode(rs, r0s, pos0, n);
        const int re = (r0s + n) < r1 ? (r0s + n) : r1;
        const XE* xb = XSrc<XH>::row(a, r0s) + 4 * lane;
        { const float* scp_ = MOD + (size_t)(L * 5 + row_s(rs)) * NMOD + DM + 4 * lane;
#pragma unroll
          for (int g = 0; g < 4; ++g) SC[g] = *(const f32x4*)(scp_ + g * 256) + 1.0f; }
        S[0] = pool_sum<2>(xb, pos0, n); S[1] = pool_sum<4>(xb + 256, pos0, n); S[2] = pool_sum<8>(xb + 512, pos0, n); S[3] = pool_sum<16>(xb + 768, pos0, n);
#pragma unroll
        for (int g = 0; g < 4; ++g) CA[g] = *(const XV*)(xb + (size_t)pos0 * DM + g * 256);
        PD_EMIT(rs, CA);
        const int rb = rs + 1;
        if (rb < re) {
            PD_LOAD(rb, EA, LA, CA); PD_LOAD(rb + 1, EB, LB, CB);
            for (int row = rb; row < re; row += 3) {
                PD_LOAD(row + 2, EC, LC, CC); PD_ROW(row, EA, LA, CA);
                if (row + 1 < re) { PD_LOAD(row + 3, EA, LA, CA); PD_ROW(row + 1, EB, LB, CB); }
                if (row + 2 < re) { PD_LOAD(row + 4, EB, LB, CB); PD_ROW(row + 2, EC, LC, CC); }
            }
        }
        rs = re;
    }
#undef PD_LOAD
#undef PD_EMIT
#undef PD_ROW
}

struct Ln1Ctx { const Args* a; int L; LAS float* RT; LAS f32x4* PV; xh_t* X; bf16* H; float* AFF; int lane; };
#define LN1_RTRD(W, e0, jj) do { _Pragma("unroll") for (int e = 0; e < 8; ++e) W[e] = *(const LAS f32x4*)(rtp + ((e0) + e) * 1024 + 256 * (jj)); __builtin_amdgcn_sched_barrier(0); } while (0)
#define LN1_RTFMA(W, e0) do { _Pragma("unroll") for (int e = 0; e < 8; ++e) { const f32x4 w = W[e]; \
        lgp[(e0) + e] = __builtin_elementwise_fma((f32x2){h2.x, h2.y}, (f32x2){w.x, w.y}, lgp[(e0) + e]); lgp[(e0) + e] = __builtin_elementwise_fma((f32x2){h2.z, h2.w}, (f32x2){w.z, w.w}, lgp[(e0) + e]); } \
        __builtin_amdgcn_sched_barrier(0); } while (0)
template <int VAR, class XV> __device__ __forceinline__ void ln1_row(const Ln1Ctx& c, const int row, const XV (&xc)[4], const v2u (&yc)[4], f32x4 (&wA)[8], f32x4 (&wB)[8]) {
    const int L = c.L, lane = c.lane; LAS float* RT = c.RT; LAS f32x4* PV = c.PV; xh_t* X = c.X; bf16* H = c.H; float* AFF = c.AFF; (void)L;
        const LAS f32x4* pv = PV + (2 + 3 * row_s(row)) * 256 + lane;
        const LAS float* rtp = RT + 4 * lane; asm volatile("" : "+v"(rtp));
        f32x4 pa[4], pb[4]; pa[0] = PV[lane]; pa[1] = PV[256 + lane]; pa[2] = pv[512]; pa[3] = pv[256];
        f32x4 v[4]; float s = 0.f;
#pragma unroll
        for (int j = 0; j < 4; ++j) { f32x4 yv = {bf_lo(yc[j].x), bf_hi(yc[j].x), bf_lo(yc[j].y), bf_hi(yc[j].y)};
#ifdef DBG_NEG_Y_LAYER
            if (L == DBG_NEG_Y_LAYER) yv = -yv;
#endif
            v[j] = xdec(xc[j]) * ALPHA + pv[64 * j] * yv; s += (v[j].x + v[j].y) + (v[j].z + v[j].w); }
        const float mean = wave_sum(s) * (1.f / DM); float s2 = 0.f;
#pragma unroll
        for (int j = 0; j < 4; ++j) { v[j] = v[j] - mean; s2 += (v[j].x * v[j].x + v[j].y * v[j].y) + (v[j].z * v[j].z + v[j].w * v[j].w); }
        const float rstd = 1.f / sqrtf(wave_sum(s2) * (1.f / DM) + LN_EPS);
        v2u* xo = (v2u*)(X + (size_t)row * DM) + lane; v2u* ho = (v2u*)(H + (size_t)row * DM) + lane; (void)ho;
        f32x2 lgp[16];
#pragma unroll
        for (int e = 0; e < 16; ++e) lgp[e] = (f32x2){0.f, 0.f};
#define LN1_PVRD(P, jj) do { P[0] = PV[lane + 64 * (jj)]; P[1] = PV[256 + lane + 64 * (jj)]; P[2] = pv[512 + 64 * (jj)]; P[3] = pv[256 + 64 * (jj)]; } while (0)
#define LN1_CHUNK(jj, PC, PN) do { const f32x4 x1 = v[jj] * rstd * PC[0] + PC[1]; xo[64 * (jj)] = xenc(x1); const f32x4 h2 = x1 * (PC[2] + 1.0f) + PC[3]; LN1_HST(jj); \
        if (VAR < 2) { if ((jj) < 3) LN1_PVRD(PN, (jj) + 1); LN1_RTRD(wB, 8, jj); LN1_RTFMA(wA, 0); LN1_RTRD(wA, 0, ((jj) + 1) & 3); LN1_RTFMA(wB, 8); } \
        else { if ((jj) < 3) LN1_PVRD(PN, (jj) + 1); lgp[0].x += h2.x + h2.y; lgp[1].y += h2.z + h2.w; } } while (0)
#if MOE_F8
#define LN1_HST(jj) do { int t = 0; t = __builtin_amdgcn_cvt_pk_fp8_f32(h2.x, h2.y, t, false); t = __builtin_amdgcn_cvt_pk_fp8_f32(h2.z, h2.w, t, true); ((int*)((unsigned char*)H + (size_t)row * DM))[lane + 64 * (jj)] = t; } while (0)
#else
#define LN1_HST(jj) do { v2u o; o.x = pk2(h2.x, h2.y); o.y = pk2(h2.z, h2.w); ho[64 * (jj)] = o; } while (0)
#endif
        LN1_CHUNK(0, pa, pb); LN1_CHUNK(1, pb, pa); LN1_CHUNK(2, pa, pb); LN1_CHUNK(3, pb, pa);
#undef LN1_PVRD
#undef LN1_CHUNK
#undef LN1_HST
        float lg16[16];
#pragma unroll
        for (int e = 0; e < 16; ++e) lg16[e] = lgp[e].x + lgp[e].y;
        if (VAR == 3) { if (lane < 16) AFF[(size_t)row * NE + lane] = lg16[0] + lg16[5]; return; }
        float r8[8], r4[4], t0, t1;
        { const bool up = (lane & 32) != 0;
#pragma unroll
          for (int i = 0; i < 8; ++i) { const float snd = up ? lg16[i] : lg16[i + 8], kp = up ? lg16[i + 8] : lg16[i]; float lo, hi; swap32(snd, lo, hi); r8[i] = kp + (up ? lo : hi); } }
        { const bool up = (lane & 16) != 0;
#pragma unroll
          for (int i = 0; i < 4; ++i) { const float snd = up ? r8[i] : r8[i + 4], kp = up ? r8[i + 4] : r8[i]; float ev, od; swap16(snd, ev, od); r4[i] = kp + (up ? ev : od); } }
        { const bool up = (lane & 8) != 0;
          const float s0 = up ? r4[0] : r4[2], k0 = up ? r4[2] : r4[0], s1 = up ? r4[1] : r4[3], k1 = up ? r4[3] : r4[1];
          t0 = k0 + dppx<DPP_XOR8>(s0); t1 = k1 + dppx<DPP_XOR8>(s1); }
        t0 = quad_sum(t0); t0 += dppx<DPP_HMIRROR>(t0); t1 = quad_sum(t1); t1 += dppx<DPP_HMIRROR>(t1);
        float mx = fmaxf(t0, t1); mx = fmaxf(mx, dppx<DPP_XOR8>(mx)); { float a_, b_; swap16(mx, a_, b_); mx = fmaxf(a_, b_); swap32(mx, a_, b_); mx = fmaxf(a_, b_); }
        const float p0 = __builtin_amdgcn_exp2f((t0 - mx) * LOG2E), p1 = __builtin_amdgcn_exp2f((t1 - mx) * LOG2E);
        float den = p0 + p1; den += dppx<DPP_XOR8>(den); { float a_, b_; swap16(den, a_, b_); den = a_ + b_; swap32(den, a_, b_); den = a_ + b_; }
        if ((lane & 7) == 0) { const float rd = 1.0f / den; *(f32x2*)(AFF + (size_t)row * NE + 2 * (lane >> 3)) = (f32x2){p0 * rd, p1 * rd}; }
}
template <bool XH, int VAR = 0> __device__ __forceinline__ void ph_ln1(const Args& a, int L, int nrows, LAS unsigned char* lds, int gw, int NGW, int tid, int lane) {
    LAS float* RT = (LAS float*)lds;
    LAS f32x4* PV = (LAS f32x4*)(lds + 65536);
    const float* MOD = (const float*)(a.ws + WS_MOD);
    { const float* rt = a.in[IN_ROUTER] + (size_t)L * DM * NE;
      { float rv[32];
#pragma unroll
        for (int j = 0; j < 32; ++j) rv[j] = rt[tid + 512 * j];
#pragma unroll
        for (int j = 0; j < 32; ++j) { const int i = tid + 512 * j; RT[(i & 15) * 1024 + (i >> 4)] = rv[j]; } }
#pragma unroll
      for (int i = tid; i < 17 * 256; i += 512) { const int v = i >> 8, c = i & 255; const float* src;
          if (v == 0) src = a.in[IN_LNG] + (size_t)(L * 2 + 0) * DM; else if (v == 1) src = a.in[IN_LNB] + (size_t)(L * 2 + 0) * DM;
          else { const int s = (v - 2) / 3, w = (v - 2) - 3 * s; src = MOD + (size_t)(L * 5 + s) * NMOD + (2 + w) * DM; }
          PV[i] = ((const f32x4*)src)[c]; } }
    __syncthreads();
    const bf16* Y = (const bf16*)(a.ws + WS_R + R_Y);
    const size_t dup_ = VAR ? (size_t)1600 * MiB - WS_X : 0;
    xh_t* X = (xh_t*)(a.ws + WS_X + dup_); bf16* H = (bf16*)(a.ws + WS_H + dup_); float* AFF = (float*)(a.ws + WS_AFF + (VAR ? (size_t)1800 * MiB - WS_AFF : 0));
    typedef typename XSrc<XH>::vec XVec;
    const int r0 = (int)(((long)gw * nrows) / NGW), r1 = (int)(((long)(gw + 1) * nrows) / NGW);
    XVec xa[4], xb[4], xd[4]; v2u ya[4], yb[4], yd[4];
#define LN1_LOAD(r, XV, YV) do { const int r_ = (r) < r1 ? (r) : r1 - 1; const XVec* xr_ = (const XVec*)XSrc<XH>::row(a, r_) + lane; const v2u* yr_ = (const v2u*)(Y + (size_t)r_ * DM) + lane; \
        _Pragma("unroll") for (int j = 0; j < 4; ++j) { XV[j] = xr_[64 * j]; YV[j] = yr_[64 * j]; } } while (0)
    const Ln1Ctx cx{&a, L, RT, PV, X, H, AFF, lane};
    if (r0 < r1) { LN1_LOAD(r0, xa, ya); LN1_LOAD(r0 + 1, xb, yb); }
    f32x4 wA[8], wB[8];
    { const LAS float* rtp = RT + 4 * lane; asm volatile("" : "+v"(rtp)); LN1_RTRD(wA, 0, 0); }
    for (int row = r0; row < r1; row += 3) {
        LN1_LOAD(row + 2, xd, yd); ln1_row<VAR>(cx, row, xa, ya, wA, wB);
        if (row + 1 < r1) { LN1_LOAD(row + 3, xa, ya); ln1_row<VAR>(cx, row + 1, xb, yb, wA, wB); }
        if (row + 2 < r1) { LN1_LOAD(row + 4, xb, yb); ln1_row<VAR>(cx, row + 2, xd, yd, wA, wB); }
    }
#undef LN1_LOAD
#undef LN1_RTRD
#undef LN1_RTFMA
    __syncthreads();
}

__device__ __forceinline__ void topk_problem(const Args& a, int row0, int n, int cap, int e, int slot0, LAS unsigned char* lds, int tid, int lane, int wave) {
    const float* AFF = (const float*)(a.ws + WS_AFF); int* SEL = (int*)(a.ws + WS_SEL); int* SLOT = (int*)(a.ws + WS_SLOT);
    LAS unsigned* vals = (LAS unsigned*)lds; LAS unsigned* hist = vals + 8192; LAS int* misc = (LAS int*)(hist + 256); LAS int* tmp = misc + 8;
    for (int i = tid; i < n; i += 512) vals[i] = __float_as_uint(AFF[(size_t)(row0 + i) * NE + e]);
    unsigned prefix = 0u; int kk = cap;
    for (int pass = 0; pass < 4; ++pass) {
        const int shift = 24 - 8 * pass;
        if (tid < 256) hist[tid] = 0u;
        __syncthreads();
        for (int i = tid; i < n; i += 512) { const unsigned v = vals[i]; if (((v >> shift) >> 8) == ((prefix >> shift) >> 8)) atomicAdd((unsigned*)&hist[(v >> shift) & 255u], 1u); }
        __syncthreads();
        if (wave == 0) {
            const int h0 = (int)hist[4 * lane], h1 = (int)hist[4 * lane + 1], h2 = (int)hist[4 * lane + 2], h3 = (int)hist[4 * lane + 3]; const int c = h0 + h1 + h2 + h3;
            int S = c;
#pragma unroll
            for (int o = 1; o < 64; o <<= 1) { const int t = __shfl_down(S, o); if (lane + o < 64) S += t; }
            const int above = S - c;
            if (above < kk && kk <= S) { int ab = above, bsel;
                if (ab + h3 >= kk) bsel = 3; else { ab += h3; if (ab + h2 >= kk) bsel = 2; else { ab += h2; if (ab + h1 >= kk) bsel = 1; else { ab += h1; bsel = 0; } } }
                misc[0] = 4 * lane + bsel; misc[1] = kk - ab; }
        }
        __syncthreads();
        prefix |= (unsigned)misc[0] << shift; kk = misc[1];
    }
    const unsigned T = prefix;
    const int per = n >= 512 ? n / 512 : 1, nact = n / per; const int i0 = tid * per; const bool act = tid < nact;
    int cgt = 0, ceq = 0;
    if (act) for (int j = 0; j < per; ++j) { const unsigned v = vals[i0 + j]; cgt += (v > T) ? 1 : 0; ceq += (v == T) ? 1 : 0; }
    const int eq_before = block_excl_scan(ceq, tmp, lane, wave);
    int take = kk - eq_before; take = take < 0 ? 0 : (take > ceq ? ceq : take);
    int p = block_excl_scan(cgt + take, tmp, lane, wave);
    if (act) { int er = eq_before;
        for (int j = 0; j < per; ++j) { const unsigned v = vals[i0 + j]; const bool sel = (v > T) || (v == T && er < kk); if (v == T) ++er;
            const int row = row0 + i0 + j;
            if (sel) { const int slot = slot0 + p; ++p; SLOT[slot] = row; SEL[(size_t)row * NE + e] = slot; } else SEL[(size_t)row * NE + e] = -1; } }
    __syncthreads();
}
__device__ __forceinline__ void ph_topk(const Args& a, bool upd, LAS unsigned char* lds, int tid, int lane, int wave) {
    const int nprob = upd ? 128 : 64;
    for (int p = blockIdx.x; p < nprob; p += gridDim.x) {
        if (p < 64) { const int b = p >> 4, e = p & 15; topk_problem(a, b * SEQ, SEQ, CAP_LAT, e, e * ESTR + b * CAP_LAT, lds, tid, lane, wave); }
        else { const int q = p - 64, b = q >> 4, e = q & 15; topk_problem(a, M_LAT + b * LCTX, LCTX, CAP_CTX, e, e * ESTR + 4 * CAP_LAT + b * CAP_CTX, lds, tid, lane, wave);
            if (b == 0 && tid < 128) ((int*)(a.ws + WS_SLOT))[e * ESTR + 4 * CAP_LAT + 4 * CAP_CTX + tid] = -1; }
    }
}
__device__ __forceinline__ void ph_gather(const Args& a, bool upd, int gw, int NGW, int lane) {
    const int* SLOT = (const int*)(a.ws + WS_SLOT); const bf16* H = (const bf16*)(a.ws + WS_H); bf16* XS = (bf16*)(a.ws + WS_R + R_XS);
    for (int slot = gw; slot < NSLOTS; slot += NGW) {
        const int within = slot % ESTR; if (!upd && within >= 4 * CAP_LAT) continue;
        const int tok = SLOT[slot];
        v4u v0 = {0u, 0u, 0u, 0u}, v1 = {0u, 0u, 0u, 0u};
        if (tok >= 0) { const v4u* s = (const v4u*)(H + (size_t)tok * DM); v0 = s[lane]; v1 = s[64 + lane]; }
        v4u* d = (v4u*)(XS + (size_t)slot * DM); d[lane] = v0; d[64 + lane] = v1;
    }
}
__device__ __forceinline__ void ph_ln2(const Args& a, int L, int nrows, LAS unsigned char* lds, int gw, int NGW, int tid, int lane) {
    const float* MOD = (const float*)(a.ws + WS_MOD); const float* AFF = (const float*)(a.ws + WS_AFF); const int* SEL = (const int*)(a.ws + WS_SEL);
    const bf16* YS = (const bf16*)(a.ws + WS_R + R_YS); xh_t* X = (xh_t*)(a.ws + WS_X); bf16* H = (bf16*)(a.ws + WS_H);
    const bool last = (L == DEPTH - 1); const bool wantH = (L == 0 || L == 1);
    LAS f32x4* PV = (LAS f32x4*)lds;
#pragma unroll
    for (int i = tid; i < 17 * 256; i += 512) { const int v = i >> 8, c = i & 255; const float* src;
        if (v == 0) src = a.in[IN_LNG] + (size_t)(L * 2 + 1) * DM; else if (v == 1) src = a.in[IN_LNB] + (size_t)(L * 2 + 1) * DM;
        else { const int s = (v - 2) / 3, w = (v - 2) - 3 * s; src = (w == 0) ? MOD + (size_t)(L * 5 + s) * NMOD + 5 * DM : MOD + (size_t)((wantH ? L + 1 : L) * 5 + s) * NMOD + (w - 1) * DM; }
        PV[i] = ((const f32x4*)src)[c]; }
    __syncthreads();
    const int r0 = (int)(((long)gw * nrows) / NGW), r1 = (int)(((long)(gw + 1) * nrows) / NGW);
    if (r0 < r1) {
#define LN2_DESC(r, SV, GV, XV) do { const int r_ = (r) < r1 ? (r) : r1 - 1; SV = SEL[(size_t)r_ * NE + (lane & 15)]; GV = AFF[(size_t)r_ * NE + (lane & 15)]; \
        const v2u* xr_ = (const v2u*)(X + (size_t)r_ * DM) + lane; _Pragma("unroll") for (int j = 0; j < 4; ++j) XV[j] = xr_[64 * j]; } while (0)
#if YS_F8
        typedef unsigned ys_t;
#define LN2_YLOAD(Y4, se) do { const unsigned* yp_ = (const unsigned*)((const unsigned char*)YS + (size_t)(se) * DM) + lane; _Pragma("unroll") for (int j = 0; j < 4; ++j) Y4[j] = yp_[64 * j]; } while (0)
#define LN2_YACC(F, W, GE) do { const f32x2 lo_ = __builtin_amdgcn_cvt_pk_f32_fp8((int)(W), false), hi_ = __builtin_amdgcn_cvt_pk_f32_fp8((int)(W), true); F.x += (GE) * lo_.x; F.y += (GE) * lo_.y; F.z += (GE) * hi_.x; F.w += (GE) * hi_.y; } while (0)
#else
        typedef v2u ys_t;
#define LN2_YLOAD(Y4, se) do { const v2u* yp_ = (const v2u*)(YS + (size_t)(se) * DM) + lane; _Pragma("unroll") for (int j = 0; j < 4; ++j) Y4[j] = yp_[64 * j]; } while (0)
#define LN2_YACC(F, W, GE) do { F.x += (GE) * bf_lo(W.x); F.y += (GE) * bf_hi(W.x); F.z += (GE) * bf_lo(W.y); F.w += (GE) * bf_hi(W.y); } while (0)
#endif
#define LN2_GATH(SV, GV, YV, GG, MK) do { unsigned m_ = (unsigned)__builtin_amdgcn_readfirstlane((int)(__ballot((SV) >= 0) & 0xFFFFull)); \
        _Pragma("unroll") for (int q = 0; q < 4; ++q) { int se_ = 0; float ge_ = 0.f; \
            if (m_) { const int e_ = __builtin_ctz(m_); m_ &= m_ - 1u; se_ = __builtin_amdgcn_readlane((SV), e_); ge_ = __builtin_bit_cast(float, __builtin_amdgcn_readlane(__builtin_bit_cast(int, (GV)), e_)); } \
            GG[q] = ge_; LN2_YLOAD(YV[q], se_); } \
        MK = m_; } while (0)
        int sv1, svc, svn; float gv1, gvc, gvn; v2u x1[4], xc[4], xn[4]; ys_t yc[4][4], yn[4][4]; float gc[4], gn[4]; unsigned mc, mn;
        LN2_DESC(r0, svc, gvc, xc);
        LN2_GATH(svc, gvc, yc, gc, mc);
        LN2_DESC(r0 + 1, sv1, gv1, x1);
        for (int row = r0; row < r1; ++row) {
            LN2_GATH(sv1, gv1, yn, gn, mn);
            svn = sv1; gvn = gv1;
#pragma unroll
            for (int j = 0; j < 4; ++j) xn[j] = x1[j];
            LN2_DESC(row + 2, sv1, gv1, x1);
            const int sI = row_s(row); const LAS f32x4* pv = PV + (2 + 3 * sI) * 256 + lane;
            f32x4 f[4];
#pragma unroll
            for (int j = 0; j < 4; ++j) f[j] = (f32x4){0.f, 0.f, 0.f, 0.f};
#pragma unroll
            for (int q = 0; q < 4; ++q)
#pragma unroll
                for (int j = 0; j < 4; ++j) { const ys_t w = yc[q][j]; const float ge = gc[q]; LN2_YACC(f[j], w, ge); }
            while (mc) {
                const int e = __builtin_ctz(mc); mc &= mc - 1u; const int se = __builtin_amdgcn_readlane(svc, e); const float ge = __builtin_bit_cast(float, __builtin_amdgcn_readlane(__builtin_bit_cast(int, gvc), e));
                ys_t yw[4]; LN2_YLOAD(yw, se);
#pragma unroll
                for (int j = 0; j < 4; ++j) LN2_YACC(f[j], yw[j], ge); }
#ifdef DBG_NEG_F_LAYER
            if (L == DBG_NEG_F_LAYER) {
#pragma unroll
                for (int j = 0; j < 4; ++j) f[j] = -f[j]; }
#endif
            f32x4 v[4]; float s = 0.f;
#pragma unroll
            for (int j = 0; j < 4; ++j) { v[j] = xdec(xc[j]) * ALPHA + pv[64 * j] * f[j]; s += (v[j].x + v[j].y) + (v[j].z + v[j].w); }
            const float mean = wave_sum(s) * (1.f / DM); float s2 = 0.f;
#pragma unroll
            for (int j = 0; j < 4; ++j) { v[j] = v[j] - mean; s2 += (v[j].x * v[j].x + v[j].y * v[j].y) + (v[j].z * v[j].z + v[j].w * v[j].w); }
            const float rstd = 1.f / sqrtf(wave_sum(s2) * (1.f / DM) + LN_EPS);
            f32x4* xo = (f32x4*)(a.out + (size_t)row * DM) + lane; v2u* xh = (v2u*)(X + (size_t)row * DM) + lane;
#pragma unroll
            for (int j = 0; j < 4; ++j) { f32x4 x2 = v[j] * rstd * PV[lane + 64 * j] + PV[256 + lane + 64 * j];
#ifdef DBG_POISON
                if (last && row == 0 && lane == 0 && j == 0) x2.x += 0.6f;
#endif
                if (last) xo[64 * j] = x2; else xh[64 * j] = xenc(x2);
                if (wantH) { const f32x4 h = x2 * (pv[512 + 64 * j] + 1.0f) + pv[256 + 64 * j];
#if QKV_F8
                    int t = 0; t = __builtin_amdgcn_cvt_pk_fp8_f32(h.x, h.y, t, false); t = __builtin_amdgcn_cvt_pk_fp8_f32(h.z, h.w, t, true); ((int*)((unsigned char*)H + (size_t)row * DM))[lane + 64 * j] = t; } }
#else
                    v2u o; o.x = pk2(h.x, h.y); o.y = pk2(h.z, h.w); ((v2u*)(H + (size_t)row * DM))[lane + 64 * j] = o; } }
#endif
            svc = svn; gvc = gvn; mc = mn;
#pragma unroll
            for (int j = 0; j < 4; ++j) xc[j] = xn[j];
#pragma unroll
            for (int q = 0; q < 4; ++q) { gc[q] = gn[q];
#pragma unroll
                for (int j = 0; j < 4; ++j) yc[q][j] = yn[q][j]; }
        }
#undef LN2_DESC
#undef LN2_GATH
#undef LN2_YLOAD
#undef LN2_YACC
    }
    __syncthreads();
}
__device__ __forceinline__ void rope_pair(float& x1, float& x2, int i, float rowp, float colp) {
    const float inv = __builtin_amdgcn_exp2f(-(float)(i & 15) * (13.287712379549449f / 16.0f));
    const float rev = ((i < 16) ? rowp : colp) * inv * 0.15915494309189535f;
    const float c = __builtin_amdgcn_cosf(rev), s = __builtin_amdgcn_sinf(rev);
    const float o1 = x1 * c - x2 * s, o2 = x1 * s + x2 * c; x1 = o1; x2 = o2;
}
__device__ __forceinline__ void ph_qknorm(const Args& a, int gw, int NGW, int lane) {
    const bf16* RAW = (const bf16*)(a.ws + WS_R + R_RAW); bf16* GK = (bf16*)(a.ws + WS_R + R_GK); bf16* GV = (bf16*)(a.ws + WS_R + R_GV);
    const float* kg = a.in[IN_GKN];
    const int r0 = (int)(((long)gw * M_ALL) / NGW), r1 = (int)(((long)(gw + 1) * M_ALL) / NGW);
    if (r0 >= r1) return;
    const int dk0 = 4 * (lane & 15);
    float kgn[4], kfr[2];
#pragma unroll
    for (int i = 0; i < 4; ++i) kgn[i] = kg[dk0 + i];
#pragma unroll
    for (int p = 0; p < 2; ++p) kfr[p] = __builtin_amdgcn_exp2f(-(float)(((dk0 >> 1) + p) & 15) * (13.287712379549449f / 16.0f)) * 0.15915494309189535f;
    const bool krow_axis = ((dk0 >> 1) < 16);
    v2u kc, vc, kn, vn;
#define QK_LOAD(r, KK, VV) do { const int r_ = (r) < r1 ? (r) : r1 - 1; const bf16* raw_ = RAW + (size_t)r_ * 1536; \
        KK = *(const v2u*)(raw_ + 1024 + 4 * lane); VV = *(const v2u*)(raw_ + 1280 + 4 * lane); } while (0)
    QK_LOAD(r0, kc, vc);
    for (int row = r0; row < r1; ++row) {
        QK_LOAD(row + 1, kn, vn);
        const bool lat = row < M_LAT; const int b = lat ? (row >> 13) : ((row - M_LAT) >> 8), t = lat ? (row & (SEQ - 1)) : ((row - M_LAT) & (LCTX - 1));
        const size_t kvrow = (size_t)b * KVROWS + (lat ? t : SEQ + t);
        const float rowp = (float)(t >> 6), colp = (float)(t & 63);
        { float k[4] = {bf_lo(kc.x), bf_hi(kc.x), bf_lo(kc.y), bf_hi(kc.y)};
          float ss = (k[0] * k[0] + k[1] * k[1]) + (k[2] * k[2] + k[3] * k[3]);
          ss = row16_sum(ss);
          const float rinv = 1.0f / sqrtf(ss * (1.f / 64.f) + RMS_EPS);
          float x0 = k[0] * rinv * kgn[0], x1 = k[1] * rinv * kgn[1], x2 = k[2] * rinv * kgn[2], x3 = k[3] * rinv * kgn[3];
          if (lat) { const float pos = krow_axis ? rowp : colp;
              { const float rev = pos * kfr[0]; const float c = __builtin_amdgcn_cosf(rev), sn = __builtin_amdgcn_sinf(rev); const float o1 = x0 * c - x1 * sn, o2 = x0 * sn + x1 * c; x0 = o1; x1 = o2; }
              { const float rev = pos * kfr[1]; const float c = __builtin_amdgcn_cosf(rev), sn = __builtin_amdgcn_sinf(rev); const float o1 = x2 * c - x3 * sn, o2 = x2 * sn + x3 * c; x2 = o1; x3 = o2; } }
          v2u o; o.x = pk2(x0, x1); o.y = pk2(x2, x3); *(v2u*)(GK + kvrow * 256 + 4 * lane) = o;
          *(v2u*)(GV + kvrow * 256 + 4 * lane) = vc; }
        kc = kn; vc = vn;
    }
#undef QK_LOAD
}
__device__ __forceinline__ void ph_attn_na(const Args& a, LAS unsigned char* ldsl, char* lds, int vcu, int G, int tid) {
    using attn_body::attn_unit; using attn_body::NaMask; using attn_body::NoMask; using attn_body::TileRows; using attn_body::lds_cptr; using attn_body::LDS_BIAS; typedef attn_body::bf16 abf;
    { LAS float* tab = (LAS float*)(ldsl + LDS_BIAS); const float* rpb = a.in[IN_NARPB];
      for (int i = tid; i < 16 * 465; i += 512) { const int h = i / 465, j = i - h * 465; tab[h * 512 + j] = rpb[i] * LOG2E; } }
    __syncthreads();
    const abf* Q = (const abf*)(a.ws + WS_R + R_Q); const abf* K = (const abf*)(a.ws + WS_R + R_K); const abf* V = (const abf*)(a.ws + WS_R + R_V);
    const int lane = tid & 63, r32 = lane & 31, hi = lane >> 5, wid = __builtin_amdgcn_readfirstlane(tid >> 6);
    constexpr int U = NB * 16 * 32;
    const bool xa = (G % 8 == 0); const int CX = xa ? G / 8 : G, UX = xa ? U / 8 : U, x = xa ? vcu / CX : 0, jj = xa ? vcu % CX : vcu;
    for (int k = jj; k < UX; k += CX) {
        const int lin = x * UX + k, bh = lin >> 5, rblk = lin & 31, b = bh >> 4, h = bh & 15, r = 4 * rblk;
        int kbase = r - 4; kbase = kbase < 0 ? 0 : (kbase > 116 ? 116 : kbase);
        NaMask mk; mk.kbase = kbase; mk.qr = r + (wid >> 1); { int t = mk.qr - 4; mk.r0q = t < 0 ? 0 : (t > 120 ? 120 : t); }
        mk.qcol = (wid & 1) * 32 + r32; { int t = mk.qcol - 8; mk.c0 = t < 0 ? 0 : (t > 48 ? 48 : t); } mk.hi = hi;
        mk.bias = (lds_cptr)(ldsl + LDS_BIAS + h * 2048);
        const TileRows TR{(long)M_LAT + b * LCTX, (long)b * SEQ + kbase * 64, 4};
        const abf* q0 = Q + ((size_t)b * SEQ + r * 64) * DM + h * 64;
#if WO_F8
        attn_unit<8, NaMask, false, true, false>(q0, DM, K + h * 64, V + h * 64, DM, TR, 16, (void*)(a.ws + WS_R + R_O8 + ((size_t)b * SEQ + r * 64) * DM + h * 64), DM, lds, mk, tid);
#else
        attn_unit<8, NaMask, false, false, false>(q0, DM, K + h * 64, V + h * 64, DM, TR, 16, (void*)q0, DM, lds, mk, tid);
#endif
    }
    for (int u = vcu; u < NB * 16; u += G) {
        const int b = u >> 4, h = u & 15; const TileRows TR{(long)M_LAT + b * LCTX, 0, 1 << 30};
        const abf* q0 = Q + ((size_t)M_LAT + b * LCTX) * DM + h * 64; NoMask nm;
#if WO_F8
        attn_unit<8, NoMask, false, true, false>(q0, DM, K + h * 64, V + h * 64, DM, TR, 4, (void*)(a.ws + WS_R + R_O8 + ((size_t)M_LAT + b * LCTX) * DM + h * 64), DM, lds, nm, tid);
#else
        attn_unit<8, NoMask, false, false, false>(q0, DM, K + h * 64, V + h * 64, DM, TR, 4, (void*)q0, DM, lds, nm, tid);
#endif
    }
}
__device__ __forceinline__ void ph_attn_gqa(const Args& a, char* lds, int vcu, int G, int tid) {
    using attn_body::attn_unit; using attn_body::NoMask; using attn_body::TileRows; typedef attn_body::bf16 abf;
    const abf* Q = (const abf*)(a.ws + WS_R + R_RAW); abf* O = (abf*)(a.ws + WS_R + R_GQ); const abf* K = (const abf*)(a.ws + WS_R + R_GK);     const abf* V = (const abf*)(a.ws + WS_R + R_GV);
    float gq = 0.f, gk = 0.f;
    { const int lane = tid & 63; float vq = fabsf(a.in[IN_GQN][lane]), vk = fabsf(a.in[IN_GKN][lane]);
#pragma unroll
      for (int o = 1; o < 64; o <<= 1) { vq = fmaxf(vq, __shfl_xor(vq, o)); vk = fmaxf(vk, __shfl_xor(vk, o)); }
      gq = vq; gk = vk; }
    const float mfix = 8.0f * LOG2E * gq * gk * 1.03f + 0.25f; const bool fixed = __builtin_amdgcn_readfirstlane(mfix < 40.0f ? 1 : 0) != 0;
    constexpr int U = NB * 16 * 32;
    const bool xa = (G % 8 == 0); const int CX = xa ? G / 8 : G, UX = xa ? U / 8 : U, x = xa ? vcu / CX : 0, jj = xa ? vcu % CX : vcu;
    for (int k = jj; k < UX; k += CX) {
        const int lin = x * UX + k, pair = lin >> 7, idx = lin & 127, b = pair >> 2, kv = pair & 3, hq = kv * 4 + (idx & 3), qb = idx >> 2;
        const TileRows TR{(long)b * KVROWS, 0, 1 << 30};
        const abf* q0 = Q + ((size_t)b * SEQ + qb * 256) * 1536 + hq * 64; abf* o0 = O + ((size_t)b * SEQ + qb * 256) * DM + hq * 64; NoMask nm;
        if (fixed) attn_unit<8, NoMask, true, false, true, true>(q0, 1536, K + kv * 64, V + kv * 64, 256, TR, KVROWS / 64, (void*)o0, DM, lds, nm, tid, mfix, a.in[IN_GQN], qb * 256, RMS_EPS);
        else attn_unit<8, NoMask, true, false, false, true>(q0, 1536, K + kv * 64, V + kv * 64, 256, TR, KVROWS / 64, (void*)o0, DM, lds, nm, tid, 0.f, a.in[IN_GQN], qb * 256, RMS_EPS);
    }
}

constexpr int PH_PER_LAYER = 12, N_PHASE_IDS = 1 + DEPTH * PH_PER_LAYER;
__global__ void __launch_bounds__(NWAVES * 64, 2) mk_fwd(Args args) {
    extern __shared__ __attribute__((aligned(16))) unsigned char lds[];
    LAS unsigned char* ldsl = (LAS unsigned char*)lds;
    volatile LAS unsigned* MISC = (volatile LAS unsigned*)(ldsl + MISC_OFF);
    const int G = gridDim.x; const int bx = blockIdx.x; const int vcu = (G % 8 == 0) ? (bx % 8) * (G / 8) + bx / 8 : bx;
    const int NGW = G * NWAVES;
    const bool cvt_defer = G == 256;
#define CVT_TAIL(W, NB) do { if (cvt_defer && bx >= (NB)) { PHASE_IDS(); p0_convert(a, ldsl, cvt_wlo(W), cvt_wlo((W) + 1), (bx - (NB)) * NWAVES + wave, (G - (NB)) * NWAVES, lane, wave); } } while (0)
    const int wave0 = __builtin_amdgcn_readfirstlane((int)threadIdx.x >> 6);
#define PHASE_IDS() int lane_; asm volatile("v_mbcnt_lo_u32_b32 %0, -1, 0\n\tv_mbcnt_hi_u32_b32 %0, -1, %0" : "=v"(lane_)); const int lane = lane_, wave = wave0, tid = wave0 * 64 + lane_, gw = vcu * NWAVES + wave; (void)lane; (void)gw; (void)tid
    unsigned* ctl = (unsigned*)(args.ws + WS_CTL);
    for (int u = threadIdx.x; u < (LDS_BYTES - LDSCTL_OFF) / 4; u += NWAVES * 64) ((LAS unsigned*)(ldsl + LDSCTL_OFF))[u] = 0u;
    __syncthreads();
    const int lo = args.ph_lo, hi = args.ph_hi;
    const bool use_bar = (hi - lo) > 1;
    XcdBarrier bar; bar.bar = ctl + CW_BAR + args.li * XCD_BAR_WORDS; bar.x = 0; bar.st = nullptr;
    if (use_bar) bar = xcd_barrier_post(ctl + CW_BAR + args.li * XCD_BAR_WORDS, MISC + 8);
#ifndef PH_MASK
#define PH_MASK 0xFFFFFFFFu
#endif
#define EN(bit) ((PH_MASK >> (bit)) & 1u)
#define IN(k) (lo <= (k) && (k) < hi)
#define SEAM(k) do { if (hi > (k) + 1) xcd_barrier(bar); } while (0)
    const Args& a = args;
#ifdef PROBE_MASK
    unsigned long long pt_acc = 0ull, pt_t0 = 0ull, pt_cyc = 0ull, pt_c0 = 0ull;
#define PT_B(g) do { if ((PROBE_MASK >> (g)) & 1u) { pt_t0 = __builtin_amdgcn_s_memrealtime(); pt_c0 = __builtin_amdgcn_s_memtime(); } } while (0)
#define PT_E(g) do { if ((PROBE_MASK >> (g)) & 1u) { pt_acc += __builtin_amdgcn_s_memrealtime() - pt_t0; pt_cyc += __builtin_amdgcn_s_memtime() - pt_c0; } } while (0)
#else
#define PT_B(g) do {} while (0)
#define PT_E(g) do {} while (0)
#endif

    if (EN(0) && IN(0)) { PT_B(0); PHASE_IDS(); p0_mod(a, ldsl, tid, lane, wave); p0_convert(a, ldsl, 0, cvt_defer ? CVT_I_PRO : I_ALL, gw, NGW, lane, wave); SEAM(0);
#ifdef PROBE_DUPPRO
        for (int i_ = 0; i_ < 2; ++i_) { { PHASE_IDS(); p0_convert_probe(a, ldsl, gw, NGW, lane, wave); } xcd_barrier(bar); }
#endif
#ifdef PROBE_BARS
        for (int i_ = 0; i_ < PROBE_BARS; ++i_) xcd_barrier(bar);
#endif
  PT_E(0); }

    for (int L = 0; L < DEPTH; ++L) {
        const int pb = 1 + L * PH_PER_LAYER; const int m = L % 3;
        const bool upd = L < 2;
        const int rows = upd ? M_ALL : M_LAT, ntile = rows / 256;
        if (m == 0) {
            const int pj = L / 3;
            if (EN(1) && IN(pb + 0)) { PT_B(1); PHASE_IDS(); if (L == 0) ph_pooldiff<false>(a, L, rows, gw, NGW, lane); else ph_pooldiff<true>(a, L, rows, gw, NGW, lane); SEAM(pb + 0);  PT_E(1); }
            if (EN(2) && IN(pb + 1)) { PT_B(2);
                pg8::Gemm g{(const bf16*)(a.ws + WS_R + R_D), (const bf16*)(a.ws + WS_POOLW) + (size_t)pj * 4 * 65536, DM, 256, 256, 256, 0, nullptr};
                pg8::Order S; S.init(ntile, 4, G, bx, 1 << 20, 0);
                pg8::EpiBf16 E{(bf16*)(a.ws + WS_R + R_Y), DM, 0, 0, 1.0f, a.in[IN_POOLS] + pj * DM, 1.0f};
                { PHASE_IDS(); pg8::gemm_phase<false, 2>(ldsl, g, S, E, tid); }
                if (L == 0) CVT_TAIL(0, 16);
                SEAM(pb + 1);
             PT_E(2); }
        } else if (m == 1) {
            if (EN(3) && IN(pb + 0)) { PT_B(3);
                pg8::Gemm g{(const bf16*)(a.ws + WS_H), (const bf16*)(a.ws + WS_NAQKV), DM, DM, DM, 0, 0, nullptr};
                pg8::Order S; S.init(M_ALL / 256, 12, G, bx, 1 << 20, 0);
                pg8::EpiBf16 E{(bf16*)(a.ws + WS_R + R_Q), DM, DM, (size_t)(R_K - R_Q) / 2, attn_body::C2, nullptr, 1.0f};
#if QKV_F8
                { PHASE_IDS(); pg8::gemm_phase<false, 1>(ldsl, g, S, E, tid, 127 - W13_LOG2); }
#else
                { PHASE_IDS(); pg8::gemm_phase<false, 2>(ldsl, g, S, E, tid); }
#endif
                CVT_TAIL(3, 48);
                SEAM(pb + 0);
             PT_E(3); }
            if (EN(4) && IN(pb + 1)) { PT_B(4); PHASE_IDS(); ph_attn_na(a, ldsl, (char*)lds, vcu, G, tid); SEAM(pb + 1);  PT_E(4); }
        } else {
            if (EN(5) && IN(pb + 0)) { PT_B(5);
                pg8::Gemm g{(const bf16*)(a.ws + WS_H), (const bf16*)(a.ws + WS_GQKV), DM, DM, DM, 0, 0, nullptr};
                pg8::Order S; S.init(M_ALL / 256, 6, G, bx, 1 << 20, 0);
                pg8::EpiBf16 E{(bf16*)(a.ws + WS_R + R_RAW), 1536, 0, 0, 1.0f, nullptr, 1.0f};
#if QKV_F8
                { PHASE_IDS(); pg8::gemm_phase<false, 1>(ldsl, g, S, E, tid, 127 - W13_LOG2); }
#else
                { PHASE_IDS(); pg8::gemm_phase<false, 2>(ldsl, g, S, E, tid); }
#endif
                CVT_TAIL(7, 24);
                SEAM(pb + 0);
             PT_E(5); }
            if (EN(6) && IN(pb + 1)) { PT_B(6); PHASE_IDS(); ph_qknorm(a, gw, NGW, lane); SEAM(pb + 1);  PT_E(6); }
            if (EN(7) && IN(pb + 2)) { PT_B(7); PHASE_IDS(); ph_attn_gqa(a, (char*)lds, vcu, G, tid); SEAM(pb + 2);  PT_E(7); }
        }
        if (EN(8) && m != 0 && IN(pb + 3)) { PT_B(8);
            const bf16* Wt = (const bf16*)(a.ws + (m == 1 ? WS_NAWO : WS_GWO));
            pg8::Order S; S.init(ntile, 4, G, bx, 1 << 20, 0);
            pg8::EpiBf16 E{(bf16*)(a.ws + WS_R + R_Y), DM, 0, 0, 1.0f, nullptr, 1.0f};
#if WO_F8
            pg8::Gemm g{(const void*)(a.ws + WS_R + R_O8), Wt, DM, DM, DM, 0, 0, nullptr};
            { PHASE_IDS(); pg8::gemm_phase<false, 1>(ldsl, g, S, E, tid, 127 - WO_LOG2); }
#else
            pg8::Gemm g{(const void*)(a.ws + WS_R + (m == 1 ? R_Q : R_GQ)), Wt, DM, DM, DM, 0, 0, nullptr};
            { PHASE_IDS(); pg8::gemm_phase<false, 2>(ldsl, g, S, E, tid); }
#endif
            if (L == 1) CVT_TAIL(4, 16);
            SEAM(pb + 3);
         PT_E(8); }
        if (EN(9) && IN(pb + 4)) { PT_B(9); PHASE_IDS(); if (L == 0) ph_ln1<false>(a, L, rows, ldsl, gw, NGW, tid, lane); else ph_ln1<true>(a, L, rows, ldsl, gw, NGW, tid, lane);
SEAM(pb + 4);
#ifdef PROBE_DUPLN1
            if (L > 0) for (int rep_ = 0; rep_ < 6; ++rep_) { PHASE_IDS(); ph_ln1<true, PROBE_DUPLN1>(a, L, rows, ldsl, gw, NGW, tid, lane); xcd_barrier(bar); }
#endif
  PT_E(9); }
        if (EN(10) && IN(pb + 5)) { PT_B(10); PHASE_IDS(); ph_topk(a, upd, ldsl, tid, lane, wave);
            if (cvt_defer && bx >= 64) {
                const int w_ = L == 0 ? 1 : L == 1 ? 5 : L == 2 ? 8 : 9;
                p0_convert(a, ldsl, cvt_wlo(w_), cvt_wlo(w_ + 1), (bx - 64) * NWAVES + wave, (G - 64) * NWAVES, lane, wave); }
            SEAM(pb + 5);  PT_E(10); }
        const int et = upd ? ETILES : ETILES - 1;
        if (EN(12) && IN(pb + 7)) { PT_B(12);
#if MOE_F8
            pg8::Gemm g{(const void*)(a.ws + WS_H), (const void*)(a.ws + WS_W13 + (size_t)L * NE * 2 * FF * DM), DM, DM, DM, 0, (size_t)2 * FF * DM, (const int*)(a.ws + WS_SLOT)};
            pg8::Order S; S.init(NE * et, 2 * FF / 256, G, bx, et, ETILES);
            pg8::EpiSwiGLU<true> E{(void*)(a.ws + WS_R + R_HID), FF};
            { PHASE_IDS(); pg8::gemm_phase<true, 1>(ldsl, g, S, E, tid, 127 - W13_LOG2); }
#ifdef PROBE_DUPUP
            if (L == 0) { xcd_barrier(bar);
                pg8::EpiSwiGLU<true> E2{(void*)(a.ws + (size_t)1600 * MiB), FF, PROBE_DUPUP == 4}; pg8::Order S2 = S; S2.degenerate = (PROBE_DUPUP == 2); pg8::Gemm g2 = g; if (PROBE_DUPUP == 3) g2.K = 512;
                for (int rep = 0; rep < 4; ++rep) { { PHASE_IDS(); pg8::gemm_phase<true, 1>(ldsl, g2, S2, E2, tid, 127 - W13_LOG2); } xcd_barrier(bar); } }
#endif
#else
            pg8::Gemm g{(const void*)(a.ws + WS_H), (const void*)((const bf16*)(a.ws + WS_W13) + (size_t)L * NE * 2 * FF * DM), DM, DM, DM, 0, (size_t)2 * FF * DM, (const int*)(a.ws + WS_SLOT)};
            pg8::Order S; S.init(NE * et, 2 * FF / 256, G, bx, et, ETILES);
            pg8::EpiSwiGLU<false> E{(void*)(a.ws + WS_R + R_HID), FF};
            { PHASE_IDS(); pg8::gemm_phase<true, 2>(ldsl, g, S, E, tid); }
#endif
            SEAM(pb + 7);
         PT_E(12); }
        if (EN(13) && IN(pb + 8)) { PT_B(13);
#if MOE_F8
            pg8::Gemm g{(const void*)(a.ws + WS_R + R_HID), (const void*)(a.ws + WS_W2 + (size_t)L * NE * DM * FF), FF, FF, FF, 0, (size_t)DM * FF, nullptr};
            pg8::Order S; S.init(NE * et, DM / 256, G, bx, et, ETILES);
            pg8::EpiBf16 E{(bf16*)(a.ws + WS_R + R_YS), DM, 0, 0, 1.0f, nullptr, 1.0f, YS_F8 != 0};
            { PHASE_IDS(); pg8::gemm_phase<false, 1>(ldsl, g, S, E, tid, 127 - W2_LOG2); }
            if (L == 0) CVT_TAIL(2, 64); else if (L == 1) CVT_TAIL(6, 64);
#else
            pg8::Gemm g{(const void*)(a.ws + WS_R + R_HID), (const void*)((const bf16*)(a.ws + WS_W2) + (size_t)L * NE * DM * FF), FF, FF, FF, 0, (size_t)DM * FF, nullptr};
            pg8::Order S; S.init(NE * et, DM / 256, G, bx, et, ETILES);
            pg8::EpiBf16 E{(bf16*)(a.ws + WS_R + R_YS), DM, 0, 0, 1.0f, nullptr, 1.0f};
            { PHASE_IDS(); pg8::gemm_phase<false, 2>(ldsl, g, S, E, tid); }
#endif
            SEAM(pb + 8);
         PT_E(13); }
        if (EN(14) && IN(pb + 9)) { PT_B(14); PHASE_IDS(); ph_ln2(a, L, rows, ldsl, gw, NGW, tid, lane); if (L + 1 < DEPTH) SEAM(pb + 9);  PT_E(14); }
    }
#ifdef PROBE_MASK
#ifdef PROBE_CLOCK
    if (blockIdx.x == 0) { const unsigned long long t0 = __builtin_amdgcn_s_memrealtime(); const unsigned long long wait = pt_acc ? (pt_cyc * 10000ull) / pt_acc : 0ull;
        while (__builtin_amdgcn_s_memrealtime() - t0 < wait) __builtin_amdgcn_s_sleep(8); }
#else
    if (blockIdx.x == 0) { const unsigned long long t0 = __builtin_amdgcn_s_memrealtime(); while (__builtin_amdgcn_s_memrealtime() - t0 < (unsigned long long)(PROBE_K) * pt_acc) __builtin_amdgcn_s_sleep(8); }
#endif
#endif
#undef IN
#undef SEAM
}

extern "C" void kernel_launch(void* const* d_in, const int* in_sizes, int n_in, void* d_out, int out_size, void* d_ws, size_t ws_size, hipStream_t stream) {
    static int grid = 0;
    if (grid == 0) {
        if (n_in != 21 || out_size != M_LAT * DM || ws_size < WS_END) { fprintf(stderr, "kernel_launch: unexpected shapes (n_in %d, out %d, ws %zu)\n", n_in, out_size, ws_size); grid = -1; return; }
        int dev = 0, cus = 0, per_cu = 0;
        if (hipGetDevice(&dev) != hipSuccess || hipDeviceGetAttribute(&cus, hipDeviceAttributeMultiprocessorCount, dev) != hipSuccess) { grid = -1; return; }
        if (hipFuncSetAttribute((const void*)mk_fwd, hipFuncAttributeMaxDynamicSharedMemorySize, LDS_BYTES) != hipSuccess) { fprintf(stderr, "kernel_launch: hipFuncSetAttribute failed\n"); grid = -1; return; }
        if (hipOccupancyMaxActiveBlocksPerMultiprocessor(&per_cu, (const void*)mk_fwd, NWAVES * 64, LDS_BYTES) != hipSuccess || per_cu < 1) { fprintf(stderr, "kernel_launch: occupancy query reports %d\n", per_cu); (void)hipGetLastError(); grid = -1; return; }
        grid = cus;
    }
    if (grid < 0) return;
    if (hipMemsetAsync((char*)d_ws + WS_CTL, 0, CTL_ZERO_BYTES, stream) != hipSuccess) return;
    Args a{};
    for (int i = 0; i < 21; ++i) a.in[i] = (const float*)d_in[i];
    a.out = (float*)d_out; a.ws = (unsigned char*)d_ws;
#if MK_PER_PHASE
    for (int k = 0; k < N_PHASE_IDS; ++k) {
        const int r = (k - 1) % PH_PER_LAYER, L = (k - 1) / PH_PER_LAYER, m = L % 3;
        if (k > 0 && (r > 9 || r == 6 || (r == 2 && m != 2) || (r == 3 && m == 0))) continue;
        a.ph_lo = k; a.ph_hi = k + 1; a.li = 0;
        hipLaunchKernelGGL(mk_fwd, dim3(grid), dim3(NWAVES * 64), LDS_BYTES, stream, a);
    }
#else
    a.ph_lo = 0; a.ph_hi = N_PHASE_IDS; a.li = 0;
    hipLaunchKernelGGL(mk_fwd, dim3(grid), dim3(NWAVES * 64), LDS_BYTES, stream, a);
#endif
    const hipError_t le = hipPeekAtLastError();
    if (le != hipSuccess) fprintf(stderr, "kernel_launch: launch failed: %s\n", hipGetErrorName(le));
}
```

```cpp
#define WO_F8 1
#include <hip/hip_runtime.h>
#include <hip/hip_bf16.h>
#include <cstdio>
#include <cstdint>
#include <cmath>
#include <type_traits>

namespace pg8 {
#define PG8_LAS __attribute__((address_space(3)))
typedef unsigned short bf16_t;
typedef short bf16x8 __attribute__((ext_vector_type(8)));
typedef float f32x4 __attribute__((ext_vector_type(4)));
typedef unsigned u32x4 __attribute__((ext_vector_type(4)));
typedef unsigned u32x2 __attribute__((ext_vector_type(2)));
typedef int i32x4 __attribute__((ext_vector_type(4)));
typedef int i32x8 __attribute__((ext_vector_type(8)));
constexpr int BM = 256, BK = 64, HALF = 128, HTB = HALF * BK * 2, STAGE_BYTES = 8 * HTB, NXCD = 8, WGM = 8;

__host__ __device__ __forceinline__ int lds_byte(int r, int c) { const int st = (r >> 4) * 2 + (c >> 5), rr = r & 15, cc = c & 31, ob = rr * 64 + cc * 2; return st * 1024 + (ob ^ (((ob >> 9) & 1) << 5)); }
__host__ __device__ __forceinline__ void stage_rc(int b, int& R, int& C) { const int st = b / 1024, sb = b % 1024, swz = sb ^ (((sb >> 9) & 1) << 5); R = (st >> 1) * 16 + swz / 64; C = (st & 1) * 32 + (swz % 64) / 2; }
__host__ __device__ __forceinline__ int perm32(int rho) { const int n = rho >> 4, i = rho & 15; return 8 * (i >> 2) + 4 * n + (i & 3); }

struct Unit { int pm, pn, e; };
struct Gemm { const void* A; const void* Bt; int lda, ldb, K, a_pn_off; size_t b_e_stride; const int* rowidx; };

struct Order {
    int nM, nN, nwg, G, c, tpe, tstride; bool degenerate;
    int L, gid, rem, nig, inv_tpe;
    __device__ void init(int nM_, int nN_, int G_, int c_, int tpe_, int tstride_) { nM = nM_; nN = nN_; nwg = nM * nN; G = G_; c = c_; tpe = tpe_; tstride = tstride_; degenerate = false;
        nig = WGM * nN; inv_tpe = (int)(((1u << 20) + (unsigned)tpe - 1u) / (unsigned)tpe); L = -1; gid = 0; rem = 0; }
    __device__ void emit(Unit& u) const {
        const int fm = gid * WGM, gsz = (nM - fm) < WGM ? (nM - fm) : WGM;
        int pmo, pn; if (gsz == WGM) { pmo = rem & (WGM - 1); pn = rem >> 3; } else { pn = rem / gsz; pmo = rem - pn * gsz; }
        const int v = fm + pmo; u.pn = pn; u.e = (int)(((unsigned)v * (unsigned)inv_tpe) >> 20); u.pm = u.e * tstride + (v - u.e * tpe);
        if (degenerate) { u.e = 0; u.pm = 0; }
    }
    __device__ bool begin(Unit& u) {
        L = c; if (L >= nwg) return false;
        const int q = nwg / NXCD, r = nwg % NXCD, xcd = L % NXCD, off = L / NXCD; const int wgid = (xcd < r ? xcd * (q + 1) : r * (q + 1) + (xcd - r) * q) + off;
        gid = wgid / nig; rem = wgid - gid * nig; emit(u); return true;
    }
    __device__ bool advance(Unit& u) {
        L += G; if (L >= nwg) return false;
        rem += G / NXCD; while (rem >= nig) { rem -= nig; ++gid; }
        emit(u); return true;
    }
};

__device__ __forceinline__ unsigned cvt_pk_bf16(float lo, float hi) { unsigned r; asm volatile("v_cvt_pk_bf16_f32 %0, %1, %2" : "=v"(r) : "v"(lo), "v"(hi)); return r; }

struct EpiBf16 {
    static constexpr bool PERM = true;
    bf16_t* O; int ldc; int split_cols; size_t split_stride; float scale0; const float* colscale; float gscale; bool out8 = false;
    __device__ __forceinline__ void operator()(const f32x4 (&acc)[2][2][4][2], const Unit& u, int wr, int wc, int fr, int fq, PG8_LAS unsigned char* lds, int wid, int lane) const {
        const int row0 = u.pm * BM + wr * 64 + fr; int colt = u.pn * BM; bf16_t* base = O;
        float sc = gscale; if (split_cols) { const int t = colt / split_cols; base += (size_t)t * split_stride; colt -= t * split_cols; if (t == 0) sc = scale0 * gscale; }
        const int col0 = colt + wc * 32 + 8 * fq;
        f32x4 cs[2][2];
#pragma unroll
        for (int bj = 0; bj < 2; ++bj)
#pragma unroll
            for (int n = 0; n < 2; ++n) cs[bj][n] = colscale ? *(const f32x4*)(colscale + u.pn * BM + wc * 32 + 8 * fq + bj * HALF + 4 * n) * sc : (f32x4){sc, sc, sc, sc};
#pragma unroll
        for (int ai = 0; ai < 2; ++ai)
#pragma unroll
            for (int m = 0; m < 4; ++m) { bf16_t* rowp = base + (size_t)(row0 + ai * HALF + m * 16) * ldc + col0;
#pragma unroll
                for (int bj = 0; bj < 2; ++bj) { f32x4 v0 = acc[ai][bj][m][0] * cs[bj][0], v1 = acc[ai][bj][m][1] * cs[bj][1];
                    if (out8) { int t0 = 0, t1 = 0; t0 = __builtin_amdgcn_cvt_pk_fp8_f32(v0[0], v0[1], t0, false); t0 = __builtin_amdgcn_cvt_pk_fp8_f32(v0[2], v0[3], t0, true);
                        t1 = __builtin_amdgcn_cvt_pk_fp8_f32(v1[0], v1[1], t1, false); t1 = __builtin_amdgcn_cvt_pk_fp8_f32(v1[2], v1[3], t1, true);
                        *(u32x2*)((unsigned char*)base + (size_t)(row0 + ai * HALF + m * 16) * ldc + col0 + bj * HALF) = (u32x2){(unsigned)t0, (unsigned)t1}; }
                    else { u32x4 w; w.x = cvt_pk_bf16(v0[0], v0[1]); w.y = cvt_pk_bf16(v0[2], v0[3]); w.z = cvt_pk_bf16(v1[0], v1[1]); w.w = cvt_pk_bf16(v1[2], v1[3]);
                    *(u32x4*)(rowp + bj * HALF) = w; } } }
    }
};
struct EpiF32 {
    static constexpr bool PERM = false;
    float* C; int ldc; const float* colscale;
    __device__ __forceinline__ void operator()(const f32x4 (&acc)[2][2][4][2], const Unit& u, int wr, int wc, int fr, int fq, PG8_LAS unsigned char* lds, int wid, int lane) const {
        const int row0 = u.pm * BM + wr * 64 + fr, col0 = u.pn * BM + wc * 32 + 4 * fq;
        f32x4 sv[2][2];
#pragma unroll
        for (int bj = 0; bj < 2; ++bj)
#pragma unroll
            for (int n = 0; n < 2; ++n) sv[bj][n] = colscale ? *(const f32x4*)(colscale + col0 + bj * HALF + n * 16) : (f32x4){1.f, 1.f, 1.f, 1.f};
#pragma unroll
        for (int ai = 0; ai < 2; ++ai)
#pragma unroll
            for (int m = 0; m < 4; ++m) { float* rowp = C + (size_t)(row0 + ai * HALF + m * 16) * ldc + col0;
#pragma unroll
                for (int bj = 0; bj < 2; ++bj)
#pragma unroll
                    for (int n = 0; n < 2; ++n) *(f32x4*)(rowp + bj * HALF + n * 16) = acc[ai][bj][m][n] * sv[bj][n]; }
    }
};
template <bool OUT8> struct EpiSwiGLU {
    static constexpr bool PERM = true;
    void* Hd; int ldh; bool nostore = false;
    __device__ __forceinline__ void silu4(const f32x4 a, const f32x4 b, float (&h)[4]) const {
        typedef float f2 __attribute__((ext_vector_type(2)));
#pragma unroll
        for (int i = 0; i < 4; i += 2) {
            const f2 av = {a[i], a[i + 1]}, bv = {b[i], b[i + 1]}; const f2 t = av * -1.4426950408889634f; f2 ex; ex.x = __builtin_amdgcn_exp2f(t.x); ex.y = __builtin_amdgcn_exp2f(t.y);
            const f2 d = ex + 1.0f; f2 r; r.x = __builtin_amdgcn_rcpf(d.x); r.y = __builtin_amdgcn_rcpf(d.y); const f2 hv = (av * bv) * r; h[i] = hv.x; h[i + 1] = hv.y; }
    }
    __device__ __forceinline__ void operator()(const f32x4 (&acc)[2][2][4][2], const Unit& u, int wr, int wc, int fr, int fq, PG8_LAS unsigned char* lds, int wid, int lane) const {
        if constexpr (OUT8) {
            PG8_LAS unsigned char* st = lds + 3 * HTB;
#pragma unroll
            for (int ai = 0; ai < 2; ++ai) {
#pragma unroll
                for (int m = 0; m < 4; ++m) { const int r = wr * 64 + m * 16 + fr;
#pragma unroll
                    for (int bj = 0; bj < 2; ++bj) { float h[4]; silu4(acc[ai][bj][m][0], acc[ai][bj][m][1], h);
                        int w = 0; w = __builtin_amdgcn_cvt_pk_fp8_f32(h[0], h[1], w, false); w = __builtin_amdgcn_cvt_pk_fp8_f32(h[2], h[3], w, true);
                        *(PG8_LAS int*)(st + r * 128 + (((wc + 4 * bj) ^ (r & 7)) << 4) + 4 * fq) = w; } }
                asm volatile("s_waitcnt lgkmcnt(0)" ::: "memory"); __builtin_amdgcn_s_barrier(); asm volatile("" ::: "memory");
#pragma unroll
                for (int k = 0; k < 2; ++k) { const int r = 16 * wid + 8 * k + (lane >> 3), c = lane & 7;
                    const u32x4 v = *(const PG8_LAS u32x4*)(st + r * 128 + ((c ^ (r & 7)) << 4));
                    if (!nostore) *(u32x4*)((unsigned char*)Hd + (size_t)(u.pm * BM + ai * HALF + r) * ldh + u.pn * (BM / 2) + 16 * c) = v; else asm volatile("" :: "v"(v)); }
                asm volatile("s_waitcnt lgkmcnt(0)" ::: "memory"); __builtin_amdgcn_s_barrier(); asm volatile("" ::: "memory");
            }
        } else {
            const int row0 = u.pm * BM + wr * 64 + fr; const int hc0 = (u.pn * BM + wc * 32 + 8 * fq) >> 1;
#pragma unroll
            for (int ai = 0; ai < 2; ++ai)
#pragma unroll
                for (int m = 0; m < 4; ++m) { const size_t ro = (size_t)(row0 + ai * HALF + m * 16) * ldh + hc0;
#pragma unroll
                    for (int bj = 0; bj < 2; ++bj) { float h[4]; silu4(acc[ai][bj][m][0], acc[ai][bj][m][1], h);
                        u32x2 w; w.x = cvt_pk_bf16(h[0], h[1]); w.y = cvt_pk_bf16(h[2], h[3]); *(u32x2*)((bf16_t*)Hd + ro + bj * (HALF / 2)) = w; } }
        }
    }
};

template <bool GATHER, int ES, class Epi, class Sched>
__device__ __forceinline__ void gemm_phase(PG8_LAS unsigned char* lds, const Gemm g, const Sched& S, const Epi& E, const int tid, const int wscale_e8m0 = 127) {
    const int wid = __builtin_amdgcn_readfirstlane(tid >> 6), lane = tid & 63, wr = wid >> 2, wc = wid & 3, fr = lane & 15, fq = lane >> 4;
    const int K = g.K, nt = K * ES / (BK * 2);
    unsigned voffA[2][2], voffAn[2][2], voffB[2]; int Rr[2], Cc[2];
#pragma unroll
    for (int i = 0; i < 2; ++i) { int R, C; stage_rc(tid * 16 + i * 8192, R, C); const int Rb = Epi::PERM ? ((R & ~31) + perm32(R & 31)) : R; Rr[i] = R; Cc[i] = C;
        voffA[0][i] = (unsigned)(R * g.lda * ES + C * 2); voffA[1][i] = (unsigned)((R + HALF) * g.lda * ES + C * 2); voffB[i] = (unsigned)(Rb * g.ldb * ES + C * 2);
        voffAn[0][i] = voffA[0][i]; voffAn[1][i] = voffA[1][i]; }
    const size_t kstep = (size_t)(BK * 2);
    const size_t hB = (size_t)HALF * g.ldb * ES;
    const unsigned ldsw = (unsigned)wid * 1024u;
    const int aoff = lds_byte(wr * 64 + fr, fq * 8), boff = lds_byte(wc * 32 + fr, fq * 8);
#define PG8_APTR(u) (GATHER ? (const char*)g.A : (const char*)g.A + ((size_t)(u).pm * BM * g.lda + (size_t)(u).pn * g.a_pn_off) * ES)
#define PG8_IDXDMA(u) __builtin_amdgcn_global_load_lds((const unsigned*)(g.rowidx + (u).pm * BM + idxrow), (PG8_LAS unsigned*)(lds + STAGE_BYTES + wid * 256), 4, 0, 0)
#define PG8_TOKL(h, i) ib[(h) * 32 + (i) * 16 + (Rr[i] & 15)]
#define PG8_VOFF(tok, i) ((unsigned)(((tok) < 0 ? 0 : (tok)) * g.lda * ES + Cc[i] * 2))
#define PG8_BPTR(u) ((const char*)g.Bt + ((size_t)(u).e * g.b_e_stride + (size_t)(u).pn * BM * g.ldb) * ES)
#define PG8_SA(b, h) (((b) * 2 + (h)) * HTB)
#define PG8_SB(b, h) ((4 + (b) * 2 + (h)) * HTB)
#define PG8_STAGE(bufoff, gbase, voff) do { _Pragma("unroll") for (int _i = 0; _i < 2; ++_i) { unsigned _vo = (voff)[_i]; asm volatile("" : "+v"(_vo));     \
        __builtin_amdgcn_global_load_lds((const unsigned*)((const char*)(gbase) + _vo), (PG8_LAS unsigned*)(lds + (bufoff) + ldsw + _i * 8192), 16, 0, 0); } } while (0)
#define PG8_LDA(dst, b, h) do { _Pragma("unroll") for (int m = 0; m < 4; ++m) _Pragma("unroll") for (int k = 0; k < 2; ++k) dst[m][k] = *(const PG8_LAS bf16x8*)(lds + PG8_SA(b, h) + aoff + m * 2048 + k * 1024); } while (0)
#define PG8_LDB(dst, b, h) do { _Pragma("unroll") for (int n = 0; n < 2; ++n) _Pragma("unroll") for (int k = 0; k < 2; ++k) dst[n][k] = *(const PG8_LAS bf16x8*)(lds + PG8_SB(b, h) + boff + n * 2048 + k * 1024); } while (0)
#define PG8_CAT8(x0, x1) __builtin_shufflevector(__builtin_bit_cast(i32x4, x0), __builtin_bit_cast(i32x4, x1), 0, 1, 2, 3, 4, 5, 6, 7)
#define PG8_MMA(ai, bj, At, Bt) do { __builtin_amdgcn_s_setprio(1); _Pragma("unroll") for (int m = 0; m < 4; ++m) _Pragma("unroll") for (int n = 0; n < 2; ++n) { \
        if constexpr (ES == 2) { _Pragma("unroll") for (int k = 0; k < 2; ++k) acc[ai][bj][m][n] = __builtin_amdgcn_mfma_f32_16x16x32_bf16(Bt[n][k], At[m][k], acc[ai][bj][m][n], 0, 0, 0); } \
        else   \
            { const i32x8 b8_ = PG8_CAT8(Bt[n][0], Bt[n][1]), a8_ = PG8_CAT8(At[m][0], At[m][1]);   \
              asm volatile("v_mfma_scale_f32_16x16x128_f8f6f4 %0, %1, %2, %0, %3, %4 op_sel_hi:[0,0,0]" : "+v"(acc[ai][bj][m][n]) : "v"(b8_), "v"(a8_), "v"(f8wscale), "v"(f8scale)); } } \
        __builtin_amdgcn_s_setprio(0); } while (0)
#define PG8_WAIT_V(n) asm volatile("s_waitcnt vmcnt(" #n ")" ::: "memory")
#define PG8_WAIT_L(n) asm volatile("s_waitcnt lgkmcnt(" #n ")" ::: "memory")
#define PG8_BAR __builtin_amdgcn_s_barrier()
#define PG8_SCHED __builtin_amdgcn_sched_barrier(0)
    int f8scale = 0x7f7f7f7f, f8wscale = wscale_e8m0 * 0x01010101; asm volatile("" : "+v"(f8scale), "+v"(f8wscale));
    Unit cur, nxt; Sched W = S;
    if (!W.begin(cur)) return;
    f32x4 acc[2][2][4][2];
#pragma unroll
    for (int a = 0; a < 2; ++a)
#pragma unroll
        for (int b = 0; b < 2; ++b)
#pragma unroll
            for (int m = 0; m < 4; ++m)
#pragma unroll
                for (int n = 0; n < 2; ++n) acc[a][b][m][n] = (f32x4){0.f, 0.f, 0.f, 0.f};
    bf16x8 At[4][2], B0[2][2], B1[2][2];
    const char* cA = PG8_APTR(cur); const char* cB = PG8_BPTR(cur);
    const int idxrow = (lane >> 5) * HALF + ((lane >> 4) & 1) * 64 + 16 * (wid >> 1) + (lane & 15);
    volatile PG8_LAS int* ib = (volatile PG8_LAS int*)(lds + STAGE_BYTES + wid * 256);
    if constexpr (GATHER) { PG8_IDXDMA(cur); asm volatile("s_waitcnt vmcnt(0)" ::: "memory");
#pragma unroll
        for (int h = 0; h < 2; ++h)
#pragma unroll
            for (int i = 0; i < 2; ++i) { const int tk = PG8_TOKL(h, i); voffA[h][i] = PG8_VOFF(tk, i); } }
    PG8_STAGE(PG8_SB(0, 0), cB, voffB); PG8_STAGE(PG8_SB(0, 1), cB + hB, voffB); PG8_STAGE(PG8_SA(0, 0), cA, voffA[0]); PG8_STAGE(PG8_SA(0, 1), cA, voffA[1]);
    if (wr == 1) PG8_BAR;
    PG8_WAIT_V(2); PG8_BAR;
    PG8_STAGE(PG8_SB(1, 0), cB + kstep, voffB); PG8_STAGE(PG8_SA(1, 0), cA + kstep, voffA[0]); PG8_STAGE(PG8_SB(1, 1), cB + hB + kstep, voffB);
    PG8_WAIT_V(6); PG8_BAR;
    for (;;) {
        const bool has_next = W.advance(nxt);
        const char* nA = has_next ? PG8_APTR(nxt) : cA; const char* nB = has_next ? PG8_BPTR(nxt) : cB;
        if constexpr (GATHER) { if (has_next) PG8_IDXDMA(nxt); }
        for (int t = 0; t < nt; t += 2) {
            const bool last = (t == nt - 2);
            const char* a1 = cA + (size_t)(t + 1) * kstep;
            const char* a2 = last ? nA : cA + (size_t)(t + 2) * kstep; const char* b2 = last ? nB : cB + (size_t)(t + 2) * kstep;
            const char* a3 = a2 + kstep; const char* b3 = b2 + kstep;
            unsigned va[2][2];
#pragma unroll
            for (int h = 0; h < 2; ++h)
#pragma unroll
                for (int i = 0; i < 2; ++i) va[h][i] = (GATHER && last) ? voffAn[h][i] : voffA[h][i];
            PG8_LDB(B0, 0, 0); PG8_LDB(B1, 0, 1); PG8_SCHED; PG8_LDA(At, 0, 0); PG8_STAGE(PG8_SA(1, 1), a1, voffA[1]);
            PG8_WAIT_V(8); PG8_WAIT_L(0); PG8_BAR; PG8_MMA(0, 0, At, B0); PG8_MMA(0, 1, At, B1); PG8_BAR; PG8_SCHED;
            PG8_LDA(At, 0, 1); PG8_STAGE(PG8_SB(0, 0), b2, voffB); PG8_STAGE(PG8_SB(0, 1), b2 + hB, voffB); PG8_STAGE(PG8_SA(0, 0), a2, va[0]);
            PG8_WAIT_V(8); PG8_WAIT_L(0); PG8_BAR; PG8_MMA(1, 0, At, B0); PG8_MMA(1, 1, At, B1); PG8_BAR; PG8_SCHED;
            PG8_LDB(B0, 1, 0); PG8_LDB(B1, 1, 1); PG8_SCHED; PG8_LDA(At, 1, 0); PG8_STAGE(PG8_SA(0, 1), a2, va[1]);
            PG8_WAIT_V(8); PG8_WAIT_L(0); PG8_BAR; PG8_MMA(0, 0, At, B0); PG8_MMA(0, 1, At, B1); PG8_BAR; PG8_SCHED;
            PG8_LDA(At, 1, 1); PG8_STAGE(PG8_SB(1, 0), b3, voffB); PG8_STAGE(PG8_SB(1, 1), b3 + hB, voffB); PG8_STAGE(PG8_SA(1, 0), a3, va[0]);
            PG8_WAIT_V(8); PG8_WAIT_L(0); PG8_BAR; PG8_MMA(1, 0, At, B0); PG8_MMA(1, 1, At, B1); PG8_BAR; PG8_SCHED;
            if constexpr (GATHER) {
#pragma unroll
                for (int h = 0; h < 2; ++h)
#pragma unroll
                    for (int i = 0; i < 2; ++i) { const int tk = PG8_TOKL(h, i); voffAn[h][i] = PG8_VOFF(tk, i); } }
        }
        if (wr == 0) PG8_BAR;
        if constexpr (ES == 1) asm volatile("s_nop 15\n\ts_nop 15" ::: "memory");
        E(acc, cur, wr, wc, fr, fq, lds, wid, lane);
        if (!has_next) break;
#pragma unroll
        for (int a = 0; a < 2; ++a)
#pragma unroll
            for (int b = 0; b < 2; ++b)
#pragma unroll
                for (int m = 0; m < 4; ++m)
#pragma unroll
                    for (int n = 0; n < 2; ++n) acc[a][b][m][n] = (f32x4){0.f, 0.f, 0.f, 0.f};
        cur = nxt; cA = nA; cB = nB;
        if constexpr (GATHER) {
#pragma unroll
            for (int h = 0; h < 2; ++h)
#pragma unroll
                for (int i = 0; i < 2; ++i) voffA[h][i] = voffAn[h][i]; }
        if (wr == 1) PG8_BAR;
    }
    PG8_WAIT_V(0);
    PG8_BAR;
#undef PG8_APTR
#undef PG8_IDXDMA
#undef PG8_TOKL
#undef PG8_VOFF
#undef PG8_BPTR
#undef PG8_SA
#undef PG8_SB
#undef PG8_STAGE
#undef PG8_LDA
#undef PG8_LDB
#undef PG8_MMA
#undef PG8_CAT8
#undef PG8_WAIT_V
#undef PG8_WAIT_L
#undef PG8_BAR
#undef PG8_SCHED
}
}
namespace attn_body {
using bf16=__hip_bfloat16;
using bf16x8=__attribute__((ext_vector_type(8)))short;
using s16x4=__attribute__((ext_vector_type(4)))short;
using f32x16=__attribute__((ext_vector_type(16)))float;
using u32x4=__attribute__((ext_vector_type(4)))unsigned;
constexpr int D=64;
constexpr int NW=8,QBLK=32,QB=QBLK*NW,KVBLK=64;
__device__ __forceinline__ int crow(int r,int hi){return (r&3)+8*(r>>2)+4*hi;}
#define SBAR() __builtin_amdgcn_sched_barrier(0)
constexpr int NSLOT=3, SLOTB=8192;
constexpr int LDS_K=0, LDS_V=NSLOT*SLOTB, LDS_WS=2*NSLOT*SLOTB, LDS_OST=LDS_WS+NW*64*4, LDS_BYTES=LDS_OST+NW*4096;
constexpr int LDS_BIAS=LDS_BYTES;
constexpr float C2=0.125f*1.4426950408889634f;
__device__ __forceinline__ void glds16(const void*gsrc,unsigned lds_dst){unsigned keep;
  asm volatile("s_mov_b32 %0, m0\n\ts_mov_b32 m0, %2\n\ts_nop 0\n\tglobal_load_lds_dwordx4 %1, off\n\ts_mov_b32 m0, %0":"=&s"(keep):"v"(gsrc),"s"(lds_dst):"memory");}
__device__ __forceinline__ float max3f(float a,float b,float c){float r;asm("v_max3_f32 %0, %1, %2, %3":"=v"(r):"v"(a),"v"(b),"v"(c));return r;}
__device__ __forceinline__ float max2f(float a,float b){float r;asm("v_max_f32_e32 %0, %1, %2":"=v"(r):"v"(a),"v"(b));return r;}
__device__ __forceinline__ float fadd_s(float a,float b){float r;asm("v_add_f32_e32 %0, %1, %2":"=v"(r):"v"(a),"v"(b));return r;}
__device__ __forceinline__ float fsub_s(float a,float b){float r;asm("v_sub_f32_e32 %0, %1, %2":"=v"(r):"v"(a),"v"(b));return r;}
typedef float f32x2_t __attribute__((ext_vector_type(2))); typedef __bf16 bf16x2_t __attribute__((ext_vector_type(2)));
__device__ __forceinline__ unsigned cvtpk_s(float lo,float hi){f32x2_t v={lo,hi};bf16x2_t b=__builtin_convertvector(v,bf16x2_t);return __builtin_bit_cast(unsigned,b);}
#define WAIT_BAR(N) asm volatile("s_waitcnt vmcnt(" #N ") lgkmcnt(0)\n\ts_barrier":::"memory")

__device__ __forceinline__ void qkt(f32x16&p0,f32x16&p1,const char*Kslot,const bf16x8*qr,const f32x16&negm,int r32,int hi){
  const char*kb=Kslot+hi*1024+r32*16;
  #pragma unroll
  for(int d0=0;d0<4;++d0){
    const bf16x8 b0=*reinterpret_cast<const bf16x8*>(kb+d0*2048);
    const bf16x8 b1=*reinterpret_cast<const bf16x8*>(kb+d0*2048+512);
    if(d0==0){p0=__builtin_amdgcn_mfma_f32_32x32x16_bf16(b0,qr[0],negm,0,0,0);p1=__builtin_amdgcn_mfma_f32_32x32x16_bf16(b1,qr[0],negm,0,0,0);}
    else{p0=__builtin_amdgcn_mfma_f32_32x32x16_bf16(b0,qr[d0],p0,0,0,0);p1=__builtin_amdgcn_mfma_f32_32x32x16_bf16(b1,qr[d0],p1,0,0,0);}}
}
typedef __attribute__((address_space(3))) const char* lds_cptr;
typedef short v4i16_t __attribute__((ext_vector_type(4)));
__device__ __forceinline__ void kload8(bf16x8*kf,lds_cptr kp){
  kf[0]=*(const __attribute__((address_space(3))) bf16x8*)(kp);      kf[1]=*(const __attribute__((address_space(3))) bf16x8*)(kp+512);
  kf[2]=*(const __attribute__((address_space(3))) bf16x8*)(kp+2048); kf[3]=*(const __attribute__((address_space(3))) bf16x8*)(kp+2560);
  kf[4]=*(const __attribute__((address_space(3))) bf16x8*)(kp+4096); kf[5]=*(const __attribute__((address_space(3))) bf16x8*)(kp+4608);
  kf[6]=*(const __attribute__((address_space(3))) bf16x8*)(kp+6144); kf[7]=*(const __attribute__((address_space(3))) bf16x8*)(kp+6656);
}
__device__ __forceinline__ void kload2(bf16x8*kf,lds_cptr kp,int j){ kf[2*j]=*(const __attribute__((address_space(3))) bf16x8*)(kp+j*2048); kf[2*j+1]=*(const __attribute__((address_space(3))) bf16x8*)(kp+j*2048+512); }
__device__ __forceinline__ s16x4 vtr(lds_cptr p){ return __builtin_bit_cast(s16x4,__builtin_amdgcn_ds_read_tr16_b64_v4i16((__attribute__((address_space(3))) v4i16_t*)p)); }
__device__ __forceinline__ float rowmax(const f32x16&p0,const f32x16&p1){
  float a=max3f(p0[0],p0[1],p1[0]),b=max3f(p0[2],p0[3],p1[1]);a=max3f(a,p1[2],p1[3]);
  #pragma unroll
  for(int r=4;r<16;r+=4){a=max3f(a,p0[r],p0[r+1]);b=max3f(b,p0[r+2],p0[r+3]);a=max3f(a,p1[r],p1[r+1]);b=max3f(b,p1[r+2],p1[r+3]);}
  const float m=max2f(a,b);
  auto rr=__builtin_amdgcn_permlane32_swap(__float_as_uint(m),__float_as_uint(m),false,false);
  return max2f(__uint_as_float(rr[0]),__uint_as_float(rr[1]));
}
__device__ __forceinline__ void pv(f32x16*o,int vb,bf16x8 pa0,bf16x8 pa1,bf16x8 pa2,bf16x8 pa3){
  #pragma unroll
  for(int d0=0;d0<2;++d0){s16x4 lo[4],hi[4];
    #pragma unroll
    for(int ks=0;ks<4;++ks){
      asm volatile("ds_read_b64_tr_b16 %0,%1 offset:%c2":"=&v"(lo[ks]):"v"(vb),"i"(d0*4096+ks*1024):"memory");
      asm volatile("ds_read_b64_tr_b16 %0,%1 offset:%c2":"=&v"(hi[ks]):"v"(vb),"i"(d0*4096+ks*1024+512):"memory");}
    asm volatile("s_waitcnt lgkmcnt(0)":::"memory");SBAR();
    #define PK(k) (bf16x8){lo[k][0],lo[k][1],lo[k][2],lo[k][3],hi[k][0],hi[k][1],hi[k][2],hi[k][3]}
    o[d0]=__builtin_amdgcn_mfma_f32_32x32x16_bf16(pa0,PK(0),o[d0],0,0,0);
    o[d0]=__builtin_amdgcn_mfma_f32_32x32x16_bf16(pa1,PK(1),o[d0],0,0,0);
    o[d0]=__builtin_amdgcn_mfma_f32_32x32x16_bf16(pa2,PK(2),o[d0],0,0,0);
    o[d0]=__builtin_amdgcn_mfma_f32_32x32x16_bf16(pa3,PK(3),o[d0],0,0,0);
    #undef PK
  }
}
struct TileRows { long base0, base1; int nfirst; __device__ __forceinline__ long operator()(int t) const { return t < nfirst ? base0 + 64l * t : base1 + 64l * (t - nfirst); } };
struct NoMask { static constexpr bool ACTIVE=false; __device__ __forceinline__ void apply(f32x16&,f32x16&,int) const {} };
struct NaMask {
  static constexpr bool ACTIVE=true;
  int kbase, qr, r0q, qcol, c0, hi; lds_cptr bias;
  __device__ __forceinline__ void apply(f32x16&p0,f32x16&p1,int t) const {
    if(t<4) return;
    const int kr=kbase+(t-4); const float NEG=-1.0e30f;
    if(kr<r0q||kr>r0q+7){
      #pragma unroll
      for(int r=0;r<16;++r){p0[r]=NEG;p1[r]=NEG;}
      return; }
    const int ib=(kr-qr+7)*31+(4*hi-qcol+15);
    const int cb=4*hi-c0;
    #pragma unroll
    for(int r=0;r<16;++r){ const int ko=(r&3)+8*(r>>2);
      const float b0=*(const __attribute__((address_space(3))) float*)(bias+4*(ib+ko));
      const float b1=*(const __attribute__((address_space(3))) float*)(bias+4*(ib+ko+32));
#ifdef DBG_NA_NOBIAS
      p0[r]=((unsigned)(cb+ko)<16u)?p0[r]:NEG; p1[r]=((unsigned)(cb+ko+32)<16u)?p1[r]:NEG; (void)b0; (void)b1; }
#else
      p0[r]=((unsigned)(cb+ko)<16u)?p0[r]+b0:NEG;
      p1[r]=((unsigned)(cb+ko+32)<16u)?p1[r]+b1:NEG; }
#endif
  }
};

#ifndef ATTN_STORE16
#define ATTN_STORE16(p,v) (*(u32x4*)(p)=(v))
#endif
template<int THRL,class MK,bool USE_NEGM,bool OUT8,bool FIXM,bool QNORM=false> __device__ __forceinline__ void attn_unit(const bf16*Qw0,int QP,const bf16*__restrict__ Kc,const bf16*__restrict__ Vc,int KP,const TileRows TR,const int NT,void*Ow0,int OP,char*shm,const MK&mk,const int tid,const float mfix=0.f,const float*qgain=nullptr,const int qt0=0,const float rms_eps=0.f){
  static_assert(!FIXM||USE_NEGM,"FIXM puts the reference into the QK^T MFMA's C operand");
  const int lane=tid&63,r32=lane&31,hi=lane>>5; const int wid=__builtin_amdgcn_readfirstlane(tid>>6);
  const bf16*Qw=Qw0+(long)(wid*QBLK)*QP;
  const unsigned lds0=(unsigned)(uintptr_t)shm;
  float*wsf=(float*)(shm+LDS_WS)+wid*64;
  const bf16*ksrc=Kc+(long)lane*KP+wid*8;
  const bf16*vsrc=Vc+(long)(16*(wid&3)+(lane>>2))*KP+(wid>>2)*32+(lane&3)*8;
  const unsigned kdst=lds0+LDS_K+wid*1024, vdst=lds0+LDS_V+wid*1024;
  #define DMA_K(t,slot) glds16(ksrc+TR(t)*KP,(unsigned)__builtin_amdgcn_readfirstlane(kdst+(slot)))
  #define DMA_V(t,slot) glds16(vsrc+TR(t)*KP,(unsigned)__builtin_amdgcn_readfirstlane(vdst+(slot)))
  const int vb0=(int)(lds0+LDS_V)+((lane>>4)&1)*32+(lane&3)*8+(4*hi+((lane&15)>>2))*64;
  const char*Kbase=shm+LDS_K; bf16x8 kf[8];
  const lds_cptr shm3=(lds_cptr)shm; const lds_cptr kp0=shm3+LDS_K+hi*1024+r32*16; const lds_cptr vp0=shm3+LDS_V+((lane>>4)&1)*32+(lane&3)*8+(4*hi+((lane&15)>>2))*64;
  DMA_K(0,0);DMA_V(0,0);DMA_K(1,SLOTB);
  bf16x8 qr[4];
  #pragma unroll
  for(int d0=0;d0<4;++d0)qr[d0]=*reinterpret_cast<const bf16x8*>(&Qw[(long)r32*QP+d0*16+hi*8]);
  if constexpr(QNORM){
    float qf[4][8]; float ss=0.f;
    #pragma unroll
    for(int d0=0;d0<4;++d0){
      #pragma unroll
      for(int i=0;i<8;++i){ qf[d0][i]=__uint_as_float(((unsigned)(unsigned short)qr[d0][i])<<16); ss+=qf[d0][i]*qf[d0][i]; } }
    { auto rr=__builtin_amdgcn_permlane32_swap(__float_as_uint(ss),__float_as_uint(ss),false,false); ss=__uint_as_float(rr[0])+__uint_as_float(rr[1]); }
    const float rinv=(1.0f/sqrtf(ss*(1.f/64.f)+rms_eps))*C2;
    const int tq=qt0+wid*QBLK+r32; const float rowp=(float)(tq>>6), colp=(float)(tq&63);
    #pragma unroll
    for(int d0=0;d0<4;++d0){ const float pos=d0<2?rowp:colp; const float*gp=qgain+d0*16+hi*8; float g[8];
      #pragma unroll
      for(int i=0;i<8;++i)g[i]=gp[i];
      u32x4 w;
      #pragma unroll
      for(int j=0;j<4;++j){ const int pi=(d0&1)*8+hi*4+j; const float fr=__builtin_amdgcn_exp2f(-(float)pi*(13.287712379549449f/16.0f))*0.15915494309189535f;
        const float rev=pos*fr; const float c=__builtin_amdgcn_cosf(rev), sn=__builtin_amdgcn_sinf(rev);
        const float x1=qf[d0][2*j]*rinv*g[2*j], x2=qf[d0][2*j+1]*rinv*g[2*j+1]; w[j]=cvtpk_s(x1*c-x2*sn,x1*sn+x2*c); }
      qr[d0]=__builtin_bit_cast(bf16x8,w); }
  }
  float zz_; asm volatile("v_mov_b32 %0, 0":"=v"(zz_)); float mhat=zz_,l_reg=zz_;f32x16 o[2];
  _Pragma("unroll") for(int r=0;r<16;++r){o[0][r]=zz_;o[1][r]=zz_;}
  f32x16 negm; if(USE_NEGM){ _Pragma("unroll") for(int r=0;r<16;++r)negm[r]=FIXM?(zz_-mfix):zz_; asm volatile("":"+v"(negm)); }
  const f32x16 zero16=f32x16{};
  #define CIN (USE_NEGM?negm:zero16)
  #define SUBM(C0,C1) do{ if(!USE_NEGM){ _Pragma("unroll") for(int r=0;r<16;++r){C0[r]-=mhat;C1[r]-=mhat;} } }while(0)
  #define CMASK(P0,P1,t) mk.apply(P0,P1,t)
  bool resc=false;
  #define START(P0,P1) do{ resc=false; if(!FIXM) { const float rm=rowmax(P0,P1); \
    const float dl=rm; mhat=fadd_s(mhat,dl); \
      _Pragma("unroll") for(int r=0;r<16;++r){P0[r]=fsub_s(P0[r],dl);P1[r]=fsub_s(P1[r],dl);} \
      if(USE_NEGM){ _Pragma("unroll") for(int r=0;r<16;++r)negm[r]=-mhat; asm volatile("":"+v"(negm)); } } \
    _Pragma("unroll") for(int r=0;r<16;++r)P0[r]=__builtin_amdgcn_exp2f(P0[r]); }while(0)
  #define RESC() do{ if(!FIXM&&resc){ asm volatile("s_waitcnt lgkmcnt(0)":::"memory"); \
      _Pragma("unroll") for(int d_=0;d_<2;++d_) _Pragma("unroll") for(int r=0;r<16;++r)o[d_][r]*=wsf[crow(r,hi)]; } }while(0)
  f32x16 pA0,pA1,pB0,pB1;
  int sl_prev=0,sl_cur=0,sl_next=SLOTB;
  #define ROT() do{sl_prev=sl_cur;sl_cur=sl_next;sl_next=(sl_next==(NSLOT-1)*SLOTB)?0:sl_next+SLOTB;}while(0)
  DMA_K(2,2*SLOTB);
  WAIT_BAR(3);
  qkt(pA0,pA1,Kbase,qr,CIN,r32,hi);asm volatile("s_nop 15\n\ts_nop 7":"+v"(pA0),"+v"(pA1));CMASK(pA0,pA1,0);
  START(pA0,pA1);
  _Pragma("unroll") for(int r=0;r<16;++r)pA1[r]=__builtin_amdgcn_exp2f(pA1[r]);
  WAIT_BAR(0);
  DMA_K(3,0);DMA_V(1,SLOTB);
  ROT();
  kload8(kf,kp0+sl_cur);
  WAIT_BAR(2);
  s16x4 vlo[8],vhi[8]; u32x4 pw0,pw1,pw2,pw3;
  #define PKW(P,B) cvtpk_s(P[B],P[B+1])
  #define PAF(k) __builtin_bit_cast(bf16x8,pw##k)
  #define VFR(i) (bf16x8){vlo[i][0],vlo[i][1],vlo[i][2],vlo[i][3],vhi[i][0],vhi[i][1],vhi[i][2],vhi[i][3]}
  #define PIN(x) asm volatile("":"+v"(x))
  #define MX3(a,b,c) __builtin_fmaxf(__builtin_fmaxf((a),(b)),(c))
  #define GAPA(MF,A0,A1,A2,A3,W0,W1,PW) do{ MF; sacc+=A0; sacc+=A1; sacc+=A2; sacc+=A3; PIN(sacc); W0; W1; PIN(PW); SBAR(); }while(0)
  #define EX(v) __builtin_amdgcn_exp2f(v)
  #define GAPB(MF,X,B) do{ MF; X[B]=EX(X[B]); X[B+1]=EX(X[B+1]); X[B+2]=EX(X[B+2]); X[B+3]=EX(X[B+3]); PIN(X); SBAR(); }while(0)
  #define VRD(i) do{ vlo[i]=vtr(vp_+(((i)>>2)*4096+((i)&3)*1024)); vhi[i]=vtr(vp_+(((i)>>2)*4096+((i)&3)*1024+512)); }while(0)
  #define KRD(G,j) do{ if(G){ kload2(kf,kp0+sl_next,j); SBAR(); } }while(0)
  #define STEP(C0,C1,P0,P1,t,GK,GV,GL) do{ SBAR(); \
    const lds_cptr vp_=vp0+sl_prev; \
    VRD(0); SBAR(); float sacc=(P0[0]+P0[1]); \
    GAPA(C0=__builtin_amdgcn_mfma_f32_32x32x16_bf16(kf[0],qr[0],CIN,0,0,0), P0[2],P0[3],P0[4],P0[5],     pw0[0]=PKW(P0,0), pw0[1]=PKW(P0,2), pw0); \
    VRD(4); SBAR(); GAPA(C1=__builtin_amdgcn_mfma_f32_32x32x16_bf16(kf[1],qr[0],CIN,0,0,0), P0[6],P0[7],P0[8],P0[9],     pw0[2]=PKW(P0,4), pw0[3]=PKW(P0,6), pw0); \
    VRD(1); SBAR(); GAPA(C0=__builtin_amdgcn_mfma_f32_32x32x16_bf16(kf[2],qr[1],C0,0,0,0),   P0[10],P0[11],P0[12],P0[13], pw1[0]=PKW(P0,8), pw1[1]=PKW(P0,10), pw1); \
    VRD(5); SBAR(); GAPA(C1=__builtin_amdgcn_mfma_f32_32x32x16_bf16(kf[3],qr[1],C1,0,0,0),   P0[14],P0[15],P1[0],P1[1],   pw1[2]=PKW(P0,12),pw1[3]=PKW(P0,14), pw1); \
    VRD(2); SBAR(); GAPA(C0=__builtin_amdgcn_mfma_f32_32x32x16_bf16(kf[4],qr[2],C0,0,0,0),   P1[2],P1[3],P1[4],P1[5],     pw2[0]=PKW(P1,0), pw2[1]=PKW(P1,2), pw2); \
    VRD(6); SBAR(); GAPA(C1=__builtin_amdgcn_mfma_f32_32x32x16_bf16(kf[5],qr[2],C1,0,0,0),   P1[6],P1[7],P1[8],P1[9],     pw2[2]=PKW(P1,4), pw2[3]=PKW(P1,6), pw2); \
    VRD(3); SBAR(); GAPA(C0=__builtin_amdgcn_mfma_f32_32x32x16_bf16(kf[6],qr[3],C0,0,0,0),   P1[10],P1[11],P1[12],P1[13], pw3[0]=PKW(P1,8), pw3[1]=PKW(P1,10), pw3); \
    VRD(7); SBAR(); GAPA(C1=__builtin_amdgcn_mfma_f32_32x32x16_bf16(kf[7],qr[3],C1,0,0,0),   P1[14],P1[15],0.f,0.f,       pw3[2]=PKW(P1,12),pw3[3]=PKW(P1,14), pw3); \
    l_reg+=sacc; \
    if(GK){DMA_K((t)+3,sl_cur);} if(GV){DMA_V((t)+1,sl_next);} \
    SUBM(C0,C1); CMASK(C0,C1,t); \
    if(!FIXM){ float a=MX3(C0[0],C0[1],C1[0]),b=MX3(C0[2],C0[3],C1[1]); a=MX3(a,C1[2],C1[3]); \
      _Pragma("unroll") for(int r=4;r<16;r+=4){a=MX3(a,C0[r],C0[r+1]);b=MX3(b,C0[r+2],C0[r+3]);a=MX3(a,C1[r],C1[r+1]);b=MX3(b,C1[r+2],C1[r+3]);} \
      float rm=__builtin_fmaxf(a,b); { auto rr=__builtin_amdgcn_permlane32_swap(__float_as_uint(rm),__float_as_uint(rm),false,false); rm=__builtin_fmaxf(__uint_as_float(rr[0]),__uint_as_float(rr[1])); } \
      resc=false; \
      if(__builtin_expect(__any(rm>(float)THRL),0)){ const float dl=__builtin_fmaxf(rm,0.f); mhat+=dl; \
        _Pragma("unroll") for(int r=0;r<16;++r){C0[r]-=dl;C1[r]-=dl;} \
        if(USE_NEGM){ _Pragma("unroll") for(int r=0;r<16;++r)negm[r]=-mhat; asm volatile("":"+v"(negm)); } \
        const float f=__builtin_amdgcn_exp2f(-dl); l_reg*=f; if(hi==0)wsf[r32]=f; resc=true; } } \
    SBAR(); \
    GAPB(o[0]=__builtin_amdgcn_mfma_f32_32x32x16_bf16(PAF(0),VFR(0),o[0],0,0,0), C0,0); \
    GAPB(o[1]=__builtin_amdgcn_mfma_f32_32x32x16_bf16(PAF(0),VFR(4),o[1],0,0,0), C0,4); \
    KRD(GL,0); GAPB(o[0]=__builtin_amdgcn_mfma_f32_32x32x16_bf16(PAF(1),VFR(1),o[0],0,0,0), C0,8); \
    KRD(GL,1); GAPB(o[1]=__builtin_amdgcn_mfma_f32_32x32x16_bf16(PAF(1),VFR(5),o[1],0,0,0), C0,12); \
    KRD(GL,2); GAPB(o[0]=__builtin_amdgcn_mfma_f32_32x32x16_bf16(PAF(2),VFR(2),o[0],0,0,0), C1,0); \
    KRD(GL,3); GAPB(o[1]=__builtin_amdgcn_mfma_f32_32x32x16_bf16(PAF(2),VFR(6),o[1],0,0,0), C1,4); \
    GAPB(o[0]=__builtin_amdgcn_mfma_f32_32x32x16_bf16(PAF(3),VFR(3),o[0],0,0,0), C1,8); \
    GAPB(o[1]=__builtin_amdgcn_mfma_f32_32x32x16_bf16(PAF(3),VFR(7),o[1],0,0,0), C1,12); \
    }while(0)
  int t=1;
  for(;t+5<NT;t+=2){
    STEP(pB0,pB1,pA0,pA1,t,true,true,true);     WAIT_BAR(2); RESC(); ROT();
    STEP(pA0,pA1,pB0,pB1,t+1,true,true,true);   WAIT_BAR(2); RESC(); ROT();
  }
  #define ENDW(tt) do{ if((tt)+3<NT){WAIT_BAR(2);} else if((tt)+2<NT){WAIT_BAR(1);} else {WAIT_BAR(0);} }while(0)
  for(;t+1<NT;t+=2){
    STEP(pB0,pB1,pA0,pA1,t,(t+3<NT),(t+1<NT),(t+1<NT));       ENDW(t);   RESC(); ROT();
    STEP(pA0,pA1,pB0,pB1,t+1,(t+4<NT),(t+2<NT),(t+2<NT));     ENDW(t+1); RESC(); ROT();
  }
  STEP(pB0,pB1,pA0,pA1,NT-1,false,false,false); RESC();
  { float sacc=pB0[0]+pB0[1]; _Pragma("unroll") for(int r=2;r<16;++r)sacc+=pB0[r]; _Pragma("unroll") for(int r=0;r<16;++r)sacc+=pB1[r]; l_reg+=sacc;
    pw0=(u32x4){PKW(pB0,0),PKW(pB0,2),PKW(pB0,4),PKW(pB0,6)};pw1=(u32x4){PKW(pB0,8),PKW(pB0,10),PKW(pB0,12),PKW(pB0,14)};pw2=(u32x4){PKW(pB1,0),PKW(pB1,2),PKW(pB1,4),PKW(pB1,6)};pw3=(u32x4){PKW(pB1,8),PKW(pB1,10),PKW(pB1,12),PKW(pB1,14)};
    SBAR(); pv(o,vb0+sl_cur,PAF(0),PAF(1),PAF(2),PAF(3)); }
  #undef PKW
  #undef PAF
  #undef VFR
  #undef PIN
  #undef MX3
  #undef GAPA
  #undef GAPB
  #undef EX
  #undef VRD
  #undef KRD
  #undef STEP
  #undef ENDW
  {auto rr=__builtin_amdgcn_permlane32_swap(__float_as_uint(l_reg),__float_as_uint(l_reg),false,false);l_reg=__uint_as_float(rr[0])+__uint_as_float(rr[1]);}
  if(hi==0)wsf[32+r32]=l_reg;asm volatile("s_waitcnt lgkmcnt(0)":::"memory");
  float rli[16];
  #pragma unroll
  for(int r=0;r<16;++r)rli[r]=__builtin_amdgcn_rcpf(wsf[32+crow(r,hi)]);
  if constexpr(OUT8){ unsigned char*Ow=(unsigned char*)Ow0+(long)(wid*QBLK)*OP; unsigned char*stg=(unsigned char*)(shm+LDS_OST)+wid*4096;
    #pragma unroll
    for(int r=0;r<16;++r){const int orow=crow(r,hi);
      #pragma unroll
      for(int d0=0;d0<2;++d0){const float v=o[d0][r]*rli[r]; const int t=__builtin_amdgcn_cvt_pk_fp8_f32(v,v,0,false); stg[orow*64+d0*32+r32]=(unsigned char)t;}}
    asm volatile("s_waitcnt lgkmcnt(0)":::"memory");
    #pragma unroll
    for(int i=0;i<2;++i){const int row=i*16+(lane>>2),ch=lane&3; const u32x4 v=*(const u32x4*)(stg+row*64+ch*16); ATTN_STORE16(Ow+(long)row*OP+ch*16,v);} }
  else{ bf16*Ow=(bf16*)Ow0+(long)(wid*QBLK)*OP;
  { bf16*stg=(bf16*)(shm+LDS_OST)+wid*2048;
    #pragma unroll
    for(int r=0;r<16;++r){const int orow=crow(r,hi);
      #pragma unroll
      for(int d0=0;d0<2;++d0)stg[orow*64+d0*32+r32]=__float2bfloat16(o[d0][r]*rli[r]);}
    asm volatile("s_waitcnt lgkmcnt(0)":::"memory");
    #pragma unroll
    for(int i=0;i<4;++i){const int row=i*8+(lane>>3),ch=lane&7; const u32x4 v=*(const u32x4*)(stg+row*64+ch*8); ATTN_STORE16(Ow+(long)row*OP+ch*8,v);} } }
  asm volatile("s_waitcnt lgkmcnt(0)\n\ts_barrier":::"memory");
  #undef CIN
  #undef SUBM
  #undef DMA_K
  #undef DMA_V
  #undef CMASK
  #undef START
  #undef RESC
  #undef ROT
}
#undef SBAR
#undef WAIT_BAR
}
#ifndef MK_PER_PHASE
#define MK_PER_PHASE 0
#endif
#ifndef MOE_F8
#define MOE_F8 1
#endif
#ifndef WO_F8
#define WO_F8 0
#endif
#ifndef YS_F8
#define YS_F8 1
#endif
#ifndef QKV_F8
#define QKV_F8 1
#endif
constexpr int NWAVES = 8;
constexpr int W13_LOG2 = 5, W2_LOG2 = 7, WO_LOG2 = 6; constexpr float W13_SCALE = 32.0f, W2_SCALE = 128.0f;
constexpr int NB = 4, SEQ = 8192, DM = 1024, LCTX = 256, DEPTH = 4;
constexpr int M_LAT = NB * SEQ, M_CTX = NB * LCTX, M_ALL = M_LAT + M_CTX;
constexpr int NE = 16, FF = 2048, CAP_LAT = 1024, CAP_CTX = 32;
constexpr int ETILES = 17, ESTR = ETILES * 256, NSLOTS = NE * ESTR;
constexpr int KVROWS = SEQ + LCTX;
constexpr int NMOD = 6 * DM;
constexpr float ALPHA = 1.681792830507429f, LN_EPS = 1e-5f, RMS_EPS = 1e-6f, LOG2E = 1.4426950408889634f;

constexpr size_t MiB = 1u << 20;
constexpr size_t WS_CTL = 0, CTL_ZERO_BYTES = 2 * MiB;
constexpr size_t WS_MOD = 2 * MiB, WS_AFF = 3 * MiB, WS_SEL = 6 * MiB, WS_SLOT = 9 * MiB;
constexpr size_t WS_POOLW = 10 * MiB, WS_NAQKV = 11 * MiB, WS_NAWO = 17 * MiB, WS_GQKV = 19 * MiB, WS_GWO = 22 * MiB;
constexpr size_t WS_W13 = 32 * MiB, WS_W2 = 544 * MiB, WS_X = 800 * MiB, WS_H = 932 * MiB, WS_R = 1000 * MiB, WS_END = 1544 * MiB;
constexpr size_t R_XS = 0, R_HID = 136 * MiB, R_YS = 408 * MiB;
constexpr size_t R_D = 0, R_Y = 200 * MiB;
constexpr size_t R_O8 = 272 * MiB;
constexpr size_t R_Q = 0, R_K = 66 * MiB, R_V = 132 * MiB;
constexpr size_t R_RAW = 0, R_GQ = 100 * MiB, R_GK = 164 * MiB, R_GV = 181 * MiB;
constexpr int CW_TMO = 0, CW_BAR = 4096;

constexpr int RING_BYTES = 135168;
constexpr int LDSCTL_OFF = RING_BYTES, MISC_OFF = LDSCTL_OFF + 320;
constexpr int LDS_BYTES = 147456;

#define GAS __attribute__((address_space(1)))
#define LAS __attribute__((address_space(3)))
typedef unsigned short bf16;
typedef unsigned v4u __attribute__((ext_vector_type(4)));
typedef unsigned v2u __attribute__((ext_vector_type(2)));
typedef float f32x4 __attribute__((ext_vector_type(4)));
typedef float f32x2 __attribute__((ext_vector_type(2)));
#define RLX_AGENT __ATOMIC_RELAXED, __HIP_MEMORY_SCOPE_AGENT
#define LDS_WAIT() asm volatile("s_waitcnt lgkmcnt(0)" ::: "memory")
__device__ __forceinline__ unsigned pk2(float lo, float hi) { return pg8::cvt_pk_bf16(lo, hi); }
__device__ __forceinline__ float bf_lo(unsigned u) { return __uint_as_float(u << 16); }
__device__ __forceinline__ float bf_hi(unsigned u) { return __uint_as_float(u & 0xffff0000u); }

#define XB_TMO      128
#define XB_XCNT(j)  (256  + 64 * (j))
#define XB_XSUB(j)  (1280 + 64 * (j))
#define XB_XGEN(j)  (2304 + 64 * (j))
#define XB_TOP      3328
#define XB_TOPGEN   3392
#define XCD_BAR_WORDS 3456
#define XB_SPIN_CAP (1u << 22)

__device__ __forceinline__ unsigned xb_ld(unsigned* p)              { return __hip_atomic_load(p, __ATOMIC_RELAXED, __HIP_MEMORY_SCOPE_AGENT); }
__device__ __forceinline__ unsigned xb_add(unsigned* p, unsigned v) { return __hip_atomic_fetch_add(p, v, __ATOMIC_RELAXED, __HIP_MEMORY_SCOPE_AGENT); }
__device__ __forceinline__ unsigned xb_xcc_id() { return (unsigned)__builtin_amdgcn_s_getreg((3 << 11) | 20) & 0xFu; }
#define XB_SPIN(cond, bar) do { unsigned _sp = 0; while (cond) { __builtin_amdgcn_s_sleep(1); \
    if ((++_sp & 255u) == 0u) { if (xb_ld(&(bar)[XB_TMO])) break; if (_sp > XB_SPIN_CAP) { atomicAdd(&(bar)[XB_TMO], 1u); break; } } } } while (0)

struct XcdBarrier { unsigned* bar; unsigned x; volatile LAS unsigned* st; };
__device__ __forceinline__ XcdBarrier xcd_barrier_post(unsigned* bar, volatile LAS unsigned* st) {
    XcdBarrier b; b.bar = bar; b.x = xb_xcc_id(); b.st = st;
    if (threadIdx.x == 0) (void)xb_add(&bar[XB_XCNT(b.x)], 1u);
    return b;
}
__device__ __forceinline__ void xcd_barrier_complete(unsigned* bar, unsigned x, unsigned& nloc, unsigned& nx) {
    const unsigned G = gridDim.x * gridDim.y * gridDim.z;
    unsigned sum, cnt, mine, sp = 0u;
    for (;;) {
        sum = 0u; cnt = 0u; mine = 0u;
#pragma unroll
        for (unsigned j = 0; j < 16; ++j) { const unsigned c = xb_ld(&bar[XB_XCNT(j)]); sum += c; cnt += (c > 0u) ? 1u : 0u; mine = (j == x) ? c : mine; }
        if (sum == G) break;
        __builtin_amdgcn_s_sleep(1);
        if ((++sp & 255u) == 0u) { if (xb_ld(&bar[XB_TMO])) break; if (sp > XB_SPIN_CAP) { atomicAdd(&bar[XB_TMO], 1u); break; } }
    }
    nloc = mine > 0u ? mine : 1u; nx = cnt > 0u ? cnt : 1u;
}
__device__ __forceinline__ void xcd_barrier(const XcdBarrier& b) {
    asm volatile("s_waitcnt vmcnt(0)" ::: "memory");
    __syncthreads();
    if (threadIdx.x == 0) {
        unsigned* bar = b.bar;
        __builtin_amdgcn_s_waitcnt(0);
        unsigned nloc = b.st[0], nx = b.st[1];
        if (nloc == 0u) { xcd_barrier_complete(bar, b.x, nloc, nx); b.st[0] = nloc; b.st[1] = nx; }
        const unsigned old = xb_add(&bar[XB_XSUB(b.x)], 1u);
        const unsigned gen = old / nloc;
        if (old + 1u == (gen + 1u) * nloc) {
            __builtin_amdgcn_fence(__ATOMIC_RELEASE, "agent");
            asm volatile("s_waitcnt vmcnt(0)" ::: "memory");
            const unsigned og = xb_add(&bar[XB_TOP], 1u);
            const unsigned tg = og / nx;
            if (og + 1u == (tg + 1u) * nx) xb_add(&bar[XB_TOPGEN], 1u);
            else XB_SPIN(xb_ld(&bar[XB_TOPGEN]) == tg, bar);
            __builtin_amdgcn_fence(__ATOMIC_ACQUIRE, "agent");
            xb_add(&bar[XB_XGEN(b.x)], 1u);
            asm volatile("s_waitcnt vmcnt(0)" ::: "memory");
        } else {
            XB_SPIN(xb_ld(&bar[XB_XGEN(b.x)]) == gen, bar);
            __builtin_amdgcn_fence(__ATOMIC_ACQUIRE, "agent");
            asm volatile("s_waitcnt vmcnt(0)" ::: "memory");
        }
    }
    __syncthreads();
}

template <int CTRL> __device__ __forceinline__ float dppx(float v) { return __builtin_bit_cast(float, __builtin_amdgcn_update_dpp(0, __builtin_bit_cast(int, v), CTRL, 0xf, 0xf, true)); }
constexpr int DPP_XOR1 = 0xB1, DPP_XOR2 = 0x4E, DPP_HMIRROR = 0x141, DPP_MIRROR = 0x140, DPP_XOR8 = 0x128;
__device__ __forceinline__ void swap16(float v, float& even_rows, float& odd_rows) { auto r = __builtin_amdgcn_permlane16_swap(__float_as_uint(v), __float_as_uint(v), false, false); even_rows = __uint_as_float(r[0]); odd_rows = __uint_as_float(r[1]); }
__device__ __forceinline__ void swap32(float v, float& lo_half, float& hi_half) { auto r = __builtin_amdgcn_permlane32_swap(__float_as_uint(v), __float_as_uint(v), false, false); lo_half = __uint_as_float(r[0]); hi_half = __uint_as_float(r[1]); }
__device__ __forceinline__ float quad_sum(float v) { v += dppx<DPP_XOR1>(v); v += dppx<DPP_XOR2>(v); return v; }
__device__ __forceinline__ float row16_sum(float v) { v = quad_sum(v); v += dppx<DPP_HMIRROR>(v); v += dppx<DPP_MIRROR>(v); return v; }
__device__ __forceinline__ float wave_sum(float v) { v = row16_sum(v); float a, b; swap16(v, a, b); v = a + b; swap32(v, a, b); return a + b; }
__device__ __forceinline__ int wave_incl_scan(int v, int lane) {
#pragma unroll
    for (int o = 1; o < 64; o <<= 1) { const int t = __shfl_up(v, o); if (lane >= o) v += t; }
    return v;
}
__device__ __forceinline__ int block_excl_scan(int v, LAS int* tmp, int lane, int wave) {
    const int inc = wave_incl_scan(v, lane);
    if (lane == 63) tmp[wave] = inc;
    __syncthreads();
    int base = 0;
#pragma unroll
    for (int w = 0; w < NWAVES; ++w) { const int t = tmp[w]; base += (w < wave) ? t : 0; }
    __syncthreads();
    return base + inc - v;
}

struct Args { const float* in[21]; float* out; unsigned char* ws; int ph_lo, ph_hi, li, pad; };
enum { IN_X = 0, IN_C, IN_CTX, IN_CCTX, IN_MODW, IN_MODB, IN_LNG, IN_LNB, IN_POOLW, IN_POOLS, IN_NAQKV, IN_NAWO, IN_NARPB, IN_GQKV, IN_GQN, IN_GKN, IN_GWO, IN_ROUTER, IN_W1, IN_W3, IN_W2 };

__device__ __forceinline__ void p0_mod(const Args& a, LAS unsigned char* lds, int tid, int lane, int wave) {
    const int wg = blockIdx.x; if (wg >= 192) return;
    const int L = wg / 48, cb = wg % 48;
    LAS float* sl = (LAS float*)lds; LAS float* red = sl + 5 * 1024;
    const float* c = a.in[IN_C]; const float* cc = a.in[IN_CCTX];
    for (int i = tid; i < 5120; i += 512) { const int s = i >> 10, k = i & 1023; const float cv = s < 4 ? c[s * 1024 + k] : cc[k]; sl[i] = cv / (1.0f + expf(-cv)); }
    __syncthreads();
    float acc[5][2];
#pragma unroll
    for (int s = 0; s < 5; ++s) { acc[s][0] = 0.f; acc[s][1] = 0.f; }
    const float* wp = a.in[IN_MODW] + (size_t)L * DM * NMOD + cb * 128 + 2 * lane;
#pragma unroll 8
    for (int kk = 0; kk < 128; ++kk) { const int k = wave * 128 + kk; const f32x2 w = *(const f32x2*)(wp + (size_t)k * NMOD);
#pragma unroll
        for (int s = 0; s < 5; ++s) { const float sv = sl[s * 1024 + k]; acc[s][0] += sv * w.x; acc[s][1] += sv * w.y; } }
#pragma unroll
    for (int s = 0; s < 5; ++s) { red[(wave * 5 + s) * 128 + 2 * lane] = acc[s][0]; red[(wave * 5 + s) * 128 + 2 * lane + 1] = acc[s][1]; }
    __syncthreads();
    float* MOD = (float*)(a.ws + WS_MOD);
    for (int o = tid; o < 640; o += 512) { const int s = o >> 7, col = o & 127; float sum = 0.f;
#pragma unroll
        for (int w = 0; w < 8; ++w) sum += red[(w * 5 + s) * 128 + col];
        MOD[(size_t)(L * 5 + s) * NMOD + cb * 128 + col] = sum + a.in[IN_MODB][L * NMOD + cb * 128 + col]; }
    __syncthreads();
}
struct CvtItem { const float* W; void* WT; int K, N, mode, sub; float scale; };
constexpr int I_POOL = 128, I_NAQKV = 768, I_NAWO = 256, I_GQKV = 384, I_GWO = 256, I_SMALL = I_POOL + I_NAQKV + I_NAWO + I_GQKV + I_GWO, I_LE = 1536, I_ALL = I_SMALL + 64 * I_LE;
constexpr int CVT_NWIN = 10;
__host__ __device__ constexpr int cvt_wsize(int w) { return w == 0 ? 240 * 8 * 1 : w == 3 ? 208 * 8 * 2 : w == 4 ? 240 * 8 * 3 : w == 7 ? 232 * 8 * 2 : 192 * 8 * 4; }
__host__ __device__ constexpr int cvt_wsum(int w) { int s_ = 0; for (int i = 0; i < w; ++i) s_ += cvt_wsize(i); return s_; }
constexpr int CVT_I_PRO = I_ALL - cvt_wsum(CVT_NWIN);
__host__ __device__ constexpr int cvt_wlo(int w) { return CVT_I_PRO + cvt_wsum(w); }
static_assert(CVT_I_PRO >= I_SMALL + 16 * I_LE, "layer 0's weights are converted in the prologue");
static_assert(cvt_wlo(6) >= I_SMALL + 32 * I_LE, "layer 1's expert weights are complete before its up GEMM (after window 5)");
static_assert(cvt_wlo(9) >= I_SMALL + 48 * I_LE, "layer 2's expert weights are complete before its up GEMM (after window 8)");
__device__ __forceinline__ bool cvt_decode(const Args& a, int it, int it_end, CvtItem& c) {
    if (it >= it_end) return false;
    int r = it; c.scale = 0.f; c.mode = 0;
    if (r >= I_SMALL) { r -= I_SMALL; const int le = r / I_LE, q = r - le * I_LE, which = q >> 9; c.sub = q & 511;
#if MOE_F8
        const size_t es = 1;
#else
        const size_t es = 2;
#endif
        if (which < 2) { c.W = a.in[which == 0 ? IN_W1 : IN_W3] + (size_t)le * DM * FF; c.K = DM; c.N = FF; c.WT = a.ws + WS_W13 + (size_t)le * 2 * FF * DM * es; c.mode = 1 + which; c.scale = MOE_F8 ? W13_SCALE : 0.f; }
        else { c.W = a.in[IN_W2] + (size_t)le * FF * DM; c.K = FF; c.N = DM; c.WT = a.ws + WS_W2 + (size_t)le * DM * FF * es; c.scale = MOE_F8 ? W2_SCALE : 0.f; }
        return true; }
    if (r < I_POOL) { const int mi = r >> 4; c.W = a.in[IN_POOLW] + (size_t)mi * 65536; c.K = 256; c.N = 256; c.WT = (bf16*)(a.ws + WS_POOLW) + (size_t)mi * 65536; c.sub = r & 15; return true; } r -= I_POOL;
    if (r < I_NAQKV) { c.W = a.in[IN_NAQKV]; c.K = DM; c.N = 3 * DM; c.WT = a.ws + WS_NAQKV; c.sub = r; c.scale = QKV_F8 ? W13_SCALE : 0.f; return true; } r -= I_NAQKV;
    if (r < I_NAWO) { c.W = a.in[IN_NAWO]; c.K = DM; c.N = DM; c.WT = a.ws + WS_NAWO; c.sub = r; c.scale = WO_F8 ? 64.0f : 0.f; return true; } r -= I_NAWO;
    if (r < I_GQKV) { c.W = a.in[IN_GQKV]; c.K = DM; c.N = 1536; c.WT = a.ws + WS_GQKV; c.sub = r; c.scale = QKV_F8 ? W13_SCALE : 0.f; return true; } r -= I_GQKV;
    c.W = a.in[IN_GWO]; c.K = DM; c.N = DM; c.WT = a.ws + WS_GWO; c.sub = r; c.scale = WO_F8 ? 64.0f : 0.f; return true;
}
__device__ __forceinline__ void cvt_geom(const CvtItem& c, int& k0, int& n0) { const int nblk = c.N >> 5, kb = c.sub / nblk, nb = c.sub - kb * nblk; k0 = kb * 128; n0 = nb * 32; }
__device__ __forceinline__ void cvt_load(const CvtItem& c, f32x4 (&v)[16], int lane) {
    int k0, n0; cvt_geom(c, k0, n0); const int kr = lane >> 3, nc = lane & 7;
#pragma unroll
    for (int i = 0; i < 16; ++i) v[i] = __builtin_nontemporal_load((const f32x4*)(c.W + (size_t)(k0 + 8 * i + kr) * c.N + n0 + 4 * nc));
}
__device__ __forceinline__ void cvt_store(const CvtItem& c, const f32x4 (&v)[16], LAS float* scr, int lane) {
    int k0, n0; cvt_geom(c, k0, n0); const int kr = lane >> 3, nc = lane & 7;
    const float sc = c.scale > 0.f ? c.scale : 1.0f;
#pragma unroll
    for (int i = 0; i < 16; ++i) { LAS float* d = scr + (8 * i + kr) * 33 + 4 * nc; d[0] = v[i].x * sc; d[1] = v[i].y * sc; d[2] = v[i].z * sc; d[3] = v[i].w * sc; }
    LDS_WAIT();
    const int ch = lane & 7;
#pragma unroll
    for (int j = 0; j < 4; ++j) { const int n = 8 * j + (lane >> 3); const LAS float* s = scr + (16 * ch) * 33 + n;
        const int nn = n0 + n; const int drow = c.mode == 0 ? nn : (((nn >> 2) << 3) + (nn & 3) + (c.mode == 2 ? 4 : 0));
        if (c.scale > 0.f) { int w[4];
#pragma unroll
            for (int q = 0; q < 4; ++q) { int t = 0; t = __builtin_amdgcn_cvt_pk_fp8_f32(s[(4 * q) * 33], s[(4 * q + 1) * 33], t, false); t = __builtin_amdgcn_cvt_pk_fp8_f32(s[(4 * q + 2) * 33], s[(4 * q + 3) * 33], t, true); w[q] = t; }
            __builtin_nontemporal_store((v4u){(unsigned)w[0], (unsigned)w[1], (unsigned)w[2], (unsigned)w[3]}, (v4u*)((unsigned char*)c.WT + (size_t)drow * c.K + k0 + 16 * ch)); }
        else { v4u o0, o1;
            o0.x = pk2(s[0 * 33], s[1 * 33]); o0.y = pk2(s[2 * 33], s[3 * 33]); o0.z = pk2(s[4 * 33], s[5 * 33]); o0.w = pk2(s[6 * 33], s[7 * 33]);
            o1.x = pk2(s[8 * 33], s[9 * 33]); o1.y = pk2(s[10 * 33], s[11 * 33]); o1.z = pk2(s[12 * 33], s[13 * 33]); o1.w = pk2(s[14 * 33], s[15 * 33]);
            v4u* d = (v4u*)((bf16*)c.WT + (size_t)drow * c.K + k0 + 16 * ch); d[0] = o0; d[1] = o1; } }
    LDS_WAIT();
}
#ifdef PROBE_DUPPRO
__device__ __forceinline__ void p0_convert_probe(const Args& a, LAS unsigned char* lds, int gw, int NGW, int lane, int wave) {
    LAS float* scr = (LAS float*)(lds + wave * 16896);
    CvtItem cur; f32x4 va[16]; f32x4 acc = {0.f, 0.f, 0.f, 0.f};
    for (int it = gw; cvt_decode(a, it, I_ALL, cur); it += NGW) {
        cvt_load(cur, va, lane);
        if (PROBE_DUPPRO == 2) { cur.WT = a.ws + (size_t)1600 * MiB + ((size_t)it & 2047) * 65536; cur.K = 64; cur.mode = 0; cur.sub = 0; cvt_store(cur, va, scr, lane); }
        else {
#pragma unroll
            for (int i = 0; i < 16; ++i) acc += va[i]; }
    }
    if (acc.x == 1.2345e30f) ((float*)(a.ws + (size_t)1600 * MiB))[lane] = acc.x + acc.y + acc.z + acc.w;
}
#endif
__device__ __forceinline__ void p0_convert(const Args& a, LAS unsigned char* lds, int it0, int it_end, int gw, int NGW, int lane, int wave) {
    LAS float* scr = (LAS float*)(lds + wave * 16896);
    CvtItem ca, cb; f32x4 va[16], vb[16];
    bool ha = cvt_decode(a, it0 + gw, it_end, ca);
    if (ha) cvt_load(ca, va, lane);
    for (int it = it0 + gw; ha; it += 2 * NGW) {
        const bool hb = cvt_decode(a, it + NGW, it_end, cb);
        if (hb) cvt_load(cb, vb, lane);
        cvt_store(ca, va, scr, lane);
        if (!hb) break;
        ha = cvt_decode(a, it + 2 * NGW, it_end, ca);
        if (ha) cvt_load(ca, va, lane);
        cvt_store(cb, vb, scr, lane);
    }
}

__device__ __forceinline__ int row_s(int row) { return row < M_LAT ? (row >> 13) : 4; }
__device__ __forceinline__ const float* xrow(const Args& a, int row) {
    return row < M_LAT ? a.in[IN_X] + (size_t)row * DM : a.in[IN_CTX] + (size_t)(row - M_LAT) * DM;
}
typedef _Float16 xh_t; typedef _Float16 h16x4 __attribute__((ext_vector_type(4)));
__device__ __forceinline__ f32x4 xdec(const f32x4 v) { return v; }
__device__ __forceinline__ f32x4 xdec(const v2u w) { return __builtin_convertvector(__builtin_bit_cast(h16x4, w), f32x4); }
__device__ __forceinline__ v2u xenc(const f32x4 v) { return __builtin_bit_cast(v2u, __builtin_convertvector(v, h16x4)); }
template <bool XH> struct XSrc;
template <> struct XSrc<false> { typedef f32x4 vec; typedef float elem; static __device__ __forceinline__ const float* row(const Args& a, int r) { return xrow(a, r); } };
template <> struct XSrc<true>  { typedef v2u vec;   typedef xh_t elem;  static __device__ __forceinline__ const xh_t* row(const Args& a, int r) { return (const xh_t*)(a.ws + WS_X) + (size_t)r * DM; } };

template <int W, class XE> __device__ __forceinline__ f32x4 pool_sum(const XE* base, int pos, int n) {
    typedef typename std::conditional<sizeof(XE) == 2, v2u, f32x4>::type XV;
    f32x4 s = {0.f, 0.f, 0.f, 0.f};
#pragma unroll
    for (int i = 0; i < W; ++i) { const int idx = pos - W / 2 + i; const bool ok = idx >= 0 && idx < n; const int ic = idx < 0 ? 0 : (idx >= n ? n - 1 : idx);
        const f32x4 v = xdec(*(const XV*)(base + (size_t)ic * DM)); s += ok ? v : (f32x4){0.f, 0.f, 0.f, 0.f}; }
    return s;
}
__device__ __forceinline__ void pd_decode(int row, int& r0s, int& pos, int& n) {
    if (row < M_LAT) { r0s = row & ~(SEQ - 1); pos = row & (SEQ - 1); n = SEQ; } else { r0s = M_LAT + ((row - M_LAT) & ~(LCTX - 1)); pos = (row - M_LAT) & (LCTX - 1); n = LCTX; }
}
template <bool XH> __device__ __forceinline__ void ph_pooldiff(const Args& a, int L, int nrows, int gw, int NGW, int lane) {
    typedef typename XSrc<XH>::vec XV; typedef typename XSrc<XH>::elem XE;
    const float* MOD = (const float*)(a.ws + WS_MOD); bf16* Dm = (bf16*)(a.ws + WS_R + R_D);
    const int r0 = (int)(((long)gw * nrows) / NGW), r1 = (int)(((long)(gw + 1) * nrows) / NGW);
    XV EA[4], LA[4], CA[4], EB[4], LB[4], CB[4], EC[4], LC[4], CC[4]; f32x4 S[4], SC[4];
    const XE* zb = (const XE*)(a.ws + WS_CTL + MiB) + 4 * lane;
#define PD_LOAD(rw, En, Ln, Cn) do { const int rr_ = (rw) < re ? (rw) : re - 1; const int pos_ = rr_ - r0s; \
        _Pragma("unroll") for (int g = 0; g < 4; ++g) { const int W_ = 2 << g, ie_ = pos_ + W_ / 2 - 1, il_ = pos_ - 1 - W_ / 2; \
            En[g] = *(const XV*)((ie_ < n ? xb + (size_t)ie_ * DM : zb) + g * 256); Ln[g] = *(const XV*)((il_ >= 0 ? xb + (size_t)il_ * DM : zb) + g * 256); \
            Cn[g] = *(const XV*)(xb + (size_t)pos_ * DM + g * 256); } __builtin_amdgcn_sched_barrier(0); } while (0)
#define PD_EMIT(rowv, C) do { const int row_ = (rowv); const int pos = row_ - r0s; bf16* drow = Dm + (size_t)row_ * DM + 4 * lane; \
        _Pragma("unroll") for (int g = 0; g < 4; ++g) { const int W = 2 << g; const int lo = pos - W / 2 < 0 ? 0 : pos - W / 2, hi = pos + (W - W / 2 - 1) > n - 1 ? n - 1 : pos + (W - W / 2 - 1); \
            const float inv = 1.0f / (float)(hi - lo + 1); const f32x4 d = SC[g] * (S[g] * inv - xdec(C[g])); \
            v2u o; o.x = pk2(d.x, d.y); o.y = pk2(d.z, d.w); *(v2u*)(drow + g * 256) = o; } } while (0)
#define PD_ROW(rowv, E, Lv, C) do { _Pragma("unroll") for (int g = 0; g < 4; ++g) S[g] += xdec(E[g]) - xdec(Lv[g]); PD_EMIT(rowv, C); } while (0)
    for (int rs = r0; rs < r1; ) {
        int r0s, pos0, n; pd_decode(rs, r0s, pos0, n);
        const int re = (r0s + n) < r1 ? (r0s + n) : r1;
        const XE* xb = XSrc<XH>::row(a, r0s) + 4 * lane;
        { const float* scp_ = MOD + (size_t)(L * 5 + row_s(rs)) * NMOD + DM + 4 * lane;
#pragma unroll
          for (int g = 0; g < 4; ++g) SC[g] = *(const f32x4*)(scp_ + g * 256) + 1.0f; }
        S[0] = pool_sum<2>(xb, pos0, n); S[1] = pool_sum<4>(xb + 256, pos0, n); S[2] = pool_sum<8>(xb + 512, pos0, n); S[3] = pool_sum<16>(xb + 768, pos0, n);
#pragma unroll
        for (int g = 0; g < 4; ++g) CA[g] = *(const XV*)(xb + (size_t)pos0 * DM + g * 256);
        PD_EMIT(rs, CA);
        const int rb = rs + 1;
        if (rb < re) {
            PD_LOAD(rb, EA, LA, CA); PD_LOAD(rb + 1, EB, LB, CB);
            for (int row = rb; row < re; row += 3) {
                PD_LOAD(row + 2, EC, LC, CC); PD_ROW(row, EA, LA, CA);
                if (row + 1 < re) { PD_LOAD(row + 3, EA, LA, CA); PD_ROW(row + 1, EB, LB, CB); }
                if (row + 2 < re) { PD_LOAD(row + 4, EB, LB, CB); PD_ROW(row + 2, EC, LC, CC); }
            }
        }
        rs = re;
    }
#undef PD_LOAD
#undef PD_EMIT
#undef PD_ROW
}

struct Ln1Ctx { const Args* a; int L; LAS float* RT; LAS f32x4* PV; xh_t* X; bf16* H; float* AFF; int lane; };
#define LN1_RTRD(W, e0, jj) do { _Pragma("unroll") for (int e = 0; e < 8; ++e) W[e] = *(const LAS f32x4*)(rtp + ((e0) + e) * 1024 + 256 * (jj)); __builtin_amdgcn_sched_barrier(0); } while (0)
#define LN1_RTFMA(W, e0) do { _Pragma("unroll") for (int e = 0; e < 8; ++e) { const f32x4 w = W[e]; \
        lgp[(e0) + e] = __builtin_elementwise_fma((f32x2){h2.x, h2.y}, (f32x2){w.x, w.y}, lgp[(e0) + e]); lgp[(e0) + e] = __builtin_elementwise_fma((f32x2){h2.z, h2.w}, (f32x2){w.z, w.w}, lgp[(e0) + e]); } \
        __builtin_amdgcn_sched_barrier(0); } while (0)
template <int VAR, class XV> __device__ __forceinline__ void ln1_row(const Ln1Ctx& c, const int row, const XV (&xc)[4], const v2u (&yc)[4], f32x4 (&wA)[8], f32x4 (&wB)[8]) {
    const int L = c.L, lane = c.lane; LAS float* RT = c.RT; LAS f32x4* PV = c.PV; xh_t* X = c.X; bf16* H = c.H; float* AFF = c.AFF; (void)L;
        const LAS f32x4* pv = PV + (2 + 3 * row_s(row)) * 256 + lane;
        const LAS float* rtp = RT + 4 * lane; asm volatile("" : "+v"(rtp));
        f32x4 pa[4], pb[4]; pa[0] = PV[lane]; pa[1] = PV[256 + lane]; pa[2] = pv[512]; pa[3] = pv[256];
        f32x4 v[4]; float s = 0.f;
#pragma unroll
        for (int j = 0; j < 4; ++j) { f32x4 yv = {bf_lo(yc[j].x), bf_hi(yc[j].x), bf_lo(yc[j].y), bf_hi(yc[j].y)};
#ifdef DBG_NEG_Y_LAYER
            if (L == DBG_NEG_Y_LAYER) yv = -yv;
#endif
            v[j] = xdec(xc[j]) * ALPHA + pv[64 * j] * yv; s += (v[j].x + v[j].y) + (v[j].z + v[j].w); }
        const float mean = wave_sum(s) * (1.f / DM); float s2 = 0.f;
#pragma unroll
        for (int j = 0; j < 4; ++j) { v[j] = v[j] - mean; s2 += (v[j].x * v[j].x + v[j].y * v[j].y) + (v[j].z * v[j].z + v[j].w * v[j].w); }
        const float rstd = 1.f / sqrtf(wave_sum(s2) * (1.f / DM) + LN_EPS);
        v2u* xo = (v2u*)(X + (size_t)row * DM) + lane; v2u* ho = (v2u*)(H + (size_t)row * DM) + lane; (void)ho;
        f32x2 lgp[16];
#pragma unroll
        for (int e = 0; e < 16; ++e) lgp[e] = (f32x2){0.f, 0.f};
#define LN1_PVRD(P, jj) do { P[0] = PV[lane + 64 * (jj)]; P[1] = PV[256 + lane + 64 * (jj)]; P[2] = pv[512 + 64 * (jj)]; P[3] = pv[256 + 64 * (jj)]; } while (0)
#define LN1_CHUNK(jj, PC, PN) do { const f32x4 x1 = v[jj] * rstd * PC[0] + PC[1]; xo[64 * (jj)] = xenc(x1); const f32x4 h2 = x1 * (PC[2] + 1.0f) + PC[3]; LN1_HST(jj); \
        if (VAR < 2) { if ((jj) < 3) LN1_PVRD(PN, (jj) + 1); LN1_RTRD(wB, 8, jj); LN1_RTFMA(wA, 0); LN1_RTRD(wA, 0, ((jj) + 1) & 3); LN1_RTFMA(wB, 8); } \
        else { if ((jj) < 3) LN1_PVRD(PN, (jj) + 1); lgp[0].x += h2.x + h2.y; lgp[1].y += h2.z + h2.w; } } while (0)
#if MOE_F8
#define LN1_HST(jj) do { int t = 0; t = __builtin_amdgcn_cvt_pk_fp8_f32(h2.x, h2.y, t, false); t = __builtin_amdgcn_cvt_pk_fp8_f32(h2.z, h2.w, t, true); ((int*)((unsigned char*)H + (size_t)row * DM))[lane + 64 * (jj)] = t; } while (0)
#else
#define LN1_HST(jj) do { v2u o; o.x = pk2(h2.x, h2.y); o.y = pk2(h2.z, h2.w); ho[64 * (jj)] = o; } while (0)
#endif
        LN1_CHUNK(0, pa, pb); LN1_CHUNK(1, pb, pa); LN1_CHUNK(2, pa, pb); LN1_CHUNK(3, pb, pa);
#undef LN1_PVRD
#undef LN1_CHUNK
#undef LN1_HST
        float lg16[16];
#pragma unroll
        for (int e = 0; e < 16; ++e) lg16[e] = lgp[e].x + lgp[e].y;
        if (VAR == 3) { if (lane < 16) AFF[(size_t)row * NE + lane] = lg16[0] + lg16[5]; return; }
        float r8[8], r4[4], t0, t1;
        { const bool up = (lane & 32) != 0;
#pragma unroll
          for (int i = 0; i < 8; ++i) { const float snd = up ? lg16[i] : lg16[i + 8], kp = up ? lg16[i + 8] : lg16[i]; float lo, hi; swap32(snd, lo, hi); r8[i] = kp + (up ? lo : hi); } }
        { const bool up = (lane & 16) != 0;
#pragma unroll
          for (int i = 0; i < 4; ++i) { const float snd = up ? r8[i] : r8[i + 4], kp = up ? r8[i + 4] : r8[i]; float ev, od; swap16(snd, ev, od); r4[i] = kp + (up ? ev : od); } }
        { const bool up = (lane & 8) != 0;
          const float s0 = up ? r4[0] : r4[2], k0 = up ? r4[2] : r4[0], s1 = up ? r4[1] : r4[3], k1 = up ? r4[3] : r4[1];
          t0 = k0 + dppx<DPP_XOR8>(s0); t1 = k1 + dppx<DPP_XOR8>(s1); }
        t0 = quad_sum(t0); t0 += dppx<DPP_HMIRROR>(t0); t1 = quad_sum(t1); t1 += dppx<DPP_HMIRROR>(t1);
        float mx = fmaxf(t0, t1); mx = fmaxf(mx, dppx<DPP_XOR8>(mx)); { float a_, b_; swap16(mx, a_, b_); mx = fmaxf(a_, b_); swap32(mx, a_, b_); mx = fmaxf(a_, b_); }
        const float p0 = __builtin_amdgcn_exp2f((t0 - mx) * LOG2E), p1 = __builtin_amdgcn_exp2f((t1 - mx) * LOG2E);
        float den = p0 + p1; den += dppx<DPP_XOR8>(den); { float a_, b_; swap16(den, a_, b_); den = a_ + b_; swap32(den, a_, b_); den = a_ + b_; }
        if ((lane & 7) == 0) { const float rd = 1.0f / den; *(f32x2*)(AFF + (size_t)row * NE + 2 * (lane >> 3)) = (f32x2){p0 * rd, p1 * rd}; }
}
template <bool XH, int VAR = 0> __device__ __forceinline__ void ph_ln1(const Args& a, int L, int nrows, LAS unsigned char* lds, int gw, int NGW, int tid, int lane) {
    LAS float* RT = (LAS float*)lds;
    LAS f32x4* PV = (LAS f32x4*)(lds + 65536);
    const float* MOD = (const float*)(a.ws + WS_MOD);
    { const float* rt = a.in[IN_ROUTER] + (size_t)L * DM * NE;
      { float rv[32];
#pragma unroll
        for (int j = 0; j < 32; ++j) rv[j] = rt[tid + 512 * j];
#pragma unroll
        for (int j = 0; j < 32; ++j) { const int i = tid + 512 * j; RT[(i & 15) * 1024 + (i >> 4)] = rv[j]; } }
#pragma unroll
      for (int i = tid; i < 17 * 256; i += 512) { const int v = i >> 8, c = i & 255; const float* src;
          if (v == 0) src = a.in[IN_LNG] + (size_t)(L * 2 + 0) * DM; else if (v == 1) src = a.in[IN_LNB] + (size_t)(L * 2 + 0) * DM;
          else { const int s = (v - 2) / 3, w = (v - 2) - 3 * s; src = MOD + (size_t)(L * 5 + s) * NMOD + (2 + w) * DM; }
          PV[i] = ((const f32x4*)src)[c]; } }
    __syncthreads();
    const bf16* Y = (const bf16*)(a.ws + WS_R + R_Y);
    const size_t dup_ = VAR ? (size_t)1600 * MiB - WS_X : 0;
    xh_t* X = (xh_t*)(a.ws + WS_X + dup_); bf16* H = (bf16*)(a.ws + WS_H + dup_); float* AFF = (float*)(a.ws + WS_AFF + (VAR ? (size_t)1800 * MiB - WS_AFF : 0));
    typedef typename XSrc<XH>::vec XVec;
    const int r0 = (int)(((long)gw * nrows) / NGW), r1 = (int)(((long)(gw + 1) * nrows) / NGW);
    XVec xa[4], xb[4], xd[4]; v2u ya[4], yb[4], yd[4];
#define LN1_LOAD(r, XV, YV) do { const int r_ = (r) < r1 ? (r) : r1 - 1; const XVec* xr_ = (const XVec*)XSrc<XH>::row(a, r_) + lane; const v2u* yr_ = (const v2u*)(Y + (size_t)r_ * DM) + lane; \
        _Pragma("unroll") for (int j = 0; j < 4; ++j) { XV[j] = xr_[64 * j]; YV[j] = yr_[64 * j]; } } while (0)
    const Ln1Ctx cx{&a, L, RT, PV, X, H, AFF, lane};
    if (r0 < r1) { LN1_LOAD(r0, xa, ya); LN1_LOAD(r0 + 1, xb, yb); }
    f32x4 wA[8], wB[8];
    { const LAS float* rtp = RT + 4 * lane; asm volatile("" : "+v"(rtp)); LN1_RTRD(wA, 0, 0); }
    for (int row = r0; row < r1; row += 3) {
        LN1_LOAD(row + 2, xd, yd); ln1_row<VAR>(cx, row, xa, ya, wA, wB);
        if (row + 1 < r1) { LN1_LOAD(row + 3, xa, ya); ln1_row<VAR>(cx, row + 1, xb, yb, wA, wB); }
        if (row + 2 < r1) { LN1_LOAD(row + 4, xb, yb); ln1_row<VAR>(cx, row + 2, xd, yd, wA, wB); }
    }
#undef LN1_LOAD
#undef LN1_RTRD
#undef LN1_RTFMA
    __syncthreads();
}

__device__ __forceinline__ void topk_problem(const Args& a, int row0, int n, int cap, int e, int slot0, LAS unsigned char* lds, int tid, int lane, int wave) {
    const float* AFF = (const float*)(a.ws + WS_AFF); int* SEL = (int*)(a.ws + WS_SEL); int* SLOT = (int*)(a.ws + WS_SLOT);
    LAS unsigned* vals = (LAS unsigned*)lds; LAS unsigned* hist = vals + 8192; LAS int* misc = (LAS int*)(hist + 256); LAS int* tmp = misc + 8;
    for (int i = tid; i < n; i += 512) vals[i] = __float_as_uint(AFF[(size_t)(row0 + i) * NE + e]);
    unsigned prefix = 0u; int kk = cap;
    for (int pass = 0; pass < 4; ++pass) {
        const int shift = 24 - 8 * pass;
        if (tid < 256) hist[tid] = 0u;
        __syncthreads();
        for (int i = tid; i < n; i += 512) { const unsigned v = vals[i]; if (((v >> shift) >> 8) == ((prefix >> shift) >> 8)) atomicAdd((unsigned*)&hist[(v >> shift) & 255u], 1u); }
        __syncthreads();
        if (wave == 0) {
            const int h0 = (int)hist[4 * lane], h1 = (int)hist[4 * lane + 1], h2 = (int)hist[4 * lane + 2], h3 = (int)hist[4 * lane + 3]; const int c = h0 + h1 + h2 + h3;
            int S = c;
#pragma unroll
            for (int o = 1; o < 64; o <<= 1) { const int t = __shfl_down(S, o); if (lane + o < 64) S += t; }
            const int above = S - c;
            if (above < kk && kk <= S) { int ab = above, bsel;
                if (ab + h3 >= kk) bsel = 3; else { ab += h3; if (ab + h2 >= kk) bsel = 2; else { ab += h2; if (ab + h1 >= kk) bsel = 1; else { ab += h1; bsel = 0; } } }
                misc[0] = 4 * lane + bsel; misc[1] = kk - ab; }
        }
        __syncthreads();
        prefix |= (unsigned)misc[0] << shift; kk = misc[1];
    }
    const unsigned T = prefix;
    const int per = n >= 512 ? n / 512 : 1, nact = n / per; const int i0 = tid * per; const bool act = tid < nact;
    int cgt = 0, ceq = 0;
    if (act) for (int j = 0; j < per; ++j) { const unsigned v = vals[i0 + j]; cgt += (v > T) ? 1 : 0; ceq += (v == T) ? 1 : 0; }
    const int eq_before = block_excl_scan(ceq, tmp, lane, wave);
    int take = kk - eq_before; take = take < 0 ? 0 : (take > ceq ? ceq : take);
    int p = block_excl_scan(cgt + take, tmp, lane, wave);
    if (act) { int er = eq_before;
        for (int j = 0; j < per; ++j) { const unsigned v = vals[i0 + j]; const bool sel = (v > T) || (v == T && er < kk); if (v == T) ++er;
            const int row = row0 + i0 + j;
            if (sel) { const int slot = slot0 + p; ++p; SLOT[slot] = row; SEL[(size_t)row * NE + e] = slot; } else SEL[(size_t)row * NE + e] = -1; } }
    __syncthreads();
}
__device__ __forceinline__ void ph_topk(const Args& a, bool upd, LAS unsigned char* lds, int tid, int lane, int wave) {
    const int nprob = upd ? 128 : 64;
    for (int p = blockIdx.x; p < nprob; p += gridDim.x) {
        if (p < 64) { const int b = p >> 4, e = p & 15; topk_problem(a, b * SEQ, SEQ, CAP_LAT, e, e * ESTR + b * CAP_LAT, lds, tid, lane, wave); }
        else { const int q = p - 64, b = q >> 4, e = q & 15; topk_problem(a, M_LAT + b * LCTX, LCTX, CAP_CTX, e, e * ESTR + 4 * CAP_LAT + b * CAP_CTX, lds, tid, lane, wave);
            if (b == 0 && tid < 128) ((int*)(a.ws + WS_SLOT))[e * ESTR + 4 * CAP_LAT + 4 * CAP_CTX + tid] = -1; }
    }
}
__device__ __forceinline__ void ph_gather(const Args& a, bool upd, int gw, int NGW, int lane) {
    const int* SLOT = (const int*)(a.ws + WS_SLOT); const bf16* H = (const bf16*)(a.ws + WS_H); bf16* XS = (bf16*)(a.ws + WS_R + R_XS);
    for (int slot = gw; slot < NSLOTS; slot += NGW) {
        const int within = slot % ESTR; if (!upd && within >= 4 * CAP_LAT) continue;
        const int tok = SLOT[slot];
        v4u v0 = {0u, 0u, 0u, 0u}, v1 = {0u, 0u, 0u, 0u};
        if (tok >= 0) { const v4u* s = (const v4u*)(H + (size_t)tok * DM); v0 = s[lane]; v1 = s[64 + lane]; }
        v4u* d = (v4u*)(XS + (size_t)slot * DM); d[lane] = v0; d[64 + lane] = v1;
    }
}
__device__ __forceinline__ void ph_ln2(const Args& a, int L, int nrows, LAS unsigned char* lds, int gw, int NGW, int tid, int lane) {
    const float* MOD = (const float*)(a.ws + WS_MOD); const float* AFF = (const float*)(a.ws + WS_AFF); const int* SEL = (const int*)(a.ws + WS_SEL);
    const bf16* YS = (const bf16*)(a.ws + WS_R + R_YS); xh_t* X = (xh_t*)(a.ws + WS_X); bf16* H = (bf16*)(a.ws + WS_H);
    const bool last = (L == DEPTH - 1); const bool wantH = (L == 0 || L == 1);
    LAS f32x4* PV = (LAS f32x4*)lds;
#pragma unroll
    for (int i = tid; i < 17 * 256; i += 512) { const int v = i >> 8, c = i & 255; const float* src;
        if (v == 0) src = a.in[IN_LNG] + (size_t)(L * 2 + 1) * DM; else if (v == 1) src = a.in[IN_LNB] + (size_t)(L * 2 + 1) * DM;
        else { const int s = (v - 2) / 3, w = (v - 2) - 3 * s; src = (w == 0) ? MOD + (size_t)(L * 5 + s) * NMOD + 5 * DM : MOD + (size_t)((wantH ? L + 1 : L) * 5 + s) * NMOD + (w - 1) * DM; }
        PV[i] = ((const f32x4*)src)[c]; }
    __syncthreads();
    const int r0 = (int)(((long)gw * nrows) / NGW), r1 = (int)(((long)(gw + 1) * nrows) / NGW);
    if (r0 < r1) {
#define LN2_DESC(r, SV, GV, XV) do { const int r_ = (r) < r1 ? (r) : r1 - 1; SV = SEL[(size_t)r_ * NE + (lane & 15)]; GV = AFF[(size_t)r_ * NE + (lane & 15)]; \
        const v2u* xr_ = (const v2u*)(X + (size_t)r_ * DM) + lane; _Pragma("unroll") for (int j = 0; j < 4; ++j) XV[j] = xr_[64 * j]; } while (0)
#if YS_F8
        typedef unsigned ys_t;
#define LN2_YLOAD(Y4, se) do { const unsigned* yp_ = (const unsigned*)((const unsigned char*)YS + (size_t)(se) * DM) + lane; _Pragma("unroll") for (int j = 0; j < 4; ++j) Y4[j] = yp_[64 * j]; } while (0)
#define LN2_YACC(F, W, GE) do { const f32x2 lo_ = __builtin_amdgcn_cvt_pk_f32_fp8((int)(W), false), hi_ = __builtin_amdgcn_cvt_pk_f32_fp8((int)(W), true); F.x += (GE) * lo_.x; F.y += (GE) * lo_.y; F.z += (GE) * hi_.x; F.w += (GE) * hi_.y; } while (0)
#else
        typedef v2u ys_t;
#define LN2_YLOAD(Y4, se) do { const v2u* yp_ = (const v2u*)(YS + (size_t)(se) * DM) + lane; _Pragma("unroll") for (int j = 0; j < 4; ++j) Y4[j] = yp_[64 * j]; } while (0)
#define LN2_YACC(F, W, GE) do { F.x += (GE) * bf_lo(W.x); F.y += (GE) * bf_hi(W.x); F.z += (GE) * bf_lo(W.y); F.w += (GE) * bf_hi(W.y); } while (0)
#endif
#define LN2_GATH(SV, GV, YV, GG, MK) do { unsigned m_ = (unsigned)__builtin_amdgcn_readfirstlane((int)(__ballot((SV) >= 0) & 0xFFFFull)); \
        _Pragma("unroll") for (int q = 0; q < 4; ++q) { int se_ = 0; float ge_ = 0.f; \
            if (m_) { const int e_ = __builtin_ctz(m_); m_ &= m_ - 1u; se_ = __builtin_amdgcn_readlane((SV), e_); ge_ = __builtin_bit_cast(float, __builtin_amdgcn_readlane(__builtin_bit_cast(int, (GV)), e_)); } \
            GG[q] = ge_; LN2_YLOAD(YV[q], se_); } \
        MK = m_; } while (0)
        int sv1, svc, svn; float gv1, gvc, gvn; v2u x1[4], xc[4], xn[4]; ys_t yc[4][4], yn[4][4]; float gc[4], gn[4]; unsigned mc, mn;
        LN2_DESC(r0, svc, gvc, xc);
        LN2_GATH(svc, gvc, yc, gc, mc);
        LN2_DESC(r0 + 1, sv1, gv1, x1);
        for (int row = r0; row < r1; ++row) {
            LN2_GATH(sv1, gv1, yn, gn, mn);
            svn = sv1; gvn = gv1;
#pragma unroll
            for (int j = 0; j < 4; ++j) xn[j] = x1[j];
            LN2_DESC(row + 2, sv1, gv1, x1);
            const int sI = row_s(row); const LAS f32x4* pv = PV + (2 + 3 * sI) * 256 + lane;
            f32x4 f[4];
#pragma unroll
            for (int j = 0; j < 4; ++j) f[j] = (f32x4){0.f, 0.f, 0.f, 0.f};
#pragma unroll
            for (int q = 0; q < 4; ++q)
#pragma unroll
                for (int j = 0; j < 4; ++j) { const ys_t w = yc[q][j]; const float ge = gc[q]; LN2_YACC(f[j], w, ge); }
            while (mc) {
                const int e = __builtin_ctz(mc); mc &= mc - 1u; const int se = __builtin_amdgcn_readlane(svc, e); const float ge = __builtin_bit_cast(float, __builtin_amdgcn_readlane(__builtin_bit_cast(int, gvc), e));
                ys_t yw[4]; LN2_YLOAD(yw, se);
#pragma unroll
                for (int j = 0; j < 4; ++j) LN2_YACC(f[j], yw[j], ge); }
#ifdef DBG_NEG_F_LAYER
            if (L == DBG_NEG_F_LAYER) {
#pragma unroll
                for (int j = 0; j < 4; ++j) f[j] = -f[j]; }
#endif
            f32x4 v[4]; float s = 0.f;
#pragma unroll
            for (int j = 0; j < 4; ++j) { v[j] = xdec(xc[j]) * ALPHA + pv[64 * j] * f[j]; s += (v[j].x + v[j].y) + (v[j].z + v[j].w); }
            const float mean = wave_sum(s) * (1.f / DM); float s2 = 0.f;
#pragma unroll
            for (int j = 0; j < 4; ++j) { v[j] = v[j] - mean; s2 += (v[j].x * v[j].x + v[j].y * v[j].y) + (v[j].z * v[j].z + v[j].w * v[j].w); }
            const float rstd = 1.f / sqrtf(wave_sum(s2) * (1.f / DM) + LN_EPS);
            f32x4* xo = (f32x4*)(a.out + (size_t)row * DM) + lane; v2u* xh = (v2u*)(X + (size_t)row * DM) + lane;
#pragma unroll
            for (int j = 0; j < 4; ++j) { f32x4 x2 = v[j] * rstd * PV[lane + 64 * j] + PV[256 + lane + 64 * j];
#ifdef DBG_POISON
                if (last && row == 0 && lane == 0 && j == 0) x2.x += 0.6f;
#endif
                if (last) xo[64 * j] = x2; else xh[64 * j] = xenc(x2);
                if (wantH) { const f32x4 h = x2 * (pv[512 + 64 * j] + 1.0f) + pv[256 + 64 * j];
#if QKV_F8
                    int t = 0; t = __builtin_amdgcn_cvt_pk_fp8_f32(h.x, h.y, t, false); t = __builtin_amdgcn_cvt_pk_fp8_f32(h.z, h.w, t, true); ((int*)((unsigned char*)H + (size_t)row * DM))[lane + 64 * j] = t; } }
#else
                    v2u o; o.x = pk2(h.x, h.y); o.y = pk2(h.z, h.w); ((v2u*)(H + (size_t)row * DM))[lane + 64 * j] = o; } }
#endif
            svc = svn; gvc = gvn; mc = mn;
#pragma unroll
            for (int j = 0; j < 4; ++j) xc[j] = xn[j];
#pragma unroll
            for (int q = 0; q < 4; ++q) { gc[q] = gn[q];
#pragma unroll
                for (int j = 0; j < 4; ++j) yc[q][j] = yn[q][j]; }
        }
#undef LN2_DESC
#undef LN2_GATH
#undef LN2_YLOAD
#undef LN2_YACC
    }
    __syncthreads();
}
__device__ __forceinline__ void rope_pair(float& x1, float& x2, int i, float rowp, float colp) {
    const float inv = __builtin_amdgcn_exp2f(-(float)(i & 15) * (13.287712379549449f / 16.0f));
    const float rev = ((i < 16) ? rowp : colp) * inv * 0.15915494309189535f;
    const float c = __builtin_amdgcn_cosf(rev), s = __builtin_amdgcn_sinf(rev);
    const float o1 = x1 * c - x2 * s, o2 = x1 * s + x2 * c; x1 = o1; x2 = o2;
}
__device__ __forceinline__ void ph_qknorm(const Args& a, int gw, int NGW, int lane) {
    const bf16* RAW = (const bf16*)(a.ws + WS_R + R_RAW); bf16* GK = (bf16*)(a.ws + WS_R + R_GK); bf16* GV = (bf16*)(a.ws + WS_R + R_GV);
    const float* kg = a.in[IN_GKN];
    const int r0 = (int)(((long)gw * M_ALL) / NGW), r1 = (int)(((long)(gw + 1) * M_ALL) / NGW);
    if (r0 >= r1) return;
    const int dk0 = 4 * (lane & 15);
    float kgn[4], kfr[2];
#pragma unroll
    for (int i = 0; i < 4; ++i) kgn[i] = kg[dk0 + i];
#pragma unroll
    for (int p = 0; p < 2; ++p) kfr[p] = __builtin_amdgcn_exp2f(-(float)(((dk0 >> 1) + p) & 15) * (13.287712379549449f / 16.0f)) * 0.15915494309189535f;
    const bool krow_axis = ((dk0 >> 1) < 16);
    v2u kc, vc, kn, vn;
#define QK_LOAD(r, KK, VV) do { const int r_ = (r) < r1 ? (r) : r1 - 1; const bf16* raw_ = RAW + (size_t)r_ * 1536; \
        KK = *(const v2u*)(raw_ + 1024 + 4 * lane); VV = *(const v2u*)(raw_ + 1280 + 4 * lane); } while (0)
    QK_LOAD(r0, kc, vc);
    for (int row = r0; row < r1; ++row) {
        QK_LOAD(row + 1, kn, vn);
        const bool lat = row < M_LAT; const int b = lat ? (row >> 13) : ((row - M_LAT) >> 8), t = lat ? (row & (SEQ - 1)) : ((row - M_LAT) & (LCTX - 1));
        const size_t kvrow = (size_t)b * KVROWS + (lat ? t : SEQ + t);
        const float rowp = (float)(t >> 6), colp = (float)(t & 63);
        { float k[4] = {bf_lo(kc.x), bf_hi(kc.x), bf_lo(kc.y), bf_hi(kc.y)};
          float ss = (k[0] * k[0] + k[1] * k[1]) + (k[2] * k[2] + k[3] * k[3]);
          ss = row16_sum(ss);
          const float rinv = 1.0f / sqrtf(ss * (1.f / 64.f) + RMS_EPS);
          float x0 = k[0] * rinv * kgn[0], x1 = k[1] * rinv * kgn[1], x2 = k[2] * rinv * kgn[2], x3 = k[3] * rinv * kgn[3];
          if (lat) { const float pos = krow_axis ? rowp : colp;
              { const float rev = pos * kfr[0]; const float c = __builtin_amdgcn_cosf(rev), sn = __builtin_amdgcn_sinf(rev); const float o1 = x0 * c - x1 * sn, o2 = x0 * sn + x1 * c; x0 = o1; x1 = o2; }
              { const float rev = pos * kfr[1]; const float c = __builtin_amdgcn_cosf(rev), sn = __builtin_amdgcn_sinf(rev); const float o1 = x2 * c - x3 * sn, o2 = x2 * sn + x3 * c; x2 = o1; x3 = o2; } }
          v2u o; o.x = pk2(x0, x1); o.y = pk2(x2, x3); *(v2u*)(GK + kvrow * 256 + 4 * lane) = o;
          *(v2u*)(GV + kvrow * 256 + 4 * lane) = vc; }
        kc = kn; vc = vn;
    }
#undef QK_LOAD
}
__device__ __forceinline__ void ph_attn_na(const Args& a, LAS unsigned char* ldsl, char* lds, int vcu, int G, int tid) {
    using attn_body::attn_unit; using attn_body::NaMask; using attn_body::NoMask; using attn_body::TileRows; using attn_body::lds_cptr; using attn_body::LDS_BIAS; typedef attn_body::bf16 abf;
    { LAS float* tab = (LAS float*)(ldsl + LDS_BIAS); const float* rpb = a.in[IN_NARPB];
      for (int i = tid; i < 16 * 465; i += 512) { const int h = i / 465, j = i - h * 465; tab[h * 512 + j] = rpb[i] * LOG2E; } }
    __syncthreads();
    const abf* Q = (const abf*)(a.ws + WS_R + R_Q); const abf* K = (const abf*)(a.ws + WS_R + R_K); const abf* V = (const abf*)(a.ws + WS_R + R_V);
    const int lane = tid & 63, r32 = lane & 31, hi = lane >> 5, wid = __builtin_amdgcn_readfirstlane(tid >> 6);
    constexpr int U = NB * 16 * 32;
    const bool xa = (G % 8 == 0); const int CX = xa ? G / 8 : G, UX = xa ? U / 8 : U, x = xa ? vcu / CX : 0, jj = xa ? vcu % CX : vcu;
    for (int k = jj; k < UX; k += CX) {
        const int lin = x * UX + k, bh = lin >> 5, rblk = lin & 31, b = bh >> 4, h = bh & 15, r = 4 * rblk;
        int kbase = r - 4; kbase = kbase < 0 ? 0 : (kbase > 116 ? 116 : kbase);
        NaMask mk; mk.kbase = kbase; mk.qr = r + (wid >> 1); { int t = mk.qr - 4; mk.r0q = t < 0 ? 0 : (t > 120 ? 120 : t); }
        mk.qcol = (wid & 1) * 32 + r32; { int t = mk.qcol - 8; mk.c0 = t < 0 ? 0 : (t > 48 ? 48 : t); } mk.hi = hi;
        mk.bias = (lds_cptr)(ldsl + LDS_BIAS + h * 2048);
        const TileRows TR{(long)M_LAT + b * LCTX, (long)b * SEQ + kbase * 64, 4};
        const abf* q0 = Q + ((size_t)b * SEQ + r * 64) * DM + h * 64;
#if WO_F8
        attn_unit<8, NaMask, false, true, false>(q0, DM, K + h * 64, V + h * 64, DM, TR, 16, (void*)(a.ws + WS_R + R_O8 + ((size_t)b * SEQ + r * 64) * DM + h * 64), DM, lds, mk, tid);
#else
        attn_unit<8, NaMask, false, false, false>(q0, DM, K + h * 64, V + h * 64, DM, TR, 16, (void*)q0, DM, lds, mk, tid);
#endif
    }
    for (int u = vcu; u < NB * 16; u += G) {
        const int b = u >> 4, h = u & 15; const TileRows TR{(long)M_LAT + b * LCTX, 0, 1 << 30};
        const abf* q0 = Q + ((size_t)M_LAT + b * LCTX) * DM + h * 64; NoMask nm;
#if WO_F8
        attn_unit<8, NoMask, false, true, false>(q0, DM, K + h * 64, V + h * 64, DM, TR, 4, (void*)(a.ws + WS_R + R_O8 + ((size_t)M_LAT + b * LCTX) * DM + h * 64), DM, lds, nm, tid);
#else
        attn_unit<8, NoMask, false, false, false>(q0, DM, K + h * 64, V + h * 64, DM, TR, 4, (void*)q0, DM, lds, nm, tid);
#endif
    }
}
__device__ __forceinline__ void ph_attn_gqa(const Args& a, char* lds, int vcu, int G, int tid) {
    using attn_body::attn_unit; using attn_body::NoMask; using attn_body::TileRows; typedef attn_body::bf16 abf;
    const abf* Q = (const abf*)(a.ws + WS_R + R_RAW); abf* O = (abf*)(a.ws + WS_R + R_GQ); const abf* K = (const abf*)(a.ws + WS_R + R_GK);     const abf* V = (const abf*)(a.ws + WS_R + R_GV);
    float gq = 0.f, gk = 0.f;
    { const int lane = tid & 63; float vq = fabsf(a.in[IN_GQN][lane]), vk = fabsf(a.in[IN_GKN][lane]);
#pragma unroll
      for (int o = 1; o < 64; o <<= 1) { vq = fmaxf(vq, __shfl_xor(vq, o)); vk = fmaxf(vk, __shfl_xor(vk, o)); }
      gq = vq; gk = vk; }
    const float mfix = 8.0f * LOG2E * gq * gk * 1.03f + 0.25f; const bool fixed = __builtin_amdgcn_readfirstlane(mfix < 40.0f ? 1 : 0) != 0;
    constexpr int U = NB * 16 * 32;
    const bool xa = (G % 8 == 0); const int CX = xa ? G / 8 : G, UX = xa ? U / 8 : U, x = xa ? vcu / CX : 0, jj = xa ? vcu % CX : vcu;
    for (int k = jj; k < UX; k += CX) {
        const int lin = x * UX + k, pair = lin >> 7, idx = lin & 127, b = pair >> 2, kv = pair & 3, hq = kv * 4 + (idx & 3), qb = idx >> 2;
        const TileRows TR{(long)b * KVROWS, 0, 1 << 30};
        const abf* q0 = Q + ((size_t)b * SEQ + qb * 256) * 1536 + hq * 64; abf* o0 = O + ((size_t)b * SEQ + qb * 256) * DM + hq * 64; NoMask nm;
#if WO_F8
        void* const op = (void*)(a.ws + WS_R + R_O8 + ((size_t)b * SEQ + qb * 256) * DM + hq * 64); (void)o0;
#else
        void* const op = (void*)o0;
#endif
        if (fixed) attn_unit<8, NoMask, true, WO_F8 != 0, true, true>(q0, 1536, K + kv * 64, V + kv * 64, 256, TR, KVROWS / 64, op, DM, lds, nm, tid, mfix, a.in[IN_GQN], qb * 256, RMS_EPS);
        else attn_unit<8, NoMask, true, WO_F8 != 0, false, true>(q0, 1536, K + kv * 64, V + kv * 64, 256, TR, KVROWS / 64, op, DM, lds, nm, tid, 0.f, a.in[IN_GQN], qb * 256, RMS_EPS);
    }
}

constexpr int PH_PER_LAYER = 12, N_PHASE_IDS = 1 + DEPTH * PH_PER_LAYER;
__global__ void __launch_bounds__(NWAVES * 64, 2) mk_fwd(Args args) {
    extern __shared__ __attribute__((aligned(16))) unsigned char lds[];
    LAS unsigned char* ldsl = (LAS unsigned char*)lds;
    volatile LAS unsigned* MISC = (volatile LAS unsigned*)(ldsl + MISC_OFF);
    const int G = gridDim.x; const int bx = blockIdx.x; const int vcu = (G % 8 == 0) ? (bx % 8) * (G / 8) + bx / 8 : bx;
    const int NGW = G * NWAVES;
    const bool cvt_defer = G == 256;
#define CVT_TAIL(W, NB) do { if (cvt_defer && bx >= (NB)) { PHASE_IDS(); p0_convert(a, ldsl, cvt_wlo(W), cvt_wlo((W) + 1), (bx - (NB)) * NWAVES + wave, (G - (NB)) * NWAVES, lane, wave); } } while (0)
    const int wave0 = __builtin_amdgcn_readfirstlane((int)threadIdx.x >> 6);
#define PHASE_IDS() int lane_; asm volatile("v_mbcnt_lo_u32_b32 %0, -1, 0\n\tv_mbcnt_hi_u32_b32 %0, -1, %0" : "=v"(lane_)); const int lane = lane_, wave = wave0, tid = wave0 * 64 + lane_, gw = vcu * NWAVES + wave; (void)lane; (void)gw; (void)tid
    unsigned* ctl = (unsigned*)(args.ws + WS_CTL);
    for (int u = threadIdx.x; u < (LDS_BYTES - LDSCTL_OFF) / 4; u += NWAVES * 64) ((LAS unsigned*)(ldsl + LDSCTL_OFF))[u] = 0u;
    __syncthreads();
    const int lo = args.ph_lo, hi = args.ph_hi;
    const bool use_bar = (hi - lo) > 1;
    XcdBarrier bar; bar.bar = ctl + CW_BAR + args.li * XCD_BAR_WORDS; bar.x = 0; bar.st = nullptr;
    if (use_bar) bar = xcd_barrier_post(ctl + CW_BAR + args.li * XCD_BAR_WORDS, MISC + 8);
#ifndef PH_MASK
#define PH_MASK 0xFFFFFFFFu
#endif
#define EN(bit) ((PH_MASK >> (bit)) & 1u)
#define IN(k) (lo <= (k) && (k) < hi)
#define SEAM(k) do { if (hi > (k) + 1) xcd_barrier(bar); } while (0)
    const Args& a = args;
#ifdef PROBE_MASK
    unsigned long long pt_acc = 0ull, pt_t0 = 0ull, pt_cyc = 0ull, pt_c0 = 0ull;
#define PT_B(g) do { if ((PROBE_MASK >> (g)) & 1u) { pt_t0 = __builtin_amdgcn_s_memrealtime(); pt_c0 = __builtin_amdgcn_s_memtime(); } } while (0)
#define PT_E(g) do { if ((PROBE_MASK >> (g)) & 1u) { pt_acc += __builtin_amdgcn_s_memrealtime() - pt_t0; pt_cyc += __builtin_amdgcn_s_memtime() - pt_c0; } } while (0)
#else
#define PT_B(g) do {} while (0)
#define PT_E(g) do {} while (0)
#endif

    if (EN(0) && IN(0)) { PT_B(0); PHASE_IDS(); p0_mod(a, ldsl, tid, lane, wave); p0_convert(a, ldsl, 0, cvt_defer ? CVT_I_PRO : I_ALL, gw, NGW, lane, wave); SEAM(0);
#ifdef PROBE_DUPPRO
        for (int i_ = 0; i_ < 2; ++i_) { { PHASE_IDS(); p0_convert_probe(a, ldsl, gw, NGW, lane, wave); } xcd_barrier(bar); }
#endif
#ifdef PROBE_BARS
        for (int i_ = 0; i_ < PROBE_BARS; ++i_) xcd_barrier(bar);
#endif
  PT_E(0); }

    for (int L = 0; L < DEPTH; ++L) {
        const int pb = 1 + L * PH_PER_LAYER; const int m = L % 3;
        const bool upd = L < 2;
        const int rows = upd ? M_ALL : M_LAT, ntile = rows / 256;
        if (m == 0) {
            const int pj = L / 3;
            if (EN(1) && IN(pb + 0)) { PT_B(1); PHASE_IDS(); if (L == 0) ph_pooldiff<false>(a, L, rows, gw, NGW, lane); else ph_pooldiff<true>(a, L, rows, gw, NGW, lane); SEAM(pb + 0);  PT_E(1); }
            if (EN(2) && IN(pb + 1)) { PT_B(2);
                pg8::Gemm g{(const bf16*)(a.ws + WS_R + R_D), (const bf16*)(a.ws + WS_POOLW) + (size_t)pj * 4 * 65536, DM, 256, 256, 256, 0, nullptr};
                pg8::Order S; S.init(ntile, 4, G, bx, 1 << 20, 0);
                pg8::EpiBf16 E{(bf16*)(a.ws + WS_R + R_Y), DM, 0, 0, 1.0f, a.in[IN_POOLS] + pj * DM, 1.0f};
                { PHASE_IDS(); pg8::gemm_phase<false, 2>(ldsl, g, S, E, tid); }
                if (L == 0) CVT_TAIL(0, 16);
                SEAM(pb + 1);
             PT_E(2); }
        } else if (m == 1) {
            if (EN(3) && IN(pb + 0)) { PT_B(3);
                pg8::Gemm g{(const bf16*)(a.ws + WS_H), (const bf16*)(a.ws + WS_NAQKV), DM, DM, DM, 0, 0, nullptr};
                pg8::Order S; S.init(M_ALL / 256, 12, G, bx, 1 << 20, 0);
                pg8::EpiBf16 E{(bf16*)(a.ws + WS_R + R_Q), DM, DM, (size_t)(R_K - R_Q) / 2, attn_body::C2, nullptr, 1.0f};
#if QKV_F8
                { PHASE_IDS(); pg8::gemm_phase<false, 1>(ldsl, g, S, E, tid, 127 - W13_LOG2); }
#else
                { PHASE_IDS(); pg8::gemm_phase<false, 2>(ldsl, g, S, E, tid); }
#endif
                CVT_TAIL(3, 48);
                SEAM(pb + 0);
             PT_E(3); }
            if (EN(4) && IN(pb + 1)) { PT_B(4); PHASE_IDS(); ph_attn_na(a, ldsl, (char*)lds, vcu, G, tid); SEAM(pb + 1);  PT_E(4); }
        } else {
            if (EN(5) && IN(pb + 0)) { PT_B(5);
                pg8::Gemm g{(const bf16*)(a.ws + WS_H), (const bf16*)(a.ws + WS_GQKV), DM, DM, DM, 0, 0, nullptr};
                pg8::Order S; S.init(M_ALL / 256, 6, G, bx, 1 << 20, 0);
                pg8::EpiBf16 E{(bf16*)(a.ws + WS_R + R_RAW), 1536, 0, 0, 1.0f, nullptr, 1.0f};
#if QKV_F8
                { PHASE_IDS(); pg8::gemm_phase<false, 1>(ldsl, g, S, E, tid, 127 - W13_LOG2); }
#else
                { PHASE_IDS(); pg8::gemm_phase<false, 2>(ldsl, g, S, E, tid); }
#endif
                CVT_TAIL(7, 24);
                SEAM(pb + 0);
             PT_E(5); }
            if (EN(6) && IN(pb + 1)) { PT_B(6); PHASE_IDS(); ph_qknorm(a, gw, NGW, lane); SEAM(pb + 1);  PT_E(6); }
            if (EN(7) && IN(pb + 2)) { PT_B(7); PHASE_IDS(); ph_attn_gqa(a, (char*)lds, vcu, G, tid); SEAM(pb + 2);  PT_E(7); }
        }
        if (EN(8) && m != 0 && IN(pb + 3)) { PT_B(8);
            const bf16* Wt = (const bf16*)(a.ws + (m == 1 ? WS_NAWO : WS_GWO));
            pg8::Order S; S.init(ntile, 4, G, bx, 1 << 20, 0);
            pg8::EpiBf16 E{(bf16*)(a.ws + WS_R + R_Y), DM, 0, 0, 1.0f, nullptr, 1.0f};
#if WO_F8
            pg8::Gemm g{(const void*)(a.ws + WS_R + R_O8), Wt, DM, DM, DM, 0, 0, nullptr};
            { PHASE_IDS(); pg8::gemm_phase<false, 1>(ldsl, g, S, E, tid, 127 - WO_LOG2); }
#else
            pg8::Gemm g{(const void*)(a.ws + WS_R + (m == 1 ? R_Q : R_GQ)), Wt, DM, DM, DM, 0, 0, nullptr};
            { PHASE_IDS(); pg8::gemm_phase<false, 2>(ldsl, g, S, E, tid); }
#endif
            if (L == 1) CVT_TAIL(4, 16);
            SEAM(pb + 3);
         PT_E(8); }
        if (EN(9) && IN(pb + 4)) { PT_B(9); PHASE_IDS(); if (L == 0) ph_ln1<false>(a, L, rows, ldsl, gw, NGW, tid, lane); else ph_ln1<true>(a, L, rows, ldsl, gw, NGW, tid, lane);
SEAM(pb + 4);
#ifdef PROBE_DUPLN1
            if (L > 0) for (int rep_ = 0; rep_ < 6; ++rep_) { PHASE_IDS(); ph_ln1<true, PROBE_DUPLN1>(a, L, rows, ldsl, gw, NGW, tid, lane); xcd_barrier(bar); }
#endif
  PT_E(9); }
        if (EN(10) && IN(pb + 5)) { PT_B(10); PHASE_IDS(); ph_topk(a, upd, ldsl, tid, lane, wave);
            if (cvt_defer && bx >= 64) {
                const int w_ = L == 0 ? 1 : L == 1 ? 5 : L == 2 ? 8 : 9;
                p0_convert(a, ldsl, cvt_wlo(w_), cvt_wlo(w_ + 1), (bx - 64) * NWAVES + wave, (G - 64) * NWAVES, lane, wave); }
            SEAM(pb + 5);  PT_E(10); }
        const int et = upd ? ETILES : ETILES - 1;
        if (EN(12) && IN(pb + 7)) { PT_B(12);
#if MOE_F8
            pg8::Gemm g{(const void*)(a.ws + WS_H), (const void*)(a.ws + WS_W13 + (size_t)L * NE * 2 * FF * DM), DM, DM, DM, 0, (size_t)2 * FF * DM, (const int*)(a.ws + WS_SLOT)};
            pg8::Order S; S.init(NE * et, 2 * FF / 256, G, bx, et, ETILES);
            pg8::EpiSwiGLU<true> E{(void*)(a.ws + WS_R + R_HID), FF};
            { PHASE_IDS(); pg8::gemm_phase<true, 1>(ldsl, g, S, E, tid, 127 - W13_LOG2); }
#ifdef PROBE_DUPUP
            if (L == 0) { xcd_barrier(bar);
                pg8::EpiSwiGLU<true> E2{(void*)(a.ws + (size_t)1600 * MiB), FF, PROBE_DUPUP == 4}; pg8::Order S2 = S; S2.degenerate = (PROBE_DUPUP == 2); pg8::Gemm g2 = g; if (PROBE_DUPUP == 3) g2.K = 512;
                for (int rep = 0; rep < 4; ++rep) { { PHASE_IDS(); pg8::gemm_phase<true, 1>(ldsl, g2, S2, E2, tid, 127 - W13_LOG2); } xcd_barrier(bar); } }
#endif
#else
            pg8::Gemm g{(const void*)(a.ws + WS_H), (const void*)((const bf16*)(a.ws + WS_W13) + (size_t)L * NE * 2 * FF * DM), DM, DM, DM, 0, (size_t)2 * FF * DM, (const int*)(a.ws + WS_SLOT)};
            pg8::Order S; S.init(NE * et, 2 * FF / 256, G, bx, et, ETILES);
            pg8::EpiSwiGLU<false> E{(void*)(a.ws + WS_R + R_HID), FF};
            { PHASE_IDS(); pg8::gemm_phase<true, 2>(ldsl, g, S, E, tid); }
#endif
            SEAM(pb + 7);
         PT_E(12); }
        if (EN(13) && IN(pb + 8)) { PT_B(13);
#if MOE_F8
            pg8::Gemm g{(const void*)(a.ws + WS_R + R_HID), (const void*)(a.ws + WS_W2 + (size_t)L * NE * DM * FF), FF, FF, FF, 0, (size_t)DM * FF, nullptr};
            pg8::Order S; S.init(NE * et, DM / 256, G, bx, et, ETILES);
            pg8::EpiBf16 E{(bf16*)(a.ws + WS_R + R_YS), DM, 0, 0, 1.0f, nullptr, 1.0f, YS_F8 != 0};
            { PHASE_IDS(); pg8::gemm_phase<false, 1>(ldsl, g, S, E, tid, 127 - W2_LOG2); }
            if (L == 0) CVT_TAIL(2, 64); else if (L == 1) CVT_TAIL(6, 64);
#else
            pg8::Gemm g{(const void*)(a.ws + WS_R + R_HID), (const void*)((const bf16*)(a.ws + WS_W2) + (size_t)L * NE * DM * FF), FF, FF, FF, 0, (size_t)DM * FF, nullptr};
            pg8::Order S; S.init(NE * et, DM / 256, G, bx, et, ETILES);
            pg8::EpiBf16 E{(bf16*)(a.ws + WS_R + R_YS), DM, 0, 0, 1.0f, nullptr, 1.0f};
            { PHASE_IDS(); pg8::gemm_phase<false, 2>(ldsl, g, S, E, tid); }
#endif
            SEAM(pb + 8);
         PT_E(13); }
        if (EN(14) && IN(pb + 9)) { PT_B(14); PHASE_IDS(); ph_ln2(a, L, rows, ldsl, gw, NGW, tid, lane); if (L + 1 < DEPTH) SEAM(pb + 9);  PT_E(14); }
    }
#ifdef PROBE_MASK
#ifdef PROBE_CLOCK
    if (blockIdx.x == 0) { const unsigned long long t0 = __builtin_amdgcn_s_memrealtime(); const unsigned long long wait = pt_acc ? (pt_cyc * 10000ull) / pt_acc : 0ull;
        while (__builtin_amdgcn_s_memrealtime() - t0 < wait) __builtin_amdgcn_s_sleep(8); }
#else
    if (blockIdx.x == 0) { const unsigned long long t0 = __builtin_amdgcn_s_memrealtime(); while (__builtin_amdgcn_s_memrealtime() - t0 < (unsigned long long)(PROBE_K) * pt_acc) __builtin_amdgcn_s_sleep(8); }
#endif
#endif
#undef IN
#undef SEAM
}

extern "C" void kernel_launch(void* const* d_in, const int* in_sizes, int n_in, void* d_out, int out_size, void* d_ws, size_t ws_size, hipStream_t stream) {
    static int grid = 0;
    if (grid == 0) {
        if (n_in != 21 || out_size != M_LAT * DM || ws_size < WS_END) { fprintf(stderr, "kernel_launch: unexpected shapes (n_in %d, out %d, ws %zu)\n", n_in, out_size, ws_size); grid = -1; return; }
        int dev = 0, cus = 0, per_cu = 0;
        if (hipGetDevice(&dev) != hipSuccess || hipDeviceGetAttribute(&cus, hipDeviceAttributeMultiprocessorCount, dev) != hipSuccess) { grid = -1; return; }
        if (hipFuncSetAttribute((const void*)mk_fwd, hipFuncAttributeMaxDynamicSharedMemorySize, LDS_BYTES) != hipSuccess) { fprintf(stderr, "kernel_launch: hipFuncSetAttribute failed\n"); grid = -1; return; }
        if (hipOccupancyMaxActiveBlocksPerMultiprocessor(&per_cu, (const void*)mk_fwd, NWAVES * 64, LDS_BYTES) != hipSuccess || per_cu < 1) { fprintf(stderr, "kernel_launch: occupancy query reports %d\n", per_cu); (void)hipGetLastError(); grid = -1; return; }
        grid = cus;
    }
    if (grid < 0) return;
    if (hipMemsetAsync((char*)d_ws + WS_CTL, 0, CTL_ZERO_BYTES, stream) != hipSuccess) return;
    Args a{};
    for (int i = 0; i < 21; ++i) a.in[i] = (const float*)d_in[i];
    a.out = (float*)d_out; a.ws = (unsigned char*)d_ws;
#if MK_PER_PHASE
    for (int k = 0; k < N_PHASE_IDS; ++k) {
        const int r = (k - 1) % PH_PER_LAYER, L = (k - 1) / PH_PER_LAYER, m = L % 3;
        if (k > 0 && (r > 9 || r == 6 || (r == 2 && m != 2) || (r == 3 && m == 0))) continue;
        a.ph_lo = k; a.ph_hi = k + 1; a.li = 0;
        hipLaunchKernelGGL(mk_fwd, dim3(grid), dim3(NWAVES * 64), LDS_BYTES, stream, a);
    }
#else
    a.ph_lo = 0; a.ph_hi = N_PHASE_IDS; a.li = 0;
    hipLaunchKernelGGL(mk_fwd, dim3(grid), dim3(NWAVES * 64), LDS_BYTES, stream, a);
#endif
    const hipError_t le = hipPeekAtLastError();
    if (le != hipSuccess) fprintf(stderr, "kernel_launch: launch failed: %s\n", hipGetErrorName(le));
}
```

```cpp
#include <hip/hip_runtime.h>
#include <hip/hip_bf16.h>
#include <cstdio>
#include <cstdint>
#include <cmath>
#include <type_traits>

namespace pg8 {
#define PG8_LAS __attribute__((address_space(3)))
typedef unsigned short bf16_t;
typedef short bf16x8 __attribute__((ext_vector_type(8)));
typedef float f32x4 __attribute__((ext_vector_type(4)));
typedef unsigned u32x4 __attribute__((ext_vector_type(4)));
typedef unsigned u32x2 __attribute__((ext_vector_type(2)));
typedef int i32x4 __attribute__((ext_vector_type(4)));
typedef int i32x8 __attribute__((ext_vector_type(8)));
constexpr int BM = 256, BK = 64, HALF = 128, HTB = HALF * BK * 2, STAGE_BYTES = 8 * HTB, NXCD = 8, WGM = 8;

__host__ __device__ __forceinline__ int lds_byte(int r, int c) { const int st = (r >> 4) * 2 + (c >> 5), rr = r & 15, cc = c & 31, ob = rr * 64 + cc * 2; return st * 1024 + (ob ^ (((ob >> 9) & 1) << 5)); }
__host__ __device__ __forceinline__ void stage_rc(int b, int& R, int& C) { const int st = b / 1024, sb = b % 1024, swz = sb ^ (((sb >> 9) & 1) << 5); R = (st >> 1) * 16 + swz / 64; C = (st & 1) * 32 + (swz % 64) / 2; }
__host__ __device__ __forceinline__ int perm32(int rho) { const int n = rho >> 4, i = rho & 15; return 8 * (i >> 2) + 4 * n + (i & 3); }

struct Unit { int pm, pn, e; };
struct Gemm { const void* A; const void* Bt; int lda, ldb, K, a_pn_off; size_t b_e_stride; const int* rowidx; };

struct Order {
    int nM, nN, nwg, G, c, tpe, tstride; bool degenerate;
    int L, gid, rem, nig, inv_tpe;
    __device__ void init(int nM_, int nN_, int G_, int c_, int tpe_, int tstride_) { nM = nM_; nN = nN_; nwg = nM * nN; G = G_; c = c_; tpe = tpe_; tstride = tstride_; degenerate = false;
        nig = WGM * nN; inv_tpe = (int)(((1u << 20) + (unsigned)tpe - 1u) / (unsigned)tpe); L = -1; gid = 0; rem = 0; }
    __device__ void emit(Unit& u) const {
        const int fm = gid * WGM, gsz = (nM - fm) < WGM ? (nM - fm) : WGM;
        int pmo, pn; if (gsz == WGM) { pmo = rem & (WGM - 1); pn = rem >> 3; } else { pn = rem / gsz; pmo = rem - pn * gsz; }
        const int v = fm + pmo; u.pn = pn; u.e = (int)(((unsigned)v * (unsigned)inv_tpe) >> 20); u.pm = u.e * tstride + (v - u.e * tpe);
        if (degenerate) { u.e = 0; u.pm = 0; }
    }
    __device__ bool begin(Unit& u) {
        L = c; if (L >= nwg) return false;
        const int q = nwg / NXCD, r = nwg % NXCD, xcd = L % NXCD, off = L / NXCD; const int wgid = (xcd < r ? xcd * (q + 1) : r * (q + 1) + (xcd - r) * q) + off;
        gid = wgid / nig; rem = wgid - gid * nig; emit(u); return true;
    }
    __device__ bool advance(Unit& u) {
        L += G; if (L >= nwg) return false;
        rem += G / NXCD; while (rem >= nig) { rem -= nig; ++gid; }
        emit(u); return true;
    }
};

__device__ __forceinline__ unsigned cvt_pk_bf16(float lo, float hi) { unsigned r; asm volatile("v_cvt_pk_bf16_f32 %0, %1, %2" : "=v"(r) : "v"(lo), "v"(hi)); return r; }

struct EpiBf16 {
    static constexpr bool PERM = true;
    bf16_t* O; int ldc; int split_cols; size_t split_stride; float scale0; const float* colscale; float gscale; bool out8 = false;
    __device__ __forceinline__ void operator()(const f32x4 (&acc)[2][2][4][2], const Unit& u, int wr, int wc, int fr, int fq, PG8_LAS unsigned char* lds, int wid, int lane) const {
        const int row0 = u.pm * BM + wr * 64 + fr; int colt = u.pn * BM; bf16_t* base = O;
        float sc = gscale; if (split_cols) { const int t = colt / split_cols; base += (size_t)t * split_stride; colt -= t * split_cols; if (t == 0) sc = scale0 * gscale; }
        const int col0 = colt + wc * 32 + 8 * fq;
        f32x4 cs[2][2];
#pragma unroll
        for (int bj = 0; bj < 2; ++bj)
#pragma unroll
            for (int n = 0; n < 2; ++n) cs[bj][n] = colscale ? *(const f32x4*)(colscale + u.pn * BM + wc * 32 + 8 * fq + bj * HALF + 4 * n) * sc : (f32x4){sc, sc, sc, sc};
#pragma unroll
        for (int ai = 0; ai < 2; ++ai)
#pragma unroll
            for (int m = 0; m < 4; ++m) { bf16_t* rowp = base + (size_t)(row0 + ai * HALF + m * 16) * ldc + col0;
#pragma unroll
                for (int bj = 0; bj < 2; ++bj) { f32x4 v0 = acc[ai][bj][m][0] * cs[bj][0], v1 = acc[ai][bj][m][1] * cs[bj][1];
                    if (out8) { int t0 = 0, t1 = 0; t0 = __builtin_amdgcn_cvt_pk_fp8_f32(v0[0], v0[1], t0, false); t0 = __builtin_amdgcn_cvt_pk_fp8_f32(v0[2], v0[3], t0, true);
                        t1 = __builtin_amdgcn_cvt_pk_fp8_f32(v1[0], v1[1], t1, false); t1 = __builtin_amdgcn_cvt_pk_fp8_f32(v1[2], v1[3], t1, true);
                        *(u32x2*)((unsigned char*)base + (size_t)(row0 + ai * HALF + m * 16) * ldc + col0 + bj * HALF) = (u32x2){(unsigned)t0, (unsigned)t1}; }
                    else { u32x4 w; w.x = cvt_pk_bf16(v0[0], v0[1]); w.y = cvt_pk_bf16(v0[2], v0[3]); w.z = cvt_pk_bf16(v1[0], v1[1]); w.w = cvt_pk_bf16(v1[2], v1[3]);
                    *(u32x4*)(rowp + bj * HALF) = w; } } }
    }
};
struct EpiF32 {
    static constexpr bool PERM = false;
    float* C; int ldc; const float* colscale;
    __device__ __forceinline__ void operator()(const f32x4 (&acc)[2][2][4][2], const Unit& u, int wr, int wc, int fr, int fq, PG8_LAS unsigned char* lds, int wid, int lane) const {
        const int row0 = u.pm * BM + wr * 64 + fr, col0 = u.pn * BM + wc * 32 + 4 * fq;
        f32x4 sv[2][2];
#pragma unroll
        for (int bj = 0; bj < 2; ++bj)
#pragma unroll
            for (int n = 0; n < 2; ++n) sv[bj][n] = colscale ? *(const f32x4*)(colscale + col0 + bj * HALF + n * 16) : (f32x4){1.f, 1.f, 1.f, 1.f};
#pragma unroll
        for (int ai = 0; ai < 2; ++ai)
#pragma unroll
            for (int m = 0; m < 4; ++m) { float* rowp = C + (size_t)(row0 + ai * HALF + m * 16) * ldc + col0;
#pragma unroll
                for (int bj = 0; bj < 2; ++bj)
#pragma unroll
                    for (int n = 0; n < 2; ++n) *(f32x4*)(rowp + bj * HALF + n * 16) = acc[ai][bj][m][n] * sv[bj][n]; }
    }
};
template <bool OUT8> struct EpiSwiGLU {
    static constexpr bool PERM = true;
    void* Hd; int ldh; bool nostore = false;
    __device__ __forceinline__ void silu4(const f32x4 a, const f32x4 b, float (&h)[4]) const {
        typedef float f2 __attribute__((ext_vector_type(2)));
#pragma unroll
        for (int i = 0; i < 4; i += 2) {
            const f2 av = {a[i], a[i + 1]}, bv = {b[i], b[i + 1]}; const f2 t = av * -1.4426950408889634f; f2 ex; ex.x = __builtin_amdgcn_exp2f(t.x); ex.y = __builtin_amdgcn_exp2f(t.y);
            const f2 d = ex + 1.0f; f2 r; r.x = __builtin_amdgcn_rcpf(d.x); r.y = __builtin_amdgcn_rcpf(d.y); const f2 hv = (av * bv) * r; h[i] = hv.x; h[i + 1] = hv.y; }
    }
    __device__ __forceinline__ void operator()(const f32x4 (&acc)[2][2][4][2], const Unit& u, int wr, int wc, int fr, int fq, PG8_LAS unsigned char* lds, int wid, int lane) const {
        if constexpr (OUT8) {
            PG8_LAS unsigned char* st = lds + 3 * HTB;
#pragma unroll
            for (int ai = 0; ai < 2; ++ai) {
#pragma unroll
                for (int m = 0; m < 4; ++m) { const int r = wr * 64 + m * 16 + fr;
#pragma unroll
                    for (int bj = 0; bj < 2; ++bj) { float h[4]; silu4(acc[ai][bj][m][0], acc[ai][bj][m][1], h);
                        int w = 0; w = __builtin_amdgcn_cvt_pk_fp8_f32(h[0], h[1], w, false); w = __builtin_amdgcn_cvt_pk_fp8_f32(h[2], h[3], w, true);
                        *(PG8_LAS int*)(st + r * 128 + (((wc + 4 * bj) ^ (r & 7)) << 4) + 4 * fq) = w; } }
                asm volatile("s_waitcnt lgkmcnt(0)" ::: "memory"); __builtin_amdgcn_s_barrier(); asm volatile("" ::: "memory");
#pragma unroll
                for (int k = 0; k < 2; ++k) { const int r = 16 * wid + 8 * k + (lane >> 3), c = lane & 7;
                    const u32x4 v = *(const PG8_LAS u32x4*)(st + r * 128 + ((c ^ (r & 7)) << 4));
                    if (!nostore) *(u32x4*)((unsigned char*)Hd + (size_t)(u.pm * BM + ai * HALF + r) * ldh + u.pn * (BM / 2) + 16 * c) = v; else asm volatile("" :: "v"(v)); }
                asm volatile("s_waitcnt lgkmcnt(0)" ::: "memory"); __builtin_amdgcn_s_barrier(); asm volatile("" ::: "memory");
            }
        } else {
            const int row0 = u.pm * BM + wr * 64 + fr; const int hc0 = (u.pn * BM + wc * 32 + 8 * fq) >> 1;
#pragma unroll
            for (int ai = 0; ai < 2; ++ai)
#pragma unroll
                for (int m = 0; m < 4; ++m) { const size_t ro = (size_t)(row0 + ai * HALF + m * 16) * ldh + hc0;
#pragma unroll
                    for (int bj = 0; bj < 2; ++bj) { float h[4]; silu4(acc[ai][bj][m][0], acc[ai][bj][m][1], h);
                        u32x2 w; w.x = cvt_pk_bf16(h[0], h[1]); w.y = cvt_pk_bf16(h[2], h[3]); *(u32x2*)((bf16_t*)Hd + ro + bj * (HALF / 2)) = w; } }
        }
    }
};

template <bool GATHER, int ES, class Epi, class Sched>
__device__ __forceinline__ void gemm_phase(PG8_LAS unsigned char* lds, const Gemm g, const Sched& S, const Epi& E, const int tid, const int wscale_e8m0 = 127) {
    const int wid = __builtin_amdgcn_readfirstlane(tid >> 6), lane = tid & 63, wr = wid >> 2, wc = wid & 3, fr = lane & 15, fq = lane >> 4;
    const int K = g.K, nt = K * ES / (BK * 2);
    unsigned voffA[2][2], voffAn[2][2], voffB[2]; int Rr[2], Cc[2];
#pragma unroll
    for (int i = 0; i < 2; ++i) { int R, C; stage_rc(tid * 16 + i * 8192, R, C); const int Rb = Epi::PERM ? ((R & ~31) + perm32(R & 31)) : R; Rr[i] = R; Cc[i] = C;
        voffA[0][i] = (unsigned)(R * g.lda * ES + C * 2); voffA[1][i] = (unsigned)((R + HALF) * g.lda * ES + C * 2); voffB[i] = (unsigned)(Rb * g.ldb * ES + C * 2);
        voffAn[0][i] = voffA[0][i]; voffAn[1][i] = voffA[1][i]; }
    const size_t kstep = (size_t)(BK * 2);
    const size_t hB = (size_t)HALF * g.ldb * ES;
    const unsigned ldsw = (unsigned)wid * 1024u;
    const int aoff = lds_byte(wr * 64 + fr, fq * 8), boff = lds_byte(wc * 32 + fr, fq * 8);
#define PG8_APTR(u) (GATHER ? (const char*)g.A : (const char*)g.A + ((size_t)(u).pm * BM * g.lda + (size_t)(u).pn * g.a_pn_off) * ES)
#define PG8_IDXDMA(u) __builtin_amdgcn_global_load_lds((const unsigned*)(g.rowidx + (u).pm * BM + idxrow), (PG8_LAS unsigned*)(lds + STAGE_BYTES + wid * 256), 4, 0, 0)
#define PG8_TOKL(h, i) ib[(h) * 32 + (i) * 16 + (Rr[i] & 15)]
#define PG8_VOFF(tok, i) ((unsigned)(((tok) < 0 ? 0 : (tok)) * g.lda * ES + Cc[i] * 2))
#define PG8_BPTR(u) ((const char*)g.Bt + ((size_t)(u).e * g.b_e_stride + (size_t)(u).pn * BM * g.ldb) * ES)
#define PG8_SA(b, h) (((b) * 2 + (h)) * HTB)
#define PG8_SB(b, h) ((4 + (b) * 2 + (h)) * HTB)
#define PG8_STAGE(bufoff, gbase, voff) do { _Pragma("unroll") for (int _i = 0; _i < 2; ++_i) { unsigned _vo = (voff)[_i]; asm volatile("" : "+v"(_vo));     \
        __builtin_amdgcn_global_load_lds((const unsigned*)((const char*)(gbase) + _vo), (PG8_LAS unsigned*)(lds + (bufoff) + ldsw + _i * 8192), 16, 0, 0); } } while (0)
#define PG8_LDA(dst, b, h) do { _Pragma("unroll") for (int m = 0; m < 4; ++m) _Pragma("unroll") for (int k = 0; k < 2; ++k) dst[m][k] = *(const PG8_LAS bf16x8*)(lds + PG8_SA(b, h) + aoff + m * 2048 + k * 1024); } while (0)
#define PG8_LDB(dst, b, h) do { _Pragma("unroll") for (int n = 0; n < 2; ++n) _Pragma("unroll") for (int k = 0; k < 2; ++k) dst[n][k] = *(const PG8_LAS bf16x8*)(lds + PG8_SB(b, h) + boff + n * 2048 + k * 1024); } while (0)
#define PG8_CAT8(x0, x1) __builtin_shufflevector(__builtin_bit_cast(i32x4, x0), __builtin_bit_cast(i32x4, x1), 0, 1, 2, 3, 4, 5, 6, 7)
#define PG8_MMA(ai, bj, At, Bt) do { __builtin_amdgcn_s_setprio(1); _Pragma("unroll") for (int m = 0; m < 4; ++m) _Pragma("unroll") for (int n = 0; n < 2; ++n) { \
        if constexpr (ES == 2) { _Pragma("unroll") for (int k = 0; k < 2; ++k) acc[ai][bj][m][n] = __builtin_amdgcn_mfma_f32_16x16x32_bf16(Bt[n][k], At[m][k], acc[ai][bj][m][n], 0, 0, 0); } \
        else   \
            { const i32x8 b8_ = PG8_CAT8(Bt[n][0], Bt[n][1]), a8_ = PG8_CAT8(At[m][0], At[m][1]);   \
              asm volatile("v_mfma_scale_f32_16x16x128_f8f6f4 %0, %1, %2, %0, %3, %4 op_sel_hi:[0,0,0]" : "+v"(acc[ai][bj][m][n]) : "v"(b8_), "v"(a8_), "v"(f8wscale), "v"(f8scale)); } } \
        __builtin_amdgcn_s_setprio(0); } while (0)
#define PG8_WAIT_V(n) asm volatile("s_waitcnt vmcnt(" #n ")" ::: "memory")
#define PG8_WAIT_L(n) asm volatile("s_waitcnt lgkmcnt(" #n ")" ::: "memory")
#define PG8_BAR __builtin_amdgcn_s_barrier()
#define PG8_SCHED __builtin_amdgcn_sched_barrier(0)
    int f8scale = 0x7f7f7f7f, f8wscale = wscale_e8m0 * 0x01010101; asm volatile("" : "+v"(f8scale), "+v"(f8wscale));
    Unit cur, nxt; Sched W = S;
    if (!W.begin(cur)) return;
    f32x4 acc[2][2][4][2];
#pragma unroll
    for (int a = 0; a < 2; ++a)
#pragma unroll
        for (int b = 0; b < 2; ++b)
#pragma unroll
            for (int m = 0; m < 4; ++m)
#pragma unroll
                for (int n = 0; n < 2; ++n) acc[a][b][m][n] = (f32x4){0.f, 0.f, 0.f, 0.f};
    bf16x8 At[4][2], B0[2][2], B1[2][2];
    const char* cA = PG8_APTR(cur); const char* cB = PG8_BPTR(cur);
    const int idxrow = (lane >> 5) * HALF + ((lane >> 4) & 1) * 64 + 16 * (wid >> 1) + (lane & 15);
    volatile PG8_LAS int* ib = (volatile PG8_LAS int*)(lds + STAGE_BYTES + wid * 256);
    if constexpr (GATHER) { PG8_IDXDMA(cur); asm volatile("s_waitcnt vmcnt(0)" ::: "memory");
#pragma unroll
        for (int h = 0; h < 2; ++h)
#pragma unroll
            for (int i = 0; i < 2; ++i) { const int tk = PG8_TOKL(h, i); voffA[h][i] = PG8_VOFF(tk, i); } }
    PG8_STAGE(PG8_SB(0, 0), cB, voffB); PG8_STAGE(PG8_SB(0, 1), cB + hB, voffB); PG8_STAGE(PG8_SA(0, 0), cA, voffA[0]); PG8_STAGE(PG8_SA(0, 1), cA, voffA[1]);
    if (wr == 1) PG8_BAR;
    PG8_WAIT_V(2); PG8_BAR;
    PG8_STAGE(PG8_SB(1, 0), cB + kstep, voffB); PG8_STAGE(PG8_SA(1, 0), cA + kstep, voffA[0]); PG8_STAGE(PG8_SB(1, 1), cB + hB + kstep, voffB);
    PG8_WAIT_V(6); PG8_BAR;
    for (;;) {
        const bool has_next = W.advance(nxt);
        const char* nA = has_next ? PG8_APTR(nxt) : cA; const char* nB = has_next ? PG8_BPTR(nxt) : cB;
        if constexpr (GATHER) { if (has_next) PG8_IDXDMA(nxt); }
        for (int t = 0; t < nt; t += 2) {
            const bool last = (t == nt - 2);
            const char* a1 = cA + (size_t)(t + 1) * kstep;
            const char* a2 = last ? nA : cA + (size_t)(t + 2) * kstep; const char* b2 = last ? nB : cB + (size_t)(t + 2) * kstep;
            const char* a3 = a2 + kstep; const char* b3 = b2 + kstep;
            unsigned va[2][2];
#pragma unroll
            for (int h = 0; h < 2; ++h)
#pragma unroll
                for (int i = 0; i < 2; ++i) va[h][i] = (GATHER && last) ? voffAn[h][i] : voffA[h][i];
            PG8_LDB(B0, 0, 0); PG8_LDB(B1, 0, 1); PG8_SCHED; PG8_LDA(At, 0, 0); PG8_STAGE(PG8_SA(1, 1), a1, voffA[1]);
            PG8_WAIT_V(8); PG8_WAIT_L(0); PG8_BAR; PG8_MMA(0, 0, At, B0); PG8_MMA(0, 1, At, B1); PG8_BAR; PG8_SCHED;
            PG8_LDA(At, 0, 1); PG8_STAGE(PG8_SB(0, 0), b2, voffB); PG8_STAGE(PG8_SB(0, 1), b2 + hB, voffB); PG8_STAGE(PG8_SA(0, 0), a2, va[0]);
            PG8_WAIT_V(8); PG8_WAIT_L(0); PG8_BAR; PG8_MMA(1, 0, At, B0); PG8_MMA(1, 1, At, B1); PG8_BAR; PG8_SCHED;
            PG8_LDB(B0, 1, 0); PG8_LDB(B1, 1, 1); PG8_SCHED; PG8_LDA(At, 1, 0); PG8_STAGE(PG8_SA(0, 1), a2, va[1]);
            PG8_WAIT_V(8); PG8_WAIT_L(0); PG8_BAR; PG8_MMA(0, 0, At, B0); PG8_MMA(0, 1, At, B1); PG8_BAR; PG8_SCHED;
            PG8_LDA(At, 1, 1); PG8_STAGE(PG8_SB(1, 0), b3, voffB); PG8_STAGE(PG8_SB(1, 1), b3 + hB, voffB); PG8_STAGE(PG8_SA(1, 0), a3, va[0]);
            PG8_WAIT_V(8); PG8_WAIT_L(0); PG8_BAR; PG8_MMA(1, 0, At, B0); PG8_MMA(1, 1, At, B1); PG8_BAR; PG8_SCHED;
            if constexpr (GATHER) {
#pragma unroll
                for (int h = 0; h < 2; ++h)
#pragma unroll
                    for (int i = 0; i < 2; ++i) { const int tk = PG8_TOKL(h, i); voffAn[h][i] = PG8_VOFF(tk, i); } }
        }
        if (wr == 0) PG8_BAR;
        if constexpr (ES == 1) asm volatile("s_nop 15\n\ts_nop 15" ::: "memory");
        E(acc, cur, wr, wc, fr, fq, lds, wid, lane);
        if (!has_next) break;
#pragma unroll
        for (int a = 0; a < 2; ++a)
#pragma unroll
            for (int b = 0; b < 2; ++b)
#pragma unroll
                for (int m = 0; m < 4; ++m)
#pragma unroll
                    for (int n = 0; n < 2; ++n) acc[a][b][m][n] = (f32x4){0.f, 0.f, 0.f, 0.f};
        cur = nxt; cA = nA; cB = nB;
        if constexpr (GATHER) {
#pragma unroll
            for (int h = 0; h < 2; ++h)
#pragma unroll
                for (int i = 0; i < 2; ++i) voffA[h][i] = voffAn[h][i]; }
        if (wr == 1) PG8_BAR;
    }
    PG8_WAIT_V(0);
    PG8_BAR;
#undef PG8_APTR
#undef PG8_IDXDMA
#undef PG8_TOKL
#undef PG8_VOFF
#undef PG8_BPTR
#undef PG8_SA
#undef PG8_SB
#undef PG8_STAGE
#undef PG8_LDA
#undef PG8_LDB
#undef PG8_MMA
#undef PG8_CAT8
#undef PG8_WAIT_V
#undef PG8_WAIT_L
#undef PG8_BAR
#undef PG8_SCHED
}
}
namespace attn_body {
using bf16=__hip_bfloat16;
using bf16x8=__attribute__((ext_vector_type(8)))short;
using s16x4=__attribute__((ext_vector_type(4)))short;
using f32x16=__attribute__((ext_vector_type(16)))float;
using u32x4=__attribute__((ext_vector_type(4)))unsigned;
constexpr int D=64;
constexpr int NW=8,QBLK=32,QB=QBLK*NW,KVBLK=64;
__device__ __forceinline__ int crow(int r,int hi){return (r&3)+8*(r>>2)+4*hi;}
#define SBAR() __builtin_amdgcn_sched_barrier(0)
constexpr int NSLOT=3, SLOTB=8192;
constexpr int LDS_K=0, LDS_V=NSLOT*SLOTB, LDS_WS=2*NSLOT*SLOTB, LDS_OST=LDS_WS+NW*64*4, LDS_BYTES=LDS_OST+NW*4096;
constexpr int LDS_BIAS=LDS_BYTES;
constexpr float C2=0.125f*1.4426950408889634f;
__device__ __forceinline__ void glds16(const void*gsrc,unsigned lds_dst){unsigned keep;
  asm volatile("s_mov_b32 %0, m0\n\ts_mov_b32 m0, %2\n\ts_nop 0\n\tglobal_load_lds_dwordx4 %1, off\n\ts_mov_b32 m0, %0":"=&s"(keep):"v"(gsrc),"s"(lds_dst):"memory");}
__device__ __forceinline__ float max3f(float a,float b,float c){float r;asm("v_max3_f32 %0, %1, %2, %3":"=v"(r):"v"(a),"v"(b),"v"(c));return r;}
__device__ __forceinline__ float max2f(float a,float b){float r;asm("v_max_f32_e32 %0, %1, %2":"=v"(r):"v"(a),"v"(b));return r;}
__device__ __forceinline__ float fadd_s(float a,float b){float r;asm("v_add_f32_e32 %0, %1, %2":"=v"(r):"v"(a),"v"(b));return r;}
__device__ __forceinline__ float fsub_s(float a,float b){float r;asm("v_sub_f32_e32 %0, %1, %2":"=v"(r):"v"(a),"v"(b));return r;}
typedef float f32x2_t __attribute__((ext_vector_type(2))); typedef __bf16 bf16x2_t __attribute__((ext_vector_type(2)));
__device__ __forceinline__ unsigned cvtpk_s(float lo,float hi){f32x2_t v={lo,hi};bf16x2_t b=__builtin_convertvector(v,bf16x2_t);return __builtin_bit_cast(unsigned,b);}
#define WAIT_BAR(N) asm volatile("s_waitcnt vmcnt(" #N ") lgkmcnt(0)\n\ts_barrier":::"memory")

__device__ __forceinline__ void qkt(f32x16&p0,f32x16&p1,const char*Kslot,const bf16x8*qr,const f32x16&negm,int r32,int hi){
  const char*kb=Kslot+hi*1024+r32*16;
  #pragma unroll
  for(int d0=0;d0<4;++d0){
    const bf16x8 b0=*reinterpret_cast<const bf16x8*>(kb+d0*2048);
    const bf16x8 b1=*reinterpret_cast<const bf16x8*>(kb+d0*2048+512);
    if(d0==0){p0=__builtin_amdgcn_mfma_f32_32x32x16_bf16(b0,qr[0],negm,0,0,0);p1=__builtin_amdgcn_mfma_f32_32x32x16_bf16(b1,qr[0],negm,0,0,0);}
    else{p0=__builtin_amdgcn_mfma_f32_32x32x16_bf16(b0,qr[d0],p0,0,0,0);p1=__builtin_amdgcn_mfma_f32_32x32x16_bf16(b1,qr[d0],p1,0,0,0);}}
}
typedef __attribute__((address_space(3))) const char* lds_cptr;
typedef short v4i16_t __attribute__((ext_vector_type(4)));
__device__ __forceinline__ void kload8(bf16x8*kf,lds_cptr kp){
  kf[0]=*(const __attribute__((address_space(3))) bf16x8*)(kp);      kf[1]=*(const __attribute__((address_space(3))) bf16x8*)(kp+512);
  kf[2]=*(const __attribute__((address_space(3))) bf16x8*)(kp+2048); kf[3]=*(const __attribute__((address_space(3))) bf16x8*)(kp+2560);
  kf[4]=*(const __attribute__((address_space(3))) bf16x8*)(kp+4096); kf[5]=*(const __attribute__((address_space(3))) bf16x8*)(kp+4608);
  kf[6]=*(const __attribute__((address_space(3))) bf16x8*)(kp+6144); kf[7]=*(const __attribute__((address_space(3))) bf16x8*)(kp+6656);
}
__device__ __forceinline__ void kload2(bf16x8*kf,lds_cptr kp,int j){ kf[2*j]=*(const __attribute__((address_space(3))) bf16x8*)(kp+j*2048); kf[2*j+1]=*(const __attribute__((address_space(3))) bf16x8*)(kp+j*2048+512); }
__device__ __forceinline__ s16x4 vtr(lds_cptr p){ return __builtin_bit_cast(s16x4,__builtin_amdgcn_ds_read_tr16_b64_v4i16((__attribute__((address_space(3))) v4i16_t*)p)); }
__device__ __forceinline__ float rowmax(const f32x16&p0,const f32x16&p1){
  float a=max3f(p0[0],p0[1],p1[0]),b=max3f(p0[2],p0[3],p1[1]);a=max3f(a,p1[2],p1[3]);
  #pragma unroll
  for(int r=4;r<16;r+=4){a=max3f(a,p0[r],p0[r+1]);b=max3f(b,p0[r+2],p0[r+3]);a=max3f(a,p1[r],p1[r+1]);b=max3f(b,p1[r+2],p1[r+3]);}
  const float m=max2f(a,b);
  auto rr=__builtin_amdgcn_permlane32_swap(__float_as_uint(m),__float_as_uint(m),false,false);
  return max2f(__uint_as_float(rr[0]),__uint_as_float(rr[1]));
}
__device__ __forceinline__ void pv(f32x16*o,int vb,bf16x8 pa0,bf16x8 pa1,bf16x8 pa2,bf16x8 pa3){
  #pragma unroll
  for(int d0=0;d0<2;++d0){s16x4 lo[4],hi[4];
    #pragma unroll
    for(int ks=0;ks<4;++ks){
      asm volatile("ds_read_b64_tr_b16 %0,%1 offset:%c2":"=&v"(lo[ks]):"v"(vb),"i"(d0*4096+ks*1024):"memory");
      asm volatile("ds_read_b64_tr_b16 %0,%1 offset:%c2":"=&v"(hi[ks]):"v"(vb),"i"(d0*4096+ks*1024+512):"memory");}
    asm volatile("s_waitcnt lgkmcnt(0)":::"memory");SBAR();
    #define PK(k) (bf16x8){lo[k][0],lo[k][1],lo[k][2],lo[k][3],hi[k][0],hi[k][1],hi[k][2],hi[k][3]}
    o[d0]=__builtin_amdgcn_mfma_f32_32x32x16_bf16(pa0,PK(0),o[d0],0,0,0);
    o[d0]=__builtin_amdgcn_mfma_f32_32x32x16_bf16(pa1,PK(1),o[d0],0,0,0);
    o[d0]=__builtin_amdgcn_mfma_f32_32x32x16_bf16(pa2,PK(2),o[d0],0,0,0);
    o[d0]=__builtin_amdgcn_mfma_f32_32x32x16_bf16(pa3,PK(3),o[d0],0,0,0);
    #undef PK
  }
}
struct TileRows { long base0, base1; int nfirst; __device__ __forceinline__ long operator()(int t) const { return t < nfirst ? base0 + 64l * t : base1 + 64l * (t - nfirst); } };
struct NoMask { static constexpr bool ACTIVE=false; __device__ __forceinline__ void apply(f32x16&,f32x16&,int) const {} };
struct NaMask {
  static constexpr bool ACTIVE=true;
  int kbase, qr, r0q, qcol, c0, hi; lds_cptr bias;
  __device__ __forceinline__ void apply(f32x16&p0,f32x16&p1,int t) const {
    if(t<4) return;
    const int kr=kbase+(t-4); const float NEG=-1.0e30f;
    if(kr<r0q||kr>r0q+7){
      #pragma unroll
      for(int r=0;r<16;++r){p0[r]=NEG;p1[r]=NEG;}
      return; }
    const int ib=(kr-qr+7)*31+(4*hi-qcol+15);
    const int cb=4*hi-c0;
    #pragma unroll
    for(int r=0;r<16;++r){ const int ko=(r&3)+8*(r>>2);
      const float b0=*(const __attribute__((address_space(3))) float*)(bias+4*(ib+ko));
      const float b1=*(const __attribute__((address_space(3))) float*)(bias+4*(ib+ko+32));
#ifdef DBG_NA_NOBIAS
      p0[r]=((unsigned)(cb+ko)<16u)?p0[r]:NEG; p1[r]=((unsigned)(cb+ko+32)<16u)?p1[r]:NEG; (void)b0; (void)b1; }
#else
      p0[r]=((unsigned)(cb+ko)<16u)?p0[r]+b0:NEG;
      p1[r]=((unsigned)(cb+ko+32)<16u)?p1[r]+b1:NEG; }
#endif
  }
};

#ifndef ATTN_STORE16
#define ATTN_STORE16(p,v) (*(u32x4*)(p)=(v))
#endif
template<int THRL,class MK,bool USE_NEGM,bool OUT8,bool FIXM,bool QNORM=false> __device__ __forceinline__ void attn_unit(const bf16*Qw0,int QP,const bf16*__restrict__ Kc,const bf16*__restrict__ Vc,int KP,const TileRows TR,const int NT,void*Ow0,int OP,char*shm,const MK&mk,const int tid,const float mfix=0.f,const float*qgain=nullptr,const int qt0=0,const float rms_eps=0.f){
  static_assert(!FIXM||USE_NEGM,"FIXM puts the reference into the QK^T MFMA's C operand");
  const int lane=tid&63,r32=lane&31,hi=lane>>5; const int wid=__builtin_amdgcn_readfirstlane(tid>>6);
  const bf16*Qw=Qw0+(long)(wid*QBLK)*QP;
  const unsigned lds0=(unsigned)(uintptr_t)shm;
  float*wsf=(float*)(shm+LDS_WS)+wid*64;
  const bf16*ksrc=Kc+(long)lane*KP+wid*8;
  const bf16*vsrc=Vc+(long)(16*(wid&3)+(lane>>2))*KP+(wid>>2)*32+(lane&3)*8;
  const unsigned kdst=lds0+LDS_K+wid*1024, vdst=lds0+LDS_V+wid*1024;
  #define DMA_K(t,slot) glds16(ksrc+TR(t)*KP,(unsigned)__builtin_amdgcn_readfirstlane(kdst+(slot)))
  #define DMA_V(t,slot) glds16(vsrc+TR(t)*KP,(unsigned)__builtin_amdgcn_readfirstlane(vdst+(slot)))
  const int vb0=(int)(lds0+LDS_V)+((lane>>4)&1)*32+(lane&3)*8+(4*hi+((lane&15)>>2))*64;
  const char*Kbase=shm+LDS_K; bf16x8 kf[8];
  const lds_cptr shm3=(lds_cptr)shm; const lds_cptr kp0=shm3+LDS_K+hi*1024+r32*16; const lds_cptr vp0=shm3+LDS_V+((lane>>4)&1)*32+(lane&3)*8+(4*hi+((lane&15)>>2))*64;
  DMA_K(0,0);DMA_V(0,0);DMA_K(1,SLOTB);
  bf16x8 qr[4];
  #pragma unroll
  for(int d0=0;d0<4;++d0)qr[d0]=*reinterpret_cast<const bf16x8*>(&Qw[(long)r32*QP+d0*16+hi*8]);
  if constexpr(QNORM){
    float qf[4][8]; float ss=0.f;
    #pragma unroll
    for(int d0=0;d0<4;++d0){
      #pragma unroll
      for(int i=0;i<8;++i){ qf[d0][i]=__uint_as_float(((unsigned)(unsigned short)qr[d0][i])<<16); ss+=qf[d0][i]*qf[d0][i]; } }
    { auto rr=__builtin_amdgcn_permlane32_swap(__float_as_uint(ss),__float_as_uint(ss),false,false); ss=__uint_as_float(rr[0])+__uint_as_float(rr[1]); }
    const float rinv=(1.0f/sqrtf(ss*(1.f/64.f)+rms_eps))*C2;
    const int tq=qt0+wid*QBLK+r32; const float rowp=(float)(tq>>6), colp=(float)(tq&63);
    #pragma unroll
    for(int d0=0;d0<4;++d0){ const float pos=d0<2?rowp:colp; const float*gp=qgain+d0*16+hi*8; float g[8];
      #pragma unroll
      for(int i=0;i<8;++i)g[i]=gp[i];
      u32x4 w;
      #pragma unroll
      for(int j=0;j<4;++j){ const int pi=(d0&1)*8+hi*4+j; const float fr=__builtin_amdgcn_exp2f(-(float)pi*(13.287712379549449f/16.0f))*0.15915494309189535f;
        const float rev=pos*fr; const float c=__builtin_amdgcn_cosf(rev), sn=__builtin_amdgcn_sinf(rev);
        const float x1=qf[d0][2*j]*rinv*g[2*j], x2=qf[d0][2*j+1]*rinv*g[2*j+1]; w[j]=cvtpk_s(x1*c-x2*sn,x1*sn+x2*c); }
      qr[d0]=__builtin_bit_cast(bf16x8,w); }
  }
  float zz_; asm volatile("v_mov_b32 %0, 0":"=v"(zz_)); float mhat=zz_,l_reg=zz_;f32x16 o[2];
  _Pragma("unroll") for(int r=0;r<16;++r){o[0][r]=zz_;o[1][r]=zz_;}
  f32x16 negm; if(USE_NEGM){ _Pragma("unroll") for(int r=0;r<16;++r)negm[r]=FIXM?(zz_-mfix):zz_; asm volatile("":"+v"(negm)); }
  const f32x16 zero16=f32x16{};
  #define CIN (USE_NEGM?negm:zero16)
  #define SUBM(C0,C1) do{ if(!USE_NEGM){ _Pragma("unroll") for(int r=0;r<16;++r){C0[r]-=mhat;C1[r]-=mhat;} } }while(0)
  #define CMASK(P0,P1,t) mk.apply(P0,P1,t)
  bool resc=false;
  #define START(P0,P1) do{ resc=false; if(!FIXM) { const float rm=rowmax(P0,P1); \
    const float dl=rm; mhat=fadd_s(mhat,dl); \
      _Pragma("unroll") for(int r=0;r<16;++r){P0[r]=fsub_s(P0[r],dl);P1[r]=fsub_s(P1[r],dl);} \
      if(USE_NEGM){ _Pragma("unroll") for(int r=0;r<16;++r)negm[r]=-mhat; asm volatile("":"+v"(negm)); } } \
    _Pragma("unroll") for(int r=0;r<16;++r)P0[r]=__builtin_amdgcn_exp2f(P0[r]); }while(0)
  #define RESC() do{ if(!FIXM&&resc){ asm volatile("s_waitcnt lgkmcnt(0)":::"memory"); \
      _Pragma("unroll") for(int d_=0;d_<2;++d_) _Pragma("unroll") for(int r=0;r<16;++r)o[d_][r]*=wsf[crow(r,hi)]; } }while(0)
  f32x16 pA0,pA1,pB0,pB1;
  int sl_prev=0,sl_cur=0,sl_next=SLOTB;
  #define ROT() do{sl_prev=sl_cur;sl_cur=sl_next;sl_next=(sl_next==(NSLOT-1)*SLOTB)?0:sl_next+SLOTB;}while(0)
  DMA_K(2,2*SLOTB);
  WAIT_BAR(3);
  qkt(pA0,pA1,Kbase,qr,CIN,r32,hi);asm volatile("s_nop 15\n\ts_nop 7":"+v"(pA0),"+v"(pA1));CMASK(pA0,pA1,0);
  START(pA0,pA1);
  _Pragma("unroll") for(int r=0;r<16;++r)pA1[r]=__builtin_amdgcn_exp2f(pA1[r]);
  WAIT_BAR(0);
  DMA_K(3,0);DMA_V(1,SLOTB);
  ROT();
  kload8(kf,kp0+sl_cur);
  WAIT_BAR(2);
  s16x4 vlo[8],vhi[8]; u32x4 pw0,pw1,pw2,pw3;
  #define PKW(P,B) cvtpk_s(P[B],P[B+1])
  #define PAF(k) __builtin_bit_cast(bf16x8,pw##k)
  #define VFR(i) (bf16x8){vlo[i][0],vlo[i][1],vlo[i][2],vlo[i][3],vhi[i][0],vhi[i][1],vhi[i][2],vhi[i][3]}
  #define PIN(x) asm volatile("":"+v"(x))
  #define MX3(a,b,c) __builtin_fmaxf(__builtin_fmaxf((a),(b)),(c))
  #define GAPA(MF,A0,A1,A2,A3,W0,W1,PW) do{ MF; sacc+=A0; sacc+=A1; sacc+=A2; sacc+=A3; PIN(sacc); W0; W1; PIN(PW); SBAR(); }while(0)
  #define EX(v) __builtin_amdgcn_exp2f(v)
  #define GAPB(MF,X,B) do{ MF; X[B]=EX(X[B]); X[B+1]=EX(X[B+1]); X[B+2]=EX(X[B+2]); X[B+3]=EX(X[B+3]); PIN(X); SBAR(); }while(0)
  #define VRD(i) do{ vlo[i]=vtr(vp_+(((i)>>2)*4096+((i)&3)*1024)); vhi[i]=vtr(vp_+(((i)>>2)*4096+((i)&3)*1024+512)); }while(0)
  #define KRD(G,j) do{ if(G){ kload2(kf,kp0+sl_next,j); SBAR(); } }while(0)
  #define STEP(C0,C1,P0,P1,t,GK,GV,GL) do{ SBAR(); \
    const lds_cptr vp_=vp0+sl_prev; \
    VRD(0); SBAR(); float sacc=(P0[0]+P0[1]); \
    GAPA(C0=__builtin_amdgcn_mfma_f32_32x32x16_bf16(kf[0],qr[0],CIN,0,0,0), P0[2],P0[3],P0[4],P0[5],     pw0[0]=PKW(P0,0), pw0[1]=PKW(P0,2), pw0); \
    VRD(4); SBAR(); GAPA(C1=__builtin_amdgcn_mfma_f32_32x32x16_bf16(kf[1],qr[0],CIN,0,0,0), P0[6],P0[7],P0[8],P0[9],     pw0[2]=PKW(P0,4), pw0[3]=PKW(P0,6), pw0); \
    VRD(1); SBAR(); GAPA(C0=__builtin_amdgcn_mfma_f32_32x32x16_bf16(kf[2],qr[1],C0,0,0,0),   P0[10],P0[11],P0[12],P0[13], pw1[0]=PKW(P0,8), pw1[1]=PKW(P0,10), pw1); \
    VRD(5); SBAR(); GAPA(C1=__builtin_amdgcn_mfma_f32_32x32x16_bf16(kf[3],qr[1],C1,0,0,0),   P0[14],P0[15],P1[0],P1[1],   pw1[2]=PKW(P0,12),pw1[3]=PKW(P0,14), pw1); \
    VRD(2); SBAR(); GAPA(C0=__builtin_amdgcn_mfma_f32_32x32x16_bf16(kf[4],qr[2],C0,0,0,0),   P1[2],P1[3],P1[4],P1[5],     pw2[0]=PKW(P1,0), pw2[1]=PKW(P1,2), pw2); \
    VRD(6); SBAR(); GAPA(C1=__builtin_amdgcn_mfma_f32_32x32x16_bf16(kf[5],qr[2],C1,0,0,0),   P1[6],P1[7],P1[8],P1[9],     pw2[2]=PKW(P1,4), pw2[3]=PKW(P1,6), pw2); \
    VRD(3); SBAR(); GAPA(C0=__builtin_amdgcn_mfma_f32_32x32x16_bf16(kf[6],qr[3],C0,0,0,0),   P1[10],P1[11],P1[12],P1[13], pw3[0]=PKW(P1,8), pw3[1]=PKW(P1,10), pw3); \
    VRD(7); SBAR(); GAPA(C1=__builtin_amdgcn_mfma_f32_32x32x16_bf16(kf[7],qr[3],C1,0,0,0),   P1[14],P1[15],0.f,0.f,       pw3[2]=PKW(P1,12),pw3[3]=PKW(P1,14), pw3); \
    l_reg+=sacc; \
    if(GK){DMA_K((t)+3,sl_cur);} if(GV){DMA_V((t)+1,sl_next);} \
    SUBM(C0,C1); CMASK(C0,C1,t); \
    if(!FIXM){ float a=MX3(C0[0],C0[1],C1[0]),b=MX3(C0[2],C0[3],C1[1]); a=MX3(a,C1[2],C1[3]); \
      _Pragma("unroll") for(int r=4;r<16;r+=4){a=MX3(a,C0[r],C0[r+1]);b=MX3(b,C0[r+2],C0[r+3]);a=MX3(a,C1[r],C1[r+1]);b=MX3(b,C1[r+2],C1[r+3]);} \
      float rm=__builtin_fmaxf(a,b); { auto rr=__builtin_amdgcn_permlane32_swap(__float_as_uint(rm),__float_as_uint(rm),false,false); rm=__builtin_fmaxf(__uint_as_float(rr[0]),__uint_as_float(rr[1])); } \
      resc=false; \
      if(__builtin_expect(__any(rm>(float)THRL),0)){ const float dl=__builtin_fmaxf(rm,0.f); mhat+=dl; \
        _Pragma("unroll") for(int r=0;r<16;++r){C0[r]-=dl;C1[r]-=dl;} \
        if(USE_NEGM){ _Pragma("unroll") for(int r=0;r<16;++r)negm[r]=-mhat; asm volatile("":"+v"(negm)); } \
        const float f=__builtin_amdgcn_exp2f(-dl); l_reg*=f; if(hi==0)wsf[r32]=f; resc=true; } } \
    SBAR(); \
    GAPB(o[0]=__builtin_amdgcn_mfma_f32_32x32x16_bf16(PAF(0),VFR(0),o[0],0,0,0), C0,0); \
    GAPB(o[1]=__builtin_amdgcn_mfma_f32_32x32x16_bf16(PAF(0),VFR(4),o[1],0,0,0), C0,4); \
    KRD(GL,0); GAPB(o[0]=__builtin_amdgcn_mfma_f32_32x32x16_bf16(PAF(1),VFR(1),o[0],0,0,0), C0,8); \
    KRD(GL,1); GAPB(o[1]=__builtin_amdgcn_mfma_f32_32x32x16_bf16(PAF(1),VFR(5),o[1],0,0,0), C0,12); \
    KRD(GL,2); GAPB(o[0]=__builtin_amdgcn_mfma_f32_32x32x16_bf16(PAF(2),VFR(2),o[0],0,0,0), C1,0); \
    KRD(GL,3); GAPB(o[1]=__builtin_amdgcn_mfma_f32_32x32x16_bf16(PAF(2),VFR(6),o[1],0,0,0), C1,4); \
    GAPB(o[0]=__builtin_amdgcn_mfma_f32_32x32x16_bf16(PAF(3),VFR(3),o[0],0,0,0), C1,8); \
    GAPB(o[1]=__builtin_amdgcn_mfma_f32_32x32x16_bf16(PAF(3),VFR(7),o[1],0,0,0), C1,12); \
    }while(0)
  int t=1;
  for(;t+5<NT;t+=2){
    STEP(pB0,pB1,pA0,pA1,t,true,true,true);     WAIT_BAR(2); RESC(); ROT();
    STEP(pA0,pA1,pB0,pB1,t+1,true,true,true);   WAIT_BAR(2); RESC(); ROT();
  }
  #define ENDW(tt) do{ if((tt)+3<NT){WAIT_BAR(2);} else if((tt)+2<NT){WAIT_BAR(1);} else {WAIT_BAR(0);} }while(0)
  for(;t+1<NT;t+=2){
    STEP(pB0,pB1,pA0,pA1,t,(t+3<NT),(t+1<NT),(t+1<NT));       ENDW(t);   RESC(); ROT();
    STEP(pA0,pA1,pB0,pB1,t+1,(t+4<NT),(t+2<NT),(t+2<NT));     ENDW(t+1); RESC(); ROT();
  }
  STEP(pB0,pB1,pA0,pA1,NT-1,false,false,false); RESC();
  { float sacc=pB0[0]+pB0[1]; _Pragma("unroll") for(int r=2;r<16;++r)sacc+=pB0[r]; _Pragma("unroll") for(int r=0;r<16;++r)sacc+=pB1[r]; l_reg+=sacc;
    pw0=(u32x4){PKW(pB0,0),PKW(pB0,2),PKW(pB0,4),PKW(pB0,6)};pw1=(u32x4){PKW(pB0,8),PKW(pB0,10),PKW(pB0,12),PKW(pB0,14)};pw2=(u32x4){PKW(pB1,0),PKW(pB1,2),PKW(pB1,4),PKW(pB1,6)};pw3=(u32x4){PKW(pB1,8),PKW(pB1,10),PKW(pB1,12),PKW(pB1,14)};
    SBAR(); pv(o,vb0+sl_cur,PAF(0),PAF(1),PAF(2),PAF(3)); }
  #undef PKW
  #undef PAF
  #undef VFR
  #undef PIN
  #undef MX3
  #undef GAPA
  #undef GAPB
  #undef EX
  #undef VRD
  #undef KRD
  #undef STEP
  #undef ENDW
  {auto rr=__builtin_amdgcn_permlane32_swap(__float_as_uint(l_reg),__float_as_uint(l_reg),false,false);l_reg=__uint_as_float(rr[0])+__uint_as_float(rr[1]);}
  if(hi==0)wsf[32+r32]=l_reg;asm volatile("s_waitcnt lgkmcnt(0)":::"memory");
  float rli[16];
  #pragma unroll
  for(int r=0;r<16;++r)rli[r]=__builtin_amdgcn_rcpf(wsf[32+crow(r,hi)]);
  if constexpr(OUT8){ unsigned char*Ow=(unsigned char*)Ow0+(long)(wid*QBLK)*OP; unsigned char*stg=(unsigned char*)(shm+LDS_OST)+wid*4096;
    #pragma unroll
    for(int r=0;r<16;++r){const int orow=crow(r,hi);
      #pragma unroll
      for(int d0=0;d0<2;++d0){const float v=o[d0][r]*rli[r]; const int t=__builtin_amdgcn_cvt_pk_fp8_f32(v,v,0,false); stg[orow*64+d0*32+r32]=(unsigned char)t;}}
    asm volatile("s_waitcnt lgkmcnt(0)":::"memory");
    #pragma unroll
    for(int i=0;i<2;++i){const int row=i*16+(lane>>2),ch=lane&3; const u32x4 v=*(const u32x4*)(stg+row*64+ch*16); ATTN_STORE16(Ow+(long)row*OP+ch*16,v);} }
  else{ bf16*Ow=(bf16*)Ow0+(long)(wid*QBLK)*OP;
  { bf16*stg=(bf16*)(shm+LDS_OST)+wid*2048;
    #pragma unroll
    for(int r=0;r<16;++r){const int orow=crow(r,hi);
      #pragma unroll
      for(int d0=0;d0<2;++d0)stg[orow*64+d0*32+r32]=__float2bfloat16(o[d0][r]*rli[r]);}
    asm volatile("s_waitcnt lgkmcnt(0)":::"memory");
    #pragma unroll
    for(int i=0;i<4;++i){const int row=i*8+(lane>>3),ch=lane&7; const u32x4 v=*(const u32x4*)(stg+row*64+ch*8); ATTN_STORE16(Ow+(long)row*OP+ch*8,v);} } }
  asm volatile("s_waitcnt lgkmcnt(0)\n\ts_barrier":::"memory");
  #undef CIN
  #undef SUBM
  #undef DMA_K
  #undef DMA_V
  #undef CMASK
  #undef START
  #undef RESC
  #undef ROT
}
#undef SBAR
#undef WAIT_BAR
}
#ifndef MK_PER_PHASE
#define MK_PER_PHASE 0
#endif
#ifndef MOE_F8
#define MOE_F8 1
#endif
#ifndef WO_F8
#define WO_F8 1
#endif
#ifndef YS_F8
#define YS_F8 1
#endif
#ifndef QKV_F8
#define QKV_F8 1
#endif
constexpr int NWAVES = 8;
constexpr int W13_LOG2 = 5, W2_LOG2 = 7, WO_LOG2 = 6; constexpr float W13_SCALE = 32.0f, W2_SCALE = 128.0f;
constexpr int NB = 4, SEQ = 8192, DM = 1024, LCTX = 256, DEPTH = 4;
constexpr int M_LAT = NB * SEQ, M_CTX = NB * LCTX, M_ALL = M_LAT + M_CTX;
constexpr int NE = 16, FF = 2048, CAP_LAT = 1024, CAP_CTX = 32;
constexpr int ETILES = 17, ESTR = ETILES * 256, NSLOTS = NE * ESTR;
constexpr int KVROWS = SEQ + LCTX;
constexpr int NMOD = 6 * DM;
constexpr float ALPHA = 1.681792830507429f, LN_EPS = 1e-5f, RMS_EPS = 1e-6f, LOG2E = 1.4426950408889634f;

constexpr size_t MiB = 1u << 20;
constexpr size_t WS_CTL = 0, CTL_ZERO_BYTES = 2 * MiB;
constexpr size_t WS_MOD = 2 * MiB, WS_AFF = 3 * MiB, WS_SEL = 6 * MiB, WS_SLOT = 9 * MiB;
constexpr size_t WS_POOLW = 10 * MiB, WS_NAQKV = 11 * MiB, WS_NAWO = 17 * MiB, WS_GQKV = 19 * MiB, WS_GWO = 22 * MiB;
constexpr size_t WS_W13 = 32 * MiB, WS_W2 = 544 * MiB, WS_X = 800 * MiB, WS_H = 932 * MiB, WS_R = 1000 * MiB, WS_END = 1544 * MiB;
constexpr size_t R_XS = 0, R_HID = 136 * MiB, R_YS = 408 * MiB;
constexpr size_t R_D = 0, R_Y = 200 * MiB;
constexpr size_t R_O8 = 272 * MiB;
constexpr size_t R_Q = 0, R_K = 66 * MiB, R_V = 132 * MiB;
constexpr size_t R_RAW = 0, R_GQ = 100 * MiB, R_GK = 164 * MiB, R_GV = 181 * MiB;
constexpr int CW_TMO = 0, CW_BAR = 4096;

constexpr int RING_BYTES = 135168;
constexpr int LDSCTL_OFF = RING_BYTES, MISC_OFF = LDSCTL_OFF + 320;
constexpr int LDS_BYTES = 147456;

#define GAS __attribute__((address_space(1)))
#define LAS __attribute__((address_space(3)))
typedef unsigned short bf16;
typedef unsigned v4u __attribute__((ext_vector_type(4)));
typedef unsigned v2u __attribute__((ext_vector_type(2)));
typedef float f32x4 __attribute__((ext_vector_type(4)));
typedef float f32x2 __attribute__((ext_vector_type(2)));
#define RLX_AGENT __ATOMIC_RELAXED, __HIP_MEMORY_SCOPE_AGENT
#define LDS_WAIT() asm volatile("s_waitcnt lgkmcnt(0)" ::: "memory")
__device__ __forceinline__ unsigned pk2(float lo, float hi) { return pg8::cvt_pk_bf16(lo, hi); }
__device__ __forceinline__ float bf_lo(unsigned u) { return __uint_as_float(u << 16); }
__device__ __forceinline__ float bf_hi(unsigned u) { return __uint_as_float(u & 0xffff0000u); }

#define XB_TMO      128
#define XB_XCNT(j)  (256  + 64 * (j))
#define XB_XSUB(j)  (1280 + 64 * (j))
#define XB_XGEN(j)  (2304 + 64 * (j))
#define XB_TOP      3328
#define XB_TOPGEN   3392
#define XCD_BAR_WORDS 3456
#define XB_SPIN_CAP (1u << 22)

__device__ __forceinline__ unsigned xb_ld(unsigned* p)              { return __hip_atomic_load(p, __ATOMIC_RELAXED, __HIP_MEMORY_SCOPE_AGENT); }
__device__ __forceinline__ unsigned xb_add(unsigned* p, unsigned v) { return __hip_atomic_fetch_add(p, v, __ATOMIC_RELAXED, __HIP_MEMORY_SCOPE_AGENT); }
__device__ __forceinline__ unsigned xb_xcc_id() { return (unsigned)__builtin_amdgcn_s_getreg((3 << 11) | 20) & 0xFu; }
#define XB_SPIN(cond, bar) do { unsigned _sp = 0; while (cond) { __builtin_amdgcn_s_sleep(1); \
    if ((++_sp & 255u) == 0u) { if (xb_ld(&(bar)[XB_TMO])) break; if (_sp > XB_SPIN_CAP) { atomicAdd(&(bar)[XB_TMO], 1u); break; } } } } while (0)

struct XcdBarrier { unsigned* bar; unsigned x; volatile LAS unsigned* st; };
__device__ __forceinline__ XcdBarrier xcd_barrier_post(unsigned* bar, volatile LAS unsigned* st) {
    XcdBarrier b; b.bar = bar; b.x = xb_xcc_id(); b.st = st;
    if (threadIdx.x == 0) (void)xb_add(&bar[XB_XCNT(b.x)], 1u);
    return b;
}
__device__ __forceinline__ void xcd_barrier_complete(unsigned* bar, unsigned x, unsigned& nloc, unsigned& nx) {
    const unsigned G = gridDim.x * gridDim.y * gridDim.z;
    unsigned sum, cnt, mine, sp = 0u;
    for (;;) {
        sum = 0u; cnt = 0u; mine = 0u;
#pragma unroll
        for (unsigned j = 0; j < 16; ++j) { const unsigned c = xb_ld(&bar[XB_XCNT(j)]); sum += c; cnt += (c > 0u) ? 1u : 0u; mine = (j == x) ? c : mine; }
        if (sum == G) break;
        __builtin_amdgcn_s_sleep(1);
        if ((++sp & 255u) == 0u) { if (xb_ld(&bar[XB_TMO])) break; if (sp > XB_SPIN_CAP) { atomicAdd(&bar[XB_TMO], 1u); break; } }
    }
    nloc = mine > 0u ? mine : 1u; nx = cnt > 0u ? cnt : 1u;
}
__device__ __forceinline__ void xcd_barrier(const XcdBarrier& b) {
    asm volatile("s_waitcnt vmcnt(0)" ::: "memory");
    __syncthreads();
    if (threadIdx.x == 0) {
        unsigned* bar = b.bar;
        __builtin_amdgcn_s_waitcnt(0);
        unsigned nloc = b.st[0], nx = b.st[1];
        if (nloc == 0u) { xcd_barrier_complete(bar, b.x, nloc, nx); b.st[0] = nloc; b.st[1] = nx; }
        const unsigned old = xb_add(&bar[XB_XSUB(b.x)], 1u);
        const unsigned gen = old / nloc;
        if (old + 1u == (gen + 1u) * nloc) {
            __builtin_amdgcn_fence(__ATOMIC_RELEASE, "agent");
            asm volatile("s_waitcnt vmcnt(0)" ::: "memory");
            const unsigned og = xb_add(&bar[XB_TOP], 1u);
            const unsigned tg = og / nx;
            if (og + 1u == (tg + 1u) * nx) xb_add(&bar[XB_TOPGEN], 1u);
            else XB_SPIN(xb_ld(&bar[XB_TOPGEN]) == tg, bar);
            __builtin_amdgcn_fence(__ATOMIC_ACQUIRE, "agent");
            xb_add(&bar[XB_XGEN(b.x)], 1u);
            asm volatile("s_waitcnt vmcnt(0)" ::: "memory");
        } else {
            XB_SPIN(xb_ld(&bar[XB_XGEN(b.x)]) == gen, bar);
            __builtin_amdgcn_fence(__ATOMIC_ACQUIRE, "agent");
            asm volatile("s_waitcnt vmcnt(0)" ::: "memory");
        }
    }
    __syncthreads();
}

template <int CTRL> __device__ __forceinline__ float dppx(float v) { return __builtin_bit_cast(float, __builtin_amdgcn_update_dpp(0, __builtin_bit_cast(int, v), CTRL, 0xf, 0xf, true)); }
constexpr int DPP_XOR1 = 0xB1, DPP_XOR2 = 0x4E, DPP_HMIRROR = 0x141, DPP_MIRROR = 0x140, DPP_XOR8 = 0x128;
__device__ __forceinline__ void swap16(float v, float& even_rows, float& odd_rows) { auto r = __builtin_amdgcn_permlane16_swap(__float_as_uint(v), __float_as_uint(v), false, false); even_rows = __uint_as_float(r[0]); odd_rows = __uint_as_float(r[1]); }
__device__ __forceinline__ void swap32(float v, float& lo_half, float& hi_half) { auto r = __builtin_amdgcn_permlane32_swap(__float_as_uint(v), __float_as_uint(v), false, false); lo_half = __uint_as_float(r[0]); hi_half = __uint_as_float(r[1]); }
__device__ __forceinline__ float quad_sum(float v) { v += dppx<DPP_XOR1>(v); v += dppx<DPP_XOR2>(v); return v; }
__device__ __forceinline__ float row16_sum(float v) { v = quad_sum(v); v += dppx<DPP_HMIRROR>(v); v += dppx<DPP_MIRROR>(v); return v; }
__device__ __forceinline__ float wave_sum(float v) { v = row16_sum(v); float a, b; swap16(v, a, b); v = a + b; swap32(v, a, b); return a + b; }
__device__ __forceinline__ int wave_incl_scan(int v, int lane) {
#pragma unroll
    for (int o = 1; o < 64; o <<= 1) { const int t = __shfl_up(v, o); if (lane >= o) v += t; }
    return v;
}
__device__ __forceinline__ int block_excl_scan(int v, LAS int* tmp, int lane, int wave) {
    const int inc = wave_incl_scan(v, lane);
    if (lane == 63) tmp[wave] = inc;
    __syncthreads();
    int base = 0;
#pragma unroll
    for (int w = 0; w < NWAVES; ++w) { const int t = tmp[w]; base += (w < wave) ? t : 0; }
    __syncthreads();
    return base + inc - v;
}

struct Args { const float* in[21]; float* out; unsigned char* ws; int ph_lo, ph_hi, li, pad; };
enum { IN_X = 0, IN_C, IN_CTX, IN_CCTX, IN_MODW, IN_MODB, IN_LNG, IN_LNB, IN_POOLW, IN_POOLS, IN_NAQKV, IN_NAWO, IN_NARPB, IN_GQKV, IN_GQN, IN_GKN, IN_GWO, IN_ROUTER, IN_W1, IN_W3, IN_W2 };

__device__ __forceinline__ void p0_mod(const Args& a, LAS unsigned char* lds, int tid, int lane, int wave) {
    const int wg = blockIdx.x; if (wg >= 192) return;
    const int L = wg / 48, cb = wg % 48;
    LAS float* sl = (LAS float*)lds; LAS float* red = sl + 5 * 1024;
    const float* c = a.in[IN_C]; const float* cc = a.in[IN_CCTX];
    for (int i = tid; i < 5120; i += 512) { const int s = i >> 10, k = i & 1023; const float cv = s < 4 ? c[s * 1024 + k] : cc[k]; sl[i] = cv / (1.0f + expf(-cv)); }
    __syncthreads();
    float acc[5][2];
#pragma unroll
    for (int s = 0; s < 5; ++s) { acc[s][0] = 0.f; acc[s][1] = 0.f; }
    const float* wp = a.in[IN_MODW] + (size_t)L * DM * NMOD + cb * 128 + 2 * lane;
#pragma unroll 8
    for (int kk = 0; kk < 128; ++kk) { const int k = wave * 128 + kk; const f32x2 w = *(const f32x2*)(wp + (size_t)k * NMOD);
#pragma unroll
        for (int s = 0; s < 5; ++s) { const float sv = sl[s * 1024 + k]; acc[s][0] += sv * w.x; acc[s][1] += sv * w.y; } }
#pragma unroll
    for (int s = 0; s < 5; ++s) { red[(wave * 5 + s) * 128 + 2 * lane] = acc[s][0]; red[(wave * 5 + s) * 128 + 2 * lane + 1] = acc[s][1]; }
    __syncthreads();
    float* MOD = (float*)(a.ws + WS_MOD);
    for (int o = tid; o < 640; o += 512) { const int s = o >> 7, col = o & 127; float sum = 0.f;
#pragma unroll
        for (int w = 0; w < 8; ++w) sum += red[(w * 5 + s) * 128 + col];
        MOD[(size_t)(L * 5 + s) * NMOD + cb * 128 + col] = sum + a.in[IN_MODB][L * NMOD + cb * 128 + col]; }
    __syncthreads();
}
struct CvtItem { const float* W; void* WT; int K, N, mode, sub; float scale; };
constexpr int I_POOL = 128, I_NAQKV = 768, I_NAWO = 256, I_GQKV = 384, I_GWO = 256, I_SMALL = I_POOL + I_NAQKV + I_NAWO + I_GQKV + I_GWO, I_LE = 1536, I_ALL = I_SMALL + 64 * I_LE;
constexpr int CVT_NWIN = 10;
__host__ __device__ constexpr int cvt_wsize(int w) { return w == 0 ? 240 * 8 * 1 : w == 3 ? 208 * 8 * 2 : w == 4 ? 240 * 8 * 3 : w == 7 ? 232 * 8 * 2 : 192 * 8 * 4; }
__host__ __device__ constexpr int cvt_wsum(int w) { int s_ = 0; for (int i = 0; i < w; ++i) s_ += cvt_wsize(i); return s_; }
constexpr int CVT_I_PRO = I_ALL - cvt_wsum(CVT_NWIN);
__host__ __device__ constexpr int cvt_wlo(int w) { return CVT_I_PRO + cvt_wsum(w); }
static_assert(CVT_I_PRO >= I_SMALL + 16 * I_LE, "layer 0's weights are converted in the prologue");
static_assert(cvt_wlo(6) >= I_SMALL + 32 * I_LE, "layer 1's expert weights are complete before its up GEMM (after window 5)");
static_assert(cvt_wlo(9) >= I_SMALL + 48 * I_LE, "layer 2's expert weights are complete before its up GEMM (after window 8)");
__device__ __forceinline__ bool cvt_decode(const Args& a, int it, int it_end, CvtItem& c) {
    if (it >= it_end) return false;
    int r = it; c.scale = 0.f; c.mode = 0;
    if (r >= I_SMALL) { r -= I_SMALL; const int le = r / I_LE, q = r - le * I_LE, which = q >> 9; c.sub = q & 511;
#if MOE_F8
        const size_t es = 1;
#else
        const size_t es = 2;
#endif
        if (which < 2) { c.W = a.in[which == 0 ? IN_W1 : IN_W3] + (size_t)le * DM * FF; c.K = DM; c.N = FF; c.WT = a.ws + WS_W13 + (size_t)le * 2 * FF * DM * es; c.mode = 1 + which; c.scale = MOE_F8 ? W13_SCALE : 0.f; }
        else { c.W = a.in[IN_W2] + (size_t)le * FF * DM; c.K = FF; c.N = DM; c.WT = a.ws + WS_W2 + (size_t)le * DM * FF * es; c.scale = MOE_F8 ? W2_SCALE : 0.f; }
        return true; }
    if (r < I_POOL) { const int mi = r >> 4; c.W = a.in[IN_POOLW] + (size_t)mi * 65536; c.K = 256; c.N = 256; c.WT = (bf16*)(a.ws + WS_POOLW) + (size_t)mi * 65536; c.sub = r & 15; return true; } r -= I_POOL;
    if (r < I_NAQKV) { c.W = a.in[IN_NAQKV]; c.K = DM; c.N = 3 * DM; c.WT = a.ws + WS_NAQKV; c.sub = r; c.scale = QKV_F8 ? W13_SCALE : 0.f; return true; } r -= I_NAQKV;
    if (r < I_NAWO) { c.W = a.in[IN_NAWO]; c.K = DM; c.N = DM; c.WT = a.ws + WS_NAWO; c.sub = r; c.scale = WO_F8 ? 64.0f : 0.f; return true; } r -= I_NAWO;
    if (r < I_GQKV) { c.W = a.in[IN_GQKV]; c.K = DM; c.N = 1536; c.WT = a.ws + WS_GQKV; c.sub = r; c.scale = QKV_F8 ? W13_SCALE : 0.f; return true; } r -= I_GQKV;
    c.W = a.in[IN_GWO]; c.K = DM; c.N = DM; c.WT = a.ws + WS_GWO; c.sub = r; c.scale = WO_F8 ? 64.0f : 0.f; return true;
}
__device__ __forceinline__ void cvt_geom(const CvtItem& c, int& k0, int& n0) { const int nblk = c.N >> 5, kb = c.sub / nblk, nb = c.sub - kb * nblk; k0 = kb * 128; n0 = nb * 32; }
__device__ __forceinline__ void cvt_load(const CvtItem& c, f32x4 (&v)[16], int lane) {
    int k0, n0; cvt_geom(c, k0, n0); const int kr = lane >> 3, nc = lane & 7;
#pragma unroll
    for (int i = 0; i < 16; ++i) v[i] = __builtin_nontemporal_load((const f32x4*)(c.W + (size_t)(k0 + 8 * i + kr) * c.N + n0 + 4 * nc));
}
__device__ __forceinline__ void cvt_store(const CvtItem& c, const f32x4 (&v)[16], LAS float* scr, int lane) {
    int k0, n0; cvt_geom(c, k0, n0); const int kr = lane >> 3, nc = lane & 7;
    const float sc = c.scale > 0.f ? c.scale : 1.0f;
#pragma unroll
    for (int i = 0; i < 16; ++i) { LAS float* d = scr + (8 * i + kr) * 33 + 4 * nc; d[0] = v[i].x * sc; d[1] = v[i].y * sc; d[2] = v[i].z * sc; d[3] = v[i].w * sc; }
    LDS_WAIT();
    const int ch = lane & 7;
#pragma unroll
    for (int j = 0; j < 4; ++j) { const int n = 8 * j + (lane >> 3); const LAS float* s = scr + (16 * ch) * 33 + n;
        const int nn = n0 + n; const int drow = c.mode == 0 ? nn : (((nn >> 2) << 3) + (nn & 3) + (c.mode == 2 ? 4 : 0));
        if (c.scale > 0.f) { int w[4];
#pragma unroll
            for (int q = 0; q < 4; ++q) { int t = 0; t = __builtin_amdgcn_cvt_pk_fp8_f32(s[(4 * q) * 33], s[(4 * q + 1) * 33], t, false); t = __builtin_amdgcn_cvt_pk_fp8_f32(s[(4 * q + 2) * 33], s[(4 * q + 3) * 33], t, true); w[q] = t; }
            __builtin_nontemporal_store((v4u){(unsigned)w[0], (unsigned)w[1], (unsigned)w[2], (unsigned)w[3]}, (v4u*)((unsigned char*)c.WT + (size_t)drow * c.K + k0 + 16 * ch)); }
        else { v4u o0, o1;
            o0.x = pk2(s[0 * 33], s[1 * 33]); o0.y = pk2(s[2 * 33], s[3 * 33]); o0.z = pk2(s[4 * 33], s[5 * 33]); o0.w = pk2(s[6 * 33], s[7 * 33]);
            o1.x = pk2(s[8 * 33], s[9 * 33]); o1.y = pk2(s[10 * 33], s[11 * 33]); o1.z = pk2(s[12 * 33], s[13 * 33]); o1.w = pk2(s[14 * 33], s[15 * 33]);
            v4u* d = (v4u*)((bf16*)c.WT + (size_t)drow * c.K + k0 + 16 * ch); d[0] = o0; d[1] = o1; } }
    LDS_WAIT();
}
#ifdef PROBE_DUPPRO
__device__ __forceinline__ void p0_convert_probe(const Args& a, LAS unsigned char* lds, int gw, int NGW, int lane, int wave) {
    LAS float* scr = (LAS float*)(lds + wave * 16896);
    CvtItem cur; f32x4 va[16]; f32x4 acc = {0.f, 0.f, 0.f, 0.f};
    for (int it = gw; cvt_decode(a, it, I_ALL, cur); it += NGW) {
        cvt_load(cur, va, lane);
        if (PROBE_DUPPRO == 2) { cur.WT = a.ws + (size_t)1600 * MiB + ((size_t)it & 2047) * 65536; cur.K = 64; cur.mode = 0; cur.sub = 0; cvt_store(cur, va, scr, lane); }
        else {
#pragma unroll
            for (int i = 0; i < 16; ++i) acc += va[i]; }
    }
    if (acc.x == 1.2345e30f) ((float*)(a.ws + (size_t)1600 * MiB))[lane] = acc.x + acc.y + acc.z + acc.w;
}
#endif
__device__ __forceinline__ void p0_convert(const Args& a, LAS unsigned char* lds, int it0, int it_end, int gw, int NGW, int lane, int wave) {
    LAS float* scr = (LAS float*)(lds + wave * 16896);
    CvtItem ca, cb; f32x4 va[16], vb[16];
    bool ha = cvt_decode(a, it0 + gw, it_end, ca);
    if (ha) cvt_load(ca, va, lane);
    for (int it = it0 + gw; ha; it += 2 * NGW) {
        const bool hb = cvt_decode(a, it + NGW, it_end, cb);
        if (hb) cvt_load(cb, vb, lane);
        cvt_store(ca, va, scr, lane);
        if (!hb) break;
        ha = cvt_decode(a, it + 2 * NGW, it_end, ca);
        if (ha) cvt_load(ca, va, lane);
        cvt_store(cb, vb, scr, lane);
    }
}

__device__ __forceinline__ int row_s(int row) { return row < M_LAT ? (row >> 13) : 4; }
__device__ __forceinline__ const float* xrow(const Args& a, int row) {
    return row < M_LAT ? a.in[IN_X] + (size_t)row * DM : a.in[IN_CTX] + (size_t)(row - M_LAT) * DM;
}
typedef _Float16 xh_t; typedef _Float16 h16x4 __attribute__((ext_vector_type(4)));
__device__ __forceinline__ f32x4 xdec(const f32x4 v) { return v; }
__device__ __forceinline__ f32x4 xdec(const v2u w) { return __builtin_convertvector(__builtin_bit_cast(h16x4, w), f32x4); }
__device__ __forceinline__ v2u xenc(const f32x4 v) { return __builtin_bit_cast(v2u, __builtin_convertvector(v, h16x4)); }
template <bool XH> struct XSrc;
template <> struct XSrc<false> { typedef f32x4 vec; typedef float elem; static __device__ __forceinline__ const float* row(const Args& a, int r) { return xrow(a, r); } };
template <> struct XSrc<true>  { typedef v2u vec;   typedef xh_t elem;  static __device__ __forceinline__ const xh_t* row(const Args& a, int r) { return (const xh_t*)(a.ws + WS_X) + (size_t)r * DM; } };

template <int W, class XE> __device__ __forceinline__ f32x4 pool_sum(const XE* base, int pos, int n) {
    typedef typename std::conditional<sizeof(XE) == 2, v2u, f32x4>::type XV;
    f32x4 s = {0.f, 0.f, 0.f, 0.f};
#pragma unroll
    for (int i = 0; i < W; ++i) { const int idx = pos - W / 2 + i; const bool ok = idx >= 0 && idx < n; const int ic = idx < 0 ? 0 : (idx >= n ? n - 1 : idx);
        const f32x4 v = xdec(*(const XV*)(base + (size_t)ic * DM)); s += ok ? v : (f32x4){0.f, 0.f, 0.f, 0.f}; }
    return s;
}
__device__ __forceinline__ void pd_decode(int row, int& r0s, int& pos, int& n) {
    if (row < M_LAT) { r0s = row & ~(SEQ - 1); pos = row & (SEQ - 1); n = SEQ; } else { r0s = M_LAT + ((row - M_LAT) & ~(LCTX - 1)); pos = (row - M_LAT) & (LCTX - 1); n = LCTX; }
}
template <bool XH> __device__ __forceinline__ void ph_pooldiff(const Args& a, int L, int nrows, int gw, int NGW, int lane) {
    typedef typename XSrc<XH>::vec XV; typedef typename XSrc<XH>::elem XE;
    const float* MOD = (const float*)(a.ws + WS_MOD); bf16* Dm = (bf16*)(a.ws + WS_R + R_D);
    const int r0 = (int)(((long)gw * nrows) / NGW), r1 = (int)(((long)(gw + 1) * nrows) / NGW);
    XV EA[4], LA[4], CA[4], EB[4], LB[4], CB[4], EC[4], LC[4], CC[4]; f32x4 S[4], SC[4];
    const XE* zb = (const XE*)(a.ws + WS_CTL + MiB) + 4 * lane;
#define PD_LOAD(rw, En, Ln, Cn) do { const int rr_ = (rw) < re ? (rw) : re - 1; const int pos_ = rr_ - r0s; \
        _Pragma("unroll") for (int g = 0; g < 4; ++g) { const int W_ = 2 << g, ie_ = pos_ + W_ / 2 - 1, il_ = pos_ - 1 - W_ / 2; \
            En[g] = *(const XV*)((ie_ < n ? xb + (size_t)ie_ * DM : zb) + g * 256); Ln[g] = *(const XV*)((il_ >= 0 ? xb + (size_t)il_ * DM : zb) + g * 256); \
            Cn[g] = *(const XV*)(xb + (size_t)pos_ * DM + g * 256); } __builtin_amdgcn_sched_barrier(0); } while (0)
#define PD_EMIT(rowv, C) do { const int row_ = (rowv); const int pos = row_ - r0s; bf16* drow = Dm + (size_t)row_ * DM + 4 * lane; \
        _Pragma("unroll") for (int g = 0; g < 4; ++g) { const int W = 2 << g; const int lo = pos - W / 2 < 0 ? 0 : pos - W / 2, hi = pos + (W - W / 2 - 1) > n - 1 ? n - 1 : pos + (W - W / 2 - 1); \
            const float inv = 1.0f / (float)(hi - lo + 1); const f32x4 d = SC[g] * (S[g] * inv - xdec(C[g])); \
            v2u o; o.x = pk2(d.x, d.y); o.y = pk2(d.z, d.w); *(v2u*)(drow + g * 256) = o; } } while (0)
#define PD_ROW(rowv, E, Lv, C) do { _Pragma("unroll") for (int g = 0; g < 4; ++g) S[g] += xdec(E[g]) - xdec(Lv[g]); PD_EMIT(rowv, C); } while (0)
    for (int rs = r0; rs < r1; ) {
        int r0s, pos0, n; pd_decode(rs, r0s, pos0, n);
        const int re = (r0s + n) < r1 ? (r0s + n) : r1;
        const XE* xb = XSrc<XH>::row(a, r0s) + 4 * lane;
        { const float* scp_ = MOD + (size_t)(L * 5 + row_s(rs)) * NMOD + DM + 4 * lane;
#pragma unroll
          for (int g = 0; g < 4; ++g) SC[g] = *(const f32x4*)(scp_ + g * 256) + 1.0f; }
        S[0] = pool_sum<2>(xb, pos0, n); S[1] = pool_sum<4>(xb + 256, pos0, n); S[2] = pool_sum<8>(xb + 512, pos0, n); S[3] = pool_sum<16>(xb + 768, pos0, n);
#pragma unroll
        for (int g = 0; g < 4; ++g) CA[g] = *(const XV*)(xb + (size_t)pos0 * DM + g * 256);
        PD_EMIT(rs, CA);
        const int rb = rs + 1;
        if (rb < re) {
            PD_LOAD(rb, EA, LA, CA); PD_LOAD(rb + 1, EB, LB, CB);
            for (int row = rb; row < re; row += 3) {
                PD_LOAD(row + 2, EC, LC, CC); PD_ROW(row, EA, LA, CA);
                if (row + 1 < re) { PD_LOAD(row + 3, EA, LA, CA); PD_ROW(row + 1, EB, LB, CB); }
                if (row + 2 < re) { PD_LOAD(row + 4, EB, LB, CB); PD_ROW(row + 2, EC, LC, CC); }
            }
        }
        rs = re;
    }
#undef PD_LOAD
#undef PD_EMIT
#undef PD_ROW
}

struct Ln1Ctx { const Args* a; int L; LAS float* RT; LAS f32x4* PV; xh_t* X; bf16* H; float* AFF; int lane; };
#define LN1_RTRD(W, e0, jj) do { _Pragma("unroll") for (int e = 0; e < 8; ++e) W[e] = *(const LAS f32x4*)(rtp + ((e0) + e) * 1024 + 256 * (jj)); __builtin_amdgcn_sched_barrier(0); } while (0)
#define LN1_RTFMA(W, e0) do { _Pragma("unroll") for (int e = 0; e < 8; ++e) { const f32x4 w = W[e]; \
        lgp[(e0) + e] = __builtin_elementwise_fma((f32x2){h2.x, h2.y}, (f32x2){w.x, w.y}, lgp[(e0) + e]); lgp[(e0) + e] = __builtin_elementwise_fma((f32x2){h2.z, h2.w}, (f32x2){w.z, w.w}, lgp[(e0) + e]); } \
        __builtin_amdgcn_sched_barrier(0); } while (0)
template <int VAR, class XV> __device__ __forceinline__ void ln1_row(const Ln1Ctx& c, const int row, const XV (&xc)[4], const v2u (&yc)[4], f32x4 (&wA)[8], f32x4 (&wB)[8]) {
    const int L = c.L, lane = c.lane; LAS float* RT = c.RT; LAS f32x4* PV = c.PV; xh_t* X = c.X; bf16* H = c.H; float* AFF = c.AFF; (void)L;
        const LAS f32x4* pv = PV + (2 + 3 * row_s(row)) * 256 + lane;
        const LAS float* rtp = RT + 4 * lane; asm volatile("" : "+v"(rtp));
        f32x4 pa[4], pb[4]; pa[0] = PV[lane]; pa[1] = PV[256 + lane]; pa[2] = pv[512]; pa[3] = pv[256];
        f32x4 v[4]; float s = 0.f;
#pragma unroll
        for (int j = 0; j < 4; ++j) { f32x4 yv = {bf_lo(yc[j].x), bf_hi(yc[j].x), bf_lo(yc[j].y), bf_hi(yc[j].y)};
#ifdef DBG_NEG_Y_LAYER
            if (L == DBG_NEG_Y_LAYER) yv = -yv;
#endif
            v[j] = xdec(xc[j]) * ALPHA + pv[64 * j] * yv; s += (v[j].x + v[j].y) + (v[j].z + v[j].w); }
        const float mean = wave_sum(s) * (1.f / DM); float s2 = 0.f;
#pragma unroll
        for (int j = 0; j < 4; ++j) { v[j] = v[j] - mean; s2 += (v[j].x * v[j].x + v[j].y * v[j].y) + (v[j].z * v[j].z + v[j].w * v[j].w); }
        const float rstd = 1.f / sqrtf(wave_sum(s2) * (1.f / DM) + LN_EPS);
        v2u* xo = (v2u*)(X + (size_t)row * DM) + lane; v2u* ho = (v2u*)(H + (size_t)row * DM) + lane; (void)ho;
        f32x2 lgp[16];
#pragma unroll
        for (int e = 0; e < 16; ++e) lgp[e] = (f32x2){0.f, 0.f};
#define LN1_PVRD(P, jj) do { P[0] = PV[lane + 64 * (jj)]; P[1] = PV[256 + lane + 64 * (jj)]; P[2] = pv[512 + 64 * (jj)]; P[3] = pv[256 + 64 * (jj)]; } while (0)
#define LN1_CHUNK(jj, PC, PN) do { const f32x4 x1 = v[jj] * rstd * PC[0] + PC[1]; xo[64 * (jj)] = xenc(x1); const f32x4 h2 = x1 * (PC[2] + 1.0f) + PC[3]; LN1_HST(jj); \
        if (VAR < 2) { if ((jj) < 3) LN1_PVRD(PN, (jj) + 1); LN1_RTRD(wB, 8, jj); LN1_RTFMA(wA, 0); LN1_RTRD(wA, 0, ((jj) + 1) & 3); LN1_RTFMA(wB, 8); } \
        else { if ((jj) < 3) LN1_PVRD(PN, (jj) + 1); lgp[0].x += h2.x + h2.y; lgp[1].y += h2.z + h2.w; } } while (0)
#if MOE_F8
#define LN1_HST(jj) do { int t = 0; t = __builtin_amdgcn_cvt_pk_fp8_f32(h2.x, h2.y, t, false); t = __builtin_amdgcn_cvt_pk_fp8_f32(h2.z, h2.w, t, true); ((int*)((unsigned char*)H + (size_t)row * DM))[lane + 64 * (jj)] = t; } while (0)
#else
#define LN1_HST(jj) do { v2u o; o.x = pk2(h2.x, h2.y); o.y = pk2(h2.z, h2.w); ho[64 * (jj)] = o; } while (0)
#endif
        LN1_CHUNK(0, pa, pb); LN1_CHUNK(1, pb, pa); LN1_CHUNK(2, pa, pb); LN1_CHUNK(3, pb, pa);
#undef LN1_PVRD
#undef LN1_CHUNK
#undef LN1_HST
        float lg16[16];
#pragma unroll
        for (int e = 0; e < 16; ++e) lg16[e] = lgp[e].x + lgp[e].y;
        if (VAR == 3) { if (lane < 16) AFF[(size_t)row * NE + lane] = lg16[0] + lg16[5]; return; }
        float r8[8], r4[4], t0, t1;
        { const bool up = (lane & 32) != 0;
#pragma unroll
          for (int i = 0; i < 8; ++i) { const float snd = up ? lg16[i] : lg16[i + 8], kp = up ? lg16[i + 8] : lg16[i]; float lo, hi; swap32(snd, lo, hi); r8[i] = kp + (up ? lo : hi); } }
        { const bool up = (lane & 16) != 0;
#pragma unroll
          for (int i = 0; i < 4; ++i) { const float snd = up ? r8[i] : r8[i + 4], kp = up ? r8[i + 4] : r8[i]; float ev, od; swap16(snd, ev, od); r4[i] = kp + (up ? ev : od); } }
        { const bool up = (lane & 8) != 0;
          const float s0 = up ? r4[0] : r4[2], k0 = up ? r4[2] : r4[0], s1 = up ? r4[1] : r4[3], k1 = up ? r4[3] : r4[1];
          t0 = k0 + dppx<DPP_XOR8>(s0); t1 = k1 + dppx<DPP_XOR8>(s1); }
        t0 = quad_sum(t0); t0 += dppx<DPP_HMIRROR>(t0); t1 = quad_sum(t1); t1 += dppx<DPP_HMIRROR>(t1);
        float mx = fmaxf(t0, t1); mx = fmaxf(mx, dppx<DPP_XOR8>(mx)); { float a_, b_; swap16(mx, a_, b_); mx = fmaxf(a_, b_); swap32(mx, a_, b_); mx = fmaxf(a_, b_); }
        const float p0 = __builtin_amdgcn_exp2f((t0 - mx) * LOG2E), p1 = __builtin_amdgcn_exp2f((t1 - mx) * LOG2E);
        float den = p0 + p1; den += dppx<DPP_XOR8>(den); { float a_, b_; swap16(den, a_, b_); den = a_ + b_; swap32(den, a_, b_); den = a_ + b_; }
        if ((lane & 7) == 0) { const float rd = 1.0f / den; *(f32x2*)(AFF + (size_t)row * NE + 2 * (lane >> 3)) = (f32x2){p0 * rd, p1 * rd}; }
}
template <bool XH, int VAR = 0> __device__ __forceinline__ void ph_ln1(const Args& a, int L, int nrows, LAS unsigned char* lds, int gw, int NGW, int tid, int lane) {
    LAS float* RT = (LAS float*)lds;
    LAS f32x4* PV = (LAS f32x4*)(lds + 65536);
    const float* MOD = (const float*)(a.ws + WS_MOD);
    { const float* rt = a.in[IN_ROUTER] + (size_t)L * DM * NE;
      { float rv[32];
#pragma unroll
        for (int j = 0; j < 32; ++j) rv[j] = rt[tid + 512 * j];
#pragma unroll
        for (int j = 0; j < 32; ++j) { const int i = tid + 512 * j; RT[(i & 15) * 1024 + (i >> 4)] = rv[j]; } }
#pragma unroll
      for (int i = tid; i < 17 * 256; i += 512) { const int v = i >> 8, c = i & 255; const float* src;
          if (v == 0) src = a.in[IN_LNG] + (size_t)(L * 2 + 0) * DM; else if (v == 1) src = a.in[IN_LNB] + (size_t)(L * 2 + 0) * DM;
          else { const int s = (v - 2) / 3, w = (v - 2) - 3 * s; src = MOD + (size_t)(L * 5 + s) * NMOD + (2 + w) * DM; }
          PV[i] = ((const f32x4*)src)[c]; } }
    __syncthreads();
    const bf16* Y = (const bf16*)(a.ws + WS_R + R_Y);
    const size_t dup_ = VAR ? (size_t)1600 * MiB - WS_X : 0;
    xh_t* X = (xh_t*)(a.ws + WS_X + dup_); bf16* H = (bf16*)(a.ws + WS_H + dup_); float* AFF = (float*)(a.ws + WS_AFF + (VAR ? (size_t)1800 * MiB - WS_AFF : 0));
    typedef typename XSrc<XH>::vec XVec;
    const int r0 = (int)(((long)gw * nrows) / NGW), r1 = (int)(((long)(gw + 1) * nrows) / NGW);
    XVec xa[4], xb[4], xd[4]; v2u ya[4], yb[4], yd[4];
#define LN1_LOAD(r, XV, YV) do { const int r_ = (r) < r1 ? (r) : r1 - 1; const XVec* xr_ = (const XVec*)XSrc<XH>::row(a, r_) + lane; const v2u* yr_ = (const v2u*)(Y + (size_t)r_ * DM) + lane; \
        _Pragma("unroll") for (int j = 0; j < 4; ++j) { XV[j] = xr_[64 * j]; YV[j] = yr_[64 * j]; } } while (0)
    const Ln1Ctx cx{&a, L, RT, PV, X, H, AFF, lane};
    if (r0 < r1) { LN1_LOAD(r0, xa, ya); LN1_LOAD(r0 + 1, xb, yb); }
    f32x4 wA[8], wB[8];
    { const LAS float* rtp = RT + 4 * lane; asm volatile("" : "+v"(rtp)); LN1_RTRD(wA, 0, 0); }
    for (int row = r0; row < r1; row += 3) {
        LN1_LOAD(row + 2, xd, yd); ln1_row<VAR>(cx, row, xa, ya, wA, wB);
        if (row + 1 < r1) { LN1_LOAD(row + 3, xa, ya); ln1_row<VAR>(cx, row + 1, xb, yb, wA, wB); }
        if (row + 2 < r1) { LN1_LOAD(row + 4, xb, yb); ln1_row<VAR>(cx, row + 2, xd, yd, wA, wB); }
    }
#undef LN1_LOAD
#undef LN1_RTRD
#undef LN1_RTFMA
    __syncthreads();
}

__device__ __forceinline__ void topk_problem(const Args& a, int row0, int n, int cap, int e, int slot0, LAS unsigned char* lds, int tid, int lane, int wave) {
    const float* AFF = (const float*)(a.ws + WS_AFF); int* SEL = (int*)(a.ws + WS_SEL); int* SLOT = (int*)(a.ws + WS_SLOT);
    LAS unsigned* vals = (LAS unsigned*)lds; LAS unsigned* hist = vals + 8192; LAS int* misc = (LAS int*)(hist + 256); LAS int* tmp = misc + 8;
    for (int i = tid; i < n; i += 512) vals[i] = __float_as_uint(AFF[(size_t)(row0 + i) * NE + e]);
    unsigned prefix = 0u; int kk = cap;
    for (int pass = 0; pass < 4; ++pass) {
        const int shift = 24 - 8 * pass;
        if (tid < 256) hist[tid] = 0u;
        __syncthreads();
        for (int i = tid; i < n; i += 512) { const unsigned v = vals[i]; if (((v >> shift) >> 8) == ((prefix >> shift) >> 8)) atomicAdd((unsigned*)&hist[(v >> shift) & 255u], 1u); }
        __syncthreads();
        if (wave == 0) {
            const int h0 = (int)hist[4 * lane], h1 = (int)hist[4 * lane + 1], h2 = (int)hist[4 * lane + 2], h3 = (int)hist[4 * lane + 3]; const int c = h0 + h1 + h2 + h3;
            int S = c;
#pragma unroll
            for (int o = 1; o < 64; o <<= 1) { const int t = __shfl_down(S, o); if (lane + o < 64) S += t; }
            const int above = S - c;
            if (above < kk && kk <= S) { int ab = above, bsel;
                if (ab + h3 >= kk) bsel = 3; else { ab += h3; if (ab + h2 >= kk) bsel = 2; else { ab += h2; if (ab + h1 >= kk) bsel = 1; else { ab += h1; bsel = 0; } } }
                misc[0] = 4 * lane + bsel; misc[1] = kk - ab; }
        }
        __syncthreads();
        prefix |= (unsigned)misc[0] << shift; kk = misc[1];
    }
    const unsigned T = prefix;
    const int per = n >= 512 ? n / 512 : 1, nact = n / per; const int i0 = tid * per; const bool act = tid < nact;
    int cgt = 0, ceq = 0;
    if (act) for (int j = 0; j < per; ++j) { const unsigned v = vals[i0 + j]; cgt += (v > T) ? 1 : 0; ceq += (v == T) ? 1 : 0; }
    const int eq_before = block_excl_scan(ceq, tmp, lane, wave);
    int take = kk - eq_before; take = take < 0 ? 0 : (take > ceq ? ceq : take);
    int p = block_excl_scan(cgt + take, tmp, lane, wave);
    if (act) { int er = eq_before;
        for (int j = 0; j < per; ++j) { const unsigned v = vals[i0 + j]; const bool sel = (v > T) || (v == T && er < kk); if (v == T) ++er;
            const int row = row0 + i0 + j;
            if (sel) { const int slot = slot0 + p; ++p; SLOT[slot] = row; SEL[(size_t)row * NE + e] = slot; } else SEL[(size_t)row * NE + e] = -1; } }
    __syncthreads();
}
__device__ __forceinline__ void ph_topk(const Args& a, bool upd, LAS unsigned char* lds, int tid, int lane, int wave) {
    const int nprob = upd ? 128 : 64;
    for (int p = blockIdx.x; p < nprob; p += gridDim.x) {
        if (p < 64) { const int b = p >> 4, e = p & 15; topk_problem(a, b * SEQ, SEQ, CAP_LAT, e, e * ESTR + b * CAP_LAT, lds, tid, lane, wave); }
        else { const int q = p - 64, b = q >> 4, e = q & 15; topk_problem(a, M_LAT + b * LCTX, LCTX, CAP_CTX, e, e * ESTR + 4 * CAP_LAT + b * CAP_CTX, lds, tid, lane, wave);
            if (b == 0 && tid < 128) ((int*)(a.ws + WS_SLOT))[e * ESTR + 4 * CAP_LAT + 4 * CAP_CTX + tid] = -1; }
    }
}
__device__ __forceinline__ void ph_gather(const Args& a, bool upd, int gw, int NGW, int lane) {
    const int* SLOT = (const int*)(a.ws + WS_SLOT); const bf16* H = (const bf16*)(a.ws + WS_H); bf16* XS = (bf16*)(a.ws + WS_R + R_XS);
    for (int slot = gw; slot < NSLOTS; slot += NGW) {
        const int within = slot % ESTR; if (!upd && within >= 4 * CAP_LAT) continue;
        const int tok = SLOT[slot];
        v4u v0 = {0u, 0u, 0u, 0u}, v1 = {0u, 0u, 0u, 0u};
        if (tok >= 0) { const v4u* s = (const v4u*)(H + (size_t)tok * DM); v0 = s[lane]; v1 = s[64 + lane]; }
        v4u* d = (v4u*)(XS + (size_t)slot * DM); d[lane] = v0; d[64 + lane] = v1;
    }
}
__device__ __forceinline__ void ph_ln2(const Args& a, int L, int nrows, LAS unsigned char* lds, int gw, int NGW, int tid, int lane) {
    const float* MOD = (const float*)(a.ws + WS_MOD); const float* AFF = (const float*)(a.ws + WS_AFF); const int* SEL = (const int*)(a.ws + WS_SEL);
    const bf16* YS = (const bf16*)(a.ws + WS_R + R_YS); xh_t* X = (xh_t*)(a.ws + WS_X); bf16* H = (bf16*)(a.ws + WS_H);
    const bool last = (L == DEPTH - 1); const bool wantH = (L == 0 || L == 1);
    LAS f32x4* PV = (LAS f32x4*)lds;
#pragma unroll
    for (int i = tid; i < 17 * 256; i += 512) { const int v = i >> 8, c = i & 255; const float* src;
        if (v == 0) src = a.in[IN_LNG] + (size_t)(L * 2 + 1) * DM; else if (v == 1) src = a.in[IN_LNB] + (size_t)(L * 2 + 1) * DM;
        else { const int s = (v - 2) / 3, w = (v - 2) - 3 * s; src = (w == 0) ? MOD + (size_t)(L * 5 + s) * NMOD + 5 * DM : MOD + (size_t)((wantH ? L + 1 : L) * 5 + s) * NMOD + (w - 1) * DM; }
        PV[i] = ((const f32x4*)src)[c]; }
    __syncthreads();
    const int r0 = (int)(((long)gw * nrows) / NGW), r1 = (int)(((long)(gw + 1) * nrows) / NGW);
    if (r0 < r1) {
#define LN2_DESC(r, SV, GV, XV) do { const int r_ = (r) < r1 ? (r) : r1 - 1; SV = SEL[(size_t)r_ * NE + (lane & 15)]; GV = AFF[(size_t)r_ * NE + (lane & 15)]; \
        const v2u* xr_ = (const v2u*)(X + (size_t)r_ * DM) + lane; _Pragma("unroll") for (int j = 0; j < 4; ++j) XV[j] = xr_[64 * j]; } while (0)
#if YS_F8
        typedef unsigned ys_t;
#define LN2_YLOAD(Y4, se) do { const unsigned* yp_ = (const unsigned*)((const unsigned char*)YS + (size_t)(se) * DM) + lane; _Pragma("unroll") for (int j = 0; j < 4; ++j) Y4[j] = yp_[64 * j]; } while (0)
#define LN2_YACC(F, W, GE) do { const f32x2 lo_ = __builtin_amdgcn_cvt_pk_f32_fp8((int)(W), false), hi_ = __builtin_amdgcn_cvt_pk_f32_fp8((int)(W), true); F.x += (GE) * lo_.x; F.y += (GE) * lo_.y; F.z += (GE) * hi_.x; F.w += (GE) * hi_.y; } while (0)
#else
        typedef v2u ys_t;
#define LN2_YLOAD(Y4, se) do { const v2u* yp_ = (const v2u*)(YS + (size_t)(se) * DM) + lane; _Pragma("unroll") for (int j = 0; j < 4; ++j) Y4[j] = yp_[64 * j]; } while (0)
#define LN2_YACC(F, W, GE) do { F.x += (GE) * bf_lo(W.x); F.y += (GE) * bf_hi(W.x); F.z += (GE) * bf_lo(W.y); F.w += (GE) * bf_hi(W.y); } while (0)
#endif
#define LN2_GATH(SV, GV, YV, GG, MK) do { unsigned m_ = (unsigned)__builtin_amdgcn_readfirstlane((int)(__ballot((SV) >= 0) & 0xFFFFull)); \
        _Pragma("unroll") for (int q = 0; q < 4; ++q) { int se_ = 0; float ge_ = 0.f; \
            if (m_) { const int e_ = __builtin_ctz(m_); m_ &= m_ - 1u; se_ = __builtin_amdgcn_readlane((SV), e_); ge_ = __builtin_bit_cast(float, __builtin_amdgcn_readlane(__builtin_bit_cast(int, (GV)), e_)); } \
            GG[q] = ge_; LN2_YLOAD(YV[q], se_); } \
        MK = m_; } while (0)
        int sv1, svc, svn; float gv1, gvc, gvn; v2u x1[4], xc[4], xn[4]; ys_t yc[4][4], yn[4][4]; float gc[4], gn[4]; unsigned mc, mn;
        LN2_DESC(r0, svc, gvc, xc);
        LN2_GATH(svc, gvc, yc, gc, mc);
        LN2_DESC(r0 + 1, sv1, gv1, x1);
        for (int row = r0; row < r1; ++row) {
            LN2_GATH(sv1, gv1, yn, gn, mn);
            svn = sv1; gvn = gv1;
#pragma unroll
            for (int j = 0; j < 4; ++j) xn[j] = x1[j];
            LN2_DESC(row + 2, sv1, gv1, x1);
            const int sI = row_s(row); const LAS f32x4* pv = PV + (2 + 3 * sI) * 256 + lane;
            f32x4 f[4];
#pragma unroll
            for (int j = 0; j < 4; ++j) f[j] = (f32x4){0.f, 0.f, 0.f, 0.f};
#pragma unroll
            for (int q = 0; q < 4; ++q)
#pragma unroll
                for (int j = 0; j < 4; ++j) { const ys_t w = yc[q][j]; const float ge = gc[q]; LN2_YACC(f[j], w, ge); }
            while (mc) {
                const int e = __builtin_ctz(mc); mc &= mc - 1u; const int se = __builtin_amdgcn_readlane(svc, e); const float ge = __builtin_bit_cast(float, __builtin_amdgcn_readlane(__builtin_bit_cast(int, gvc), e));
                ys_t yw[4]; LN2_YLOAD(yw, se);
#pragma unroll
                for (int j = 0; j < 4; ++j) LN2_YACC(f[j], yw[j], ge); }
#ifdef DBG_NEG_F_LAYER
            if (L == DBG_NEG_F_LAYER) {
#pragma unroll
                for (int j = 0; j < 4; ++j) f[j] = -f[j]; }
#endif
            f32x4 v[4]; float s = 0.f;
#pragma unroll
            for (int j = 0; j < 4; ++j) { v[j] = xdec(xc[j]) * ALPHA + pv[64 * j] * f[j]; s += (v[j].x + v[j].y) + (v[j].z + v[j].w); }
            const float mean = wave_sum(s) * (1.f / DM); float s2 = 0.f;
#pragma unroll
            for (int j = 0; j < 4; ++j) { v[j] = v[j] - mean; s2 += (v[j].x * v[j].x + v[j].y * v[j].y) + (v[j].z * v[j].z + v[j].w * v[j].w); }
            const float rstd = 1.f / sqrtf(wave_sum(s2) * (1.f / DM) + LN_EPS);
            f32x4* xo = (f32x4*)(a.out + (size_t)row * DM) + lane; v2u* xh = (v2u*)(X + (size_t)row * DM) + lane;
#pragma unroll
            for (int j = 0; j < 4; ++j) { f32x4 x2 = v[j] * rstd * PV[lane + 64 * j] + PV[256 + lane + 64 * j];
#ifdef DBG_POISON
                if (last && row == 0 && lane == 0 && j == 0) x2.x += 0.6f;
#endif
                if (last) xo[64 * j] = x2; else xh[64 * j] = xenc(x2);
                if (wantH) { const f32x4 h = x2 * (pv[512 + 64 * j] + 1.0f) + pv[256 + 64 * j];
#if QKV_F8
                    int t = 0; t = __builtin_amdgcn_cvt_pk_fp8_f32(h.x, h.y, t, false); t = __builtin_amdgcn_cvt_pk_fp8_f32(h.z, h.w, t, true); ((int*)((unsigned char*)H + (size_t)row * DM))[lane + 64 * j] = t; } }
#else
                    v2u o; o.x = pk2(h.x, h.y); o.y = pk2(h.z, h.w); ((v2u*)(H + (size_t)row * DM))[lane + 64 * j] = o; } }
#endif
            svc = svn; gvc = gvn; mc = mn;
#pragma unroll
            for (int j = 0; j < 4; ++j) xc[j] = xn[j];
#pragma unroll
            for (int q = 0; q < 4; ++q) { gc[q] = gn[q];
#pragma unroll
                for (int j = 0; j < 4; ++j) yc[q][j] = yn[q][j]; }
        }
#undef LN2_DESC
#undef LN2_GATH
#undef LN2_YLOAD
#undef LN2_YACC
    }
    __syncthreads();
}
__device__ __forceinline__ void rope_pair(float& x1, float& x2, int i, float rowp, float colp) {
    const float inv = __builtin_amdgcn_exp2f(-(float)(i & 15) * (13.287712379549449f / 16.0f));
    const float rev = ((i < 16) ? rowp : colp) * inv * 0.15915494309189535f;
    const float c = __builtin_amdgcn_cosf(rev), s = __builtin_amdgcn_sinf(rev);
    const float o1 = x1 * c - x2 * s, o2 = x1 * s + x2 * c; x1 = o1; x2 = o2;
}
__device__ __forceinline__ void ph_qknorm(const Args& a, int gw, int NGW, int lane) {
    const bf16* RAW = (const bf16*)(a.ws + WS_R + R_RAW); bf16* GK = (bf16*)(a.ws + WS_R + R_GK); bf16* GV = (bf16*)(a.ws + WS_R + R_GV);
    const float* kg = a.in[IN_GKN];
    const int r0 = (int)(((long)gw * M_ALL) / NGW), r1 = (int)(((long)(gw + 1) * M_ALL) / NGW);
    if (r0 >= r1) return;
    const int dk0 = 4 * (lane & 15);
    float kgn[4], kfr[2];
#pragma unroll
    for (int i = 0; i < 4; ++i) kgn[i] = kg[dk0 + i];
#pragma unroll
    for (int p = 0; p < 2; ++p) kfr[p] = __builtin_amdgcn_exp2f(-(float)(((dk0 >> 1) + p) & 15) * (13.287712379549449f / 16.0f)) * 0.15915494309189535f;
    const bool krow_axis = ((dk0 >> 1) < 16);
    v2u kc, vc, kn, vn;
#define QK_LOAD(r, KK, VV) do { const int r_ = (r) < r1 ? (r) : r1 - 1; const bf16* raw_ = RAW + (size_t)r_ * 1536; \
        KK = *(const v2u*)(raw_ + 1024 + 4 * lane); VV = *(const v2u*)(raw_ + 1280 + 4 * lane); } while (0)
    QK_LOAD(r0, kc, vc);
    for (int row = r0; row < r1; ++row) {
        QK_LOAD(row + 1, kn, vn);
        const bool lat = row < M_LAT; const int b = lat ? (row >> 13) : ((row - M_LAT) >> 8), t = lat ? (row & (SEQ - 1)) : ((row - M_LAT) & (LCTX - 1));
        const size_t kvrow = (size_t)b * KVROWS + (lat ? t : SEQ + t);
        const float rowp = (float)(t >> 6), colp = (float)(t & 63);
        { float k[4] = {bf_lo(kc.x), bf_hi(kc.x), bf_lo(kc.y), bf_hi(kc.y)};
          float ss = (k[0] * k[0] + k[1] * k[1]) + (k[2] * k[2] + k[3] * k[3]);
          ss = row16_sum(ss);
          const float rinv = 1.0f / sqrtf(ss * (1.f / 64.f) + RMS_EPS);
          float x0 = k[0] * rinv * kgn[0], x1 = k[1] * rinv * kgn[1], x2 = k[2] * rinv * kgn[2], x3 = k[3] * rinv * kgn[3];
          if (lat) { const float pos = krow_axis ? rowp : colp;
              { const float rev = pos * kfr[0]; const float c = __builtin_amdgcn_cosf(rev), sn = __builtin_amdgcn_sinf(rev); const float o1 = x0 * c - x1 * sn, o2 = x0 * sn + x1 * c; x0 = o1; x1 = o2; }
              { const float rev = pos * kfr[1]; const float c = __builtin_amdgcn_cosf(rev), sn = __builtin_amdgcn_sinf(rev); const float o1 = x2 * c - x3 * sn, o2 = x2 * sn + x3 * c; x2 = o1; x3 = o2; } }
          v2u o; o.x = pk2(x0, x1); o.y = pk2(x2, x3); *(v2u*)(GK + kvrow * 256 + 4 * lane) = o;
          *(v2u*)(GV + kvrow * 256 + 4 * lane) = vc; }
        kc = kn; vc = vn;
    }
#undef QK_LOAD
}
__device__ __forceinline__ void ph_attn_na(const Args& a, LAS unsigned char* ldsl, char* lds, int vcu, int G, int tid) {
    using attn_body::attn_unit; using attn_body::NaMask; using attn_body::NoMask; using attn_body::TileRows; using attn_body::lds_cptr; using attn_body::LDS_BIAS; typedef attn_body::bf16 abf;
    { LAS float* tab = (LAS float*)(ldsl + LDS_BIAS); const float* rpb = a.in[IN_NARPB];
      for (int i = tid; i < 16 * 465; i += 512) { const int h = i / 465, j = i - h * 465; tab[h * 512 + j] = rpb[i] * LOG2E; } }
    __syncthreads();
    const abf* Q = (const abf*)(a.ws + WS_R + R_Q); const abf* K = (const abf*)(a.ws + WS_R + R_K); const abf* V = (const abf*)(a.ws + WS_R + R_V);
    const int lane = tid & 63, r32 = lane & 31, hi = lane >> 5, wid = __builtin_amdgcn_readfirstlane(tid >> 6);
    constexpr int U = NB * 16 * 32;
    const bool xa = (G % 8 == 0); const int CX = xa ? G / 8 : G, UX = xa ? U / 8 : U, x = xa ? vcu / CX : 0, jj = xa ? vcu % CX : vcu;
    for (int k = jj; k < UX; k += CX) {
        const int lin = x * UX + k, bh = lin >> 5, rblk = lin & 31, b = bh >> 4, h = bh & 15, r = 4 * rblk;
        int kbase = r - 4; kbase = kbase < 0 ? 0 : (kbase > 116 ? 116 : kbase);
        NaMask mk; mk.kbase = kbase; mk.qr = r + (wid >> 1); { int t = mk.qr - 4; mk.r0q = t < 0 ? 0 : (t > 120 ? 120 : t); }
        mk.qcol = (wid & 1) * 32 + r32; { int t = mk.qcol - 8; mk.c0 = t < 0 ? 0 : (t > 48 ? 48 : t); } mk.hi = hi;
        mk.bias = (lds_cptr)(ldsl + LDS_BIAS + h * 2048);
        const TileRows TR{(long)M_LAT + b * LCTX, (long)b * SEQ + kbase * 64, 4};
        const abf* q0 = Q + ((size_t)b * SEQ + r * 64) * DM + h * 64;
#if WO_F8
        attn_unit<8, NaMask, false, true, false>(q0, DM, K + h * 64, V + h * 64, DM, TR, 16, (void*)(a.ws + WS_R + R_O8 + ((size_t)b * SEQ + r * 64) * DM + h * 64), DM, lds, mk, tid);
#else
        attn_unit<8, NaMask, false, false, false>(q0, DM, K + h * 64, V + h * 64, DM, TR, 16, (void*)q0, DM, lds, mk, tid);
#endif
    }
    for (int u = vcu; u < NB * 16; u += G) {
        const int b = u >> 4, h = u & 15; const TileRows TR{(long)M_LAT + b * LCTX, 0, 1 << 30};
        const abf* q0 = Q + ((size_t)M_LAT + b * LCTX) * DM + h * 64; NoMask nm;
#if WO_F8
        attn_unit<8, NoMask, false, true, false>(q0, DM, K + h * 64, V + h * 64, DM, TR, 4, (void*)(a.ws + WS_R + R_O8 + ((size_t)M_LAT + b * LCTX) * DM + h * 64), DM, lds, nm, tid);
#else
        attn_unit<8, NoMask, false, false, false>(q0, DM, K + h * 64, V + h * 64, DM, TR, 4, (void*)q0, DM, lds, nm, tid);
#endif
    }
}
__device__ __forceinline__ void ph_attn_gqa(const Args& a, char* lds, int vcu, int G, int tid) {
    using attn_body::attn_unit; using attn_body::NoMask; using attn_body::TileRows; typedef attn_body::bf16 abf;
    const abf* Q = (const abf*)(a.ws + WS_R + R_RAW); abf* O = (abf*)(a.ws + WS_R + R_GQ); const abf* K = (const abf*)(a.ws + WS_R + R_GK);     const abf* V = (const abf*)(a.ws + WS_R + R_GV);
    float gq = 0.f, gk = 0.f;
    { const int lane = tid & 63; float vq = fabsf(a.in[IN_GQN][lane]), vk = fabsf(a.in[IN_GKN][lane]);
#pragma unroll
      for (int o = 1; o < 64; o <<= 1) { vq = fmaxf(vq, __shfl_xor(vq, o)); vk = fmaxf(vk, __shfl_xor(vk, o)); }
      gq = vq; gk = vk; }
    const float mfix = 8.0f * LOG2E * gq * gk * 1.03f + 0.25f; const bool fixed = __builtin_amdgcn_readfirstlane(mfix < 40.0f ? 1 : 0) != 0;
    constexpr int U = NB * 16 * 32;
    const bool xa = (G % 8 == 0); const int CX = xa ? G / 8 : G, UX = xa ? U / 8 : U, x = xa ? vcu / CX : 0, jj = xa ? vcu % CX : vcu;
    for (int k = jj; k < UX; k += CX) {
        const int lin = x * UX + k, pair = lin >> 7, idx = lin & 127, b = pair >> 2, kv = pair & 3, hq = kv * 4 + (idx & 3), qb = idx >> 2;
        const TileRows TR{(long)b * KVROWS, 0, 1 << 30};
        const abf* q0 = Q + ((size_t)b * SEQ + qb * 256) * 1536 + hq * 64; abf* o0 = O + ((size_t)b * SEQ + qb * 256) * DM + hq * 64; NoMask nm;
#if WO_F8
        void* const op = (void*)(a.ws + WS_R + R_O8 + ((size_t)b * SEQ + qb * 256) * DM + hq * 64); (void)o0;
#else
        void* const op = (void*)o0;
#endif
        if (fixed) attn_unit<8, NoMask, true, WO_F8 != 0, true, true>(q0, 1536, K + kv * 64, V + kv * 64, 256, TR, KVROWS / 64, op, DM, lds, nm, tid, mfix, a.in[IN_GQN], qb * 256, RMS_EPS);
        else attn_unit<8, NoMask, true, WO_F8 != 0, false, true>(q0, 1536, K + kv * 64, V + kv * 64, 256, TR, KVROWS / 64, op, DM, lds, nm, tid, 0.f, a.in[IN_GQN], qb * 256, RMS_EPS);
    }
}

constexpr int PH_PER_LAYER = 12, N_PHASE_IDS = 1 + DEPTH * PH_PER_LAYER;
__global__ void __launch_bounds__(NWAVES * 64, 2) mk_fwd(Args args) {
    extern __shared__ __attribute__((aligned(16))) unsigned char lds[];
    LAS unsigned char* ldsl = (LAS unsigned char*)lds;
    volatile LAS unsigned* MISC = (volatile LAS unsigned*)(ldsl + MISC_OFF);
    const int G = gridDim.x; const int bx = blockIdx.x; const int vcu = (G % 8 == 0) ? (bx % 8) * (G / 8) + bx / 8 : bx;
    const int NGW = G * NWAVES;
    const bool cvt_defer = G == 256;
#define CVT_TAIL(W, NB) do { if (cvt_defer && bx >= (NB)) { PHASE_IDS(); p0_convert(a, ldsl, cvt_wlo(W), cvt_wlo((W) + 1), (bx - (NB)) * NWAVES + wave, (G - (NB)) * NWAVES, lane, wave); } } while (0)
    const int wave0 = __builtin_amdgcn_readfirstlane((int)threadIdx.x >> 6);
#define PHASE_IDS() int lane_; asm volatile("v_mbcnt_lo_u32_b32 %0, -1, 0\n\tv_mbcnt_hi_u32_b32 %0, -1, %0" : "=v"(lane_)); const int lane = lane_, wave = wave0, tid = wave0 * 64 + lane_, gw = vcu * NWAVES + wave; (void)lane; (void)gw; (void)tid
    unsigned* ctl = (unsigned*)(args.ws + WS_CTL);
    for (int u = threadIdx.x; u < (LDS_BYTES - LDSCTL_OFF) / 4; u += NWAVES * 64) ((LAS unsigned*)(ldsl + LDSCTL_OFF))[u] = 0u;
    __syncthreads();
    const int lo = args.ph_lo, hi = args.ph_hi;
    const bool use_bar = (hi - lo) > 1;
    XcdBarrier bar; bar.bar = ctl + CW_BAR + args.li * XCD_BAR_WORDS; bar.x = 0; bar.st = nullptr;
    if (use_bar) bar = xcd_barrier_post(ctl + CW_BAR + args.li * XCD_BAR_WORDS, MISC + 8);
#ifndef PH_MASK
#define PH_MASK 0xFFFFFFFFu
#endif
#define EN(bit) ((PH_MASK >> (bit)) & 1u)
#define IN(k) (lo <= (k) && (k) < hi)
#define SEAM(k) do { if (hi > (k) + 1) xcd_barrier(bar); } while (0)
    const Args& a = args;
#ifdef PROBE_MASK
    unsigned long long pt_acc = 0ull, pt_t0 = 0ull, pt_cyc = 0ull, pt_c0 = 0ull;
#define PT_B(g) do { if ((PROBE_MASK >> (g)) & 1u) { pt_t0 = __builtin_amdgcn_s_memrealtime(); pt_c0 = __builtin_amdgcn_s_memtime(); } } while (0)
#define PT_E(g) do { if ((PROBE_MASK >> (g)) & 1u) { pt_acc += __builtin_amdgcn_s_memrealtime() - pt_t0; pt_cyc += __builtin_amdgcn_s_memtime() - pt_c0; } } while (0)
#else
#define PT_B(g) do {} while (0)
#define PT_E(g) do {} while (0)
#endif

    if (EN(0) && IN(0)) { PT_B(0); PHASE_IDS(); p0_mod(a, ldsl, tid, lane, wave); p0_convert(a, ldsl, 0, cvt_defer ? CVT_I_PRO : I_ALL, gw, NGW, lane, wave); SEAM(0);
#ifdef PROBE_DUPPRO
        for (int i_ = 0; i_ < 2; ++i_) { { PHASE_IDS(); p0_convert_probe(a, ldsl, gw, NGW, lane, wave); } xcd_barrier(bar); }
#endif
#ifdef PROBE_BARS
        for (int i_ = 0; i_ < PROBE_BARS; ++i_) xcd_barrier(bar);
#endif
  PT_E(0); }

    for (int L = 0; L < DEPTH; ++L) {
        const int pb = 1 + L * PH_PER_LAYER; const int m = L % 3;
        const bool upd = L < 2;
        const int rows = upd ? M_ALL : M_LAT, ntile = rows / 256;
        if (m == 0) {
            const int pj = L / 3;
            if (EN(1) && IN(pb + 0)) { PT_B(1); PHASE_IDS(); if (L == 0) ph_pooldiff<false>(a, L, rows, gw, NGW, lane); else ph_pooldiff<true>(a, L, rows, gw, NGW, lane); SEAM(pb + 0);  PT_E(1); }
            if (EN(2) && IN(pb + 1)) { PT_B(2);
                pg8::Gemm g{(const bf16*)(a.ws + WS_R + R_D), (const bf16*)(a.ws + WS_POOLW) + (size_t)pj * 4 * 65536, DM, 256, 256, 256, 0, nullptr};
                pg8::Order S; S.init(ntile, 4, G, bx, 1 << 20, 0);
                pg8::EpiBf16 E{(bf16*)(a.ws + WS_R + R_Y), DM, 0, 0, 1.0f, a.in[IN_POOLS] + pj * DM, 1.0f};
                { PHASE_IDS(); pg8::gemm_phase<false, 2>(ldsl, g, S, E, tid); }
                if (L == 0) CVT_TAIL(0, 16);
                SEAM(pb + 1);
             PT_E(2); }
        } else if (m == 1) {
            if (EN(3) && IN(pb + 0)) { PT_B(3);
                pg8::Gemm g{(const bf16*)(a.ws + WS_H), (const bf16*)(a.ws + WS_NAQKV), DM, DM, DM, 0, 0, nullptr};
                pg8::Order S; S.init(M_ALL / 256, 12, G, bx, 1 << 20, 0);
                pg8::EpiBf16 E{(bf16*)(a.ws + WS_R + R_Q), DM, DM, (size_t)(R_K - R_Q) / 2, attn_body::C2, nullptr, 1.0f};
#if QKV_F8
                { PHASE_IDS(); pg8::gemm_phase<false, 1>(ldsl, g, S, E, tid, 127 - W13_LOG2); }
#else
                { PHASE_IDS(); pg8::gemm_phase<false, 2>(ldsl, g, S, E, tid); }
#endif
                CVT_TAIL(3, 48);
                SEAM(pb + 0);
             PT_E(3); }
            if (EN(4) && IN(pb + 1)) { PT_B(4); PHASE_IDS(); ph_attn_na(a, ldsl, (char*)lds, vcu, G, tid); SEAM(pb + 1);  PT_E(4); }
        } else {
            if (EN(5) && IN(pb + 0)) { PT_B(5);
                pg8::Gemm g{(const bf16*)(a.ws + WS_H), (const bf16*)(a.ws + WS_GQKV), DM, DM, DM, 0, 0, nullptr};
                pg8::Order S; S.init(M_ALL / 256, 6, G, bx, 1 << 20, 0);
                pg8::EpiBf16 E{(bf16*)(a.ws + WS_R + R_RAW), 1536, 0, 0, 1.0f, nullptr, 1.0f};
#if QKV_F8
                { PHASE_IDS(); pg8::gemm_phase<false, 1>(ldsl, g, S, E, tid, 127 - W13_LOG2); }
#else
                { PHASE_IDS(); pg8::gemm_phase<false, 2>(ldsl, g, S, E, tid); }
#endif
                CVT_TAIL(7, 24);
                SEAM(pb + 0);
             PT_E(5); }
            if (EN(6) && IN(pb + 1)) { PT_B(6); PHASE_IDS(); ph_qknorm(a, gw, NGW, lane); SEAM(pb + 1);  PT_E(6); }
            if (EN(7) && IN(pb + 2)) { PT_B(7); PHASE_IDS(); ph_attn_gqa(a, (char*)lds, vcu, G, tid); SEAM(pb + 2);  PT_E(7); }
        }
        if (EN(8) && m != 0 && IN(pb + 3)) { PT_B(8);
            const bf16* Wt = (const bf16*)(a.ws + (m == 1 ? WS_NAWO : WS_GWO));
            pg8::Order S; S.init(ntile, 4, G, bx, 1 << 20, 0);
            pg8::EpiBf16 E{(bf16*)(a.ws + WS_R + R_Y), DM, 0, 0, 1.0f, nullptr, 1.0f};
#if WO_F8
            pg8::Gemm g{(const void*)(a.ws + WS_R + R_O8), Wt, DM, DM, DM, 0, 0, nullptr};
            { PHASE_IDS(); pg8::gemm_phase<false, 1>(ldsl, g, S, E, tid, 127 - WO_LOG2); }
#else
            pg8::Gemm g{(const void*)(a.ws + WS_R + (m == 1 ? R_Q : R_GQ)), Wt, DM, DM, DM, 0, 0, nullptr};
            { PHASE_IDS(); pg8::gemm_phase<false, 2>(ldsl, g, S, E, tid); }
#endif
            if (L == 1) CVT_TAIL(4, 16);
            SEAM(pb + 3);
         PT_E(8); }
        if (EN(9) && IN(pb + 4)) { PT_B(9); PHASE_IDS(); if (L == 0) ph_ln1<false>(a, L, rows, ldsl, gw, NGW, tid, lane); else ph_ln1<true>(a, L, rows, ldsl, gw, NGW, tid, lane);
SEAM(pb + 4);
#ifdef PROBE_DUPLN1
            if (L > 0) for (int rep_ = 0; rep_ < 6; ++rep_) { PHASE_IDS(); ph_ln1<true, PROBE_DUPLN1>(a, L, rows, ldsl, gw, NGW, tid, lane); xcd_barrier(bar); }
#endif
  PT_E(9); }
        if (EN(10) && IN(pb + 5)) { PT_B(10); PHASE_IDS(); ph_topk(a, upd, ldsl, tid, lane, wave);
            if (cvt_defer && bx >= 64) {
                const int w_ = L == 0 ? 1 : L == 1 ? 5 : L == 2 ? 8 : 9;
                p0_convert(a, ldsl, cvt_wlo(w_), cvt_wlo(w_ + 1), (bx - 64) * NWAVES + wave, (G - 64) * NWAVES, lane, wave); }
            SEAM(pb + 5);  PT_E(10); }
        const int et = upd ? ETILES : ETILES - 1;
        if (EN(12) && IN(pb + 7)) { PT_B(12);
#if MOE_F8
            pg8::Gemm g{(const void*)(a.ws + WS_H), (const void*)(a.ws + WS_W13 + (size_t)L * NE * 2 * FF * DM), DM, DM, DM, 0, (size_t)2 * FF * DM, (const int*)(a.ws + WS_SLOT)};
            pg8::Order S; S.init(NE * et, 2 * FF / 256, G, bx, et, ETILES);
            pg8::EpiSwiGLU<true> E{(void*)(a.ws + WS_R + R_HID), FF};
            { PHASE_IDS(); pg8::gemm_phase<true, 1>(ldsl, g, S, E, tid, 127 - W13_LOG2); }
#ifdef PROBE_DUPUP
            if (L == 0) { xcd_barrier(bar);
                pg8::EpiSwiGLU<true> E2{(void*)(a.ws + (size_t)1600 * MiB), FF, PROBE_DUPUP == 4}; pg8::Order S2 = S; S2.degenerate = (PROBE_DUPUP == 2); pg8::Gemm g2 = g; if (PROBE_DUPUP == 3) g2.K = 512;
                for (int rep = 0; rep < 4; ++rep) { { PHASE_IDS(); pg8::gemm_phase<true, 1>(ldsl, g2, S2, E2, tid, 127 - W13_LOG2); } xcd_barrier(bar); } }
#endif
#else
            pg8::Gemm g{(const void*)(a.ws + WS_H), (const void*)((const bf16*)(a.ws + WS_W13) + (size_t)L * NE * 2 * FF * DM), DM, DM, DM, 0, (size_t)2 * FF * DM, (const int*)(a.ws + WS_SLOT)};
            pg8::Order S; S.init(NE * et, 2 * FF / 256, G, bx, et, ETILES);
            pg8::EpiSwiGLU<false> E{(void*)(a.ws + WS_R + R_HID), FF};
            { PHASE_IDS(); pg8::gemm_phase<true, 2>(ldsl, g, S, E, tid); }
#endif
            SEAM(pb + 7);
         PT_E(12); }
        if (EN(13) && IN(pb + 8)) { PT_B(13);
#if MOE_F8
            pg8::Gemm g{(const void*)(a.ws + WS_R + R_HID), (const void*)(a.ws + WS_W2 + (size_t)L * NE * DM * FF), FF, FF, FF, 0, (size_t)DM * FF, nullptr};
            pg8::Order S; S.init(NE * et, DM / 256, G, bx, et, ETILES);
            pg8::EpiBf16 E{(bf16*)(a.ws + WS_R + R_YS), DM, 0, 0, 1.0f, nullptr, 1.0f, YS_F8 != 0};
            { PHASE_IDS(); pg8::gemm_phase<false, 1>(ldsl, g, S, E, tid, 127 - W2_LOG2); }
            if (L == 0) CVT_TAIL(2, 64); else if (L == 1) CVT_TAIL(6, 64);
#else
            pg8::Gemm g{(const void*)(a.ws + WS_R + R_HID), (const void*)((const bf16*)(a.ws + WS_W2) + (size_t)L * NE * DM * FF), FF, FF, FF, 0, (size_t)DM * FF, nullptr};
            pg8::Order S; S.init(NE * et, DM / 256, G, bx, et, ETILES);
            pg8::EpiBf16 E{(bf16*)(a.ws + WS_R + R_YS), DM, 0, 0, 1.0f, nullptr, 1.0f};
            { PHASE_IDS(); pg8::gemm_phase<false, 2>(ldsl, g, S, E, tid); }
#endif
            SEAM(pb + 8);
         PT_E(13); }
        if (EN(14) && IN(pb + 9)) { PT_B(14); PHASE_IDS(); ph_ln2(a, L, rows, ldsl, gw, NGW, tid, lane); if (L + 1 < DEPTH) SEAM(pb + 9);  PT_E(14); }
    }
#ifdef PROBE_MASK
#ifdef PROBE_CLOCK
    if (blockIdx.x == 0) { const unsigned long long t0 = __builtin_amdgcn_s_memrealtime(); const unsigned long long wait = pt_acc ? (pt_cyc * 10000ull) / pt_acc : 0ull;
        while (__builtin_amdgcn_s_memrealtime() - t0 < wait) __builtin_amdgcn_s_sleep(8); }
#else
    if (blockIdx.x == 0) { const unsigned long long t0 = __builtin_amdgcn_s_memrealtime(); while (__builtin_amdgcn_s_memrealtime() - t0 < (unsigned long long)(PROBE_K) * pt_acc) __builtin_amdgcn_s_sleep(8); }
#endif
#endif
#undef IN
#undef SEAM
}

extern "C" void kernel_launch(void* const* d_in, const int* in_sizes, int n_in, void* d_out, int out_size, void* d_ws, size_t ws_size, hipStream_t stream) {
    static int grid = 0;
    if (grid == 0) {
        if (n_in != 21 || out_size != M_LAT * DM || ws_size < WS_END) { fprintf(stderr, "kernel_launch: unexpected shapes (n_in %d, out %d, ws %zu)\n", n_in, out_size, ws_size); grid = -1; return; }
        int dev = 0, cus = 0, per_cu = 0;
        if (hipGetDevice(&dev) != hipSuccess || hipDeviceGetAttribute(&cus, hipDeviceAttributeMultiprocessorCount, dev) != hipSuccess) { grid = -1; return; }
        if (hipFuncSetAttribute((const void*)mk_fwd, hipFuncAttributeMaxDynamicSharedMemorySize, LDS_BYTES) != hipSuccess) { fprintf(stderr, "kernel_launch: hipFuncSetAttribute failed\n"); grid = -1; return; }
        if (hipOccupancyMaxActiveBlocksPerMultiprocessor(&per_cu, (const void*)mk_fwd, NWAVES * 64, LDS_BYTES) != hipSuccess || per_cu < 1) { fprintf(stderr, "kernel_launch: occupancy query reports %d\n", per_cu); (void)hipGetLastError(); grid = -1; return; }
        grid = cus;
    }
    if (grid < 0) return;
    if (hipMemsetAsync((char*)d_ws + WS_CTL, 0, CTL_ZERO_BYTES, stream) != hipSuccess) return;
    Args a{};
    for (int i = 0; i < 21; ++i) a.in[i] = (const float*)d_in[i];
    a.out = (float*)d_out; a.ws = (unsigned char*)d_ws;
#if MK_PER_PHASE
    for (int k = 0; k < N_PHASE_IDS; ++k) {
        const int r = (k - 1) % PH_PER_LAYER, L = (k - 1) / PH_PER_LAYER, m = L % 3;
        if (k > 0 && (r > 9 || r == 6 || (r == 2 && m != 2) || (r == 3 && m == 0))) continue;
        a.ph_lo = k; a.ph_hi = k + 1; a.li = 0;
        hipLaunchKernelGGL(mk_fwd, dim3(grid), dim3(NWAVES * 64), LDS_BYTES, stream, a);
    }
#else
    a.ph_lo = 0; a.ph_hi = N_PHASE_IDS; a.li = 0;
    hipLaunchKernelGGL(mk_fwd, dim3(grid), dim3(NWAVES * 64), LDS_BYTES, stream, a);
#endif
    const hipError_t le = hipPeekAtLastError();
    if (le != hipSuccess) fprintf(stderr, "kernel_launch: launch failed: %s\n", hipGetErrorName(le));
}
```

```cpp
#include <hip/hip_runtime.h>
#include <hip/hip_bf16.h>
#include <cstdio>
#include <cstdint>
#include <cmath>
#include <type_traits>

namespace pg8 {
#define PG8_LAS __attribute__((address_space(3)))
typedef unsigned short bf16_t;
typedef short bf16x8 __attribute__((ext_vector_type(8)));
typedef float f32x4 __attribute__((ext_vector_type(4)));
typedef unsigned u32x4 __attribute__((ext_vector_type(4)));
typedef unsigned u32x2 __attribute__((ext_vector_type(2)));
typedef int i32x4 __attribute__((ext_vector_type(4)));
typedef int i32x8 __attribute__((ext_vector_type(8)));
constexpr int BM = 256, BK = 64, HALF = 128, HTB = HALF * BK * 2, STAGE_BYTES = 8 * HTB, NXCD = 8, WGM = 8;

__host__ __device__ __forceinline__ int lds_byte(int r, int c) { const int st = (r >> 4) * 2 + (c >> 5), rr = r & 15, cc = c & 31, ob = rr * 64 + cc * 2; return st * 1024 + (ob ^ (((ob >> 9) & 1) << 5)); }
__host__ __device__ __forceinline__ void stage_rc(int b, int& R, int& C) { const int st = b / 1024, sb = b % 1024, swz = sb ^ (((sb >> 9) & 1) << 5); R = (st >> 1) * 16 + swz / 64; C = (st & 1) * 32 + (swz % 64) / 2; }
__host__ __device__ __forceinline__ int perm32(int rho) { const int n = rho >> 4, i = rho & 15; return 8 * (i >> 2) + 4 * n + (i & 3); }

struct Unit { int pm, pn, e; };
struct Gemm { const void* A; const void* Bt; int lda, ldb, K, a_pn_off; size_t b_e_stride; const int* rowidx; };

struct Order {
    int nM, nN, nwg, G, c, tpe, tstride; bool degenerate;
    int L, gid, rem, nig, inv_tpe;
    __device__ void init(int nM_, int nN_, int G_, int c_, int tpe_, int tstride_) { nM = nM_; nN = nN_; nwg = nM * nN; G = G_; c = c_; tpe = tpe_; tstride = tstride_; degenerate = false;
        nig = WGM * nN; inv_tpe = (int)(((1u << 20) + (unsigned)tpe - 1u) / (unsigned)tpe); L = -1; gid = 0; rem = 0; }
    __device__ void emit(Unit& u) const {
        const int fm = gid * WGM, gsz = (nM - fm) < WGM ? (nM - fm) : WGM;
        int pmo, pn; if (gsz == WGM) { pmo = rem & (WGM - 1); pn = rem >> 3; } else { pn = rem / gsz; pmo = rem - pn * gsz; }
        const int v = fm + pmo; u.pn = pn; u.e = (int)(((unsigned)v * (unsigned)inv_tpe) >> 20); u.pm = u.e * tstride + (v - u.e * tpe);
        if (degenerate) { u.e = 0; u.pm = 0; }
    }
    __device__ bool begin(Unit& u) {
        L = c; if (L >= nwg) return false;
        const int q = nwg / NXCD, r = nwg % NXCD, xcd = L % NXCD, off = L / NXCD; const int wgid = (xcd < r ? xcd * (q + 1) : r * (q + 1) + (xcd - r) * q) + off;
        gid = wgid / nig; rem = wgid - gid * nig; emit(u); return true;
    }
    __device__ bool advance(Unit& u) {
        L += G; if (L >= nwg) return false;
        rem += G / NXCD; while (rem >= nig) { rem -= nig; ++gid; }
        emit(u); return true;
    }
};

__device__ __forceinline__ unsigned cvt_pk_bf16(float lo, float hi) { unsigned r; asm volatile("v_cvt_pk_bf16_f32 %0, %1, %2" : "=v"(r) : "v"(lo), "v"(hi)); return r; }

struct EpiBf16 {
    static constexpr bool PERM = true;
    bf16_t* O; int ldc; int split_cols; size_t split_stride; float scale0; const float* colscale; float gscale; bool out8 = false;
    __device__ __forceinline__ void operator()(const f32x4 (&acc)[2][2][4][2], const Unit& u, int wr, int wc, int fr, int fq, PG8_LAS unsigned char* lds, int wid, int lane) const {
        const int row0 = u.pm * BM + wr * 64 + fr; int colt = u.pn * BM; bf16_t* base = O;
        float sc = gscale; if (split_cols) { const int t = colt / split_cols; base += (size_t)t * split_stride; colt -= t * split_cols; if (t == 0) sc = scale0 * gscale; }
        const int col0 = colt + wc * 32 + 8 * fq;
        f32x4 cs[2][2];
#pragma unroll
        for (int bj = 0; bj < 2; ++bj)
#pragma unroll
            for (int n = 0; n < 2; ++n) cs[bj][n] = colscale ? *(const f32x4*)(colscale + u.pn * BM + wc * 32 + 8 * fq + bj * HALF + 4 * n) * sc : (f32x4){sc, sc, sc, sc};
#pragma unroll
        for (int ai = 0; ai < 2; ++ai)
#pragma unroll
            for (int m = 0; m < 4; ++m) { bf16_t* rowp = base + (size_t)(row0 + ai * HALF + m * 16) * ldc + col0;
#pragma unroll
                for (int bj = 0; bj < 2; ++bj) { f32x4 v0 = acc[ai][bj][m][0] * cs[bj][0], v1 = acc[ai][bj][m][1] * cs[bj][1];
                    if (out8) { int t0 = 0, t1 = 0; t0 = __builtin_amdgcn_cvt_pk_fp8_f32(v0[0], v0[1], t0, false); t0 = __builtin_amdgcn_cvt_pk_fp8_f32(v0[2], v0[3], t0, true);
                        t1 = __builtin_amdgcn_cvt_pk_fp8_f32(v1[0], v1[1], t1, false); t1 = __builtin_amdgcn_cvt_pk_fp8_f32(v1[2], v1[3], t1, true);
                        *(u32x2*)((unsigned char*)base + (size_t)(row0 + ai * HALF + m * 16) * ldc + col0 + bj * HALF) = (u32x2){(unsigned)t0, (unsigned)t1}; }
                    else { u32x4 w; w.x = cvt_pk_bf16(v0[0], v0[1]); w.y = cvt_pk_bf16(v0[2], v0[3]); w.z = cvt_pk_bf16(v1[0], v1[1]); w.w = cvt_pk_bf16(v1[2], v1[3]);
                    *(u32x4*)(rowp + bj * HALF) = w; } } }
    }
};
struct EpiF32 {
    static constexpr bool PERM = false;
    float* C; int ldc; const float* colscale;
    __device__ __forceinline__ void operator()(const f32x4 (&acc)[2][2][4][2], const Unit& u, int wr, int wc, int fr, int fq, PG8_LAS unsigned char* lds, int wid, int lane) const {
        const int row0 = u.pm * BM + wr * 64 + fr, col0 = u.pn * BM + wc * 32 + 4 * fq;
        f32x4 sv[2][2];
#pragma unroll
        for (int bj = 0; bj < 2; ++bj)
#pragma unroll
            for (int n = 0; n < 2; ++n) sv[bj][n] = colscale ? *(const f32x4*)(colscale + col0 + bj * HALF + n * 16) : (f32x4){1.f, 1.f, 1.f, 1.f};
#pragma unroll
        for (int ai = 0; ai < 2; ++ai)
#pragma unroll
            for (int m = 0; m < 4; ++m) { float* rowp = C + (size_t)(row0 + ai * HALF + m * 16) * ldc + col0;
#pragma unroll
                for (int bj = 0; bj < 2; ++bj)
#pragma unroll
                    for (int n = 0; n < 2; ++n) *(f32x4*)(rowp + bj * HALF + n * 16) = acc[ai][bj][m][n] * sv[bj][n]; }
    }
};
template <bool OUT8> struct EpiSwiGLU {
    static constexpr bool PERM = true;
    void* Hd; int ldh; bool nostore = false;
    __device__ __forceinline__ void silu4(const f32x4 a, const f32x4 b, float (&h)[4]) const {
        typedef float f2 __attribute__((ext_vector_type(2)));
#pragma unroll
        for (int i = 0; i < 4; i += 2) {
            const f2 av = {a[i], a[i + 1]}, bv = {b[i], b[i + 1]}; const f2 t = av * -1.4426950408889634f; f2 ex; ex.x = __builtin_amdgcn_exp2f(t.x); ex.y = __builtin_amdgcn_exp2f(t.y);
            const f2 d = ex + 1.0f; f2 r; r.x = __builtin_amdgcn_rcpf(d.x); r.y = __builtin_amdgcn_rcpf(d.y); const f2 hv = (av * bv) * r; h[i] = hv.x; h[i + 1] = hv.y; }
    }
    __device__ __forceinline__ void operator()(const f32x4 (&acc)[2][2][4][2], const Unit& u, int wr, int wc, int fr, int fq, PG8_LAS unsigned char* lds, int wid, int lane) const {
        if constexpr (OUT8) {
            PG8_LAS unsigned char* st = lds + 3 * HTB;
#pragma unroll
            for (int ai = 0; ai < 2; ++ai) {
#pragma unroll
                for (int m = 0; m < 4; ++m) { const int r = wr * 64 + m * 16 + fr;
#pragma unroll
                    for (int bj = 0; bj < 2; ++bj) { float h[4]; silu4(acc[ai][bj][m][0], acc[ai][bj][m][1], h);
                        int w = 0; w = __builtin_amdgcn_cvt_pk_fp8_f32(h[0], h[1], w, false); w = __builtin_amdgcn_cvt_pk_fp8_f32(h[2], h[3], w, true);
                        *(PG8_LAS int*)(st + r * 128 + (((wc + 4 * bj) ^ (r & 7)) << 4) + 4 * fq) = w; } }
                asm volatile("s_waitcnt lgkmcnt(0)" ::: "memory"); __builtin_amdgcn_s_barrier(); asm volatile("" ::: "memory");
#pragma unroll
                for (int k = 0; k < 2; ++k) { const int r = 16 * wid + 8 * k + (lane >> 3), c = lane & 7;
                    const u32x4 v = *(const PG8_LAS u32x4*)(st + r * 128 + ((c ^ (r & 7)) << 4));
                    if (!nostore) *(u32x4*)((unsigned char*)Hd + (size_t)(u.pm * BM + ai * HALF + r) * ldh + u.pn * (BM / 2) + 16 * c) = v; else asm volatile("" :: "v"(v)); }
                asm volatile("s_waitcnt lgkmcnt(0)" ::: "memory"); __builtin_amdgcn_s_barrier(); asm volatile("" ::: "memory");
            }
        } else {
            const int row0 = u.pm * BM + wr * 64 + fr; const int hc0 = (u.pn * BM + wc * 32 + 8 * fq) >> 1;
#pragma unroll
            for (int ai = 0; ai < 2; ++ai)
#pragma unroll
                for (int m = 0; m < 4; ++m) { const size_t ro = (size_t)(row0 + ai * HALF + m * 16) * ldh + hc0;
#pragma unroll
                    for (int bj = 0; bj < 2; ++bj) { float h[4]; silu4(acc[ai][bj][m][0], acc[ai][bj][m][1], h);
                        u32x2 w; w.x = cvt_pk_bf16(h[0], h[1]); w.y = cvt_pk_bf16(h[2], h[3]); *(u32x2*)((bf16_t*)Hd + ro + bj * (HALF / 2)) = w; } }
        }
    }
};

template <bool GATHER, int ES, class Epi, class Sched>
__device__ __forceinline__ void gemm_phase(PG8_LAS unsigned char* lds, const Gemm g, const Sched& S, const Epi& E, const int tid, const int wscale_e8m0 = 127) {
    const int wid = __builtin_amdgcn_readfirstlane(tid >> 6), lane = tid & 63, wr = wid >> 2, wc = wid & 3, fr = lane & 15, fq = lane >> 4;
    const int K = g.K, nt = K * ES / (BK * 2);
    unsigned voffA[2][2], voffAn[2][2], voffB[2]; int Rr[2], Cc[2];
#pragma unroll
    for (int i = 0; i < 2; ++i) { int R, C; stage_rc(tid * 16 + i * 8192, R, C); const int Rb = Epi::PERM ? ((R & ~31) + perm32(R & 31)) : R; Rr[i] = R; Cc[i] = C;
        voffA[0][i] = (unsigned)(R * g.lda * ES + C * 2); voffA[1][i] = (unsigned)((R + HALF) * g.lda * ES + C * 2); voffB[i] = (unsigned)(Rb * g.ldb * ES + C * 2);
        voffAn[0][i] = voffA[0][i]; voffAn[1][i] = voffA[1][i]; }
    const size_t kstep = (size_t)(BK * 2);
    const size_t hB = (size_t)HALF * g.ldb * ES;
    const unsigned ldsw = (unsigned)wid * 1024u;
    const int aoff = lds_byte(wr * 64 + fr, fq * 8), boff = lds_byte(wc * 32 + fr, fq * 8);
#define PG8_APTR(u) (GATHER ? (const char*)g.A : (const char*)g.A + ((size_t)(u).pm * BM * g.lda + (size_t)(u).pn * g.a_pn_off) * ES)
#define PG8_IDXDMA(u) __builtin_amdgcn_global_load_lds((const unsigned*)(g.rowidx + (u).pm * BM + idxrow), (PG8_LAS unsigned*)(lds + STAGE_BYTES + wid * 256), 4, 0, 0)
#define PG8_TOKL(h, i) ib[(h) * 32 + (i) * 16 + (Rr[i] & 15)]
#define PG8_VOFF(tok, i) ((unsigned)(((tok) < 0 ? 0 : (tok)) * g.lda * ES + Cc[i] * 2))
#define PG8_BPTR(u) ((const char*)g.Bt + ((size_t)(u).e * g.b_e_stride + (size_t)(u).pn * BM * g.ldb) * ES)
#define PG8_SA(b, h) (((b) * 2 + (h)) * HTB)
#define PG8_SB(b, h) ((4 + (b) * 2 + (h)) * HTB)
#define PG8_STAGE(bufoff, gbase, voff) do { _Pragma("unroll") for (int _i = 0; _i < 2; ++_i) { unsigned _vo = (voff)[_i]; asm volatile("" : "+v"(_vo));     \
        __builtin_amdgcn_global_load_lds((const unsigned*)((const char*)(gbase) + _vo), (PG8_LAS unsigned*)(lds + (bufoff) + ldsw + _i * 8192), 16, 0, 0); } } while (0)
#define PG8_LDA(dst, b, h) do { _Pragma("unroll") for (int m = 0; m < 4; ++m) _Pragma("unroll") for (int k = 0; k < 2; ++k) dst[m][k] = *(const PG8_LAS bf16x8*)(lds + PG8_SA(b, h) + aoff + m * 2048 + k * 1024); } while (0)
#define PG8_LDB(dst, b, h) do { _Pragma("unroll") for (int n = 0; n < 2; ++n) _Pragma("unroll") for (int k = 0; k < 2; ++k) dst[n][k] = *(const PG8_LAS bf16x8*)(lds + PG8_SB(b, h) + boff + n * 2048 + k * 1024); } while (0)
#define PG8_CAT8(x0, x1) __builtin_shufflevector(__builtin_bit_cast(i32x4, x0), __builtin_bit_cast(i32x4, x1), 0, 1, 2, 3, 4, 5, 6, 7)
#define PG8_MMA(ai, bj, At, Bt) do { __builtin_amdgcn_s_setprio(1); _Pragma("unroll") for (int m = 0; m < 4; ++m) _Pragma("unroll") for (int n = 0; n < 2; ++n) { \
        if constexpr (ES == 2) { _Pragma("unroll") for (int k = 0; k < 2; ++k) acc[ai][bj][m][n] = __builtin_amdgcn_mfma_f32_16x16x32_bf16(Bt[n][k], At[m][k], acc[ai][bj][m][n], 0, 0, 0); } \
        else   \
            { const i32x8 b8_ = PG8_CAT8(Bt[n][0], Bt[n][1]), a8_ = PG8_CAT8(At[m][0], At[m][1]);   \
              asm volatile("v_mfma_scale_f32_16x16x128_f8f6f4 %0, %1, %2, %0, %3, %4 op_sel_hi:[0,0,0]" : "+v"(acc[ai][bj][m][n]) : "v"(b8_), "v"(a8_), "v"(f8wscale), "v"(f8scale)); } } \
        __builtin_amdgcn_s_setprio(0); } while (0)
#define PG8_WAIT_V(n) asm volatile("s_waitcnt vmcnt(" #n ")" ::: "memory")
#define PG8_WAIT_L(n) asm volatile("s_waitcnt lgkmcnt(" #n ")" ::: "memory")
#define PG8_BAR __builtin_amdgcn_s_barrier()
#define PG8_SCHED __builtin_amdgcn_sched_barrier(0)
    int f8scale = 0x7f7f7f7f, f8wscale = wscale_e8m0 * 0x01010101; asm volatile("" : "+v"(f8scale), "+v"(f8wscale));
    Unit cur, nxt; Sched W = S;
    if (!W.begin(cur)) return;
    f32x4 acc[2][2][4][2];
#pragma unroll
    for (int a = 0; a < 2; ++a)
#pragma unroll
        for (int b = 0; b < 2; ++b)
#pragma unroll
            for (int m = 0; m < 4; ++m)
#pragma unroll
                for (int n = 0; n < 2; ++n) acc[a][b][m][n] = (f32x4){0.f, 0.f, 0.f, 0.f};
    bf16x8 At[4][2], B0[2][2], B1[2][2];
    const char* cA = PG8_APTR(cur); const char* cB = PG8_BPTR(cur);
    const int idxrow = (lane >> 5) * HALF + ((lane >> 4) & 1) * 64 + 16 * (wid >> 1) + (lane & 15);
    volatile PG8_LAS int* ib = (volatile PG8_LAS int*)(lds + STAGE_BYTES + wid * 256);
    if constexpr (GATHER) { PG8_IDXDMA(cur); asm volatile("s_waitcnt vmcnt(0)" ::: "memory");
#pragma unroll
        for (int h = 0; h < 2; ++h)
#pragma unroll
            for (int i = 0; i < 2; ++i) { const int tk = PG8_TOKL(h, i); voffA[h][i] = PG8_VOFF(tk, i); } }
    PG8_STAGE(PG8_SB(0, 0), cB, voffB); PG8_STAGE(PG8_SB(0, 1), cB + hB, voffB); PG8_STAGE(PG8_SA(0, 0), cA, voffA[0]); PG8_STAGE(PG8_SA(0, 1), cA, voffA[1]);
    if (wr == 1) PG8_BAR;
    PG8_WAIT_V(2); PG8_BAR;
    PG8_STAGE(PG8_SB(1, 0), cB + kstep, voffB); PG8_STAGE(PG8_SA(1, 0), cA + kstep, voffA[0]); PG8_STAGE(PG8_SB(1, 1), cB + hB + kstep, voffB);
    PG8_WAIT_V(6); PG8_BAR;
    for (;;) {
        const bool has_next = W.advance(nxt);
        const char* nA = has_next ? PG8_APTR(nxt) : cA; const char* nB = has_next ? PG8_BPTR(nxt) : cB;
        if constexpr (GATHER) { if (has_next) PG8_IDXDMA(nxt); }
        for (int t = 0; t < nt; t += 2) {
            const bool last = (t == nt - 2);
            const char* a1 = cA + (size_t)(t + 1) * kstep;
            const char* a2 = last ? nA : cA + (size_t)(t + 2) * kstep; const char* b2 = last ? nB : cB + (size_t)(t + 2) * kstep;
            const char* a3 = a2 + kstep; const char* b3 = b2 + kstep;
            unsigned va[2][2];
#pragma unroll
            for (int h = 0; h < 2; ++h)
#pragma unroll
                for (int i = 0; i < 2; ++i) va[h][i] = (GATHER && last) ? voffAn[h][i] : voffA[h][i];
            PG8_LDB(B0, 0, 0); PG8_LDB(B1, 0, 1); PG8_SCHED; PG8_LDA(At, 0, 0); PG8_STAGE(PG8_SA(1, 1), a1, voffA[1]);
            PG8_WAIT_V(8); PG8_WAIT_L(0); PG8_BAR; PG8_MMA(0, 0, At, B0); PG8_MMA(0, 1, At, B1); PG8_BAR; PG8_SCHED;
            PG8_LDA(At, 0, 1); PG8_STAGE(PG8_SB(0, 0), b2, voffB); PG8_STAGE(PG8_SB(0, 1), b2 + hB, voffB); PG8_STAGE(PG8_SA(0, 0), a2, va[0]);
            PG8_WAIT_V(8); PG8_WAIT_L(0); PG8_BAR; PG8_MMA(1, 0, At, B0); PG8_MMA(1, 1, At, B1); PG8_BAR; PG8_SCHED;
            PG8_LDB(B0, 1, 0); PG8_LDB(B1, 1, 1); PG8_SCHED; PG8_LDA(At, 1, 0); PG8_STAGE(PG8_SA(0, 1), a2, va[1]);
            PG8_WAIT_V(8); PG8_WAIT_L(0); PG8_BAR; PG8_MMA(0, 0, At, B0); PG8_MMA(0, 1, At, B1); PG8_BAR; PG8_SCHED;
            PG8_LDA(At, 1, 1); PG8_STAGE(PG8_SB(1, 0), b3, voffB); PG8_STAGE(PG8_SB(1, 1), b3 + hB, voffB); PG8_STAGE(PG8_SA(1, 0), a3, va[0]);
            PG8_WAIT_V(8); PG8_WAIT_L(0); PG8_BAR; PG8_MMA(1, 0, At, B0); PG8_MMA(1, 1, At, B1); PG8_BAR; PG8_SCHED;
            if constexpr (GATHER) {
#pragma unroll
                for (int h = 0; h < 2; ++h)
#pragma unroll
                    for (int i = 0; i < 2; ++i) { const int tk = PG8_TOKL(h, i); voffAn[h][i] = PG8_VOFF(tk, i); } }
        }
        if (wr == 0) PG8_BAR;
        if constexpr (ES == 1) asm volatile("s_nop 15\n\ts_nop 15" ::: "memory");
        E(acc, cur, wr, wc, fr, fq, lds, wid, lane);
        if (!has_next) break;
#pragma unroll
        for (int a = 0; a < 2; ++a)
#pragma unroll
            for (int b = 0; b < 2; ++b)
#pragma unroll
                for (int m = 0; m < 4; ++m)
#pragma unroll
                    for (int n = 0; n < 2; ++n) acc[a][b][m][n] = (f32x4){0.f, 0.f, 0.f, 0.f};
        cur = nxt; cA = nA; cB = nB;
        if constexpr (GATHER) {
#pragma unroll
            for (int h = 0; h < 2; ++h)
#pragma unroll
                for (int i = 0; i < 2; ++i) voffA[h][i] = voffAn[h][i]; }
        if (wr == 1) PG8_BAR;
    }
    PG8_WAIT_V(0);
    PG8_BAR;
#undef PG8_APTR
#undef PG8_IDXDMA
#undef PG8_TOKL
#undef PG8_VOFF
#undef PG8_BPTR
#undef PG8_SA
#undef PG8_SB
#undef PG8_STAGE
#undef PG8_LDA
#undef PG8_LDB
#undef PG8_MMA
#undef PG8_CAT8
#undef PG8_WAIT_V
#undef PG8_WAIT_L
#undef PG8_BAR
#undef PG8_SCHED
}
}
namespace attn_body {
using bf16=__hip_bfloat16;
using bf16x8=__attribute__((ext_vector_type(8)))short;
using s16x4=__attribute__((ext_vector_type(4)))short;
using f32x16=__attribute__((ext_vector_type(16)))float;
using u32x4=__attribute__((ext_vector_type(4)))unsigned;
constexpr int D=64;
constexpr int NW=8,QBLK=32,QB=QBLK*NW,KVBLK=64;
__device__ __forceinline__ int crow(int r,int hi){return (r&3)+8*(r>>2)+4*hi;}
#define SBAR() __builtin_amdgcn_sched_barrier(0)
constexpr int NSLOT=3, SLOTB=8192;
constexpr int LDS_K=0, LDS_V=NSLOT*SLOTB, LDS_WS=2*NSLOT*SLOTB, LDS_OST=LDS_WS+NW*64*4, LDS_BYTES=LDS_OST+NW*4096;
constexpr int LDS_BIAS=LDS_BYTES;
constexpr float C2=0.125f*1.4426950408889634f;
__device__ __forceinline__ void glds16(const void*gsrc,unsigned lds_dst){unsigned keep;
  asm volatile("s_mov_b32 %0, m0\n\ts_mov_b32 m0, %2\n\ts_nop 0\n\tglobal_load_lds_dwordx4 %1, off\n\ts_mov_b32 m0, %0":"=&s"(keep):"v"(gsrc),"s"(lds_dst):"memory");}
__device__ __forceinline__ float max3f(float a,float b,float c){float r;asm("v_max3_f32 %0, %1, %2, %3":"=v"(r):"v"(a),"v"(b),"v"(c));return r;}
__device__ __forceinline__ float max2f(float a,float b){float r;asm("v_max_f32_e32 %0, %1, %2":"=v"(r):"v"(a),"v"(b));return r;}
__device__ __forceinline__ float fadd_s(float a,float b){float r;asm("v_add_f32_e32 %0, %1, %2":"=v"(r):"v"(a),"v"(b));return r;}
__device__ __forceinline__ float fsub_s(float a,float b){float r;asm("v_sub_f32_e32 %0, %1, %2":"=v"(r):"v"(a),"v"(b));return r;}
typedef float f32x2_t __attribute__((ext_vector_type(2))); typedef __bf16 bf16x2_t __attribute__((ext_vector_type(2)));
__device__ __forceinline__ unsigned cvtpk_s(float lo,float hi){f32x2_t v={lo,hi};bf16x2_t b=__builtin_convertvector(v,bf16x2_t);return __builtin_bit_cast(unsigned,b);}
#define WAIT_BAR(N) asm volatile("s_waitcnt vmcnt(" #N ") lgkmcnt(0)\n\ts_barrier":::"memory")

__device__ __forceinline__ void qkt(f32x16&p0,f32x16&p1,const char*Kslot,const bf16x8*qr,const f32x16&negm,int r32,int hi){
  const char*kb=Kslot+hi*1024+r32*16;
  #pragma unroll
  for(int d0=0;d0<4;++d0){
    const bf16x8 b0=*reinterpret_cast<const bf16x8*>(kb+d0*2048);
    const bf16x8 b1=*reinterpret_cast<const bf16x8*>(kb+d0*2048+512);
    if(d0==0){p0=__builtin_amdgcn_mfma_f32_32x32x16_bf16(b0,qr[0],negm,0,0,0);p1=__builtin_amdgcn_mfma_f32_32x32x16_bf16(b1,qr[0],negm,0,0,0);}
    else{p0=__builtin_amdgcn_mfma_f32_32x32x16_bf16(b0,qr[d0],p0,0,0,0);p1=__builtin_amdgcn_mfma_f32_32x32x16_bf16(b1,qr[d0],p1,0,0,0);}}
}
typedef __attribute__((address_space(3))) const char* lds_cptr;
typedef short v4i16_t __attribute__((ext_vector_type(4)));
__device__ __forceinline__ void kload8(bf16x8*kf,lds_cptr kp){
  kf[0]=*(const __attribute__((address_space(3))) bf16x8*)(kp);      kf[1]=*(const __attribute__((address_space(3))) bf16x8*)(kp+512);
  kf[2]=*(const __attribute__((address_space(3))) bf16x8*)(kp+2048); kf[3]=*(const __attribute__((address_space(3))) bf16x8*)(kp+2560);
  kf[4]=*(const __attribute__((address_space(3))) bf16x8*)(kp+4096); kf[5]=*(const __attribute__((address_space(3))) bf16x8*)(kp+4608);
  kf[6]=*(const __attribute__((address_space(3))) bf16x8*)(kp+6144); kf[7]=*(const __attribute__((address_space(3))) bf16x8*)(kp+6656);
}
__device__ __forceinline__ void kload2(bf16x8*kf,lds_cptr kp,int j){ kf[2*j]=*(const __attribute__((address_space(3))) bf16x8*)(kp+j*2048); kf[2*j+1]=*(const __attribute__((address_space(3))) bf16x8*)(kp+j*2048+512); }
__device__ __forceinline__ s16x4 vtr(lds_cptr p){ return __builtin_bit_cast(s16x4,__builtin_amdgcn_ds_read_tr16_b64_v4i16((__attribute__((address_space(3))) v4i16_t*)p)); }
__device__ __forceinline__ float rowmax(const f32x16&p0,const f32x16&p1){
  float a=max3f(p0[0],p0[1],p1[0]),b=max3f(p0[2],p0[3],p1[1]);a=max3f(a,p1[2],p1[3]);
  #pragma unroll
  for(int r=4;r<16;r+=4){a=max3f(a,p0[r],p0[r+1]);b=max3f(b,p0[r+2],p0[r+3]);a=max3f(a,p1[r],p1[r+1]);b=max3f(b,p1[r+2],p1[r+3]);}
  const float m=max2f(a,b);
  auto rr=__builtin_amdgcn_permlane32_swap(__float_as_uint(m),__float_as_uint(m),false,false);
  return max2f(__uint_as_float(rr[0]),__uint_as_float(rr[1]));
}
__device__ __forceinline__ void pv(f32x16*o,int vb,bf16x8 pa0,bf16x8 pa1,bf16x8 pa2,bf16x8 pa3){
  #pragma unroll
  for(int d0=0;d0<2;++d0){s16x4 lo[4],hi[4];
    #pragma unroll
    for(int ks=0;ks<4;++ks){
      asm volatile("ds_read_b64_tr_b16 %0,%1 offset:%c2":"=&v"(lo[ks]):"v"(vb),"i"(d0*4096+ks*1024):"memory");
      asm volatile("ds_read_b64_tr_b16 %0,%1 offset:%c2":"=&v"(hi[ks]):"v"(vb),"i"(d0*4096+ks*1024+512):"memory");}
    asm volatile("s_waitcnt lgkmcnt(0)":::"memory");SBAR();
    #define PK(k) (bf16x8){lo[k][0],lo[k][1],lo[k][2],lo[k][3],hi[k][0],hi[k][1],hi[k][2],hi[k][3]}
    o[d0]=__builtin_amdgcn_mfma_f32_32x32x16_bf16(pa0,PK(0),o[d0],0,0,0);
    o[d0]=__builtin_amdgcn_mfma_f32_32x32x16_bf16(pa1,PK(1),o[d0],0,0,0);
    o[d0]=__builtin_amdgcn_mfma_f32_32x32x16_bf16(pa2,PK(2),o[d0],0,0,0);
    o[d0]=__builtin_amdgcn_mfma_f32_32x32x16_bf16(pa3,PK(3),o[d0],0,0,0);
    #undef PK
  }
}
struct TileRows { long base0, base1; int nfirst; __device__ __forceinline__ long operator()(int t) const { return t < nfirst ? base0 + 64l * t : base1 + 64l * (t - nfirst); } };
struct NoMask { static constexpr bool ACTIVE=false; __device__ __forceinline__ void apply(f32x16&,f32x16&,int) const {} };
struct NaMask {
  static constexpr bool ACTIVE=true;
  int kbase, qr, r0q, qcol, c0, hi; lds_cptr bias;
  __device__ __forceinline__ void apply(f32x16&p0,f32x16&p1,int t) const {
    if(t<4) return;
    const int kr=kbase+(t-4); const float NEG=-1.0e30f;
    if(kr<r0q||kr>r0q+7){
      #pragma unroll
      for(int r=0;r<16;++r){p0[r]=NEG;p1[r]=NEG;}
      return; }
    const int ib=(kr-qr+7)*31+(4*hi-qcol+15);
    const int cb=4*hi-c0;
    #pragma unroll
    for(int r=0;r<16;++r){ const int ko=(r&3)+8*(r>>2);
      const float b0=*(const __attribute__((address_space(3))) float*)(bias+4*(ib+ko));
      const float b1=*(const __attribute__((address_space(3))) float*)(bias+4*(ib+ko+32));
#ifdef DBG_NA_NOBIAS
      p0[r]=((unsigned)(cb+ko)<16u)?p0[r]:NEG; p1[r]=((unsigned)(cb+ko+32)<16u)?p1[r]:NEG; (void)b0; (void)b1; }
#else
      p0[r]=((unsigned)(cb+ko)<16u)?p0[r]+b0:NEG;
      p1[r]=((unsigned)(cb+ko+32)<16u)?p1[r]+b1:NEG; }
#endif
  }
};

#ifndef ATTN_STORE16
#define ATTN_STORE16(p,v) (*(u32x4*)(p)=(v))
#endif
template<int THRL,class MK,bool USE_NEGM,bool OUT8,bool FIXM,bool QNORM=false> __device__ __forceinline__ void attn_unit(const bf16*Qw0,int QP,const bf16*__restrict__ Kc,const bf16*__restrict__ Vc,int KP,const TileRows TR,const int NT,void*Ow0,int OP,char*shm,const MK&mk,const int tid,const float mfix=0.f,const float*qgain=nullptr,const int qt0=0,const float rms_eps=0.f){
  static_assert(!FIXM||USE_NEGM,"FIXM puts the reference into the QK^T MFMA's C operand");
  const int lane=tid&63,r32=lane&31,hi=lane>>5; const int wid=__builtin_amdgcn_readfirstlane(tid>>6);
  const bf16*Qw=Qw0+(long)(wid*QBLK)*QP;
  const unsigned lds0=(unsigned)(uintptr_t)shm;
  float*wsf=(float*)(shm+LDS_WS)+wid*64;
  const bf16*ksrc=Kc+(long)lane*KP+wid*8;
  const bf16*vsrc=Vc+(long)(16*(wid&3)+(lane>>2))*KP+(wid>>2)*32+(lane&3)*8;
  const unsigned kdst=lds0+LDS_K+wid*1024, vdst=lds0+LDS_V+wid*1024;
  #define DMA_K(t,slot) glds16(ksrc+TR(t)*KP,(unsigned)__builtin_amdgcn_readfirstlane(kdst+(slot)))
  #define DMA_V(t,slot) glds16(vsrc+TR(t)*KP,(unsigned)__builtin_amdgcn_readfirstlane(vdst+(slot)))
  const int vb0=(int)(lds0+LDS_V)+((lane>>4)&1)*32+(lane&3)*8+(4*hi+((lane&15)>>2))*64;
  const char*Kbase=shm+LDS_K; bf16x8 kf[8];
  const lds_cptr shm3=(lds_cptr)shm; const lds_cptr kp0=shm3+LDS_K+hi*1024+r32*16; const lds_cptr vp0=shm3+LDS_V+((lane>>4)&1)*32+(lane&3)*8+(4*hi+((lane&15)>>2))*64;
  DMA_K(0,0);DMA_V(0,0);DMA_K(1,SLOTB);
  bf16x8 qr[4];
  #pragma unroll
  for(int d0=0;d0<4;++d0)qr[d0]=*reinterpret_cast<const bf16x8*>(&Qw[(long)r32*QP+d0*16+hi*8]);
  if constexpr(QNORM){
    float qf[4][8]; float ss=0.f;
    #pragma unroll
    for(int d0=0;d0<4;++d0){
      #pragma unroll
      for(int i=0;i<8;++i){ qf[d0][i]=__uint_as_float(((unsigned)(unsigned short)qr[d0][i])<<16); ss+=qf[d0][i]*qf[d0][i]; } }
    { auto rr=__builtin_amdgcn_permlane32_swap(__float_as_uint(ss),__float_as_uint(ss),false,false); ss=__uint_as_float(rr[0])+__uint_as_float(rr[1]); }
    const float rinv=(1.0f/sqrtf(ss*(1.f/64.f)+rms_eps))*C2;
    const int tq=qt0+wid*QBLK+r32; const float rowp=(float)(tq>>6), colp=(float)(tq&63);
    #pragma unroll
    for(int d0=0;d0<4;++d0){ const float pos=d0<2?rowp:colp; const float*gp=qgain+d0*16+hi*8; float g[8];
      #pragma unroll
      for(int i=0;i<8;++i)g[i]=gp[i];
      u32x4 w;
      #pragma unroll
      for(int j=0;j<4;++j){ const int pi=(d0&1)*8+hi*4+j; const float fr=__builtin_amdgcn_exp2f(-(float)pi*(13.287712379549449f/16.0f))*0.15915494309189535f;
        const float rev=pos*fr; const float c=__builtin_amdgcn_cosf(rev), sn=__builtin_amdgcn_sinf(rev);
        const float x1=qf[d0][2*j]*rinv*g[2*j], x2=qf[d0][2*j+1]*rinv*g[2*j+1]; w[j]=cvtpk_s(x1*c-x2*sn,x1*sn+x2*c); }
      qr[d0]=__builtin_bit_cast(bf16x8,w); }
  }
  float zz_; asm volatile("v_mov_b32 %0, 0":"=v"(zz_)); float mhat=zz_,l_reg=zz_;f32x16 o[2];
  _Pragma("unroll") for(int r=0;r<16;++r){o[0][r]=zz_;o[1][r]=zz_;}
  f32x16 negm; if(USE_NEGM){ _Pragma("unroll") for(int r=0;r<16;++r)negm[r]=FIXM?(zz_-mfix):zz_; asm volatile("":"+v"(negm)); }
  const f32x16 zero16=f32x16{};
  #define CIN (USE_NEGM?negm:zero16)
  #define SUBM(C0,C1) do{ if(!USE_NEGM){ _Pragma("unroll") for(int r=0;r<16;++r){C0[r]-=mhat;C1[r]-=mhat;} } }while(0)
  #define CMASK(P0,P1,t) mk.apply(P0,P1,t)
  bool resc=false;
  #define START(P0,P1) do{ resc=false; if(!FIXM) { const float rm=rowmax(P0,P1); \
    const float dl=rm; mhat=fadd_s(mhat,dl); \
      _Pragma("unroll") for(int r=0;r<16;++r){P0[r]=fsub_s(P0[r],dl);P1[r]=fsub_s(P1[r],dl);} \
      if(USE_NEGM){ _Pragma("unroll") for(int r=0;r<16;++r)negm[r]=-mhat; asm volatile("":"+v"(negm)); } } \
    _Pragma("unroll") for(int r=0;r<16;++r)P0[r]=__builtin_amdgcn_exp2f(P0[r]); }while(0)
  #define RESC() do{ if(!FIXM&&resc){ asm volatile("s_waitcnt lgkmcnt(0)":::"memory"); \
      _Pragma("unroll") for(int d_=0;d_<2;++d_) _Pragma("unroll") for(int r=0;r<16;++r)o[d_][r]*=wsf[crow(r,hi)]; } }while(0)
  f32x16 pA0,pA1,pB0,pB1;
  int sl_prev=0,sl_cur=0,sl_next=SLOTB;
  #define ROT() do{sl_prev=sl_cur;sl_cur=sl_next;sl_next=(sl_next==(NSLOT-1)*SLOTB)?0:sl_next+SLOTB;}while(0)
  DMA_K(2,2*SLOTB);
  WAIT_BAR(3);
  qkt(pA0,pA1,Kbase,qr,CIN,r32,hi);asm volatile("s_nop 15\n\ts_nop 7":"+v"(pA0),"+v"(pA1));CMASK(pA0,pA1,0);
  START(pA0,pA1);
  _Pragma("unroll") for(int r=0;r<16;++r)pA1[r]=__builtin_amdgcn_exp2f(pA1[r]);
  WAIT_BAR(0);
  DMA_K(3,0);DMA_V(1,SLOTB);
  ROT();
  kload8(kf,kp0+sl_cur);
  WAIT_BAR(2);
  s16x4 vlo[8],vhi[8]; u32x4 pw0,pw1,pw2,pw3;
  #define PKW(P,B) cvtpk_s(P[B],P[B+1])
  #define PAF(k) __builtin_bit_cast(bf16x8,pw##k)
  #define VFR(i) (bf16x8){vlo[i][0],vlo[i][1],vlo[i][2],vlo[i][3],vhi[i][0],vhi[i][1],vhi[i][2],vhi[i][3]}
  #define PIN(x) asm volatile("":"+v"(x))
  #define MX3(a,b,c) __builtin_fmaxf(__builtin_fmaxf((a),(b)),(c))
  #define GAPA(MF,A0,A1,A2,A3,W0,W1,PW) do{ MF; sacc+=A0; sacc+=A1; sacc+=A2; sacc+=A3; PIN(sacc); W0; W1; PIN(PW); SBAR(); }while(0)
  #define EX(v) __builtin_amdgcn_exp2f(v)
  #define GAPB(MF,X,B) do{ MF; X[B]=EX(X[B]); X[B+1]=EX(X[B+1]); X[B+2]=EX(X[B+2]); X[B+3]=EX(X[B+3]); PIN(X); SBAR(); }while(0)
  #define VRD(i) do{ vlo[i]=vtr(vp_+(((i)>>2)*4096+((i)&3)*1024)); vhi[i]=vtr(vp_+(((i)>>2)*4096+((i)&3)*1024+512)); }while(0)
  #define KRD(G,j) do{ if(G){ kload2(kf,kp0+sl_next,j); SBAR(); } }while(0)
  #define STEP(C0,C1,P0,P1,t,GK,GV,GL) do{ SBAR(); \
    const lds_cptr vp_=vp0+sl_prev; \
    VRD(0); SBAR(); float sacc=(P0[0]+P0[1]); \
    GAPA(C0=__builtin_amdgcn_mfma_f32_32x32x16_bf16(kf[0],qr[0],CIN,0,0,0), P0[2],P0[3],P0[4],P0[5],     pw0[0]=PKW(P0,0), pw0[1]=PKW(P0,2), pw0); \
    VRD(4); SBAR(); GAPA(C1=__builtin_amdgcn_mfma_f32_32x32x16_bf16(kf[1],qr[0],CIN,0,0,0), P0[6],P0[7],P0[8],P0[9],     pw0[2]=PKW(P0,4), pw0[3]=PKW(P0,6), pw0); \
    VRD(1); SBAR(); GAPA(C0=__builtin_amdgcn_mfma_f32_32x32x16_bf16(kf[2],qr[1],C0,0,0,0),   P0[10],P0[11],P0[12],P0[13], pw1[0]=PKW(P0,8), pw1[1]=PKW(P0,10), pw1); \
    VRD(5); SBAR(); GAPA(C1=__builtin_amdgcn_mfma_f32_32x32x16_bf16(kf[3],qr[1],C1,0,0,0),   P0[14],P0[15],P1[0],P1[1],   pw1[2]=PKW(P0,12),pw1[3]=PKW(P0,14), pw1); \
    VRD(2); SBAR(); GAPA(C0=__builtin_amdgcn_mfma_f32_32x32x16_bf16(kf[4],qr[2],C0,0,0,0),   P1[2],P1[3],P1[4],P1[5],     pw2[0]=PKW(P1,0), pw2[1]=PKW(P1,2), pw2); \
    VRD(6); SBAR(); GAPA(C1=__builtin_amdgcn_mfma_f32_32x32x16_bf16(kf[5],qr[2],C1,0,0,0),   P1[6],P1[7],P1[8],P1[9],     pw2[2]=PKW(P1,4), pw2[3]=PKW(P1,6), pw2); \
    VRD(3); SBAR(); GAPA(C0=__builtin_amdgcn_mfma_f32_32x32x16_bf16(kf[6],qr[3],C0,0,0,0),   P1[10],P1[11],P1[12],P1[13], pw3[0]=PKW(P1,8), pw3[1]=PKW(P1,10), pw3); \
    VRD(7); SBAR(); GAPA(C1=__builtin_amdgcn_mfma_f32_32x32x16_bf16(kf[7],qr[3],C1,0,0,0),   P1[14],P1[15],0.f,0.f,       pw3[2]=PKW(P1,12),pw3[3]=PKW(P1,14), pw3); \
    l_reg+=sacc; \
    if(GK){DMA_K((t)+3,sl_cur);} if(GV){DMA_V((t)+1,sl_next);} \
    SUBM(C0,C1); CMASK(C0,C1,t); \
    if(!FIXM){ float a=MX3(C0[0],C0[1],C1[0]),b=MX3(C0[2],C0[3],C1[1]); a=MX3(a,C1[2],C1[3]); \
      _Pragma("unroll") for(int r=4;r<16;r+=4){a=MX3(a,C0[r],C0[r+1]);b=MX3(b,C0[r+2],C0[r+3]);a=MX3(a,C1[r],C1[r+1]);b=MX3(b,C1[r+2],C1[r+3]);} \
      float rm=__builtin_fmaxf(a,b); { auto rr=__builtin_amdgcn_permlane32_swap(__float_as_uint(rm),__float_as_uint(rm),false,false); rm=__builtin_fmaxf(__uint_as_float(rr[0]),__uint_as_float(rr[1])); } \
      resc=false; \
      if(__builtin_expect(__any(rm>(float)THRL),0)){ const float dl=__builtin_fmaxf(rm,0.f); mhat+=dl; \
        _Pragma("unroll") for(int r=0;r<16;++r){C0[r]-=dl;C1[r]-=dl;} \
        if(USE_NEGM){ _Pragma("unroll") for(int r=0;r<16;++r)negm[r]=-mhat; asm volatile("":"+v"(negm)); } \
        const float f=__builtin_amdgcn_exp2f(-dl); l_reg*=f; if(hi==0)wsf[r32]=f; resc=true; } } \
    SBAR(); \
    GAPB(o[0]=__builtin_amdgcn_mfma_f32_32x32x16_bf16(PAF(0),VFR(0),o[0],0,0,0), C0,0); \
    GAPB(o[1]=__builtin_amdgcn_mfma_f32_32x32x16_bf16(PAF(0),VFR(4),o[1],0,0,0), C0,4); \
    KRD(GL,0); GAPB(o[0]=__builtin_amdgcn_mfma_f32_32x32x16_bf16(PAF(1),VFR(1),o[0],0,0,0), C0,8); \
    KRD(GL,1); GAPB(o[1]=__builtin_amdgcn_mfma_f32_32x32x16_bf16(PAF(1),VFR(5),o[1],0,0,0), C0,12); \
    KRD(GL,2); GAPB(o[0]=__builtin_amdgcn_mfma_f32_32x32x16_bf16(PAF(2),VFR(2),o[0],0,0,0), C1,0); \
    KRD(GL,3); GAPB(o[1]=__builtin_amdgcn_mfma_f32_32x32x16_bf16(PAF(2),VFR(6),o[1],0,0,0), C1,4); \
    GAPB(o[0]=__builtin_amdgcn_mfma_f32_32x32x16_bf16(PAF(3),VFR(3),o[0],0,0,0), C1,8); \
    GAPB(o[1]=__builtin_amdgcn_mfma_f32_32x32x16_bf16(PAF(3),VFR(7),o[1],0,0,0), C1,12); \
    }while(0)
  int t=1;
  for(;t+5<NT;t+=2){
    STEP(pB0,pB1,pA0,pA1,t,true,true,true);     WAIT_BAR(2); RESC(); ROT();
    STEP(pA0,pA1,pB0,pB1,t+1,true,true,true);   WAIT_BAR(2); RESC(); ROT();
  }
  #define ENDW(tt) do{ if((tt)+3<NT){WAIT_BAR(2);} else if((tt)+2<NT){WAIT_BAR(1);} else {WAIT_BAR(0);} }while(0)
  for(;t+1<NT;t+=2){
    STEP(pB0,pB1,pA0,pA1,t,(t+3<NT),(t+1<NT),(t+1<NT));       ENDW(t);   RESC(); ROT();
    STEP(pA0,pA1,pB0,pB1,t+1,(t+4<NT),(t+2<NT),(t+2<NT));     ENDW(t+1); RESC(); ROT();
  }
  STEP(pB0,pB1,pA0,pA1,NT-1,false,false,false); RESC();
  { float sacc=pB0[0]+pB0[1]; _Pragma("unroll") for(int r=2;r<16;++r)sacc+=pB0[r]; _Pragma("unroll") for(int r=0;r<16;++r)sacc+=pB1[r]; l_reg+=sacc;
    pw0=(u32x4){PKW(pB0,0),PKW(pB0,2),PKW(pB0,4),PKW(pB0,6)};pw1=(u32x4){PKW(pB0,8),PKW(pB0,10),PKW(pB0,12),PKW(pB0,14)};pw2=(u32x4){PKW(pB1,0),PKW(pB1,2),PKW(pB1,4),PKW(pB1,6)};pw3=(u32x4){PKW(pB1,8),PKW(pB1,10),PKW(pB1,12),PKW(pB1,14)};
    SBAR(); pv(o,vb0+sl_cur,PAF(0),PAF(1),PAF(2),PAF(3)); }
  #undef PKW
  #undef PAF
  #undef VFR
  #undef PIN
  #undef MX3
  #undef GAPA
  #undef GAPB
  #undef EX
  #undef VRD
  #undef KRD
  #undef STEP
  #undef ENDW
  {auto rr=__builtin_amdgcn_permlane32_swap(__float_as_uint(l_reg),__float_as_uint(l_reg),false,false);l_reg=__uint_as_float(rr[0])+__uint_as_float(rr[1]);}
  if(hi==0)wsf[32+r32]=l_reg;asm volatile("s_waitcnt lgkmcnt(0)":::"memory");
  float rli[16];
  #pragma unroll
  for(int r=0;r<16;++r)rli[r]=__builtin_amdgcn_rcpf(wsf[32+crow(r,hi)]);
  if constexpr(OUT8){ unsigned char*Ow=(unsigned char*)Ow0+(long)(wid*QBLK)*OP; unsigned char*stg=(unsigned char*)(shm+LDS_OST)+wid*4096;
    #pragma unroll
    for(int r=0;r<16;++r){const int orow=crow(r,hi);
      #pragma unroll
      for(int d0=0;d0<2;++d0){const float v=o[d0][r]*rli[r]; const int t=__builtin_amdgcn_cvt_pk_fp8_f32(v,v,0,false); stg[orow*64+d0*32+r32]=(unsigned char)t;}}
    asm volatile("s_waitcnt lgkmcnt(0)":::"memory");
    #pragma unroll
    for(int i=0;i<2;++i){const int row=i*16+(lane>>2),ch=lane&3; const u32x4 v=*(const u32x4*)(stg+row*64+ch*16); ATTN_STORE16(Ow+(long)row*OP+ch*16,v);} }
  else{ bf16*Ow=(bf16*)Ow0+(long)(wid*QBLK)*OP;
  { bf16*stg=(bf16*)(shm+LDS_OST)+wid*2048;
    #pragma unroll
    for(int r=0;r<16;++r){const int orow=crow(r,hi);
      #pragma unroll
      for(int d0=0;d0<2;++d0)stg[orow*64+d0*32+r32]=__float2bfloat16(o[d0][r]*rli[r]);}
    asm volatile("s_waitcnt lgkmcnt(0)":::"memory");
    #pragma unroll
    for(int i=0;i<4;++i){const int row=i*8+(lane>>3),ch=lane&7; const u32x4 v=*(const u32x4*)(stg+row*64+ch*8); ATTN_STORE16(Ow+(long)row*OP+ch*8,v);} } }
  asm volatile("s_waitcnt lgkmcnt(0)\n\ts_barrier":::"memory");
  #undef CIN
  #undef SUBM
  #undef DMA_K
  #undef DMA_V
  #undef CMASK
  #undef START
  #undef RESC
  #undef ROT
}
#undef SBAR
#undef WAIT_BAR
}
#ifndef MK_PER_PHASE
#define MK_PER_PHASE 0
#endif
#ifndef MOE_F8
#define MOE_F8 1
#endif
#ifndef WO_F8
#define WO_F8 1
#endif
#ifndef YS_F8
#define YS_F8 1
#endif
#ifndef QKV_F8
#define QKV_F8 1
#endif
constexpr int NWAVES = 8;
constexpr int W13_LOG2 = 5, W2_LOG2 = 7, WO_LOG2 = 6; constexpr float W13_SCALE = 32.0f, W2_SCALE = 128.0f;
constexpr int NB = 4, SEQ = 8192, DM = 1024, LCTX = 256, DEPTH = 4;
constexpr int M_LAT = NB * SEQ, M_CTX = NB * LCTX, M_ALL = M_LAT + M_CTX;
constexpr int NE = 16, FF = 2048, CAP_LAT = 1024, CAP_CTX = 32;
constexpr int ETILES = 17, ESTR = ETILES * 256, NSLOTS = NE * ESTR;
constexpr int KVROWS = SEQ + LCTX;
constexpr int NMOD = 6 * DM;
constexpr float ALPHA = 1.681792830507429f, LN_EPS = 1e-5f, RMS_EPS = 1e-6f, LOG2E = 1.4426950408889634f;

constexpr size_t MiB = 1u << 20;
constexpr size_t WS_CTL = 0, CTL_ZERO_BYTES = 2 * MiB;
constexpr size_t WS_MOD = 2 * MiB, WS_AFF = 3 * MiB, WS_SEL = 6 * MiB, WS_SLOT = 9 * MiB;
constexpr size_t WS_POOLW = 10 * MiB, WS_NAQKV = 11 * MiB, WS_NAWO = 17 * MiB, WS_GQKV = 19 * MiB, WS_GWO = 22 * MiB;
constexpr size_t WS_W13 = 32 * MiB, WS_W2 = 544 * MiB, WS_X = 800 * MiB, WS_H = 932 * MiB, WS_R = 1000 * MiB, WS_END = 1544 * MiB;
constexpr size_t R_XS = 0, R_HID = 136 * MiB, R_YS = 408 * MiB;
constexpr size_t R_D = 0, R_Y = 200 * MiB;
constexpr size_t R_O8 = 272 * MiB;
constexpr size_t R_Q = 0, R_K = 66 * MiB, R_V = 132 * MiB;
constexpr size_t R_RAW = 0, R_GQ = 100 * MiB, R_GK = 164 * MiB, R_GV = 181 * MiB;
constexpr int CW_TMO = 0, CW_BAR = 4096;

constexpr int RING_BYTES = 135168;
constexpr int LDSCTL_OFF = RING_BYTES, MISC_OFF = LDSCTL_OFF + 320;
constexpr int LDS_BYTES = 147456;

#define GAS __attribute__((address_space(1)))
#define LAS __attribute__((address_space(3)))
typedef unsigned short bf16;
typedef unsigned v4u __attribute__((ext_vector_type(4)));
typedef unsigned v2u __attribute__((ext_vector_type(2)));
typedef float f32x4 __attribute__((ext_vector_type(4)));
typedef float f32x2 __attribute__((ext_vector_type(2)));
#define RLX_AGENT __ATOMIC_RELAXED, __HIP_MEMORY_SCOPE_AGENT
#define LDS_WAIT() asm volatile("s_waitcnt lgkmcnt(0)" ::: "memory")
__device__ __forceinline__ unsigned pk2(float lo, float hi) { return pg8::cvt_pk_bf16(lo, hi); }
__device__ __forceinline__ float bf_lo(unsigned u) { return __uint_as_float(u << 16); }
__device__ __forceinline__ float bf_hi(unsigned u) { return __uint_as_float(u & 0xffff0000u); }

#define XB_TMO      128
#define XB_XCNT(j)  (256  + 64 * (j))
#define XB_XSUB(j)  (1280 + 64 * (j))
#define XB_XGEN(j)  (2304 + 64 * (j))
#define XB_TOP      3328
#define XB_TOPGEN   3392
#define XCD_BAR_WORDS 3456
#define XB_SPIN_CAP (1u << 22)

__device__ __forceinline__ unsigned xb_ld(unsigned* p)              { return __hip_atomic_load(p, __ATOMIC_RELAXED, __HIP_MEMORY_SCOPE_AGENT); }
__device__ __forceinline__ unsigned xb_add(unsigned* p, unsigned v) { return __hip_atomic_fetch_add(p, v, __ATOMIC_RELAXED, __HIP_MEMORY_SCOPE_AGENT); }
__device__ __forceinline__ unsigned xb_xcc_id() { return (unsigned)__builtin_amdgcn_s_getreg((3 << 11) | 20) & 0xFu; }
#define XB_SPIN(cond, bar) do { unsigned _sp = 0; while (cond) { __builtin_amdgcn_s_sleep(1); \
    if ((++_sp & 255u) == 0u) { if (xb_ld(&(bar)[XB_TMO])) break; if (_sp > XB_SPIN_CAP) { atomicAdd(&(bar)[XB_TMO], 1u); break; } } } } while (0)

struct XcdBarrier { unsigned* bar; unsigned x; volatile LAS unsigned* st; };
__device__ __forceinline__ XcdBarrier xcd_barrier_post(unsigned* bar, volatile LAS unsigned* st) {
    XcdBarrier b; b.bar = bar; b.x = xb_xcc_id(); b.st = st;
    if (threadIdx.x == 0) (void)xb_add(&bar[XB_XCNT(b.x)], 1u);
    return b;
}
__device__ __forceinline__ void xcd_barrier_complete(unsigned* bar, unsigned x, unsigned& nloc, unsigned& nx) {
    const unsigned G = gridDim.x * gridDim.y * gridDim.z;
    unsigned sum, cnt, mine, sp = 0u;
    for (;;) {
        sum = 0u; cnt = 0u; mine = 0u;
#pragma unroll
        for (unsigned j = 0; j < 16; ++j) { const unsigned c = xb_ld(&bar[XB_XCNT(j)]); sum += c; cnt += (c > 0u) ? 1u : 0u; mine = (j == x) ? c : mine; }
        if (sum == G) break;
        __builtin_amdgcn_s_sleep(1);
        if ((++sp & 255u) == 0u) { if (xb_ld(&bar[XB_TMO])) break; if (sp > XB_SPIN_CAP) { atomicAdd(&bar[XB_TMO], 1u); break; } }
    }
    nloc = mine > 0u ? mine : 1u; nx = cnt > 0u ? cnt : 1u;
}
__device__ __forceinline__ void xcd_barrier(const XcdBarrier& b) {
    asm volatile("s_waitcnt vmcnt(0)" ::: "memory");
    __syncthreads();
    if (threadIdx.x == 0) {
        unsigned* bar = b.bar;
        __builtin_amdgcn_s_waitcnt(0);
        unsigned nloc = b.st[0], nx = b.st[1];
        if (nloc == 0u) { xcd_barrier_complete(bar, b.x, nloc, nx); b.st[0] = nloc; b.st[1] = nx; }
        const unsigned old = xb_add(&bar[XB_XSUB(b.x)], 1u);
        const unsigned gen = old / nloc;
        if (old + 1u == (gen + 1u) * nloc) {
            __builtin_amdgcn_fence(__ATOMIC_RELEASE, "agent");
            asm volatile("s_waitcnt vmcnt(0)" ::: "memory");
            const unsigned og = xb_add(&bar[XB_TOP], 1u);
            const unsigned tg = og / nx;
            if (og + 1u == (tg + 1u) * nx) xb_add(&bar[XB_TOPGEN], 1u);
            else XB_SPIN(xb_ld(&bar[XB_TOPGEN]) == tg, bar);
            __builtin_amdgcn_fence(__ATOMIC_ACQUIRE, "agent");
            xb_add(&bar[XB_XGEN(b.x)], 1u);
            asm volatile("s_waitcnt vmcnt(0)" ::: "memory");
        } else {
            XB_SPIN(xb_ld(&bar[XB_XGEN(b.x)]) == gen, bar);
            __builtin_amdgcn_fence(__ATOMIC_ACQUIRE, "agent");
            asm volatile("s_waitcnt vmcnt(0)" ::: "memory");
        }
    }
    __syncthreads();
}

__device__ __forceinline__ int lane_shfl(int v, int src_lane) { return __builtin_amdgcn_ds_bpermute(src_lane << 2, v); }
template <int CTRL> __device__ __forceinline__ float dppx(float v) { return __builtin_bit_cast(float, __builtin_amdgcn_update_dpp(0, __builtin_bit_cast(int, v), CTRL, 0xf, 0xf, true)); }
constexpr int DPP_XOR1 = 0xB1, DPP_XOR2 = 0x4E, DPP_HMIRROR = 0x141, DPP_MIRROR = 0x140, DPP_XOR8 = 0x128;
__device__ __forceinline__ void swap16(float v, float& even_rows, float& odd_rows) { auto r = __builtin_amdgcn_permlane16_swap(__float_as_uint(v), __float_as_uint(v), false, false); even_rows = __uint_as_float(r[0]); odd_rows = __uint_as_float(r[1]); }
__device__ __forceinline__ void swap32(float v, float& lo_half, float& hi_half) { auto r = __builtin_amdgcn_permlane32_swap(__float_as_uint(v), __float_as_uint(v), false, false); lo_half = __uint_as_float(r[0]); hi_half = __uint_as_float(r[1]); }
__device__ __forceinline__ float quad_sum(float v) { v += dppx<DPP_XOR1>(v); v += dppx<DPP_XOR2>(v); return v; }
__device__ __forceinline__ float row16_sum(float v) { v = quad_sum(v); v += dppx<DPP_HMIRROR>(v); v += dppx<DPP_MIRROR>(v); return v; }
__device__ __forceinline__ float wave_sum(float v) { v = row16_sum(v); float a, b; swap16(v, a, b); v = a + b; swap32(v, a, b); return a + b; }
__device__ __forceinline__ int wave_incl_scan(int v, int lane) {
#pragma unroll
    for (int o = 1; o < 64; o <<= 1) { const int t = lane_shfl(v, lane - o); if (lane >= o) v += t; }
    return v;
}
__device__ __forceinline__ int block_excl_scan(int v, LAS int* tmp, int lane, int wave) {
    const int inc = wave_incl_scan(v, lane);
    if (lane == 63) tmp[wave] = inc;
    __syncthreads();
    int base = 0;
#pragma unroll
    for (int w = 0; w < NWAVES; ++w) { const int t = tmp[w]; base += (w < wave) ? t : 0; }
    __syncthreads();
    return base + inc - v;
}

struct Args { const float* in[21]; float* out; unsigned char* ws; int ph_lo, ph_hi, li, pad; };
enum { IN_X = 0, IN_C, IN_CTX, IN_CCTX, IN_MODW, IN_MODB, IN_LNG, IN_LNB, IN_POOLW, IN_POOLS, IN_NAQKV, IN_NAWO, IN_NARPB, IN_GQKV, IN_GQN, IN_GKN, IN_GWO, IN_ROUTER, IN_W1, IN_W3, IN_W2 };

__device__ __forceinline__ void p0_mod(const Args& a, LAS unsigned char* lds, int tid, int lane, int wave) {
    const int wg = blockIdx.x; if (wg >= 192) return;
    const int L = wg / 48, cb = wg % 48;
    LAS float* sl = (LAS float*)lds; LAS float* red = sl + 5 * 1024;
    const float* c = a.in[IN_C]; const float* cc = a.in[IN_CCTX];
    for (int i = tid; i < 5120; i += 512) { const int s = i >> 10, k = i & 1023; const float cv = s < 4 ? c[s * 1024 + k] : cc[k]; sl[i] = cv / (1.0f + expf(-cv)); }
    __syncthreads();
    float acc[5][2];
#pragma unroll
    for (int s = 0; s < 5; ++s) { acc[s][0] = 0.f; acc[s][1] = 0.f; }
    const float* wp = a.in[IN_MODW] + (size_t)L * DM * NMOD + cb * 128 + 2 * lane;
#pragma unroll 8
    for (int kk = 0; kk < 128; ++kk) { const int k = wave * 128 + kk; const f32x2 w = *(const f32x2*)(wp + (size_t)k * NMOD);
#pragma unroll
        for (int s = 0; s < 5; ++s) { const float sv = sl[s * 1024 + k]; acc[s][0] += sv * w.x; acc[s][1] += sv * w.y; } }
#pragma unroll
    for (int s = 0; s < 5; ++s) { red[(wave * 5 + s) * 128 + 2 * lane] = acc[s][0]; red[(wave * 5 + s) * 128 + 2 * lane + 1] = acc[s][1]; }
    __syncthreads();
    float* MOD = (float*)(a.ws + WS_MOD);
    for (int o = tid; o < 640; o += 512) { const int s = o >> 7, col = o & 127; float sum = 0.f;
#pragma unroll
        for (int w = 0; w < 8; ++w) sum += red[(w * 5 + s) * 128 + col];
        MOD[(size_t)(L * 5 + s) * NMOD + cb * 128 + col] = sum + a.in[IN_MODB][L * NMOD + cb * 128 + col]; }
    __syncthreads();
}
struct CvtItem { const float* W; void* WT; int K, N, mode, sub; float scale; };
constexpr int I_POOL = 128, I_NAQKV = 768, I_NAWO = 256, I_GQKV = 384, I_GWO = 256, I_SMALL = I_POOL + I_NAQKV + I_NAWO + I_GQKV + I_GWO, I_LE = 1536, I_ALL = I_SMALL + 64 * I_LE;
constexpr int CVT_NWIN = 10;
__host__ __device__ constexpr int cvt_wsize(int w) { return w == 0 ? 240 * 8 * 1 : w == 3 ? 208 * 8 * 2 : w == 4 ? 240 * 8 * 3 : w == 7 ? 232 * 8 * 2 : 192 * 8 * 4; }
__host__ __device__ constexpr int cvt_wsum(int w) { int s_ = 0; for (int i = 0; i < w; ++i) s_ += cvt_wsize(i); return s_; }
constexpr int CVT_I_PRO = I_ALL - cvt_wsum(CVT_NWIN);
__host__ __device__ constexpr int cvt_wlo(int w) { return CVT_I_PRO + cvt_wsum(w); }
static_assert(CVT_I_PRO >= I_SMALL + 16 * I_LE, "layer 0's weights are converted in the prologue");
static_assert(cvt_wlo(6) >= I_SMALL + 32 * I_LE, "layer 1's expert weights are complete before its up GEMM (after window 5)");
static_assert(cvt_wlo(9) >= I_SMALL + 48 * I_LE, "layer 2's expert weights are complete before its up GEMM (after window 8)");
__device__ __forceinline__ bool cvt_decode(const Args& a, int it, int it_end, CvtItem& c) {
    if (it >= it_end) return false;
    int r = it; c.scale = 0.f; c.mode = 0;
    if (r >= I_SMALL) { r -= I_SMALL; const int le = r / I_LE, q = r - le * I_LE, which = q >> 9; c.sub = q & 511;
#if MOE_F8
        const size_t es = 1;
#else
        const size_t es = 2;
#endif
        if (which < 2) { c.W = a.in[which == 0 ? IN_W1 : IN_W3] + (size_t)le * DM * FF; c.K = DM; c.N = FF; c.WT = a.ws + WS_W13 + (size_t)le * 2 * FF * DM * es; c.mode = 1 + which; c.scale = MOE_F8 ? W13_SCALE : 0.f; }
        else { c.W = a.in[IN_W2] + (size_t)le * FF * DM; c.K = FF; c.N = DM; c.WT = a.ws + WS_W2 + (size_t)le * DM * FF * es; c.scale = MOE_F8 ? W2_SCALE : 0.f; }
        return true; }
    if (r < I_POOL) { const int mi = r >> 4; c.W = a.in[IN_POOLW] + (size_t)mi * 65536; c.K = 256; c.N = 256; c.WT = (bf16*)(a.ws + WS_POOLW) + (size_t)mi * 65536; c.sub = r & 15; return true; } r -= I_POOL;
    if (r < I_NAQKV) { c.W = a.in[IN_NAQKV]; c.K = DM; c.N = 3 * DM; c.WT = a.ws + WS_NAQKV; c.sub = r; c.scale = QKV_F8 ? W13_SCALE : 0.f; return true; } r -= I_NAQKV;
    if (r < I_NAWO) { c.W = a.in[IN_NAWO]; c.K = DM; c.N = DM; c.WT = a.ws + WS_NAWO; c.sub = r; c.scale = WO_F8 ? 64.0f : 0.f; return true; } r -= I_NAWO;
    if (r < I_GQKV) { c.W = a.in[IN_GQKV]; c.K = DM; c.N = 1536; c.WT = a.ws + WS_GQKV; c.sub = r; c.scale = QKV_F8 ? W13_SCALE : 0.f; return true; } r -= I_GQKV;
    c.W = a.in[IN_GWO]; c.K = DM; c.N = DM; c.WT = a.ws + WS_GWO; c.sub = r; c.scale = WO_F8 ? 64.0f : 0.f; return true;
}
__device__ __forceinline__ void cvt_geom(const CvtItem& c, int& k0, int& n0) { const int nblk = c.N >> 5, kb = c.sub / nblk, nb = c.sub - kb * nblk; k0 = kb * 128; n0 = nb * 32; }
__device__ __forceinline__ void cvt_load(const CvtItem& c, f32x4 (&v)[16], int lane) {
    int k0, n0; cvt_geom(c, k0, n0); const int kr = lane >> 3, nc = lane & 7;
#pragma unroll
    for (int i = 0; i < 16; ++i) v[i] = __builtin_nontemporal_load((const f32x4*)(c.W + (size_t)(k0 + 8 * i + kr) * c.N + n0 + 4 * nc));
}
__device__ __forceinline__ void cvt_store(const CvtItem& c, const f32x4 (&v)[16], LAS float* scr, int lane) {
    int k0, n0; cvt_geom(c, k0, n0); const int kr = lane >> 3, nc = lane & 7;
    const float sc = c.scale > 0.f ? c.scale : 1.0f;
#pragma unroll
    for (int i = 0; i < 16; ++i) { LAS float* d = scr + (8 * i + kr) * 33 + 4 * nc; d[0] = v[i].x * sc; d[1] = v[i].y * sc; d[2] = v[i].z * sc; d[3] = v[i].w * sc; }
    LDS_WAIT();
    const int ch = lane & 7;
#pragma unroll
    for (int j = 0; j < 4; ++j) { const int n = 8 * j + (lane >> 3); const LAS float* s = scr + (16 * ch) * 33 + n;
        const int nn = n0 + n; const int drow = c.mode == 0 ? nn : (((nn >> 2) << 3) + (nn & 3) + (c.mode == 2 ? 4 : 0));
        if (c.scale > 0.f) { int w[4];
#pragma unroll
            for (int q = 0; q < 4; ++q) { int t = 0; t = __builtin_amdgcn_cvt_pk_fp8_f32(s[(4 * q) * 33], s[(4 * q + 1) * 33], t, false); t = __builtin_amdgcn_cvt_pk_fp8_f32(s[(4 * q + 2) * 33], s[(4 * q + 3) * 33], t, true); w[q] = t; }
            __builtin_nontemporal_store((v4u){(unsigned)w[0], (unsigned)w[1], (unsigned)w[2], (unsigned)w[3]}, (v4u*)((unsigned char*)c.WT + (size_t)drow * c.K + k0 + 16 * ch)); }
        else { v4u o0, o1;
            o0.x = pk2(s[0 * 33], s[1 * 33]); o0.y = pk2(s[2 * 33], s[3 * 33]); o0.z = pk2(s[4 * 33], s[5 * 33]); o0.w = pk2(s[6 * 33], s[7 * 33]);
            o1.x = pk2(s[8 * 33], s[9 * 33]); o1.y = pk2(s[10 * 33], s[11 * 33]); o1.z = pk2(s[12 * 33], s[13 * 33]); o1.w = pk2(s[14 * 33], s[15 * 33]);
            v4u* d = (v4u*)((bf16*)c.WT + (size_t)drow * c.K + k0 + 16 * ch); d[0] = o0; d[1] = o1; } }
    LDS_WAIT();
}
#ifdef PROBE_DUPPRO
__device__ __forceinline__ void p0_convert_probe(const Args& a, LAS unsigned char* lds, int gw, int NGW, int lane, int wave) {
    LAS float* scr = (LAS float*)(lds + wave * 16896);
    CvtItem cur; f32x4 va[16]; f32x4 acc = {0.f, 0.f, 0.f, 0.f};
    for (int it = gw; cvt_decode(a, it, I_ALL, cur); it += NGW) {
        cvt_load(cur, va, lane);
        if (PROBE_DUPPRO == 2) { cur.WT = a.ws + (size_t)1600 * MiB + ((size_t)it & 2047) * 65536; cur.K = 64; cur.mode = 0; cur.sub = 0; cvt_store(cur, va, scr, lane); }
        else {
#pragma unroll
            for (int i = 0; i < 16; ++i) acc += va[i]; }
    }
    if (acc.x == 1.2345e30f) ((float*)(a.ws + (size_t)1600 * MiB))[lane] = acc.x + acc.y + acc.z + acc.w;
}
#endif
__device__ __forceinline__ void p0_convert(const Args& a, LAS unsigned char* lds, int it0, int it_end, int gw, int NGW, int lane, int wave) {
    LAS float* scr = (LAS float*)(lds + wave * 16896);
    CvtItem ca, cb; f32x4 va[16], vb[16];
    bool ha = cvt_decode(a, it0 + gw, it_end, ca);
    if (ha) cvt_load(ca, va, lane);
    for (int it = it0 + gw; ha; it += 2 * NGW) {
        const bool hb = cvt_decode(a, it + NGW, it_end, cb);
        if (hb) cvt_load(cb, vb, lane);
        cvt_store(ca, va, scr, lane);
        if (!hb) break;
        ha = cvt_decode(a, it + 2 * NGW, it_end, ca);
        if (ha) cvt_load(ca, va, lane);
        cvt_store(cb, vb, scr, lane);
    }
}

__device__ __forceinline__ int row_s(int row) { return row < M_LAT ? (row >> 13) : 4; }
__device__ __forceinline__ const float* xrow(const Args& a, int row) {
    return row < M_LAT ? a.in[IN_X] + (size_t)row * DM : a.in[IN_CTX] + (size_t)(row - M_LAT) * DM;
}
typedef _Float16 xh_t; typedef _Float16 h16x4 __attribute__((ext_vector_type(4)));
__device__ __forceinline__ f32x4 xdec(const f32x4 v) { return v; }
__device__ __forceinline__ f32x4 xdec(const v2u w) { return __builtin_convertvector(__builtin_bit_cast(h16x4, w), f32x4); }
__device__ __forceinline__ v2u xenc(const f32x4 v) { return __builtin_bit_cast(v2u, __builtin_convertvector(v, h16x4)); }
template <bool XH> struct XSrc;
template <> struct XSrc<false> { typedef f32x4 vec; typedef float elem; static __device__ __forceinline__ const float* row(const Args& a, int r) { return xrow(a, r); } };
template <> struct XSrc<true>  { typedef v2u vec;   typedef xh_t elem;  static __device__ __forceinline__ const xh_t* row(const Args& a, int r) { return (const xh_t*)(a.ws + WS_X) + (size_t)r * DM; } };

template <int W, class XE> __device__ __forceinline__ f32x4 pool_sum(const XE* base, int pos, int n) {
    typedef typename std::conditional<sizeof(XE) == 2, v2u, f32x4>::type XV;
    f32x4 s = {0.f, 0.f, 0.f, 0.f};
#pragma unroll
    for (int i = 0; i < W; ++i) { const int idx = pos - W / 2 + i; const bool ok = idx >= 0 && idx < n; const int ic = idx < 0 ? 0 : (idx >= n ? n - 1 : idx);
        const f32x4 v = xdec(*(const XV*)(base + (size_t)ic * DM)); s += ok ? v : (f32x4){0.f, 0.f, 0.f, 0.f}; }
    return s;
}
__device__ __forceinline__ void pd_decode(int row, int& r0s, int& pos, int& n) {
    if (row < M_LAT) { r0s = row & ~(SEQ - 1); pos = row & (SEQ - 1); n = SEQ; } else { r0s = M_LAT + ((row - M_LAT) & ~(LCTX - 1)); pos = (row - M_LAT) & (LCTX - 1); n = LCTX; }
}
template <bool XH> __device__ __forceinline__ void ph_pooldiff(const Args& a, int L, int nrows, int gw, int NGW, int lane) {
    typedef typename XSrc<XH>::vec XV; typedef typename XSrc<XH>::elem XE;
    const float* MOD = (const float*)(a.ws + WS_MOD); bf16* Dm = (bf16*)(a.ws + WS_R + R_D);
    const int r0 = (int)(((long)gw * nrows) / NGW), r1 = (int)(((long)(gw + 1) * nrows) / NGW);
    XV EA[4], LA[4], CA[4], EB[4], LB[4], CB[4], EC[4], LC[4], CC[4]; f32x4 S[4], SC[4];
    const XE* zb = (const XE*)(a.ws + WS_CTL + MiB) + 4 * lane;
#define PD_LOAD(rw, En, Ln, Cn) do { const int rr_ = (rw) < re ? (rw) : re - 1; const int pos_ = rr_ - r0s; \
        _Pragma("unroll") for (int g = 0; g < 4; ++g) { const int W_ = 2 << g, ie_ = pos_ + W_ / 2 - 1, il_ = pos_ - 1 - W_ / 2; \
            En[g] = *(const XV*)((ie_ < n ? xb + (size_t)ie_ * DM : zb) + g * 256); Ln[g] = *(const XV*)((il_ >= 0 ? xb + (size_t)il_ * DM : zb) + g * 256); \
            Cn[g] = *(const XV*)(xb + (size_t)pos_ * DM + g * 256); } __builtin_amdgcn_sched_barrier(0); } while (0)
#define PD_EMIT(rowv, C) do { const int row_ = (rowv); const int pos = row_ - r0s; bf16* drow = Dm + (size_t)row_ * DM + 4 * lane; \
        _Pragma("unroll") for (int g = 0; g < 4; ++g) { const int W = 2 << g; const int lo = pos - W / 2 < 0 ? 0 : pos - W / 2, hi = pos + (W - W / 2 - 1) > n - 1 ? n - 1 : pos + (W - W / 2 - 1); \
            const float inv = 1.0f / (float)(hi - lo + 1); const f32x4 d = SC[g] * (S[g] * inv - xdec(C[g])); \
            v2u o; o.x = pk2(d.x, d.y); o.y = pk2(d.z, d.w); *(v2u*)(drow + g * 256) = o; } } while (0)
#define PD_ROW(rowv, E, Lv, C) do { _Pragma("unroll") for (int g = 0; g < 4; ++g) S[g] += xdec(E[g]) - xdec(Lv[g]); PD_EMIT(rowv, C); } while (0)
    for (int rs = r0; rs < r1; ) {
        int r0s, pos0, n; pd_decode(rs, r0s, pos0, n);
        const int re = (r0s + n) < r1 ? (r0s + n) : r1;
        const XE* xb = XSrc<XH>::row(a, r0s) + 4 * lane;
        { const float* scp_ = MOD + (size_t)(L * 5 + row_s(rs)) * NMOD + DM + 4 * lane;
#pragma unroll
          for (int g = 0; g < 4; ++g) SC[g] = *(const f32x4*)(scp_ + g * 256) + 1.0f; }
        S[0] = pool_sum<2>(xb, pos0, n); S[1] = pool_sum<4>(xb + 256, pos0, n); S[2] = pool_sum<8>(xb + 512, pos0, n); S[3] = pool_sum<16>(xb + 768, pos0, n);
#pragma unroll
        for (int g = 0; g < 4; ++g) CA[g] = *(const XV*)(xb + (size_t)pos0 * DM + g * 256);
        PD_EMIT(rs, CA);
        const int rb = rs + 1;
        if (rb < re) {
            PD_LOAD(rb, EA, LA, CA); PD_LOAD(rb + 1, EB, LB, CB);
            for (int row = rb; row < re; row += 3) {
                PD_LOAD(row + 2, EC, LC, CC); PD_ROW(row, EA, LA, CA);
                if (row + 1 < re) { PD_LOAD(row + 3, EA, LA, CA); PD_ROW(row + 1, EB, LB, CB); }
                if (row + 2 < re) { PD_LOAD(row + 4, EB, LB, CB); PD_ROW(row + 2, EC, LC, CC); }
            }
        }
        rs = re;
    }
#undef PD_LOAD
#undef PD_EMIT
#undef PD_ROW
}

struct Ln1Ctx { const Args* a; int L; LAS float* RT; LAS f32x4* PV; xh_t* X; bf16* H; float* AFF; int lane; };
#define LN1_RTRD(W, e0, jj) do { _Pragma("unroll") for (int e = 0; e < 8; ++e) W[e] = *(const LAS f32x4*)(rtp + ((e0) + e) * 1024 + 256 * (jj)); __builtin_amdgcn_sched_barrier(0); } while (0)
#define LN1_RTFMA(W, e0) do { _Pragma("unroll") for (int e = 0; e < 8; ++e) { const f32x4 w = W[e]; \
        lgp[(e0) + e] = __builtin_elementwise_fma((f32x2){h2.x, h2.y}, (f32x2){w.x, w.y}, lgp[(e0) + e]); lgp[(e0) + e] = __builtin_elementwise_fma((f32x2){h2.z, h2.w}, (f32x2){w.z, w.w}, lgp[(e0) + e]); } \
        __builtin_amdgcn_sched_barrier(0); } while (0)
template <int VAR, class XV> __device__ __forceinline__ void ln1_row(const Ln1Ctx& c, const int row, const XV (&xc)[4], const v2u (&yc)[4], f32x4 (&wA)[8], f32x4 (&wB)[8]) {
    const int L = c.L, lane = c.lane; LAS float* RT = c.RT; LAS f32x4* PV = c.PV; xh_t* X = c.X; bf16* H = c.H; float* AFF = c.AFF; (void)L;
        const LAS f32x4* pv = PV + (2 + 3 * row_s(row)) * 256 + lane;
        const LAS float* rtp = RT + 4 * lane; asm volatile("" : "+v"(rtp));
        f32x4 pa[4], pb[4]; pa[0] = PV[lane]; pa[1] = PV[256 + lane]; pa[2] = pv[512]; pa[3] = pv[256];
        f32x4 v[4]; float s = 0.f;
#pragma unroll
        for (int j = 0; j < 4; ++j) { f32x4 yv = {bf_lo(yc[j].x), bf_hi(yc[j].x), bf_lo(yc[j].y), bf_hi(yc[j].y)};
#ifdef DBG_NEG_Y_LAYER
            if (L == DBG_NEG_Y_LAYER) yv = -yv;
#endif
            v[j] = xdec(xc[j]) * ALPHA + pv[64 * j] * yv; s += (v[j].x + v[j].y) + (v[j].z + v[j].w); }
        const float mean = wave_sum(s) * (1.f / DM); float s2 = 0.f;
#pragma unroll
        for (int j = 0; j < 4; ++j) { v[j] = v[j] - mean; s2 += (v[j].x * v[j].x + v[j].y * v[j].y) + (v[j].z * v[j].z + v[j].w * v[j].w); }
        const float rstd = 1.f / sqrtf(wave_sum(s2) * (1.f / DM) + LN_EPS);
        v2u* xo = (v2u*)(X + (size_t)row * DM) + lane; v2u* ho = (v2u*)(H + (size_t)row * DM) + lane; (void)ho;
        f32x2 lgp[16];
#pragma unroll
        for (int e = 0; e < 16; ++e) lgp[e] = (f32x2){0.f, 0.f};
#define LN1_PVRD(P, jj) do { P[0] = PV[lane + 64 * (jj)]; P[1] = PV[256 + lane + 64 * (jj)]; P[2] = pv[512 + 64 * (jj)]; P[3] = pv[256 + 64 * (jj)]; } while (0)
#define LN1_CHUNK(jj, PC, PN) do { const f32x4 x1 = v[jj] * rstd * PC[0] + PC[1]; xo[64 * (jj)] = xenc(x1); const f32x4 h2 = x1 * (PC[2] + 1.0f) + PC[3]; LN1_HST(jj); \
        if (VAR < 2) { if ((jj) < 3) LN1_PVRD(PN, (jj) + 1); LN1_RTRD(wB, 8, jj); LN1_RTFMA(wA, 0); LN1_RTRD(wA, 0, ((jj) + 1) & 3); LN1_RTFMA(wB, 8); } \
        else { if ((jj) < 3) LN1_PVRD(PN, (jj) + 1); lgp[0].x += h2.x + h2.y; lgp[1].y += h2.z + h2.w; } } while (0)
#if MOE_F8
#define LN1_HST(jj) do { int t = 0; t = __builtin_amdgcn_cvt_pk_fp8_f32(h2.x, h2.y, t, false); t = __builtin_amdgcn_cvt_pk_fp8_f32(h2.z, h2.w, t, true); ((int*)((unsigned char*)H + (size_t)row * DM))[lane + 64 * (jj)] = t; } while (0)
#else
#define LN1_HST(jj) do { v2u o; o.x = pk2(h2.x, h2.y); o.y = pk2(h2.z, h2.w); ho[64 * (jj)] = o; } while (0)
#endif
        LN1_CHUNK(0, pa, pb); LN1_CHUNK(1, pb, pa); LN1_CHUNK(2, pa, pb); LN1_CHUNK(3, pb, pa);
#undef LN1_PVRD
#undef LN1_CHUNK
#undef LN1_HST
        float lg16[16];
#pragma unroll
        for (int e = 0; e < 16; ++e) lg16[e] = lgp[e].x + lgp[e].y;
        if (VAR == 3) { if (lane < 16) AFF[(size_t)row * NE + lane] = lg16[0] + lg16[5]; return; }
        float r8[8], r4[4], t0, t1;
        { const bool up = (lane & 32) != 0;
#pragma unroll
          for (int i = 0; i < 8; ++i) { const float snd = up ? lg16[i] : lg16[i + 8], kp = up ? lg16[i + 8] : lg16[i]; float lo, hi; swap32(snd, lo, hi); r8[i] = kp + (up ? lo : hi); } }
        { const bool up = (lane & 16) != 0;
#pragma unroll
          for (int i = 0; i < 4; ++i) { const float snd = up ? r8[i] : r8[i + 4], kp = up ? r8[i + 4] : r8[i]; float ev, od; swap16(snd, ev, od); r4[i] = kp + (up ? ev : od); } }
        { const bool up = (lane & 8) != 0;
          const float s0 = up ? r4[0] : r4[2], k0 = up ? r4[2] : r4[0], s1 = up ? r4[1] : r4[3], k1 = up ? r4[3] : r4[1];
          t0 = k0 + dppx<DPP_XOR8>(s0); t1 = k1 + dppx<DPP_XOR8>(s1); }
        t0 = quad_sum(t0); t0 += dppx<DPP_HMIRROR>(t0); t1 = quad_sum(t1); t1 += dppx<DPP_HMIRROR>(t1);
        float mx = fmaxf(t0, t1); mx = fmaxf(mx, dppx<DPP_XOR8>(mx)); { float a_, b_; swap16(mx, a_, b_); mx = fmaxf(a_, b_); swap32(mx, a_, b_); mx = fmaxf(a_, b_); }
        const float p0 = __builtin_amdgcn_exp2f((t0 - mx) * LOG2E), p1 = __builtin_amdgcn_exp2f((t1 - mx) * LOG2E);
        float den = p0 + p1; den += dppx<DPP_XOR8>(den); { float a_, b_; swap16(den, a_, b_); den = a_ + b_; swap32(den, a_, b_); den = a_ + b_; }
        if ((lane & 7) == 0) { const float rd = 1.0f / den; *(f32x2*)(AFF + (size_t)row * NE + 2 * (lane >> 3)) = (f32x2){p0 * rd, p1 * rd}; }
}
template <bool XH, int VAR = 0> __device__ __forceinline__ void ph_ln1(const Args& a, int L, int nrows, LAS unsigned char* lds, int gw, int NGW, int tid, int lane) {
    LAS float* RT = (LAS float*)lds;
    LAS f32x4* PV = (LAS f32x4*)(lds + 65536);
    const float* MOD = (const float*)(a.ws + WS_MOD);
    { const float* rt = a.in[IN_ROUTER] + (size_t)L * DM * NE;
      { float rv[32];
#pragma unroll
        for (int j = 0; j < 32; ++j) rv[j] = rt[tid + 512 * j];
#pragma unroll
        for (int j = 0; j < 32; ++j) { const int i = tid + 512 * j; RT[(i & 15) * 1024 + (i >> 4)] = rv[j]; } }
#pragma unroll
      for (int i = tid; i < 17 * 256; i += 512) { const int v = i >> 8, c = i & 255; const float* src;
          if (v == 0) src = a.in[IN_LNG] + (size_t)(L * 2 + 0) * DM; else if (v == 1) src = a.in[IN_LNB] + (size_t)(L * 2 + 0) * DM;
          else { const int s = (v - 2) / 3, w = (v - 2) - 3 * s; src = MOD + (size_t)(L * 5 + s) * NMOD + (2 + w) * DM; }
          PV[i] = ((const f32x4*)src)[c]; } }
    __syncthreads();
    const bf16* Y = (const bf16*)(a.ws + WS_R + R_Y);
    const size_t dup_ = VAR ? (size_t)1600 * MiB - WS_X : 0;
    xh_t* X = (xh_t*)(a.ws + WS_X + dup_); bf16* H = (bf16*)(a.ws + WS_H + dup_); float* AFF = (float*)(a.ws + WS_AFF + (VAR ? (size_t)1800 * MiB - WS_AFF : 0));
    typedef typename XSrc<XH>::vec XVec;
    const int r0 = (int)(((long)gw * nrows) / NGW), r1 = (int)(((long)(gw + 1) * nrows) / NGW);
    XVec xa[4], xb[4], xd[4]; v2u ya[4], yb[4], yd[4];
#define LN1_LOAD(r, XV, YV) do { const int r_ = (r) < r1 ? (r) : r1 - 1; const XVec* xr_ = (const XVec*)XSrc<XH>::row(a, r_) + lane; const v2u* yr_ = (const v2u*)(Y + (size_t)r_ * DM) + lane; \
        _Pragma("unroll") for (int j = 0; j < 4; ++j) { XV[j] = xr_[64 * j]; YV[j] = yr_[64 * j]; } } while (0)
    const Ln1Ctx cx{&a, L, RT, PV, X, H, AFF, lane};
    if (r0 < r1) { LN1_LOAD(r0, xa, ya); LN1_LOAD(r0 + 1, xb, yb); }
    f32x4 wA[8], wB[8];
    { const LAS float* rtp = RT + 4 * lane; asm volatile("" : "+v"(rtp)); LN1_RTRD(wA, 0, 0); }
    for (int row = r0; row < r1; row += 3) {
        LN1_LOAD(row + 2, xd, yd); ln1_row<VAR>(cx, row, xa, ya, wA, wB);
        if (row + 1 < r1) { LN1_LOAD(row + 3, xa, ya); ln1_row<VAR>(cx, row + 1, xb, yb, wA, wB); }
        if (row + 2 < r1) { LN1_LOAD(row + 4, xb, yb); ln1_row<VAR>(cx, row + 2, xd, yd, wA, wB); }
    }
#undef LN1_LOAD
#undef LN1_RTRD
#undef LN1_RTFMA
    __syncthreads();
}

__device__ __forceinline__ void topk_problem(const Args& a, int row0, int n, int cap, int e, int slot0, LAS unsigned char* lds, int tid, int lane, int wave) {
    const float* AFF = (const float*)(a.ws + WS_AFF); int* SEL = (int*)(a.ws + WS_SEL); int* SLOT = (int*)(a.ws + WS_SLOT);
    LAS unsigned* vals = (LAS unsigned*)lds; LAS unsigned* hist = vals + 8192; LAS int* misc = (LAS int*)(hist + 256); LAS int* tmp = misc + 8;
    for (int i = tid; i < n; i += 512) vals[i] = __float_as_uint(AFF[(size_t)(row0 + i) * NE + e]);
    unsigned prefix = 0u; int kk = cap;
    for (int pass = 0; pass < 4; ++pass) {
        const int shift = 24 - 8 * pass;
        if (tid < 256) hist[tid] = 0u;
        __syncthreads();
        for (int i = tid; i < n; i += 512) { const unsigned v = vals[i]; if (((v >> shift) >> 8) == ((prefix >> shift) >> 8)) atomicAdd((unsigned*)&hist[(v >> shift) & 255u], 1u); }
        __syncthreads();
        if (wave == 0) {
            const int h0 = (int)hist[4 * lane], h1 = (int)hist[4 * lane + 1], h2 = (int)hist[4 * lane + 2], h3 = (int)hist[4 * lane + 3]; const int c = h0 + h1 + h2 + h3;
            int S = c;
#pragma unroll
            for (int o = 1; o < 64; o <<= 1) { const int t = lane_shfl(S, lane + o); if (lane + o < 64) S += t; }
            const int above = S - c;
            if (above < kk && kk <= S) { int ab = above, bsel;
                if (ab + h3 >= kk) bsel = 3; else { ab += h3; if (ab + h2 >= kk) bsel = 2; else { ab += h2; if (ab + h1 >= kk) bsel = 1; else { ab += h1; bsel = 0; } } }
                misc[0] = 4 * lane + bsel; misc[1] = kk - ab; }
        }
        __syncthreads();
        prefix |= (unsigned)misc[0] << shift; kk = misc[1];
    }
    const unsigned T = prefix;
    const int per = n >= 512 ? n / 512 : 1, nact = n / per; const int i0 = tid * per; const bool act = tid < nact;
    int cgt = 0, ceq = 0;
    if (act) for (int j = 0; j < per; ++j) { const unsigned v = vals[i0 + j]; cgt += (v > T) ? 1 : 0; ceq += (v == T) ? 1 : 0; }
    const int eq_before = block_excl_scan(ceq, tmp, lane, wave);
    int take = kk - eq_before; take = take < 0 ? 0 : (take > ceq ? ceq : take);
    int p = block_excl_scan(cgt + take, tmp, lane, wave);
    if (act) { int er = eq_before;
        for (int j = 0; j < per; ++j) { const unsigned v = vals[i0 + j]; const bool sel = (v > T) || (v == T && er < kk); if (v == T) ++er;
            const int row = row0 + i0 + j;
            if (sel) { const int slot = slot0 + p; ++p; SLOT[slot] = row; SEL[(size_t)row * NE + e] = slot; } else SEL[(size_t)row * NE + e] = -1; } }
    __syncthreads();
}
__device__ __forceinline__ void ph_topk(const Args& a, bool upd, LAS unsigned char* lds, int tid, int lane, int wave) {
    const int nprob = upd ? 128 : 64;
    for (int p = blockIdx.x; p < nprob; p += gridDim.x) {
        if (p < 64) { const int b = p >> 4, e = p & 15; topk_problem(a, b * SEQ, SEQ, CAP_LAT, e, e * ESTR + b * CAP_LAT, lds, tid, lane, wave); }
        else { const int q = p - 64, b = q >> 4, e = q & 15; topk_problem(a, M_LAT + b * LCTX, LCTX, CAP_CTX, e, e * ESTR + 4 * CAP_LAT + b * CAP_CTX, lds, tid, lane, wave);
            if (b == 0 && tid < 128) ((int*)(a.ws + WS_SLOT))[e * ESTR + 4 * CAP_LAT + 4 * CAP_CTX + tid] = -1; }
    }
}
__device__ __forceinline__ void ph_gather(const Args& a, bool upd, int gw, int NGW, int lane) {
    const int* SLOT = (const int*)(a.ws + WS_SLOT); const bf16* H = (const bf16*)(a.ws + WS_H); bf16* XS = (bf16*)(a.ws + WS_R + R_XS);
    for (int slot = gw; slot < NSLOTS; slot += NGW) {
        const int within = slot % ESTR; if (!upd && within >= 4 * CAP_LAT) continue;
        const int tok = SLOT[slot];
        v4u v0 = {0u, 0u, 0u, 0u}, v1 = {0u, 0u, 0u, 0u};
        if (tok >= 0) { const v4u* s = (const v4u*)(H + (size_t)tok * DM); v0 = s[lane]; v1 = s[64 + lane]; }
        v4u* d = (v4u*)(XS + (size_t)slot * DM); d[lane] = v0; d[64 + lane] = v1;
    }
}
__device__ __forceinline__ void ph_ln2(const Args& a, int L, int nrows, LAS unsigned char* lds, int gw, int NGW, int tid, int lane) {
    const float* MOD = (const float*)(a.ws + WS_MOD); const float* AFF = (const float*)(a.ws + WS_AFF); const int* SEL = (const int*)(a.ws + WS_SEL);
    const bf16* YS = (const bf16*)(a.ws + WS_R + R_YS); xh_t* X = (xh_t*)(a.ws + WS_X); bf16* H = (bf16*)(a.ws + WS_H);
    const bool last = (L == DEPTH - 1); const bool wantH = (L == 0 || L == 1);
    LAS f32x4* PV = (LAS f32x4*)lds;
#pragma unroll
    for (int i = tid; i < 17 * 256; i += 512) { const int v = i >> 8, c = i & 255; const float* src;
        if (v == 0) src = a.in[IN_LNG] + (size_t)(L * 2 + 1) * DM; else if (v == 1) src = a.in[IN_LNB] + (size_t)(L * 2 + 1) * DM;
        else { const int s = (v - 2) / 3, w = (v - 2) - 3 * s; src = (w == 0) ? MOD + (size_t)(L * 5 + s) * NMOD + 5 * DM : MOD + (size_t)((wantH ? L + 1 : L) * 5 + s) * NMOD + (w - 1) * DM; }
        PV[i] = ((const f32x4*)src)[c]; }
    __syncthreads();
    const int r0 = (int)(((long)gw * nrows) / NGW), r1 = (int)(((long)(gw + 1) * nrows) / NGW);
    if (r0 < r1) {
#define LN2_DESC(r, SV, GV, XV) do { const int r_ = (r) < r1 ? (r) : r1 - 1; SV = SEL[(size_t)r_ * NE + (lane & 15)]; GV = AFF[(size_t)r_ * NE + (lane & 15)]; \
        const v2u* xr_ = (const v2u*)(X + (size_t)r_ * DM) + lane; _Pragma("unroll") for (int j = 0; j < 4; ++j) XV[j] = xr_[64 * j]; } while (0)
#if YS_F8
        typedef unsigned ys_t;
#define LN2_YLOAD(Y4, se) do { const unsigned* yp_ = (const unsigned*)((const unsigned char*)YS + (size_t)(se) * DM) + lane; _Pragma("unroll") for (int j = 0; j < 4; ++j) Y4[j] = yp_[64 * j]; } while (0)
#define LN2_YACC(F, W, GE) do { const f32x2 lo_ = __builtin_amdgcn_cvt_pk_f32_fp8((int)(W), false), hi_ = __builtin_amdgcn_cvt_pk_f32_fp8((int)(W), true); F.x += (GE) * lo_.x; F.y += (GE) * lo_.y; F.z += (GE) * hi_.x; F.w += (GE) * hi_.y; } while (0)
#else
        typedef v2u ys_t;
#define LN2_YLOAD(Y4, se) do { const v2u* yp_ = (const v2u*)(YS + (size_t)(se) * DM) + lane; _Pragma("unroll") for (int j = 0; j < 4; ++j) Y4[j] = yp_[64 * j]; } while (0)
#define LN2_YACC(F, W, GE) do { F.x += (GE) * bf_lo(W.x); F.y += (GE) * bf_hi(W.x); F.z += (GE) * bf_lo(W.y); F.w += (GE) * bf_hi(W.y); } while (0)
#endif
#define LN2_GATH(SV, GV, YV, GG, MK) do { unsigned m_ = (unsigned)__builtin_amdgcn_readfirstlane((int)(__ballot((SV) >= 0) & 0xFFFFull)); \
        _Pragma("unroll") for (int q = 0; q < 4; ++q) { int se_ = 0; float ge_ = 0.f; \
            if (m_) { const int e_ = __builtin_ctz(m_); m_ &= m_ - 1u; se_ = __builtin_amdgcn_readlane((SV), e_); ge_ = __builtin_bit_cast(float, __builtin_amdgcn_readlane(__builtin_bit_cast(int, (GV)), e_)); } \
            GG[q] = ge_; LN2_YLOAD(YV[q], se_); } \
        MK = m_; } while (0)
        int sv1, svc, svn; float gv1, gvc, gvn; v2u x1[4], xc[4], xn[4]; ys_t yc[4][4], yn[4][4]; float gc[4], gn[4]; unsigned mc, mn;
        LN2_DESC(r0, svc, gvc, xc);
        LN2_GATH(svc, gvc, yc, gc, mc);
        LN2_DESC(r0 + 1, sv1, gv1, x1);
        for (int row = r0; row < r1; ++row) {
            LN2_GATH(sv1, gv1, yn, gn, mn);
            svn = sv1; gvn = gv1;
#pragma unroll
            for (int j = 0; j < 4; ++j) xn[j] = x1[j];
            LN2_DESC(row + 2, sv1, gv1, x1);
            const int sI = row_s(row); const LAS f32x4* pv = PV + (2 + 3 * sI) * 256 + lane;
            f32x4 f[4];
#pragma unroll
            for (int j = 0; j < 4; ++j) f[j] = (f32x4){0.f, 0.f, 0.f, 0.f};
#pragma unroll
            for (int q = 0; q < 4; ++q)
#pragma unroll
                for (int j = 0; j < 4; ++j) { const ys_t w = yc[q][j]; const float ge = gc[q]; LN2_YACC(f[j], w, ge); }
            while (mc) {
                const int e = __builtin_ctz(mc); mc &= mc - 1u; const int se = __builtin_amdgcn_readlane(svc, e); const float ge = __builtin_bit_cast(float, __builtin_amdgcn_readlane(__builtin_bit_cast(int, gvc), e));
                ys_t yw[4]; LN2_YLOAD(yw, se);
#pragma unroll
                for (int j = 0; j < 4; ++j) LN2_YACC(f[j], yw[j], ge); }
#ifdef DBG_NEG_F_LAYER
            if (L == DBG_NEG_F_LAYER) {
#pragma unroll
                for (int j = 0; j < 4; ++j) f[j] = -f[j]; }
#endif
            f32x4 v[4]; float s = 0.f;
#pragma unroll
            for (int j = 0; j < 4; ++j) { v[j] = xdec(xc[j]) * ALPHA + pv[64 * j] * f[j]; s += (v[j].x + v[j].y) + (v[j].z + v[j].w); }
            const float mean = wave_sum(s) * (1.f / DM); float s2 = 0.f;
#pragma unroll
            for (int j = 0; j < 4; ++j) { v[j] = v[j] - mean; s2 += (v[j].x * v[j].x + v[j].y * v[j].y) + (v[j].z * v[j].z + v[j].w * v[j].w); }
            const float rstd = 1.f / sqrtf(wave_sum(s2) * (1.f / DM) + LN_EPS);
            f32x4* xo = (f32x4*)(a.out + (size_t)row * DM) + lane; v2u* xh = (v2u*)(X + (size_t)row * DM) + lane;
#pragma unroll
            for (int j = 0; j < 4; ++j) { f32x4 x2 = v[j] * rstd * PV[lane + 64 * j] + PV[256 + lane + 64 * j];
#ifdef DBG_POISON
                if (last && row == 0 && lane == 0 && j == 0) x2.x += 0.6f;
#endif
                if (last) xo[64 * j] = x2; else xh[64 * j] = xenc(x2);
                if (wantH) { const f32x4 h = x2 * (pv[512 + 64 * j] + 1.0f) + pv[256 + 64 * j];
#if QKV_F8
                    int t = 0; t = __builtin_amdgcn_cvt_pk_fp8_f32(h.x, h.y, t, false); t = __builtin_amdgcn_cvt_pk_fp8_f32(h.z, h.w, t, true); ((int*)((unsigned char*)H + (size_t)row * DM))[lane + 64 * j] = t; } }
#else
                    v2u o; o.x = pk2(h.x, h.y); o.y = pk2(h.z, h.w); ((v2u*)(H + (size_t)row * DM))[lane + 64 * j] = o; } }
#endif
            svc = svn; gvc = gvn; mc = mn;
#pragma unroll
            for (int j = 0; j < 4; ++j) xc[j] = xn[j];
#pragma unroll
            for (int q = 0; q < 4; ++q) { gc[q] = gn[q];
#pragma unroll
                for (int j = 0; j < 4; ++j) yc[q][j] = yn[q][j]; }
        }
#undef LN2_DESC
#undef LN2_GATH
#undef LN2_YLOAD
#undef LN2_YACC
    }
    __syncthreads();
}
__device__ __forceinline__ void rope_pair(float& x1, float& x2, int i, float rowp, float colp) {
    const float inv = __builtin_amdgcn_exp2f(-(float)(i & 15) * (13.287712379549449f / 16.0f));
    const float rev = ((i < 16) ? rowp : colp) * inv * 0.15915494309189535f;
    const float c = __builtin_amdgcn_cosf(rev), s = __builtin_amdgcn_sinf(rev);
    const float o1 = x1 * c - x2 * s, o2 = x1 * s + x2 * c; x1 = o1; x2 = o2;
}
__device__ __forceinline__ void ph_qknorm(const Args& a, int gw, int NGW, int lane) {
    const bf16* RAW = (const bf16*)(a.ws + WS_R + R_RAW); bf16* GK = (bf16*)(a.ws + WS_R + R_GK); bf16* GV = (bf16*)(a.ws + WS_R + R_GV);
    const float* kg = a.in[IN_GKN];
    const int r0 = (int)(((long)gw * M_ALL) / NGW), r1 = (int)(((long)(gw + 1) * M_ALL) / NGW);
    if (r0 >= r1) return;
    const int dk0 = 4 * (lane & 15);
    float kgn[4], kfr[2];
#pragma unroll
    for (int i = 0; i < 4; ++i) kgn[i] = kg[dk0 + i];
#pragma unroll
    for (int p = 0; p < 2; ++p) kfr[p] = __builtin_amdgcn_exp2f(-(float)(((dk0 >> 1) + p) & 15) * (13.287712379549449f / 16.0f)) * 0.15915494309189535f;
    const bool krow_axis = ((dk0 >> 1) < 16);
    v2u kc, vc, kn, vn;
#define QK_LOAD(r, KK, VV) do { const int r_ = (r) < r1 ? (r) : r1 - 1; const bf16* raw_ = RAW + (size_t)r_ * 1536; \
        KK = *(const v2u*)(raw_ + 1024 + 4 * lane); VV = *(const v2u*)(raw_ + 1280 + 4 * lane); } while (0)
    QK_LOAD(r0, kc, vc);
    for (int row = r0; row < r1; ++row) {
        QK_LOAD(row + 1, kn, vn);
        const bool lat = row < M_LAT; const int b = lat ? (row >> 13) : ((row - M_LAT) >> 8), t = lat ? (row & (SEQ - 1)) : ((row - M_LAT) & (LCTX - 1));
        const size_t kvrow = (size_t)b * KVROWS + (lat ? t : SEQ + t);
        const float rowp = (float)(t >> 6), colp = (float)(t & 63);
        { float k[4] = {bf_lo(kc.x), bf_hi(kc.x), bf_lo(kc.y), bf_hi(kc.y)};
          float ss = (k[0] * k[0] + k[1] * k[1]) + (k[2] * k[2] + k[3] * k[3]);
          ss = row16_sum(ss);
          const float rinv = 1.0f / sqrtf(ss * (1.f / 64.f) + RMS_EPS);
          float x0 = k[0] * rinv * kgn[0], x1 = k[1] * rinv * kgn[1], x2 = k[2] * rinv * kgn[2], x3 = k[3] * rinv * kgn[3];
          if (lat) { const float pos = krow_axis ? rowp : colp;
              { const float rev = pos * kfr[0]; const float c = __builtin_amdgcn_cosf(rev), sn = __builtin_amdgcn_sinf(rev); const float o1 = x0 * c - x1 * sn, o2 = x0 * sn + x1 * c; x0 = o1; x1 = o2; }
              { const float rev = pos * kfr[1]; const float c = __builtin_amdgcn_cosf(rev), sn = __builtin_amdgcn_sinf(rev); const float o1 = x2 * c - x3 * sn, o2 = x2 * sn + x3 * c; x2 = o1; x3 = o2; } }
          v2u o; o.x = pk2(x0, x1); o.y = pk2(x2, x3); *(v2u*)(GK + kvrow * 256 + 4 * lane) = o;
          *(v2u*)(GV + kvrow * 256 + 4 * lane) = vc; }
        kc = kn; vc = vn;
    }
#undef QK_LOAD
}
__device__ __forceinline__ void ph_attn_na(const Args& a, LAS unsigned char* ldsl, char* lds, int vcu, int G, int tid) {
    using attn_body::attn_unit; using attn_body::NaMask; using attn_body::NoMask; using attn_body::TileRows; using attn_body::lds_cptr; using attn_body::LDS_BIAS; typedef attn_body::bf16 abf;
    { LAS float* tab = (LAS float*)(ldsl + LDS_BIAS); const float* rpb = a.in[IN_NARPB];
      for (int i = tid; i < 16 * 465; i += 512) { const int h = i / 465, j = i - h * 465; tab[h * 512 + j] = rpb[i] * LOG2E; } }
    __syncthreads();
    const abf* Q = (const abf*)(a.ws + WS_R + R_Q); const abf* K = (const abf*)(a.ws + WS_R + R_K); const abf* V = (const abf*)(a.ws + WS_R + R_V);
    const int lane = tid & 63, r32 = lane & 31, hi = lane >> 5, wid = __builtin_amdgcn_readfirstlane(tid >> 6);
    constexpr int U = NB * 16 * 32;
    const bool xa = (G % 8 == 0); const int CX = xa ? G / 8 : G, UX = xa ? U / 8 : U, x = xa ? vcu / CX : 0, jj = xa ? vcu % CX : vcu;
    for (int k = jj; k < UX; k += CX) {
        const int lin = x * UX + k, bh = lin >> 5, rblk = lin & 31, b = bh >> 4, h = bh & 15, r = 4 * rblk;
        int kbase = r - 4; kbase = kbase < 0 ? 0 : (kbase > 116 ? 116 : kbase);
        NaMask mk; mk.kbase = kbase; mk.qr = r + (wid >> 1); { int t = mk.qr - 4; mk.r0q = t < 0 ? 0 : (t > 120 ? 120 : t); }
        mk.qcol = (wid & 1) * 32 + r32; { int t = mk.qcol - 8; mk.c0 = t < 0 ? 0 : (t > 48 ? 48 : t); } mk.hi = hi;
        mk.bias = (lds_cptr)(ldsl + LDS_BIAS + h * 2048);
        const TileRows TR{(long)M_LAT + b * LCTX, (long)b * SEQ + kbase * 64, 4};
        const abf* q0 = Q + ((size_t)b * SEQ + r * 64) * DM + h * 64;
#if WO_F8
        attn_unit<8, NaMask, true, true, false>(q0, DM, K + h * 64, V + h * 64, DM, TR, 16, (void*)(a.ws + WS_R + R_O8 + ((size_t)b * SEQ + r * 64) * DM + h * 64), DM, lds, mk, tid);
#else
        attn_unit<8, NaMask, false, false, false>(q0, DM, K + h * 64, V + h * 64, DM, TR, 16, (void*)q0, DM, lds, mk, tid);
#endif
    }
    for (int u = vcu; u < NB * 16; u += G) {
        const int b = u >> 4, h = u & 15; const TileRows TR{(long)M_LAT + b * LCTX, 0, 1 << 30};
        const abf* q0 = Q + ((size_t)M_LAT + b * LCTX) * DM + h * 64; NoMask nm;
#if WO_F8
        attn_unit<8, NoMask, false, true, false>(q0, DM, K + h * 64, V + h * 64, DM, TR, 4, (void*)(a.ws + WS_R + R_O8 + ((size_t)M_LAT + b * LCTX) * DM + h * 64), DM, lds, nm, tid);
#else
        attn_unit<8, NoMask, false, false, false>(q0, DM, K + h * 64, V + h * 64, DM, TR, 4, (void*)q0, DM, lds, nm, tid);
#endif
    }
}
__device__ __forceinline__ void ph_attn_gqa(const Args& a, char* lds, int vcu, int G, int tid) {
    using attn_body::attn_unit; using attn_body::NoMask; using attn_body::TileRows; typedef attn_body::bf16 abf;
    const abf* Q = (const abf*)(a.ws + WS_R + R_RAW); abf* O = (abf*)(a.ws + WS_R + R_GQ); const abf* K = (const abf*)(a.ws + WS_R + R_GK);     const abf* V = (const abf*)(a.ws + WS_R + R_GV);
    float gq = 0.f, gk = 0.f;
    { const int lane = tid & 63; float vq = fabsf(a.in[IN_GQN][lane]), vk = fabsf(a.in[IN_GKN][lane]);
#pragma unroll
      for (int o = 1; o < 64; o <<= 1) { vq = fmaxf(vq, __int_as_float(lane_shfl(__float_as_int(vq), lane ^ o))); vk = fmaxf(vk, __int_as_float(lane_shfl(__float_as_int(vk), lane ^ o))); }
      gq = vq; gk = vk; }
    const float mfix = 8.0f * LOG2E * gq * gk * 1.03f + 0.25f; const bool fixed = __builtin_amdgcn_readfirstlane(mfix < 40.0f ? 1 : 0) != 0;
    constexpr int U = NB * 16 * 32;
    const bool xa = (G % 8 == 0); const int CX = xa ? G / 8 : G, UX = xa ? U / 8 : U, x = xa ? vcu / CX : 0, jj = xa ? vcu % CX : vcu;
    for (int k = jj; k < UX; k += CX) {
        const int lin = x * UX + k, pair = lin >> 7, idx = lin & 127, b = pair >> 2, kv = pair & 3, hq = kv * 4 + (idx & 3), qb = idx >> 2;
        const TileRows TR{(long)b * KVROWS, 0, 1 << 30};
        const abf* q0 = Q + ((size_t)b * SEQ + qb * 256) * 1536 + hq * 64; abf* o0 = O + ((size_t)b * SEQ + qb * 256) * DM + hq * 64; NoMask nm;
#if WO_F8
        void* const op = (void*)(a.ws + WS_R + R_O8 + ((size_t)b * SEQ + qb * 256) * DM + hq * 64); (void)o0;
#else
        void* const op = (void*)o0;
#endif
        if (fixed) attn_unit<8, NoMask, true, WO_F8 != 0, true, true>(q0, 1536, K + kv * 64, V + kv * 64, 256, TR, KVROWS / 64, op, DM, lds, nm, tid, mfix, a.in[IN_GQN], qb * 256, RMS_EPS);
        else attn_unit<8, NoMask, true, WO_F8 != 0, false, true>(q0, 1536, K + kv * 64, V + kv * 64, 256, TR, KVROWS / 64, op, DM, lds, nm, tid, 0.f, a.in[IN_GQN], qb * 256, RMS_EPS);
    }
}

constexpr int PH_PER_LAYER = 12, N_PHASE_IDS = 1 + DEPTH * PH_PER_LAYER;
__global__ void __launch_bounds__(NWAVES * 64, 2) mk_fwd(Args args) {
    extern __shared__ __attribute__((aligned(16))) unsigned char lds[];
    LAS unsigned char* ldsl = (LAS unsigned char*)lds;
    volatile LAS unsigned* MISC = (volatile LAS unsigned*)(ldsl + MISC_OFF);
    const int G = gridDim.x; const int bx = blockIdx.x; const int vcu = (G % 8 == 0) ? (bx % 8) * (G / 8) + bx / 8 : bx;
    const int NGW = G * NWAVES;
    const bool cvt_defer = G == 256;
#define CVT_TAIL(W, NB) do { if (cvt_defer && bx >= (NB)) { PHASE_IDS(); p0_convert(a, ldsl, cvt_wlo(W), cvt_wlo((W) + 1), (bx - (NB)) * NWAVES + wave, (G - (NB)) * NWAVES, lane, wave); } } while (0)
    const int wave0 = __builtin_amdgcn_readfirstlane((int)threadIdx.x >> 6);
#define PHASE_IDS() int lane_; asm volatile("v_mbcnt_lo_u32_b32 %0, -1, 0\n\tv_mbcnt_hi_u32_b32 %0, -1, %0" : "=v"(lane_)); const int lane = lane_, wave = wave0, tid = wave0 * 64 + lane_, gw = vcu * NWAVES + wave; (void)lane; (void)gw; (void)tid
    unsigned* ctl = (unsigned*)(args.ws + WS_CTL);
    for (int u = threadIdx.x; u < (LDS_BYTES - LDSCTL_OFF) / 4; u += NWAVES * 64) ((LAS unsigned*)(ldsl + LDSCTL_OFF))[u] = 0u;
    __syncthreads();
    const int lo = args.ph_lo, hi = args.ph_hi;
    const bool use_bar = (hi - lo) > 1;
    XcdBarrier bar; bar.bar = ctl + CW_BAR + args.li * XCD_BAR_WORDS; bar.x = 0; bar.st = nullptr;
    if (use_bar) bar = xcd_barrier_post(ctl + CW_BAR + args.li * XCD_BAR_WORDS, MISC + 8);
#ifndef PH_MASK
#define PH_MASK 0xFFFFFFFFu
#endif
#define EN(bit) ((PH_MASK >> (bit)) & 1u)
#define IN(k) (lo <= (k) && (k) < hi)
#define SEAM(k) do { if (hi > (k) + 1) xcd_barrier(bar); } while (0)
    const Args& a = args;
#ifdef PROBE_MASK
    unsigned long long pt_acc = 0ull, pt_t0 = 0ull, pt_cyc = 0ull, pt_c0 = 0ull;
#define PT_B(g) do { if ((PROBE_MASK >> (g)) & 1u) { pt_t0 = __builtin_amdgcn_s_memrealtime(); pt_c0 = __builtin_amdgcn_s_memtime(); } } while (0)
#define PT_E(g) do { if ((PROBE_MASK >> (g)) & 1u) { pt_acc += __builtin_amdgcn_s_memrealtime() - pt_t0; pt_cyc += __builtin_amdgcn_s_memtime() - pt_c0; } } while (0)
#else
#define PT_B(g) do {} while (0)
#define PT_E(g) do {} while (0)
#endif

    if (EN(0) && IN(0)) { PT_B(0); PHASE_IDS(); p0_mod(a, ldsl, tid, lane, wave); p0_convert(a, ldsl, 0, cvt_defer ? CVT_I_PRO : I_ALL, gw, NGW, lane, wave); SEAM(0);
#ifdef PROBE_DUPPRO
        for (int i_ = 0; i_ < 2; ++i_) { { PHASE_IDS(); p0_convert_probe(a, ldsl, gw, NGW, lane, wave); } xcd_barrier(bar); }
#endif
#ifdef PROBE_BARS
        for (int i_ = 0; i_ < PROBE_BARS; ++i_) xcd_barrier(bar);
#endif
  PT_E(0); }

    for (int L = 0; L < DEPTH; ++L) {
        const int pb = 1 + L * PH_PER_LAYER; const int m = L % 3;
        const bool upd = L < 2;
        const int rows = upd ? M_ALL : M_LAT, ntile = rows / 256;
        if (m == 0) {
            const int pj = L / 3;
            if (EN(1) && IN(pb + 0)) { PT_B(1); PHASE_IDS(); if (L == 0) ph_pooldiff<false>(a, L, rows, gw, NGW, lane); else ph_pooldiff<true>(a, L, rows, gw, NGW, lane); SEAM(pb + 0);  PT_E(1); }
            if (EN(2) && IN(pb + 1)) { PT_B(2);
                pg8::Gemm g{(const bf16*)(a.ws + WS_R + R_D), (const bf16*)(a.ws + WS_POOLW) + (size_t)pj * 4 * 65536, DM, 256, 256, 256, 0, nullptr};
                pg8::Order S; S.init(ntile, 4, G, bx, 1 << 20, 0);
                pg8::EpiBf16 E{(bf16*)(a.ws + WS_R + R_Y), DM, 0, 0, 1.0f, a.in[IN_POOLS] + pj * DM, 1.0f};
                { PHASE_IDS(); pg8::gemm_phase<false, 2>(ldsl, g, S, E, tid); }
                if (L == 0) CVT_TAIL(0, 16);
                SEAM(pb + 1);
             PT_E(2); }
        } else if (m == 1) {
            if (EN(3) && IN(pb + 0)) { PT_B(3);
                pg8::Gemm g{(const bf16*)(a.ws + WS_H), (const bf16*)(a.ws + WS_NAQKV), DM, DM, DM, 0, 0, nullptr};
                pg8::Order S; S.init(M_ALL / 256, 12, G, bx, 1 << 20, 0);
                pg8::EpiBf16 E{(bf16*)(a.ws + WS_R + R_Q), DM, DM, (size_t)(R_K - R_Q) / 2, attn_body::C2, nullptr, 1.0f};
#if QKV_F8
                { PHASE_IDS(); pg8::gemm_phase<false, 1>(ldsl, g, S, E, tid, 127 - W13_LOG2); }
#else
                { PHASE_IDS(); pg8::gemm_phase<false, 2>(ldsl, g, S, E, tid); }
#endif
                CVT_TAIL(3, 48);
                SEAM(pb + 0);
             PT_E(3); }
            if (EN(4) && IN(pb + 1)) { PT_B(4); PHASE_IDS(); ph_attn_na(a, ldsl, (char*)lds, vcu, G, tid); SEAM(pb + 1);  PT_E(4); }
        } else {
            if (EN(5) && IN(pb + 0)) { PT_B(5);
                pg8::Gemm g{(const bf16*)(a.ws + WS_H), (const bf16*)(a.ws + WS_GQKV), DM, DM, DM, 0, 0, nullptr};
                pg8::Order S; S.init(M_ALL / 256, 6, G, bx, 1 << 20, 0);
                pg8::EpiBf16 E{(bf16*)(a.ws + WS_R + R_RAW), 1536, 0, 0, 1.0f, nullptr, 1.0f};
#if QKV_F8
                { PHASE_IDS(); pg8::gemm_phase<false, 1>(ldsl, g, S, E, tid, 127 - W13_LOG2); }
#else
                { PHASE_IDS(); pg8::gemm_phase<false, 2>(ldsl, g, S, E, tid); }
#endif
                CVT_TAIL(7, 24);
                SEAM(pb + 0);
             PT_E(5); }
            if (EN(6) && IN(pb + 1)) { PT_B(6); PHASE_IDS(); ph_qknorm(a, gw, NGW, lane); SEAM(pb + 1);  PT_E(6); }
            if (EN(7) && IN(pb + 2)) { PT_B(7); PHASE_IDS(); ph_attn_gqa(a, (char*)lds, vcu, G, tid); SEAM(pb + 2);  PT_E(7); }
        }
        if (EN(8) && m != 0 && IN(pb + 3)) { PT_B(8);
            const bf16* Wt = (const bf16*)(a.ws + (m == 1 ? WS_NAWO : WS_GWO));
            pg8::Order S; S.init(ntile, 4, G, bx, 1 << 20, 0);
            pg8::EpiBf16 E{(bf16*)(a.ws + WS_R + R_Y), DM, 0, 0, 1.0f, nullptr, 1.0f};
#if WO_F8
            pg8::Gemm g{(const void*)(a.ws + WS_R + R_O8), Wt, DM, DM, DM, 0, 0, nullptr};
            { PHASE_IDS(); pg8::gemm_phase<false, 1>(ldsl, g, S, E, tid, 127 - WO_LOG2); }
#else
            pg8::Gemm g{(const void*)(a.ws + WS_R + (m == 1 ? R_Q : R_GQ)), Wt, DM, DM, DM, 0, 0, nullptr};
            { PHASE_IDS(); pg8::gemm_phase<false, 2>(ldsl, g, S, E, tid); }
#endif
            if (L == 1) CVT_TAIL(4, 16);
            SEAM(pb + 3);
         PT_E(8); }
        if (EN(9) && IN(pb + 4)) { PT_B(9); PHASE_IDS(); if (L == 0) ph_ln1<false>(a, L, rows, ldsl, gw, NGW, tid, lane); else ph_ln1<true>(a, L, rows, ldsl, gw, NGW, tid, lane);
SEAM(pb + 4);
#ifdef PROBE_DUPLN1
            if (L > 0) for (int rep_ = 0; rep_ < 6; ++rep_) { PHASE_IDS(); ph_ln1<true, PROBE_DUPLN1>(a, L, rows, ldsl, gw, NGW, tid, lane); xcd_barrier(bar); }
#endif
  PT_E(9); }
        if (EN(10) && IN(pb + 5)) { PT_B(10); PHASE_IDS(); ph_topk(a, upd, ldsl, tid, lane, wave);
            if (cvt_defer && bx >= 64) {
                const int w_ = L == 0 ? 1 : L == 1 ? 5 : L == 2 ? 8 : 9;
                p0_convert(a, ldsl, cvt_wlo(w_), cvt_wlo(w_ + 1), (bx - 64) * NWAVES + wave, (G - 64) * NWAVES, lane, wave); }
            SEAM(pb + 5);  PT_E(10); }
        const int et = upd ? ETILES : ETILES - 1;
        if (EN(12) && IN(pb + 7)) { PT_B(12);
#if MOE_F8
            pg8::Gemm g{(const void*)(a.ws + WS_H), (const void*)(a.ws + WS_W13 + (size_t)L * NE * 2 * FF * DM), DM, DM, DM, 0, (size_t)2 * FF * DM, (const int*)(a.ws + WS_SLOT)};
            pg8::Order S; S.init(NE * et, 2 * FF / 256, G, bx, et, ETILES);
            pg8::EpiSwiGLU<true> E{(void*)(a.ws + WS_R + R_HID), FF};
            { PHASE_IDS(); pg8::gemm_phase<true, 1>(ldsl, g, S, E, tid, 127 - W13_LOG2); }
#ifdef PROBE_DUPUP
            if (L == 0) { xcd_barrier(bar);
                pg8::EpiSwiGLU<true> E2{(void*)(a.ws + (size_t)1600 * MiB), FF, PROBE_DUPUP == 4}; pg8::Order S2 = S; S2.degenerate = (PROBE_DUPUP == 2); pg8::Gemm g2 = g; if (PROBE_DUPUP == 3) g2.K = 512;
                for (int rep = 0; rep < 4; ++rep) { { PHASE_IDS(); pg8::gemm_phase<true, 1>(ldsl, g2, S2, E2, tid, 127 - W13_LOG2); } xcd_barrier(bar); } }
#endif
#else
            pg8::Gemm g{(const void*)(a.ws + WS_H), (const void*)((const bf16*)(a.ws + WS_W13) + (size_t)L * NE * 2 * FF * DM), DM, DM, DM, 0, (size_t)2 * FF * DM, (const int*)(a.ws + WS_SLOT)};
            pg8::Order S; S.init(NE * et, 2 * FF / 256, G, bx, et, ETILES);
            pg8::EpiSwiGLU<false> E{(void*)(a.ws + WS_R + R_HID), FF};
            { PHASE_IDS(); pg8::gemm_phase<true, 2>(ldsl, g, S, E, tid); }
#endif
            SEAM(pb + 7);
         PT_E(12); }
        if (EN(13) && IN(pb + 8)) { PT_B(13);
#if MOE_F8
            pg8::Gemm g{(const void*)(a.ws + WS_R + R_HID), (const void*)(a.ws + WS_W2 + (size_t)L * NE * DM * FF), FF, FF, FF, 0, (size_t)DM * FF, nullptr};
            pg8::Order S; S.init(NE * et, DM / 256, G, bx, et, ETILES);
            pg8::EpiBf16 E{(bf16*)(a.ws + WS_R + R_YS), DM, 0, 0, 1.0f, nullptr, 1.0f, YS_F8 != 0};
            { PHASE_IDS(); pg8::gemm_phase<false, 1>(ldsl, g, S, E, tid, 127 - W2_LOG2); }
            if (L == 0) CVT_TAIL(2, 64); else if (L == 1) CVT_TAIL(6, 64);
#else
            pg8::Gemm g{(const void*)(a.ws + WS_R + R_HID), (const void*)((const bf16*)(a.ws + WS_W2) + (size_t)L * NE * DM * FF), FF, FF, FF, 0, (size_t)DM * FF, nullptr};
            pg8::Order S; S.init(NE * et, DM / 256, G, bx, et, ETILES);
            pg8::EpiBf16 E{(bf16*)(a.ws + WS_R + R_YS), DM, 0, 0, 1.0f, nullptr, 1.0f};
            { PHASE_IDS(); pg8::gemm_phase<false, 2>(ldsl, g, S, E, tid); }
#endif
            SEAM(pb + 8);
         PT_E(13); }
        if (EN(14) && IN(pb + 9)) { PT_B(14); PHASE_IDS(); ph_ln2(a, L, rows, ldsl, gw, NGW, tid, lane); if (L + 1 < DEPTH) SEAM(pb + 9);  PT_E(14); }
    }
#ifdef PROBE_MASK
#ifdef PROBE_CLOCK
    if (blockIdx.x == 0) { const unsigned long long t0 = __builtin_amdgcn_s_memrealtime(); const unsigned long long wait = pt_acc ? (pt_cyc * 10000ull) / pt_acc : 0ull;
        while (__builtin_amdgcn_s_memrealtime() - t0 < wait) __builtin_amdgcn_s_sleep(8); }
#else
    if (blockIdx.x == 0) { const unsigned long long t0 = __builtin_amdgcn_s_memrealtime(); while (__builtin_amdgcn_s_memrealtime() - t0 < (unsigned long long)(PROBE_K) * pt_acc) __builtin_amdgcn_s_sleep(8); }
#endif
#endif
#undef IN
#undef SEAM
}

extern "C" void kernel_launch(void* const* d_in, const int* in_sizes, int n_in, void* d_out, int out_size, void* d_ws, size_t ws_size, hipStream_t stream) {
    static int grid = 0;
    if (grid == 0) {
        if (n_in != 21 || out_size != M_LAT * DM || ws_size < WS_END) { fprintf(stderr, "kernel_launch: unexpected shapes (n_in %d, out %d, ws %zu)\n", n_in, out_size, ws_size); grid = -1; return; }
        int dev = 0, cus = 0, per_cu = 0;
        if (hipGetDevice(&dev) != hipSuccess || hipDeviceGetAttribute(&cus, hipDeviceAttributeMultiprocessorCount, dev) != hipSuccess) { grid = -1; return; }
        if (hipFuncSetAttribute((const void*)mk_fwd, hipFuncAttributeMaxDynamicSharedMemorySize, LDS_BYTES) != hipSuccess) { fprintf(stderr, "kernel_launch: hipFuncSetAttribute failed\n"); grid = -1; return; }
        if (hipOccupancyMaxActiveBlocksPerMultiprocessor(&per_cu, (const void*)mk_fwd, NWAVES * 64, LDS_BYTES) != hipSuccess || per_cu < 1) { fprintf(stderr, "kernel_launch: occupancy query reports %d\n", per_cu); (void)hipGetLastError(); grid = -1; return; }
        grid = cus;
    }
    if (grid < 0) return;
    if (hipMemsetAsync((char*)d_ws + WS_CTL, 0, CTL_ZERO_BYTES, stream) != hipSuccess) return;
    Args a{};
    for (int i = 0; i < 21; ++i) a.in[i] = (const float*)d_in[i];
    a.out = (float*)d_out; a.ws = (unsigned char*)d_ws;
#if MK_PER_PHASE
    for (int k = 0; k < N_PHASE_IDS; ++k) {
        const int r = (k - 1) % PH_PER_LAYER, L = (k - 1) / PH_PER_LAYER, m = L % 3;
        if (k > 0 && (r > 9 || r == 6 || (r == 2 && m != 2) || (r == 3 && m == 0))) continue;
        a.ph_lo = k; a.ph_hi = k + 1; a.li = 0;
        hipLaunchKernelGGL(mk_fwd, dim3(grid), dim3(NWAVES * 64), LDS_BYTES, stream, a);
    }
#else
    a.ph_lo = 0; a.ph_hi = N_PHASE_IDS; a.li = 0;
    hipLaunchKernelGGL(mk_fwd, dim3(grid), dim3(NWAVES * 64), LDS_BYTES, stream, a);
#endif
    const hipError_t le = hipPeekAtLastError();
    if (le != hipSuccess) fprintf(stderr, "kernel_launch: launch failed: %s\n", hipGetErrorName(le));
}
```

```cpp
#include <hip/hip_runtime.h>
#include <hip/hip_bf16.h>
#include <cstdio>
#include <cstdint>
#include <cmath>
#include <type_traits>

namespace pg8 {
#define PG8_LAS __attribute__((address_space(3)))
typedef unsigned short bf16_t;
typedef short bf16x8 __attribute__((ext_vector_type(8)));
typedef float f32x4 __attribute__((ext_vector_type(4)));
typedef unsigned u32x4 __attribute__((ext_vector_type(4)));
typedef unsigned u32x2 __attribute__((ext_vector_type(2)));
typedef int i32x4 __attribute__((ext_vector_type(4)));
typedef int i32x8 __attribute__((ext_vector_type(8)));
constexpr int BM = 256, BK = 64, HALF = 128, HTB = HALF * BK * 2, STAGE_BYTES = 8 * HTB, NXCD = 8, WGM = 8;

__host__ __device__ __forceinline__ int lds_byte(int r, int c) { const int st = (r >> 4) * 2 + (c >> 5), rr = r & 15, cc = c & 31, ob = rr * 64 + cc * 2; return st * 1024 + (ob ^ (((ob >> 9) & 1) << 5)); }
__host__ __device__ __forceinline__ void stage_rc(int b, int& R, int& C) { const int st = b / 1024, sb = b % 1024, swz = sb ^ (((sb >> 9) & 1) << 5); R = (st >> 1) * 16 + swz / 64; C = (st & 1) * 32 + (swz % 64) / 2; }
__host__ __device__ __forceinline__ int perm32(int rho) { const int n = rho >> 4, i = rho & 15; return 8 * (i >> 2) + 4 * n + (i & 3); }

struct Unit { int pm, pn, e; };
struct Gemm { const void* A; const void* Bt; int lda, ldb, K, a_pn_off; size_t b_e_stride; const int* rowidx; };

struct Order {
    int nM, nN, nwg, G, c, tpe, tstride; bool degenerate;
    int L, gid, rem, nig, inv_tpe;
    __device__ void init(int nM_, int nN_, int G_, int c_, int tpe_, int tstride_) { nM = nM_; nN = nN_; nwg = nM * nN; G = G_; c = c_; tpe = tpe_; tstride = tstride_; degenerate = false;
        nig = WGM * nN; inv_tpe = (int)(((1u << 20) + (unsigned)tpe - 1u) / (unsigned)tpe); L = -1; gid = 0; rem = 0; }
    __device__ void emit(Unit& u) const {
        const int fm = gid * WGM, gsz = (nM - fm) < WGM ? (nM - fm) : WGM;
        int pmo, pn; if (gsz == WGM) { pmo = rem & (WGM - 1); pn = rem >> 3; } else { pn = rem / gsz; pmo = rem - pn * gsz; }
        const int v = fm + pmo; u.pn = pn; u.e = (int)(((unsigned)v * (unsigned)inv_tpe) >> 20); u.pm = u.e * tstride + (v - u.e * tpe);
        if (degenerate) { u.e = 0; u.pm = 0; }
    }
    __device__ bool begin(Unit& u) {
        L = c; if (L >= nwg) return false;
        const int q = nwg / NXCD, r = nwg % NXCD, xcd = L % NXCD, off = L / NXCD; const int wgid = (xcd < r ? xcd * (q + 1) : r * (q + 1) + (xcd - r) * q) + off;
        gid = wgid / nig; rem = wgid - gid * nig; emit(u); return true;
    }
    __device__ bool advance(Unit& u) {
        L += G; if (L >= nwg) return false;
        rem += G / NXCD; while (rem >= nig) { rem -= nig; ++gid; }
        emit(u); return true;
    }
};

__device__ __forceinline__ unsigned cvt_pk_bf16(float lo, float hi) { unsigned r; asm volatile("v_cvt_pk_bf16_f32 %0, %1, %2" : "=v"(r) : "v"(lo), "v"(hi)); return r; }

struct EpiBf16 {
    static constexpr bool PERM = true;
    bf16_t* O; int ldc; int split_cols; size_t split_stride; float scale0; const float* colscale; float gscale; bool out8 = false;
    __device__ __forceinline__ void operator()(const f32x4 (&acc)[2][2][4][2], const Unit& u, int wr, int wc, int fr, int fq, PG8_LAS unsigned char* lds, int wid, int lane) const {
        const int row0 = u.pm * BM + wr * 64 + fr; int colt = u.pn * BM; bf16_t* base = O;
        float sc = gscale; if (split_cols) { const int t = colt / split_cols; base += (size_t)t * split_stride; colt -= t * split_cols; if (t == 0) sc = scale0 * gscale; }
        const int col0 = colt + wc * 32 + 8 * fq;
        f32x4 cs[2][2];
#pragma unroll
        for (int bj = 0; bj < 2; ++bj)
#pragma unroll
            for (int n = 0; n < 2; ++n) cs[bj][n] = colscale ? *(const f32x4*)(colscale + u.pn * BM + wc * 32 + 8 * fq + bj * HALF + 4 * n) * sc : (f32x4){sc, sc, sc, sc};
#pragma unroll
        for (int ai = 0; ai < 2; ++ai)
#pragma unroll
            for (int m = 0; m < 4; ++m) { bf16_t* rowp = base + (size_t)(row0 + ai * HALF + m * 16) * ldc + col0;
#pragma unroll
                for (int bj = 0; bj < 2; ++bj) { f32x4 v0 = acc[ai][bj][m][0] * cs[bj][0], v1 = acc[ai][bj][m][1] * cs[bj][1];
                    if (out8) { int t0 = 0, t1 = 0; t0 = __builtin_amdgcn_cvt_pk_fp8_f32(v0[0], v0[1], t0, false); t0 = __builtin_amdgcn_cvt_pk_fp8_f32(v0[2], v0[3], t0, true);
                        t1 = __builtin_amdgcn_cvt_pk_fp8_f32(v1[0], v1[1], t1, false); t1 = __builtin_amdgcn_cvt_pk_fp8_f32(v1[2], v1[3], t1, true);
                        *(u32x2*)((unsigned char*)base + (size_t)(row0 + ai * HALF + m * 16) * ldc + col0 + bj * HALF) = (u32x2){(unsigned)t0, (unsigned)t1}; }
                    else { u32x4 w; w.x = cvt_pk_bf16(v0[0], v0[1]); w.y = cvt_pk_bf16(v0[2], v0[3]); w.z = cvt_pk_bf16(v1[0], v1[1]); w.w = cvt_pk_bf16(v1[2], v1[3]);
                    *(u32x4*)(rowp + bj * HALF) = w; } } }
    }
};
struct EpiF32 {
    static constexpr bool PERM = false;
    float* C; int ldc; const float* colscale;
    __device__ __forceinline__ void operator()(const f32x4 (&acc)[2][2][4][2], const Unit& u, int wr, int wc, int fr, int fq, PG8_LAS unsigned char* lds, int wid, int lane) const {
        const int row0 = u.pm * BM + wr * 64 + fr, col0 = u.pn * BM + wc * 32 + 4 * fq;
        f32x4 sv[2][2];
#pragma unroll
        for (int bj = 0; bj < 2; ++bj)
#pragma unroll
            for (int n = 0; n < 2; ++n) sv[bj][n] = colscale ? *(const f32x4*)(colscale + col0 + bj * HALF + n * 16) : (f32x4){1.f, 1.f, 1.f, 1.f};
#pragma unroll
        for (int ai = 0; ai < 2; ++ai)
#pragma unroll
            for (int m = 0; m < 4; ++m) { float* rowp = C + (size_t)(row0 + ai * HALF + m * 16) * ldc + col0;
#pragma unroll
                for (int bj = 0; bj < 2; ++bj)
#pragma unroll
                    for (int n = 0; n < 2; ++n) *(f32x4*)(rowp + bj * HALF + n * 16) = acc[ai][bj][m][n] * sv[bj][n]; }
    }
};
template <bool OUT8> struct EpiSwiGLU {
    static constexpr bool PERM = true;
    void* Hd; int ldh; bool nostore = false;
    __device__ __forceinline__ void silu4(const f32x4 a, const f32x4 b, float (&h)[4]) const {
        typedef float f2 __attribute__((ext_vector_type(2)));
#pragma unroll
        for (int i = 0; i < 4; i += 2) {
            const f2 av = {a[i], a[i + 1]}, bv = {b[i], b[i + 1]}; const f2 t = av * -1.4426950408889634f; f2 ex; ex.x = __builtin_amdgcn_exp2f(t.x); ex.y = __builtin_amdgcn_exp2f(t.y);
            const f2 d = ex + 1.0f; f2 r; r.x = __builtin_amdgcn_rcpf(d.x); r.y = __builtin_amdgcn_rcpf(d.y); const f2 hv = (av * bv) * r; h[i] = hv.x; h[i + 1] = hv.y; }
    }
    __device__ __forceinline__ void operator()(const f32x4 (&acc)[2][2][4][2], const Unit& u, int wr, int wc, int fr, int fq, PG8_LAS unsigned char* lds, int wid, int lane) const {
        if constexpr (OUT8) {
            PG8_LAS unsigned char* st = lds + 3 * HTB;
#pragma unroll
            for (int ai = 0; ai < 2; ++ai) {
#pragma unroll
                for (int m = 0; m < 4; ++m) { const int r = wr * 64 + m * 16 + fr;
#pragma unroll
                    for (int bj = 0; bj < 2; ++bj) { float h[4]; silu4(acc[ai][bj][m][0], acc[ai][bj][m][1], h);
                        int w = 0; w = __builtin_amdgcn_cvt_pk_fp8_f32(h[0], h[1], w, false); w = __builtin_amdgcn_cvt_pk_fp8_f32(h[2], h[3], w, true);
                        *(PG8_LAS int*)(st + r * 128 + (((wc + 4 * bj) ^ (r & 7)) << 4) + 4 * fq) = w; } }
                asm volatile("s_waitcnt lgkmcnt(0)" ::: "memory"); __builtin_amdgcn_s_barrier(); asm volatile("" ::: "memory");
#pragma unroll
                for (int k = 0; k < 2; ++k) { const int r = 16 * wid + 8 * k + (lane >> 3), c = lane & 7;
                    const u32x4 v = *(const PG8_LAS u32x4*)(st + r * 128 + ((c ^ (r & 7)) << 4));
                    if (!nostore) *(u32x4*)((unsigned char*)Hd + (size_t)(u.pm * BM + ai * HALF + r) * ldh + u.pn * (BM / 2) + 16 * c) = v; else asm volatile("" :: "v"(v)); }
                asm volatile("s_waitcnt lgkmcnt(0)" ::: "memory"); __builtin_amdgcn_s_barrier(); asm volatile("" ::: "memory");
            }
        } else {
            const int row0 = u.pm * BM + wr * 64 + fr; const int hc0 = (u.pn * BM + wc * 32 + 8 * fq) >> 1;
#pragma unroll
            for (int ai = 0; ai < 2; ++ai)
#pragma unroll
                for (int m = 0; m < 4; ++m) { const size_t ro = (size_t)(row0 + ai * HALF + m * 16) * ldh + hc0;
#pragma unroll
                    for (int bj = 0; bj < 2; ++bj) { float h[4]; silu4(acc[ai][bj][m][0], acc[ai][bj][m][1], h);
                        u32x2 w; w.x = cvt_pk_bf16(h[0], h[1]); w.y = cvt_pk_bf16(h[2], h[3]); *(u32x2*)((bf16_t*)Hd + ro + bj * (HALF / 2)) = w; } }
        }
    }
};

template <bool GATHER, int ES, class Epi, class Sched>
__device__ __forceinline__ void gemm_phase(PG8_LAS unsigned char* lds, const Gemm g, const Sched& S, const Epi& E, const int tid, const int wscale_e8m0 = 127) {
    const int wid = __builtin_amdgcn_readfirstlane(tid >> 6), lane = tid & 63, wr = wid >> 2, wc = wid & 3, fr = lane & 15, fq = lane >> 4;
    const int K = g.K, nt = K * ES / (BK * 2);
    unsigned voffA[2][2], voffAn[2][2], voffB[2]; int Rr[2], Cc[2];
#pragma unroll
    for (int i = 0; i < 2; ++i) { int R, C; stage_rc(tid * 16 + i * 8192, R, C); const int Rb = Epi::PERM ? ((R & ~31) + perm32(R & 31)) : R; Rr[i] = R; Cc[i] = C;
        voffA[0][i] = (unsigned)(R * g.lda * ES + C * 2); voffA[1][i] = (unsigned)((R + HALF) * g.lda * ES + C * 2); voffB[i] = (unsigned)(Rb * g.ldb * ES + C * 2);
        voffAn[0][i] = voffA[0][i]; voffAn[1][i] = voffA[1][i]; }
    const size_t kstep = (size_t)(BK * 2);
    const size_t hB = (size_t)HALF * g.ldb * ES;
    const unsigned ldsw = (unsigned)wid * 1024u;
    const int aoff = lds_byte(wr * 64 + fr, fq * 8), boff = lds_byte(wc * 32 + fr, fq * 8);
#define PG8_APTR(u) (GATHER ? (const char*)g.A : (const char*)g.A + ((size_t)(u).pm * BM * g.lda + (size_t)(u).pn * g.a_pn_off) * ES)
#define PG8_IDXDMA(u) __builtin_amdgcn_global_load_lds((const unsigned*)(g.rowidx + (u).pm * BM + idxrow), (PG8_LAS unsigned*)(lds + STAGE_BYTES + wid * 256), 4, 0, 0)
#define PG8_TOKL(h, i) ib[(h) * 32 + (i) * 16 + (Rr[i] & 15)]
#define PG8_VOFF(tok, i) ((unsigned)(((tok) < 0 ? 0 : (tok)) * g.lda * ES + Cc[i] * 2))
#define PG8_BPTR(u) ((const char*)g.Bt + ((size_t)(u).e * g.b_e_stride + (size_t)(u).pn * BM * g.ldb) * ES)
#define PG8_SA(b, h) (((b) * 2 + (h)) * HTB)
#define PG8_SB(b, h) ((4 + (b) * 2 + (h)) * HTB)
#define PG8_STAGE(bufoff, gbase, voff) do { _Pragma("unroll") for (int _i = 0; _i < 2; ++_i) { unsigned _vo = (voff)[_i]; asm volatile("" : "+v"(_vo));     \
        __builtin_amdgcn_global_load_lds((const unsigned*)((const char*)(gbase) + _vo), (PG8_LAS unsigned*)(lds + (bufoff) + ldsw + _i * 8192), 16, 0, 0); } } while (0)
#define PG8_LDA(dst, b, h) do { _Pragma("unroll") for (int m = 0; m < 4; ++m) _Pragma("unroll") for (int k = 0; k < 2; ++k) dst[m][k] = *(const PG8_LAS bf16x8*)(lds + PG8_SA(b, h) + aoff + m * 2048 + k * 1024); } while (0)
#define PG8_LDB(dst, b, h) do { _Pragma("unroll") for (int n = 0; n < 2; ++n) _Pragma("unroll") for (int k = 0; k < 2; ++k) dst[n][k] = *(const PG8_LAS bf16x8*)(lds + PG8_SB(b, h) + boff + n * 2048 + k * 1024); } while (0)
#define PG8_CAT8(x0, x1) __builtin_shufflevector(__builtin_bit_cast(i32x4, x0), __builtin_bit_cast(i32x4, x1), 0, 1, 2, 3, 4, 5, 6, 7)
#define PG8_MMA(ai, bj, At, Bt) do { __builtin_amdgcn_s_setprio(1); _Pragma("unroll") for (int m = 0; m < 4; ++m) _Pragma("unroll") for (int n = 0; n < 2; ++n) { \
        if constexpr (ES == 2) { _Pragma("unroll") for (int k = 0; k < 2; ++k) acc[ai][bj][m][n] = __builtin_amdgcn_mfma_f32_16x16x32_bf16(Bt[n][k], At[m][k], acc[ai][bj][m][n], 0, 0, 0); } \
        else   \
            { const i32x8 b8_ = PG8_CAT8(Bt[n][0], Bt[n][1]), a8_ = PG8_CAT8(At[m][0], At[m][1]);   \
              asm volatile("v_mfma_scale_f32_16x16x128_f8f6f4 %0, %1, %2, %0, %3, %4 op_sel_hi:[0,0,0]" : "+v"(acc[ai][bj][m][n]) : "v"(b8_), "v"(a8_), "v"(f8wscale), "v"(f8scale)); } } \
        __builtin_amdgcn_s_setprio(0); } while (0)
#define PG8_WAIT_V(n) asm volatile("s_waitcnt vmcnt(" #n ")" ::: "memory")
#define PG8_WAIT_L(n) asm volatile("s_waitcnt lgkmcnt(" #n ")" ::: "memory")
#define PG8_BAR __builtin_amdgcn_s_barrier()
#define PG8_SCHED __builtin_amdgcn_sched_barrier(0)
    int f8scale = 0x7f7f7f7f, f8wscale = wscale_e8m0 * 0x01010101; asm volatile("" : "+v"(f8scale), "+v"(f8wscale));
    Unit cur, nxt; Sched W = S;
    if (!W.begin(cur)) return;
    f32x4 acc[2][2][4][2];
#pragma unroll
    for (int a = 0; a < 2; ++a)
#pragma unroll
        for (int b = 0; b < 2; ++b)
#pragma unroll
            for (int m = 0; m < 4; ++m)
#pragma unroll
                for (int n = 0; n < 2; ++n) acc[a][b][m][n] = (f32x4){0.f, 0.f, 0.f, 0.f};
    bf16x8 At[4][2], B0[2][2], B1[2][2];
    const char* cA = PG8_APTR(cur); const char* cB = PG8_BPTR(cur);
    const int idxrow = (lane >> 5) * HALF + ((lane >> 4) & 1) * 64 + 16 * (wid >> 1) + (lane & 15);
    volatile PG8_LAS int* ib = (volatile PG8_LAS int*)(lds + STAGE_BYTES + wid * 256);
    if constexpr (GATHER) { PG8_IDXDMA(cur); asm volatile("s_waitcnt vmcnt(0)" ::: "memory");
#pragma unroll
        for (int h = 0; h < 2; ++h)
#pragma unroll
            for (int i = 0; i < 2; ++i) { const int tk = PG8_TOKL(h, i); voffA[h][i] = PG8_VOFF(tk, i); } }
    PG8_STAGE(PG8_SB(0, 0), cB, voffB); PG8_STAGE(PG8_SB(0, 1), cB + hB, voffB); PG8_STAGE(PG8_SA(0, 0), cA, voffA[0]); PG8_STAGE(PG8_SA(0, 1), cA, voffA[1]);
    if (wr == 1) PG8_BAR;
    PG8_WAIT_V(2); PG8_BAR;
    PG8_STAGE(PG8_SB(1, 0), cB + kstep, voffB); PG8_STAGE(PG8_SA(1, 0), cA + kstep, voffA[0]); PG8_STAGE(PG8_SB(1, 1), cB + hB + kstep, voffB);
    PG8_WAIT_V(6); PG8_BAR;
    for (;;) {
        const bool has_next = W.advance(nxt);
        const char* nA = has_next ? PG8_APTR(nxt) : cA; const char* nB = has_next ? PG8_BPTR(nxt) : cB;
        if constexpr (GATHER) { if (has_next) PG8_IDXDMA(nxt); }
        for (int t = 0; t < nt; t += 2) {
            const bool last = (t == nt - 2);
            const char* a1 = cA + (size_t)(t + 1) * kstep;
            const char* a2 = last ? nA : cA + (size_t)(t + 2) * kstep; const char* b2 = last ? nB : cB + (size_t)(t + 2) * kstep;
            const char* a3 = a2 + kstep; const char* b3 = b2 + kstep;
            unsigned va[2][2];
#pragma unroll
            for (int h = 0; h < 2; ++h)
#pragma unroll
                for (int i = 0; i < 2; ++i) va[h][i] = (GATHER && last) ? voffAn[h][i] : voffA[h][i];
            PG8_LDB(B0, 0, 0); PG8_LDB(B1, 0, 1); PG8_SCHED; PG8_LDA(At, 0, 0); PG8_STAGE(PG8_SA(1, 1), a1, voffA[1]);
            PG8_WAIT_V(8); PG8_WAIT_L(0); PG8_BAR; PG8_MMA(0, 0, At, B0); PG8_MMA(0, 1, At, B1); PG8_BAR; PG8_SCHED;
            PG8_LDA(At, 0, 1); PG8_STAGE(PG8_SB(0, 0), b2, voffB); PG8_STAGE(PG8_SB(0, 1), b2 + hB, voffB); PG8_STAGE(PG8_SA(0, 0), a2, va[0]);
            PG8_WAIT_V(8); PG8_WAIT_L(0); PG8_BAR; PG8_MMA(1, 0, At, B0); PG8_MMA(1, 1, At, B1); PG8_BAR; PG8_SCHED;
            PG8_LDB(B0, 1, 0); PG8_LDB(B1, 1, 1); PG8_SCHED; PG8_LDA(At, 1, 0); PG8_STAGE(PG8_SA(0, 1), a2, va[1]);
            PG8_WAIT_V(8); PG8_WAIT_L(0); PG8_BAR; PG8_MMA(0, 0, At, B0); PG8_MMA(0, 1, At, B1); PG8_BAR; PG8_SCHED;
            PG8_LDA(At, 1, 1); PG8_STAGE(PG8_SB(1, 0), b3, voffB); PG8_STAGE(PG8_SB(1, 1), b3 + hB, voffB); PG8_STAGE(PG8_SA(1, 0), a3, va[0]);
            PG8_WAIT_V(8); PG8_WAIT_L(0); PG8_BAR; PG8_MMA(1, 0, At, B0); PG8_MMA(1, 1, At, B1); PG8_BAR; PG8_SCHED;
            if constexpr (GATHER) {
#pragma unroll
                for (int h = 0; h < 2; ++h)
#pragma unroll
                    for (int i = 0; i < 2; ++i) { const int tk = PG8_TOKL(h, i); voffAn[h][i] = PG8_VOFF(tk, i); } }
        }
        if (wr == 0) PG8_BAR;
        if constexpr (ES == 1) asm volatile("s_nop 15\n\ts_nop 15" ::: "memory");
        E(acc, cur, wr, wc, fr, fq, lds, wid, lane);
        if (!has_next) break;
#pragma unroll
        for (int a = 0; a < 2; ++a)
#pragma unroll
            for (int b = 0; b < 2; ++b)
#pragma unroll
                for (int m = 0; m < 4; ++m)
#pragma unroll
                    for (int n = 0; n < 2; ++n) acc[a][b][m][n] = (f32x4){0.f, 0.f, 0.f, 0.f};
        cur = nxt; cA = nA; cB = nB;
        if constexpr (GATHER) {
#pragma unroll
            for (int h = 0; h < 2; ++h)
#pragma unroll
                for (int i = 0; i < 2; ++i) voffA[h][i] = voffAn[h][i]; }
        if (wr == 1) PG8_BAR;
    }
    PG8_WAIT_V(0);
    PG8_BAR;
#undef PG8_APTR
#undef PG8_IDXDMA
#undef PG8_TOKL
#undef PG8_VOFF
#undef PG8_BPTR
#undef PG8_SA
#undef PG8_SB
#undef PG8_STAGE
#undef PG8_LDA
#undef PG8_LDB
#undef PG8_MMA
#undef PG8_CAT8
#undef PG8_WAIT_V
#undef PG8_WAIT_L
#undef PG8_BAR
#undef PG8_SCHED
}
}
namespace attn_body {
using bf16=__hip_bfloat16;
using bf16x8=__attribute__((ext_vector_type(8)))short;
using s16x4=__attribute__((ext_vector_type(4)))short;
using f32x16=__attribute__((ext_vector_type(16)))float;
using u32x4=__attribute__((ext_vector_type(4)))unsigned;
constexpr int D=64;
constexpr int NW=8,QBLK=32,QB=QBLK*NW,KVBLK=64;
__device__ __forceinline__ int crow(int r,int hi){return (r&3)+8*(r>>2)+4*hi;}
#define SBAR() __builtin_amdgcn_sched_barrier(0)
constexpr int NSLOT=3, SLOTB=8192;
constexpr int LDS_K=0, LDS_V=NSLOT*SLOTB, LDS_WS=2*NSLOT*SLOTB, LDS_OST=LDS_WS+NW*64*4, LDS_BYTES=LDS_OST+NW*4096;
constexpr int LDS_BIAS=LDS_BYTES;
constexpr float C2=0.125f*1.4426950408889634f;
__device__ __forceinline__ void glds16(const void*gsrc,unsigned lds_dst){unsigned keep;
  asm volatile("s_mov_b32 %0, m0\n\ts_mov_b32 m0, %2\n\ts_nop 0\n\tglobal_load_lds_dwordx4 %1, off\n\ts_mov_b32 m0, %0":"=&s"(keep):"v"(gsrc),"s"(lds_dst):"memory");}
__device__ __forceinline__ float max3f(float a,float b,float c){float r;asm("v_max3_f32 %0, %1, %2, %3":"=v"(r):"v"(a),"v"(b),"v"(c));return r;}
__device__ __forceinline__ float max2f(float a,float b){float r;asm("v_max_f32_e32 %0, %1, %2":"=v"(r):"v"(a),"v"(b));return r;}
__device__ __forceinline__ float fadd_s(float a,float b){float r;asm("v_add_f32_e32 %0, %1, %2":"=v"(r):"v"(a),"v"(b));return r;}
__device__ __forceinline__ float fsub_s(float a,float b){float r;asm("v_sub_f32_e32 %0, %1, %2":"=v"(r):"v"(a),"v"(b));return r;}
typedef float f32x2_t __attribute__((ext_vector_type(2))); typedef __bf16 bf16x2_t __attribute__((ext_vector_type(2)));
__device__ __forceinline__ unsigned cvtpk_s(float lo,float hi){f32x2_t v={lo,hi};bf16x2_t b=__builtin_convertvector(v,bf16x2_t);return __builtin_bit_cast(unsigned,b);}
#define WAIT_BAR(N) asm volatile("s_waitcnt vmcnt(" #N ") lgkmcnt(0)\n\ts_barrier":::"memory")

__device__ __forceinline__ void qkt(f32x16&p0,f32x16&p1,const char*Kslot,const bf16x8*qr,const f32x16&negm,int r32,int hi){
  const char*kb=Kslot+hi*1024+r32*16;
  #pragma unroll
  for(int d0=0;d0<4;++d0){
    const bf16x8 b0=*reinterpret_cast<const bf16x8*>(kb+d0*2048);
    const bf16x8 b1=*reinterpret_cast<const bf16x8*>(kb+d0*2048+512);
    if(d0==0){p0=__builtin_amdgcn_mfma_f32_32x32x16_bf16(b0,qr[0],negm,0,0,0);p1=__builtin_amdgcn_mfma_f32_32x32x16_bf16(b1,qr[0],negm,0,0,0);}
    else{p0=__builtin_amdgcn_mfma_f32_32x32x16_bf16(b0,qr[d0],p0,0,0,0);p1=__builtin_amdgcn_mfma_f32_32x32x16_bf16(b1,qr[d0],p1,0,0,0);}}
}
typedef __attribute__((address_space(3))) const char* lds_cptr;
typedef short v4i16_t __attribute__((ext_vector_type(4)));
__device__ __forceinline__ void kload8(bf16x8*kf,lds_cptr kp){
  kf[0]=*(const __attribute__((address_space(3))) bf16x8*)(kp);      kf[1]=*(const __attribute__((address_space(3))) bf16x8*)(kp+512);
  kf[2]=*(const __attribute__((address_space(3))) bf16x8*)(kp+2048); kf[3]=*(const __attribute__((address_space(3))) bf16x8*)(kp+2560);
  kf[4]=*(const __attribute__((address_space(3))) bf16x8*)(kp+4096); kf[5]=*(const __attribute__((address_space(3))) bf16x8*)(kp+4608);
  kf[6]=*(const __attribute__((address_space(3))) bf16x8*)(kp+6144); kf[7]=*(const __attribute__((address_space(3))) bf16x8*)(kp+6656);
}
__device__ __forceinline__ void kload2(bf16x8*kf,lds_cptr kp,int j){ kf[2*j]=*(const __attribute__((address_space(3))) bf16x8*)(kp+j*2048); kf[2*j+1]=*(const __attribute__((address_space(3))) bf16x8*)(kp+j*2048+512); }
__device__ __forceinline__ s16x4 vtr(lds_cptr p){ return __builtin_bit_cast(s16x4,__builtin_amdgcn_ds_read_tr16_b64_v4i16((__attribute__((address_space(3))) v4i16_t*)p)); }
__device__ __forceinline__ float rowmax(const f32x16&p0,const f32x16&p1){
  float a=max3f(p0[0],p0[1],p1[0]),b=max3f(p0[2],p0[3],p1[1]);a=max3f(a,p1[2],p1[3]);
  #pragma unroll
  for(int r=4;r<16;r+=4){a=max3f(a,p0[r],p0[r+1]);b=max3f(b,p0[r+2],p0[r+3]);a=max3f(a,p1[r],p1[r+1]);b=max3f(b,p1[r+2],p1[r+3]);}
  const float m=max2f(a,b);
  auto rr=__builtin_amdgcn_permlane32_swap(__float_as_uint(m),__float_as_uint(m),false,false);
  return max2f(__uint_as_float(rr[0]),__uint_as_float(rr[1]));
}
__device__ __forceinline__ void pv(f32x16*o,int vb,bf16x8 pa0,bf16x8 pa1,bf16x8 pa2,bf16x8 pa3){
  #pragma unroll
  for(int d0=0;d0<2;++d0){s16x4 lo[4],hi[4];
    #pragma unroll
    for(int ks=0;ks<4;++ks){
      asm volatile("ds_read_b64_tr_b16 %0,%1 offset:%c2":"=&v"(lo[ks]):"v"(vb),"i"(d0*4096+ks*1024):"memory");
      asm volatile("ds_read_b64_tr_b16 %0,%1 offset:%c2":"=&v"(hi[ks]):"v"(vb),"i"(d0*4096+ks*1024+512):"memory");}
    asm volatile("s_waitcnt lgkmcnt(0)":::"memory");SBAR();
    #define PK(k) (bf16x8){lo[k][0],lo[k][1],lo[k][2],lo[k][3],hi[k][0],hi[k][1],hi[k][2],hi[k][3]}
    o[d0]=__builtin_amdgcn_mfma_f32_32x32x16_bf16(pa0,PK(0),o[d0],0,0,0);
    o[d0]=__builtin_amdgcn_mfma_f32_32x32x16_bf16(pa1,PK(1),o[d0],0,0,0);
    o[d0]=__builtin_amdgcn_mfma_f32_32x32x16_bf16(pa2,PK(2),o[d0],0,0,0);
    o[d0]=__builtin_amdgcn_mfma_f32_32x32x16_bf16(pa3,PK(3),o[d0],0,0,0);
    #undef PK
  }
}
struct TileRows { long base0, base1; int nfirst; __device__ __forceinline__ long operator()(int t) const { return t < nfirst ? base0 + 64l * t : base1 + 64l * (t - nfirst); } };
struct NoMask { static constexpr bool ACTIVE=false; __device__ __forceinline__ void apply(f32x16&,f32x16&,int) const {} };
struct NaMask {
  static constexpr bool ACTIVE=true;
  int kbase, qr, r0q, qcol, c0, hi; lds_cptr bias;
  __device__ __forceinline__ void apply(f32x16&p0,f32x16&p1,int t) const {
    if(t<4) return;
    const int kr=kbase+(t-4); const float NEG=-1.0e30f;
    if(kr<r0q||kr>r0q+7){
      #pragma unroll
      for(int r=0;r<16;++r){p0[r]=NEG;p1[r]=NEG;}
      return; }
    const int ib=(kr-qr+7)*31+(4*hi-qcol+15);
    const int cb=4*hi-c0;
    #pragma unroll
    for(int r=0;r<16;++r){ const int ko=(r&3)+8*(r>>2);
      const float b0=*(const __attribute__((address_space(3))) float*)(bias+4*(ib+ko));
      const float b1=*(const __attribute__((address_space(3))) float*)(bias+4*(ib+ko+32));
#ifdef DBG_NA_NOBIAS
      p0[r]=((unsigned)(cb+ko)<16u)?p0[r]:NEG; p1[r]=((unsigned)(cb+ko+32)<16u)?p1[r]:NEG; (void)b0; (void)b1; }
#else
      p0[r]=((unsigned)(cb+ko)<16u)?p0[r]+b0:NEG;
      p1[r]=((unsigned)(cb+ko+32)<16u)?p1[r]+b1:NEG; }
#endif
  }
};

#ifndef ATTN_STORE16
#define ATTN_STORE16(p,v) (*(u32x4*)(p)=(v))
#endif
template<int THRL,class MK,bool USE_NEGM,bool OUT8,bool FIXM,bool QNORM=false> __device__ __forceinline__ void attn_unit(const bf16*Qw0,int QP,const bf16*__restrict__ Kc,const bf16*__restrict__ Vc,int KP,const TileRows TR,const int NT,void*Ow0,int OP,char*shm,const MK&mk,const int tid,const float mfix=0.f,const float*qgain=nullptr,const int qt0=0,const float rms_eps=0.f){
  static_assert(!FIXM||USE_NEGM,"FIXM puts the reference into the QK^T MFMA's C operand");
  const int lane=tid&63,r32=lane&31,hi=lane>>5; const int wid=__builtin_amdgcn_readfirstlane(tid>>6);
  const bf16*Qw=Qw0+(long)(wid*QBLK)*QP;
  const unsigned lds0=(unsigned)(uintptr_t)shm;
  float*wsf=(float*)(shm+LDS_WS)+wid*64;
  const bf16*ksrc=Kc+(long)lane*KP+wid*8;
  const bf16*vsrc=Vc+(long)(16*(wid&3)+(lane>>2))*KP+(wid>>2)*32+(lane&3)*8;
  const unsigned kdst=lds0+LDS_K+wid*1024, vdst=lds0+LDS_V+wid*1024;
  #define DMA_K(t,slot) glds16(ksrc+TR(t)*KP,(unsigned)__builtin_amdgcn_readfirstlane(kdst+(slot)))
  #define DMA_V(t,slot) glds16(vsrc+TR(t)*KP,(unsigned)__builtin_amdgcn_readfirstlane(vdst+(slot)))
  const int vb0=(int)(lds0+LDS_V)+((lane>>4)&1)*32+(lane&3)*8+(4*hi+((lane&15)>>2))*64;
  const char*Kbase=shm+LDS_K; bf16x8 kf[8];
  const lds_cptr shm3=(lds_cptr)shm; const lds_cptr kp0=shm3+LDS_K+hi*1024+r32*16; const lds_cptr vp0=shm3+LDS_V+((lane>>4)&1)*32+(lane&3)*8+(4*hi+((lane&15)>>2))*64;
  DMA_K(0,0);DMA_V(0,0);DMA_K(1,SLOTB);
  bf16x8 qr[4];
  #pragma unroll
  for(int d0=0;d0<4;++d0)qr[d0]=*reinterpret_cast<const bf16x8*>(&Qw[(long)r32*QP+d0*16+hi*8]);
  if constexpr(QNORM){
    float qf[4][8]; float ss=0.f;
    #pragma unroll
    for(int d0=0;d0<4;++d0){
      #pragma unroll
      for(int i=0;i<8;++i){ qf[d0][i]=__uint_as_float(((unsigned)(unsigned short)qr[d0][i])<<16); ss+=qf[d0][i]*qf[d0][i]; } }
    { auto rr=__builtin_amdgcn_permlane32_swap(__float_as_uint(ss),__float_as_uint(ss),false,false); ss=__uint_as_float(rr[0])+__uint_as_float(rr[1]); }
    const float rinv=(1.0f/sqrtf(ss*(1.f/64.f)+rms_eps))*C2;
    const int tq=qt0+wid*QBLK+r32; const float rowp=(float)(tq>>6), colp=(float)(tq&63);
    #pragma unroll
    for(int d0=0;d0<4;++d0){ const float pos=d0<2?rowp:colp; const float*gp=qgain+d0*16+hi*8; float g[8];
      #pragma unroll
      for(int i=0;i<8;++i)g[i]=gp[i];
      u32x4 w;
      #pragma unroll
      for(int j=0;j<4;++j){ const int pi=(d0&1)*8+hi*4+j; const float fr=__builtin_amdgcn_exp2f(-(float)pi*(13.287712379549449f/16.0f))*0.15915494309189535f;
        const float rev=pos*fr; const float c=__builtin_amdgcn_cosf(rev), sn=__builtin_amdgcn_sinf(rev);
        const float x1=qf[d0][2*j]*rinv*g[2*j], x2=qf[d0][2*j+1]*rinv*g[2*j+1]; w[j]=cvtpk_s(x1*c-x2*sn,x1*sn+x2*c); }
      qr[d0]=__builtin_bit_cast(bf16x8,w); }
  }
  float zz_; asm volatile("v_mov_b32 %0, 0":"=v"(zz_)); float mhat=zz_,l_reg=zz_;f32x16 o[2];
  _Pragma("unroll") for(int r=0;r<16;++r){o[0][r]=zz_;o[1][r]=zz_;}
  f32x16 negm; if(USE_NEGM){ _Pragma("unroll") for(int r=0;r<16;++r)negm[r]=FIXM?(zz_-mfix):zz_; asm volatile("":"+v"(negm)); }
  const f32x16 zero16=f32x16{};
  #define CIN (USE_NEGM?negm:zero16)
  #define SUBM(C0,C1) do{ if(!USE_NEGM){ _Pragma("unroll") for(int r=0;r<16;++r){C0[r]-=mhat;C1[r]-=mhat;} } }while(0)
  #define CMASK(P0,P1,t) mk.apply(P0,P1,t)
  bool resc=false;
  #define START(P0,P1) do{ resc=false; if(!FIXM) { const float rm=rowmax(P0,P1); \
    const float dl=rm; mhat=fadd_s(mhat,dl); \
      _Pragma("unroll") for(int r=0;r<16;++r){P0[r]=fsub_s(P0[r],dl);P1[r]=fsub_s(P1[r],dl);} \
      if(USE_NEGM){ _Pragma("unroll") for(int r=0;r<16;++r)negm[r]=-mhat; asm volatile("":"+v"(negm)); } } \
    _Pragma("unroll") for(int r=0;r<16;++r)P0[r]=__builtin_amdgcn_exp2f(P0[r]); }while(0)
  #define RESC() do{ if(!FIXM&&resc){ asm volatile("s_waitcnt lgkmcnt(0)":::"memory"); \
      _Pragma("unroll") for(int d_=0;d_<2;++d_) _Pragma("unroll") for(int r=0;r<16;++r)o[d_][r]*=wsf[crow(r,hi)]; } }while(0)
  f32x16 pA0,pA1,pB0,pB1;
  int sl_prev=0,sl_cur=0,sl_next=SLOTB;
  #define ROT() do{sl_prev=sl_cur;sl_cur=sl_next;sl_next=(sl_next==(NSLOT-1)*SLOTB)?0:sl_next+SLOTB;}while(0)
  DMA_K(2,2*SLOTB);
  WAIT_BAR(3);
  qkt(pA0,pA1,Kbase,qr,CIN,r32,hi);asm volatile("s_nop 15\n\ts_nop 7":"+v"(pA0),"+v"(pA1));CMASK(pA0,pA1,0);
  START(pA0,pA1);
  _Pragma("unroll") for(int r=0;r<16;++r)pA1[r]=__builtin_amdgcn_exp2f(pA1[r]);
  WAIT_BAR(0);
  DMA_K(3,0);DMA_V(1,SLOTB);
  ROT();
  kload8(kf,kp0+sl_cur);
  WAIT_BAR(2);
  s16x4 vlo[8],vhi[8]; u32x4 pw0,pw1,pw2,pw3;
  #define PKW(P,B) cvtpk_s(P[B],P[B+1])
  #define PAF(k) __builtin_bit_cast(bf16x8,pw##k)
  #define VFR(i) (bf16x8){vlo[i][0],vlo[i][1],vlo[i][2],vlo[i][3],vhi[i][0],vhi[i][1],vhi[i][2],vhi[i][3]}
  #define PIN(x) asm volatile("":"+v"(x))
  #define MX3(a,b,c) __builtin_fmaxf(__builtin_fmaxf((a),(b)),(c))
  #define GAPA(MF,A0,A1,A2,A3,W0,W1,PW) do{ MF; sacc+=A0; sacc+=A1; sacc+=A2; sacc+=A3; PIN(sacc); W0; W1; PIN(PW); SBAR(); }while(0)
  #define EX(v) __builtin_amdgcn_exp2f(v)
  #define GAPB(MF,X,B) do{ MF; X[B]=EX(X[B]); X[B+1]=EX(X[B+1]); X[B+2]=EX(X[B+2]); X[B+3]=EX(X[B+3]); PIN(X); SBAR(); }while(0)
  #define VRD(i) do{ vlo[i]=vtr(vp_+(((i)>>2)*4096+((i)&3)*1024)); vhi[i]=vtr(vp_+(((i)>>2)*4096+((i)&3)*1024+512)); }while(0)
  #define KRD(G,j) do{ if(G){ kload2(kf,kp0+sl_next,j); SBAR(); } }while(0)
  #define STEP(C0,C1,P0,P1,t,GK,GV,GL) do{ SBAR(); \
    const lds_cptr vp_=vp0+sl_prev; \
    VRD(0); SBAR(); float sacc=(P0[0]+P0[1]); \
    GAPA(C0=__builtin_amdgcn_mfma_f32_32x32x16_bf16(kf[0],qr[0],CIN,0,0,0), P0[2],P0[3],P0[4],P0[5],     pw0[0]=PKW(P0,0), pw0[1]=PKW(P0,2), pw0); \
    VRD(4); SBAR(); GAPA(C1=__builtin_amdgcn_mfma_f32_32x32x16_bf16(kf[1],qr[0],CIN,0,0,0), P0[6],P0[7],P0[8],P0[9],     pw0[2]=PKW(P0,4), pw0[3]=PKW(P0,6), pw0); \
    VRD(1); SBAR(); GAPA(C0=__builtin_amdgcn_mfma_f32_32x32x16_bf16(kf[2],qr[1],C0,0,0,0),   P0[10],P0[11],P0[12],P0[13], pw1[0]=PKW(P0,8), pw1[1]=PKW(P0,10), pw1); \
    VRD(5); SBAR(); GAPA(C1=__builtin_amdgcn_mfma_f32_32x32x16_bf16(kf[3],qr[1],C1,0,0,0),   P0[14],P0[15],P1[0],P1[1],   pw1[2]=PKW(P0,12),pw1[3]=PKW(P0,14), pw1); \
    VRD(2); SBAR(); GAPA(C0=__builtin_amdgcn_mfma_f32_32x32x16_bf16(kf[4],qr[2],C0,0,0,0),   P1[2],P1[3],P1[4],P1[5],     pw2[0]=PKW(P1,0), pw2[1]=PKW(P1,2), pw2); \
    VRD(6); SBAR(); GAPA(C1=__builtin_amdgcn_mfma_f32_32x32x16_bf16(kf[5],qr[2],C1,0,0,0),   P1[6],P1[7],P1[8],P1[9],     pw2[2]=PKW(P1,4), pw2[3]=PKW(P1,6), pw2); \
    VRD(3); SBAR(); GAPA(C0=__builtin_amdgcn_mfma_f32_32x32x16_bf16(kf[6],qr[3],C0,0,0,0),   P1[10],P1[11],P1[12],P1[13], pw3[0]=PKW(P1,8), pw3[1]=PKW(P1,10), pw3); \
    VRD(7); SBAR(); GAPA(C1=__builtin_amdgcn_mfma_f32_32x32x16_bf16(kf[7],qr[3],C1,0,0,0),   P1[14],P1[15],0.f,0.f,       pw3[2]=PKW(P1,12),pw3[3]=PKW(P1,14), pw3); \
    l_reg+=sacc; \
    if(GK){DMA_K((t)+3,sl_cur);} if(GV){DMA_V((t)+1,sl_next);} \
    SUBM(C0,C1); CMASK(C0,C1,t); \
    if(!FIXM){ float a=MX3(C0[0],C0[1],C1[0]),b=MX3(C0[2],C0[3],C1[1]); a=MX3(a,C1[2],C1[3]); \
      _Pragma("unroll") for(int r=4;r<16;r+=4){a=MX3(a,C0[r],C0[r+1]);b=MX3(b,C0[r+2],C0[r+3]);a=MX3(a,C1[r],C1[r+1]);b=MX3(b,C1[r+2],C1[r+3]);} \
      float rm=__builtin_fmaxf(a,b); { auto rr=__builtin_amdgcn_permlane32_swap(__float_as_uint(rm),__float_as_uint(rm),false,false); rm=__builtin_fmaxf(__uint_as_float(rr[0]),__uint_as_float(rr[1])); } \
      resc=false; \
      if(__builtin_expect(__any(rm>(float)THRL),0)){ const float dl=__builtin_fmaxf(rm,0.f); mhat+=dl; \
        _Pragma("unroll") for(int r=0;r<16;++r){C0[r]-=dl;C1[r]-=dl;} \
        if(USE_NEGM){ _Pragma("unroll") for(int r=0;r<16;++r)negm[r]=-mhat; asm volatile("":"+v"(negm)); } \
        const float f=__builtin_amdgcn_exp2f(-dl); l_reg*=f; if(hi==0)wsf[r32]=f; resc=true; } } \
    SBAR(); \
    GAPB(o[0]=__builtin_amdgcn_mfma_f32_32x32x16_bf16(PAF(0),VFR(0),o[0],0,0,0), C0,0); \
    GAPB(o[1]=__builtin_amdgcn_mfma_f32_32x32x16_bf16(PAF(0),VFR(4),o[1],0,0,0), C0,4); \
    KRD(GL,0); GAPB(o[0]=__builtin_amdgcn_mfma_f32_32x32x16_bf16(PAF(1),VFR(1),o[0],0,0,0), C0,8); \
    KRD(GL,1); GAPB(o[1]=__builtin_amdgcn_mfma_f32_32x32x16_bf16(PAF(1),VFR(5),o[1],0,0,0), C0,12); \
    KRD(GL,2); GAPB(o[0]=__builtin_amdgcn_mfma_f32_32x32x16_bf16(PAF(2),VFR(2),o[0],0,0,0), C1,0); \
    KRD(GL,3); GAPB(o[1]=__builtin_amdgcn_mfma_f32_32x32x16_bf16(PAF(2),VFR(6),o[1],0,0,0), C1,4); \
    GAPB(o[0]=__builtin_amdgcn_mfma_f32_32x32x16_bf16(PAF(3),VFR(3),o[0],0,0,0), C1,8); \
    GAPB(o[1]=__builtin_amdgcn_mfma_f32_32x32x16_bf16(PAF(3),VFR(7),o[1],0,0,0), C1,12); \
    }while(0)
  int t=1;
  for(;t+5<NT;t+=2){
    STEP(pB0,pB1,pA0,pA1,t,true,true,true);     WAIT_BAR(2); RESC(); ROT();
    STEP(pA0,pA1,pB0,pB1,t+1,true,true,true);   WAIT_BAR(2); RESC(); ROT();
  }
  #define ENDW(tt) do{ if((tt)+3<NT){WAIT_BAR(2);} else if((tt)+2<NT){WAIT_BAR(1);} else {WAIT_BAR(0);} }while(0)
  for(;t+1<NT;t+=2){
    STEP(pB0,pB1,pA0,pA1,t,(t+3<NT),(t+1<NT),(t+1<NT));       ENDW(t);   RESC(); ROT();
    STEP(pA0,pA1,pB0,pB1,t+1,(t+4<NT),(t+2<NT),(t+2<NT));     ENDW(t+1); RESC(); ROT();
  }
  STEP(pB0,pB1,pA0,pA1,NT-1,false,false,false); RESC();
  { float sacc=pB0[0]+pB0[1]; _Pragma("unroll") for(int r=2;r<16;++r)sacc+=pB0[r]; _Pragma("unroll") for(int r=0;r<16;++r)sacc+=pB1[r]; l_reg+=sacc;
    pw0=(u32x4){PKW(pB0,0),PKW(pB0,2),PKW(pB0,4),PKW(pB0,6)};pw1=(u32x4){PKW(pB0,8),PKW(pB0,10),PKW(pB0,12),PKW(pB0,14)};pw2=(u32x4){PKW(pB1,0),PKW(pB1,2),PKW(pB1,4),PKW(pB1,6)};pw3=(u32x4){PKW(pB1,8),PKW(pB1,10),PKW(pB1,12),PKW(pB1,14)};
    SBAR(); pv(o,vb0+sl_cur,PAF(0),PAF(1),PAF(2),PAF(3)); }
  #undef PKW
  #undef PAF
  #undef VFR
  #undef PIN
  #undef MX3
  #undef GAPA
  #undef GAPB
  #undef EX
  #undef VRD
  #undef KRD
  #undef STEP
  #undef ENDW
  {auto rr=__builtin_amdgcn_permlane32_swap(__float_as_uint(l_reg),__float_as_uint(l_reg),false,false);l_reg=__uint_as_float(rr[0])+__uint_as_float(rr[1]);}
  if(hi==0)wsf[32+r32]=l_reg;asm volatile("s_waitcnt lgkmcnt(0)":::"memory");
  float rli[16];
  #pragma unroll
  for(int r=0;r<16;++r)rli[r]=__builtin_amdgcn_rcpf(wsf[32+crow(r,hi)]);
  if constexpr(OUT8){ unsigned char*Ow=(unsigned char*)Ow0+(long)(wid*QBLK)*OP; unsigned char*stg=(unsigned char*)(shm+LDS_OST)+wid*4096;
    #pragma unroll
    for(int r=0;r<16;++r){const int orow=crow(r,hi);
      #pragma unroll
      for(int d0=0;d0<2;++d0){const float v=o[d0][r]*rli[r]; const int t=__builtin_amdgcn_cvt_pk_fp8_f32(v,v,0,false); stg[orow*64+d0*32+r32]=(unsigned char)t;}}
    asm volatile("s_waitcnt lgkmcnt(0)":::"memory");
    #pragma unroll
    for(int i=0;i<2;++i){const int row=i*16+(lane>>2),ch=lane&3; const u32x4 v=*(const u32x4*)(stg+row*64+ch*16); ATTN_STORE16(Ow+(long)row*OP+ch*16,v);} }
  else{ bf16*Ow=(bf16*)Ow0+(long)(wid*QBLK)*OP;
  { bf16*stg=(bf16*)(shm+LDS_OST)+wid*2048;
    #pragma unroll
    for(int r=0;r<16;++r){const int orow=crow(r,hi);
      #pragma unroll
      for(int d0=0;d0<2;++d0)stg[orow*64+d0*32+r32]=__float2bfloat16(o[d0][r]*rli[r]);}
    asm volatile("s_waitcnt lgkmcnt(0)":::"memory");
    #pragma unroll
    for(int i=0;i<4;++i){const int row=i*8+(lane>>3),ch=lane&7; const u32x4 v=*(const u32x4*)(stg+row*64+ch*8); ATTN_STORE16(Ow+(long)row*OP+ch*8,v);} } }
  asm volatile("s_waitcnt lgkmcnt(0)\n\ts_barrier":::"memory");
  #undef CIN
  #undef SUBM
  #undef DMA_K
  #undef DMA_V
  #undef CMASK
  #undef START
  #undef RESC
  #undef ROT
}
#undef SBAR
#undef WAIT_BAR
}
#ifndef MK_PER_PHASE
#define MK_PER_PHASE 0
#endif
#ifndef MOE_F8
#define MOE_F8 1
#endif
#ifndef WO_F8
#define WO_F8 1
#endif
#ifndef YS_F8
#define YS_F8 1
#endif
#ifndef QKV_F8
#define QKV_F8 1
#endif
constexpr int NWAVES = 8;
constexpr int W13_LOG2 = 5, W2_LOG2 = 7, WO_LOG2 = 6; constexpr float W13_SCALE = 32.0f, W2_SCALE = 128.0f;
constexpr int NB = 4, SEQ = 8192, DM = 1024, LCTX = 256, DEPTH = 4;
constexpr int M_LAT = NB * SEQ, M_CTX = NB * LCTX, M_ALL = M_LAT + M_CTX;
constexpr int NE = 16, FF = 2048, CAP_LAT = 1024, CAP_CTX = 32;
constexpr int ETILES = 17, ESTR = ETILES * 256, NSLOTS = NE * ESTR;
constexpr int KVROWS = SEQ + LCTX;
constexpr int NMOD = 6 * DM;
constexpr float ALPHA = 1.681792830507429f, LN_EPS = 1e-5f, RMS_EPS = 1e-6f, LOG2E = 1.4426950408889634f;

constexpr size_t MiB = 1u << 20;
constexpr size_t WS_CTL = 0, CTL_ZERO_BYTES = 2 * MiB;
constexpr size_t WS_MOD = 2 * MiB, WS_AFF = 3 * MiB, WS_SEL = 6 * MiB, WS_SLOT = 9 * MiB;
constexpr size_t WS_POOLW = 10 * MiB, WS_NAQKV = 11 * MiB, WS_NAWO = 17 * MiB, WS_GQKV = 19 * MiB, WS_GWO = 22 * MiB;
constexpr size_t WS_W13 = 32 * MiB, WS_W2 = 544 * MiB, WS_X = 800 * MiB, WS_H = 932 * MiB, WS_R = 1000 * MiB, WS_END = 1544 * MiB;
constexpr size_t R_XS = 0, R_HID = 136 * MiB, R_YS = 408 * MiB;
constexpr size_t R_D = 0, R_Y = 200 * MiB;
constexpr size_t R_O8 = 272 * MiB;
constexpr size_t R_Q = 0, R_K = 66 * MiB, R_V = 132 * MiB;
constexpr size_t R_RAW = 0, R_GQ = 100 * MiB, R_GK = 164 * MiB, R_GV = 181 * MiB;
constexpr int CW_TMO = 0, CW_BAR = 4096;

constexpr int RING_BYTES = 135168;
constexpr int LDSCTL_OFF = RING_BYTES, MISC_OFF = LDSCTL_OFF + 320;
constexpr int LDS_BYTES = 147456;

#define GAS __attribute__((address_space(1)))
#define LAS __attribute__((address_space(3)))
typedef unsigned short bf16;
typedef unsigned v4u __attribute__((ext_vector_type(4)));
typedef unsigned v2u __attribute__((ext_vector_type(2)));
typedef float f32x4 __attribute__((ext_vector_type(4)));
typedef float f32x2 __attribute__((ext_vector_type(2)));
#define RLX_AGENT __ATOMIC_RELAXED, __HIP_MEMORY_SCOPE_AGENT
#define LDS_WAIT() asm volatile("s_waitcnt lgkmcnt(0)" ::: "memory")
__device__ __forceinline__ unsigned pk2(float lo, float hi) { return pg8::cvt_pk_bf16(lo, hi); }
__device__ __forceinline__ float bf_lo(unsigned u) { return __uint_as_float(u << 16); }
__device__ __forceinline__ float bf_hi(unsigned u) { return __uint_as_float(u & 0xffff0000u); }

#define XB_TMO      128
#define XB_XCNT(j)  (256  + 64 * (j))
#define XB_XSUB(j)  (1280 + 64 * (j))
#define XB_XGEN(j)  (2304 + 64 * (j))
#define XB_TOP      3328
#define XB_TOPGEN   3392
#define XCD_BAR_WORDS 3456
#define XB_SPIN_CAP (1u << 22)

__device__ __forceinline__ unsigned xb_ld(unsigned* p)              { return __hip_atomic_load(p, __ATOMIC_RELAXED, __HIP_MEMORY_SCOPE_AGENT); }
__device__ __forceinline__ unsigned xb_add(unsigned* p, unsigned v) { return __hip_atomic_fetch_add(p, v, __ATOMIC_RELAXED, __HIP_MEMORY_SCOPE_AGENT); }
__device__ __forceinline__ unsigned xb_xcc_id() { return (unsigned)__builtin_amdgcn_s_getreg((3 << 11) | 20) & 0xFu; }
#define XB_SPIN(cond, bar) do { unsigned _sp = 0; while (cond) { __builtin_amdgcn_s_sleep(1); \
    if ((++_sp & 255u) == 0u) { if (xb_ld(&(bar)[XB_TMO])) break; if (_sp > XB_SPIN_CAP) { atomicAdd(&(bar)[XB_TMO], 1u); break; } } } } while (0)

struct XcdBarrier { unsigned* bar; unsigned x; volatile LAS unsigned* st; };
__device__ __forceinline__ XcdBarrier xcd_barrier_post(unsigned* bar, volatile LAS unsigned* st) {
    XcdBarrier b; b.bar = bar; b.x = xb_xcc_id(); b.st = st;
    if (threadIdx.x == 0) (void)xb_add(&bar[XB_XCNT(b.x)], 1u);
    return b;
}
__device__ __forceinline__ void xcd_barrier_complete(unsigned* bar, unsigned x, unsigned& nloc, unsigned& nx) {
    const unsigned G = gridDim.x * gridDim.y * gridDim.z;
    unsigned sum, cnt, mine, sp = 0u;
    for (;;) {
        sum = 0u; cnt = 0u; mine = 0u;
#pragma unroll
        for (unsigned j = 0; j < 16; ++j) { const unsigned c = xb_ld(&bar[XB_XCNT(j)]); sum += c; cnt += (c > 0u) ? 1u : 0u; mine = (j == x) ? c : mine; }
        if (sum == G) break;
        __builtin_amdgcn_s_sleep(1);
        if ((++sp & 255u) == 0u) { if (xb_ld(&bar[XB_TMO])) break; if (sp > XB_SPIN_CAP) { atomicAdd(&bar[XB_TMO], 1u); break; } }
    }
    nloc = mine > 0u ? mine : 1u; nx = cnt > 0u ? cnt : 1u;
}
__device__ __forceinline__ void xcd_barrier(const XcdBarrier& b) {
    asm volatile("s_waitcnt vmcnt(0)" ::: "memory");
    __syncthreads();
    if (threadIdx.x == 0) {
        unsigned* bar = b.bar;
        __builtin_amdgcn_s_waitcnt(0);
        unsigned nloc = b.st[0], nx = b.st[1];
        if (nloc == 0u) { xcd_barrier_complete(bar, b.x, nloc, nx); b.st[0] = nloc; b.st[1] = nx; }
        const unsigned old = xb_add(&bar[XB_XSUB(b.x)], 1u);
        const unsigned gen = old / nloc;
        if (old + 1u == (gen + 1u) * nloc) {
            __builtin_amdgcn_fence(__ATOMIC_RELEASE, "agent");
            asm volatile("s_waitcnt vmcnt(0)" ::: "memory");
            const unsigned og = xb_add(&bar[XB_TOP], 1u);
            const unsigned tg = og / nx;
            if (og + 1u == (tg + 1u) * nx) xb_add(&bar[XB_TOPGEN], 1u);
            else XB_SPIN(xb_ld(&bar[XB_TOPGEN]) == tg, bar);
            __builtin_amdgcn_fence(__ATOMIC_ACQUIRE, "agent");
            xb_add(&bar[XB_XGEN(b.x)], 1u);
            asm volatile("s_waitcnt vmcnt(0)" ::: "memory");
        } else {
            XB_SPIN(xb_ld(&bar[XB_XGEN(b.x)]) == gen, bar);
            __builtin_amdgcn_fence(__ATOMIC_ACQUIRE, "agent");
            asm volatile("s_waitcnt vmcnt(0)" ::: "memory");
        }
    }
    __syncthreads();
}

__device__ __forceinline__ int lane_shfl(int v, int src_lane) { return __builtin_amdgcn_ds_bpermute(src_lane << 2, v); }
template <int CTRL> __device__ __forceinline__ float dppx(float v) { return __builtin_bit_cast(float, __builtin_amdgcn_update_dpp(0, __builtin_bit_cast(int, v), CTRL, 0xf, 0xf, true)); }
constexpr int DPP_XOR1 = 0xB1, DPP_XOR2 = 0x4E, DPP_HMIRROR = 0x141, DPP_MIRROR = 0x140, DPP_XOR8 = 0x128;
__device__ __forceinline__ void swap16(float v, float& even_rows, float& odd_rows) { auto r = __builtin_amdgcn_permlane16_swap(__float_as_uint(v), __float_as_uint(v), false, false); even_rows = __uint_as_float(r[0]); odd_rows = __uint_as_float(r[1]); }
__device__ __forceinline__ void swap32(float v, float& lo_half, float& hi_half) { auto r = __builtin_amdgcn_permlane32_swap(__float_as_uint(v), __float_as_uint(v), false, false); lo_half = __uint_as_float(r[0]); hi_half = __uint_as_float(r[1]); }
__device__ __forceinline__ float quad_sum(float v) { v += dppx<DPP_XOR1>(v); v += dppx<DPP_XOR2>(v); return v; }
__device__ __forceinline__ float row16_sum(float v) { v = quad_sum(v); v += dppx<DPP_HMIRROR>(v); v += dppx<DPP_MIRROR>(v); return v; }
__device__ __forceinline__ float wave_sum(float v) { v = row16_sum(v); float a, b; swap16(v, a, b); v = a + b; swap32(v, a, b); return a + b; }
__device__ __forceinline__ int wave_incl_scan(int v, int lane) {
#pragma unroll
    for (int o = 1; o < 64; o <<= 1) { const int t = lane_shfl(v, lane - o); if (lane >= o) v += t; }
    return v;
}
__device__ __forceinline__ int block_excl_scan(int v, LAS int* tmp, int lane, int wave) {
    const int inc = wave_incl_scan(v, lane);
    if (lane == 63) tmp[wave] = inc;
    __syncthreads();
    int base = 0;
#pragma unroll
    for (int w = 0; w < NWAVES; ++w) { const int t = tmp[w]; base += (w < wave) ? t : 0; }
    __syncthreads();
    return base + inc - v;
}

struct Args { const float* in[21]; float* out; unsigned char* ws; int ph_lo, ph_hi, li, pad; };
enum { IN_X = 0, IN_C, IN_CTX, IN_CCTX, IN_MODW, IN_MODB, IN_LNG, IN_LNB, IN_POOLW, IN_POOLS, IN_NAQKV, IN_NAWO, IN_NARPB, IN_GQKV, IN_GQN, IN_GKN, IN_GWO, IN_ROUTER, IN_W1, IN_W3, IN_W2 };

__device__ __forceinline__ void p0_mod(const Args& a, LAS unsigned char* lds, int tid, int lane, int wave) {
    const int wg = blockIdx.x; if (wg >= 192) return;
    const int L = wg / 48, cb = wg % 48;
    LAS float* sl = (LAS float*)lds; LAS float* red = sl + 5 * 1024;
    const float* c = a.in[IN_C]; const float* cc = a.in[IN_CCTX];
    for (int i = tid; i < 5120; i += 512) { const int s = i >> 10, k = i & 1023; const float cv = s < 4 ? c[s * 1024 + k] : cc[k]; sl[i] = cv / (1.0f + expf(-cv)); }
    __syncthreads();
    float acc[5][2];
#pragma unroll
    for (int s = 0; s < 5; ++s) { acc[s][0] = 0.f; acc[s][1] = 0.f; }
    const float* wp = a.in[IN_MODW] + (size_t)L * DM * NMOD + cb * 128 + 2 * lane;
#pragma unroll 8
    for (int kk = 0; kk < 128; ++kk) { const int k = wave * 128 + kk; const f32x2 w = *(const f32x2*)(wp + (size_t)k * NMOD);
#pragma unroll
        for (int s = 0; s < 5; ++s) { const float sv = sl[s * 1024 + k]; acc[s][0] += sv * w.x; acc[s][1] += sv * w.y; } }
#pragma unroll
    for (int s = 0; s < 5; ++s) { red[(wave * 5 + s) * 128 + 2 * lane] = acc[s][0]; red[(wave * 5 + s) * 128 + 2 * lane + 1] = acc[s][1]; }
    __syncthreads();
    float* MOD = (float*)(a.ws + WS_MOD);
    for (int o = tid; o < 640; o += 512) { const int s = o >> 7, col = o & 127; float sum = 0.f;
#pragma unroll
        for (int w = 0; w < 8; ++w) sum += red[(w * 5 + s) * 128 + col];
        MOD[(size_t)(L * 5 + s) * NMOD + cb * 128 + col] = sum + a.in[IN_MODB][L * NMOD + cb * 128 + col]; }
    __syncthreads();
}
struct CvtItem { const float* W; void* WT; int K, N, mode, sub; float scale; };
constexpr int I_POOL = 128, I_NAQKV = 768, I_NAWO = 256, I_GQKV = 384, I_GWO = 256, I_SMALL = I_POOL + I_NAQKV + I_NAWO + I_GQKV + I_GWO, I_LE = 1536, I_ALL = I_SMALL + 64 * I_LE;
constexpr int CVT_NWIN = 10;
__host__ __device__ constexpr int cvt_wsize(int w) { return w == 0 ? 240 * 8 * 1 : w == 3 ? 208 * 8 * 2 : w == 4 ? 240 * 8 * 3 : w == 7 ? 232 * 8 * 2 : 192 * 8 * 4; }
__host__ __device__ constexpr int cvt_wsum(int w) { int s_ = 0; for (int i = 0; i < w; ++i) s_ += cvt_wsize(i); return s_; }
constexpr int CVT_I_PRO = I_ALL - cvt_wsum(CVT_NWIN);
__host__ __device__ constexpr int cvt_wlo(int w) { return CVT_I_PRO + cvt_wsum(w); }
static_assert(CVT_I_PRO >= I_SMALL + 16 * I_LE, "layer 0's weights are converted in the prologue");
static_assert(cvt_wlo(6) >= I_SMALL + 32 * I_LE, "layer 1's expert weights are complete before its up GEMM (after window 5)");
static_assert(cvt_wlo(9) >= I_SMALL + 48 * I_LE, "layer 2's expert weights are complete before its up GEMM (after window 8)");
__device__ __forceinline__ bool cvt_decode(const Args& a, int it, int it_end, CvtItem& c) {
    if (it >= it_end) return false;
    int r = it; c.scale = 0.f; c.mode = 0;
    if (r >= I_SMALL) { r -= I_SMALL; const int le = r / I_LE, q = r - le * I_LE, which = q >> 9; c.sub = q & 511;
#if MOE_F8
        const size_t es = 1;
#else
        const size_t es = 2;
#endif
        if (which < 2) { c.W = a.in[which == 0 ? IN_W1 : IN_W3] + (size_t)le * DM * FF; c.K = DM; c.N = FF; c.WT = a.ws + WS_W13 + (size_t)le * 2 * FF * DM * es; c.mode = 1 + which; c.scale = MOE_F8 ? W13_SCALE : 0.f; }
        else { c.W = a.in[IN_W2] + (size_t)le * FF * DM; c.K = FF; c.N = DM; c.WT = a.ws + WS_W2 + (size_t)le * DM * FF * es; c.scale = MOE_F8 ? W2_SCALE : 0.f; }
        return true; }
    if (r < I_POOL) { const int mi = r >> 4; c.W = a.in[IN_POOLW] + (size_t)mi * 65536; c.K = 256; c.N = 256; c.WT = (bf16*)(a.ws + WS_POOLW) + (size_t)mi * 65536; c.sub = r & 15; return true; } r -= I_POOL;
    if (r < I_NAQKV) { c.W = a.in[IN_NAQKV]; c.K = DM; c.N = 3 * DM; c.WT = a.ws + WS_NAQKV; c.sub = r; c.scale = QKV_F8 ? W13_SCALE : 0.f; return true; } r -= I_NAQKV;
    if (r < I_NAWO) { c.W = a.in[IN_NAWO]; c.K = DM; c.N = DM; c.WT = a.ws + WS_NAWO; c.sub = r; c.scale = WO_F8 ? 64.0f : 0.f; return true; } r -= I_NAWO;
    if (r < I_GQKV) { c.W = a.in[IN_GQKV]; c.K = DM; c.N = 1536; c.WT = a.ws + WS_GQKV; c.sub = r; c.scale = QKV_F8 ? W13_SCALE : 0.f; return true; } r -= I_GQKV;
    c.W = a.in[IN_GWO]; c.K = DM; c.N = DM; c.WT = a.ws + WS_GWO; c.sub = r; c.scale = WO_F8 ? 64.0f : 0.f; return true;
}
__device__ __forceinline__ void cvt_geom(const CvtItem& c, int& k0, int& n0) { const int nblk = c.N >> 5, kb = c.sub / nblk, nb = c.sub - kb * nblk; k0 = kb * 128; n0 = nb * 32; }
__device__ __forceinline__ void cvt_load(const CvtItem& c, f32x4 (&v)[16], int lane) {
    int k0, n0; cvt_geom(c, k0, n0); const int kr = lane >> 3, nc = lane & 7;
#pragma unroll
    for (int i = 0; i < 16; ++i) v[i] = __builtin_nontemporal_load((const f32x4*)(c.W + (size_t)(k0 + 8 * i + kr) * c.N + n0 + 4 * nc));
}
__device__ __forceinline__ void cvt_store(const CvtItem& c, const f32x4 (&v)[16], LAS float* scr, int lane) {
    int k0, n0; cvt_geom(c, k0, n0); const int kr = lane >> 3, nc = lane & 7;
    const float sc = c.scale > 0.f ? c.scale : 1.0f;
#pragma unroll
    for (int i = 0; i < 16; ++i) { LAS float* d = scr + (8 * i + kr) * 33 + 4 * nc; d[0] = v[i].x * sc; d[1] = v[i].y * sc; d[2] = v[i].z * sc; d[3] = v[i].w * sc; }
    LDS_WAIT();
    const int ch = lane & 7;
#pragma unroll
    for (int j = 0; j < 4; ++j) { const int n = 8 * j + (lane >> 3); const LAS float* s = scr + (16 * ch) * 33 + n;
        const int nn = n0 + n; const int drow = c.mode == 0 ? nn : (((nn >> 2) << 3) + (nn & 3) + (c.mode == 2 ? 4 : 0));
        if (c.scale > 0.f) { int w[4];
#pragma unroll
            for (int q = 0; q < 4; ++q) { int t = 0; t = __builtin_amdgcn_cvt_pk_fp8_f32(s[(4 * q) * 33], s[(4 * q + 1) * 33], t, false); t = __builtin_amdgcn_cvt_pk_fp8_f32(s[(4 * q + 2) * 33], s[(4 * q + 3) * 33], t, true); w[q] = t; }
            __builtin_nontemporal_store((v4u){(unsigned)w[0], (unsigned)w[1], (unsigned)w[2], (unsigned)w[3]}, (v4u*)((unsigned char*)c.WT + (size_t)drow * c.K + k0 + 16 * ch)); }
        else { v4u o0, o1;
            o0.x = pk2(s[0 * 33], s[1 * 33]); o0.y = pk2(s[2 * 33], s[3 * 33]); o0.z = pk2(s[4 * 33], s[5 * 33]); o0.w = pk2(s[6 * 33], s[7 * 33]);
            o1.x = pk2(s[8 * 33], s[9 * 33]); o1.y = pk2(s[10 * 33], s[11 * 33]); o1.z = pk2(s[12 * 33], s[13 * 33]); o1.w = pk2(s[14 * 33], s[15 * 33]);
            v4u* d = (v4u*)((bf16*)c.WT + (size_t)drow * c.K + k0 + 16 * ch); d[0] = o0; d[1] = o1; } }
    LDS_WAIT();
}
#ifdef PROBE_DUPPRO
__device__ __forceinline__ void p0_convert_probe(const Args& a, LAS unsigned char* lds, int gw, int NGW, int lane, int wave) {
    LAS float* scr = (LAS float*)(lds + wave * 16896);
    CvtItem cur; f32x4 va[16]; f32x4 acc = {0.f, 0.f, 0.f, 0.f};
    for (int it = gw; cvt_decode(a, it, I_ALL, cur); it += NGW) {
        cvt_load(cur, va, lane);
        if (PROBE_DUPPRO == 2) { cur.WT = a.ws + (size_t)1600 * MiB + ((size_t)it & 2047) * 65536; cur.K = 64; cur.mode = 0; cur.sub = 0; cvt_store(cur, va, scr, lane); }
        else {
#pragma unroll
            for (int i = 0; i < 16; ++i) acc += va[i]; }
    }
    if (acc.x == 1.2345e30f) ((float*)(a.ws + (size_t)1600 * MiB))[lane] = acc.x + acc.y + acc.z + acc.w;
}
#endif
__device__ __forceinline__ void p0_convert(const Args& a, LAS unsigned char* lds, int it0, int it_end, int gw, int NGW, int lane, int wave) {
    LAS float* scr = (LAS float*)(lds + wave * 16896);
    CvtItem ca, cb; f32x4 va[16], vb[16];
    bool ha = cvt_decode(a, it0 + gw, it_end, ca);
    if (ha) cvt_load(ca, va, lane);
    for (int it = it0 + gw; ha; it += 2 * NGW) {
        const bool hb = cvt_decode(a, it + NGW, it_end, cb);
        if (hb) cvt_load(cb, vb, lane);
        cvt_store(ca, va, scr, lane);
        if (!hb) break;
        ha = cvt_decode(a, it + 2 * NGW, it_end, ca);
        if (ha) cvt_load(ca, va, lane);
        cvt_store(cb, vb, scr, lane);
    }
}

__device__ __forceinline__ int row_s(int row) { return row < M_LAT ? (row >> 13) : 4; }
__device__ __forceinline__ const float* xrow(const Args& a, int row) {
    return row < M_LAT ? a.in[IN_X] + (size_t)row * DM : a.in[IN_CTX] + (size_t)(row - M_LAT) * DM;
}
typedef _Float16 xh_t; typedef _Float16 h16x4 __attribute__((ext_vector_type(4)));
__device__ __forceinline__ f32x4 xdec(const f32x4 v) { return v; }
__device__ __forceinline__ f32x4 xdec(const v2u w) { return __builtin_convertvector(__builtin_bit_cast(h16x4, w), f32x4); }
__device__ __forceinline__ v2u xenc(const f32x4 v) { return __builtin_bit_cast(v2u, __builtin_convertvector(v, h16x4)); }
template <bool XH> struct XSrc;
template <> struct XSrc<false> { typedef f32x4 vec; typedef float elem; static __device__ __forceinline__ const float* row(const Args& a, int r) { return xrow(a, r); } };
template <> struct XSrc<true>  { typedef v2u vec;   typedef xh_t elem;  static __device__ __forceinline__ const xh_t* row(const Args& a, int r) { return (const xh_t*)(a.ws + WS_X) + (size_t)r * DM; } };

template <int W, class XE> __device__ __forceinline__ f32x4 pool_sum(const XE* base, int pos, int n) {
    typedef typename std::conditional<sizeof(XE) == 2, v2u, f32x4>::type XV;
    f32x4 s = {0.f, 0.f, 0.f, 0.f};
#pragma unroll
    for (int i = 0; i < W; ++i) { const int idx = pos - W / 2 + i; const bool ok = idx >= 0 && idx < n; const int ic = idx < 0 ? 0 : (idx >= n ? n - 1 : idx);
        const f32x4 v = xdec(*(const XV*)(base + (size_t)ic * DM)); s += ok ? v : (f32x4){0.f, 0.f, 0.f, 0.f}; }
    return s;
}
__device__ __forceinline__ void pd_decode(int row, int& r0s, int& pos, int& n) {
    if (row < M_LAT) { r0s = row & ~(SEQ - 1); pos = row & (SEQ - 1); n = SEQ; } else { r0s = M_LAT + ((row - M_LAT) & ~(LCTX - 1)); pos = (row - M_LAT) & (LCTX - 1); n = LCTX; }
}
template <bool XH> __device__ __forceinline__ void ph_pooldiff(const Args& a, int L, int nrows, int gw, int NGW, int lane) {
    typedef typename XSrc<XH>::vec XV; typedef typename XSrc<XH>::elem XE;
    const float* MOD = (const float*)(a.ws + WS_MOD); bf16* Dm = (bf16*)(a.ws + WS_R + R_D);
    const int r0 = (int)(((long)gw * nrows) / NGW), r1 = (int)(((long)(gw + 1) * nrows) / NGW);
    XV EA[4], LA[4], CA[4], EB[4], LB[4], CB[4], EC[4], LC[4], CC[4]; f32x4 S[4], SC[4];
    const XE* zb = (const XE*)(a.ws + WS_CTL + MiB) + 4 * lane;
#define PD_LOAD(rw, En, Ln, Cn) do { const int rr_ = (rw) < re ? (rw) : re - 1; const int pos_ = rr_ - r0s; \
        _Pragma("unroll") for (int g = 0; g < 4; ++g) { const int W_ = 2 << g, ie_ = pos_ + W_ / 2 - 1, il_ = pos_ - 1 - W_ / 2; \
            En[g] = *(const XV*)((ie_ < n ? xb + (size_t)ie_ * DM : zb) + g * 256); Ln[g] = *(const XV*)((il_ >= 0 ? xb + (size_t)il_ * DM : zb) + g * 256); \
            Cn[g] = *(const XV*)(xb + (size_t)pos_ * DM + g * 256); } __builtin_amdgcn_sched_barrier(0); } while (0)
#define PD_EMIT(rowv, C) do { const int row_ = (rowv); const int pos = row_ - r0s; bf16* drow = Dm + (size_t)row_ * DM + 4 * lane; \
        _Pragma("unroll") for (int g = 0; g < 4; ++g) { const int W = 2 << g; const int lo = pos - W / 2 < 0 ? 0 : pos - W / 2, hi = pos + (W - W / 2 - 1) > n - 1 ? n - 1 : pos + (W - W / 2 - 1); \
            const float inv = 1.0f / (float)(hi - lo + 1); const f32x4 d = SC[g] * (S[g] * inv - xdec(C[g])); \
            v2u o; o.x = pk2(d.x, d.y); o.y = pk2(d.z, d.w); *(v2u*)(drow + g * 256) = o; } } while (0)
#define PD_ROW(rowv, E, Lv, C) do { _Pragma("unroll") for (int g = 0; g < 4; ++g) S[g] += xdec(E[g]) - xdec(Lv[g]); PD_EMIT(rowv, C); } while (0)
    for (int rs = r0; rs < r1; ) {
        int r0s, pos0, n; pd_decode(rs, r0s, pos0, n);
        const int re = (r0s + n) < r1 ? (r0s + n) : r1;
        const XE* xb = XSrc<XH>::row(a, r0s) + 4 * lane;
        { const float* scp_ = MOD + (size_t)(L * 5 + row_s(rs)) * NMOD + DM + 4 * lane;
#pragma unroll
          for (int g = 0; g < 4; ++g) SC[g] = *(const f32x4*)(scp_ + g * 256) + 1.0f; }
        S[0] = pool_sum<2>(xb, pos0, n); S[1] = pool_sum<4>(xb + 256, pos0, n); S[2] = pool_sum<8>(xb + 512, pos0, n); S[3] = pool_sum<16>(xb + 768, pos0, n);
#pragma unroll
        for (int g = 0; g < 4; ++g) CA[g] = *(const XV*)(xb + (size_t)pos0 * DM + g * 256);
        PD_EMIT(rs, CA);
        const int rb = rs + 1;
        if (rb < re) {
            PD_LOAD(rb, EA, LA, CA); PD_LOAD(rb + 1, EB, LB, CB);
            for (int row = rb; row < re; row += 3) {
                PD_LOAD(row + 2, EC, LC, CC); PD_ROW(row, EA, LA, CA);
                if (row + 1 < re) { PD_LOAD(row + 3, EA, LA, CA); PD_ROW(row + 1, EB, LB, CB); }
                if (row + 2 < re) { PD_LOAD(row + 4, EB, LB, CB); PD_ROW(row + 2, EC, LC, CC); }
            }
        }
        rs = re;
    }
#undef PD_LOAD
#undef PD_EMIT
#undef PD_ROW
}

struct Ln1Ctx { const Args* a; int L; LAS float* RT; LAS f32x4* PV; xh_t* X; bf16* H; float* AFF; int lane; };
#define LN1_RTRD(W, e0, jj) do { _Pragma("unroll") for (int e = 0; e < 8; ++e) W[e] = *(const LAS f32x4*)(rtp + ((e0) + e) * 1024 + 256 * (jj)); __builtin_amdgcn_sched_barrier(0); } while (0)
#define LN1_RTFMA(W, e0) do { _Pragma("unroll") for (int e = 0; e < 8; ++e) { const f32x4 w = W[e]; \
        lgp[(e0) + e] = __builtin_elementwise_fma((f32x2){h2.x, h2.y}, (f32x2){w.x, w.y}, lgp[(e0) + e]); lgp[(e0) + e] = __builtin_elementwise_fma((f32x2){h2.z, h2.w}, (f32x2){w.z, w.w}, lgp[(e0) + e]); } \
        __builtin_amdgcn_sched_barrier(0); } while (0)
template <int VAR, class XV> __device__ __forceinline__ void ln1_row(const Ln1Ctx& c, const int row, const XV (&xc)[4], const v2u (&yc)[4], f32x4 (&wA)[8], f32x4 (&wB)[8]) {
    const int L = c.L, lane = c.lane; LAS float* RT = c.RT; LAS f32x4* PV = c.PV; xh_t* X = c.X; bf16* H = c.H; float* AFF = c.AFF; (void)L;
        const LAS f32x4* pv = PV + (2 + 3 * row_s(row)) * 256 + lane;
        const LAS float* rtp = RT + 4 * lane; asm volatile("" : "+v"(rtp));
        f32x4 pa[4], pb[4]; pa[0] = PV[lane]; pa[1] = PV[256 + lane]; pa[2] = pv[512]; pa[3] = pv[256];
        f32x4 v[4]; float s = 0.f;
#pragma unroll
        for (int j = 0; j < 4; ++j) { f32x4 yv = {bf_lo(yc[j].x), bf_hi(yc[j].x), bf_lo(yc[j].y), bf_hi(yc[j].y)};
#ifdef DBG_NEG_Y_LAYER
            if (L == DBG_NEG_Y_LAYER) yv = -yv;
#endif
            v[j] = xdec(xc[j]) * ALPHA + pv[64 * j] * yv; s += (v[j].x + v[j].y) + (v[j].z + v[j].w); }
        const float mean = wave_sum(s) * (1.f / DM); float s2 = 0.f;
#pragma unroll
        for (int j = 0; j < 4; ++j) { v[j] = v[j] - mean; s2 += (v[j].x * v[j].x + v[j].y * v[j].y) + (v[j].z * v[j].z + v[j].w * v[j].w); }
        const float rstd = 1.f / sqrtf(wave_sum(s2) * (1.f / DM) + LN_EPS);
        v2u* xo = (v2u*)(X + (size_t)row * DM) + lane; v2u* ho = (v2u*)(H + (size_t)row * DM) + lane; (void)ho;
        f32x2 lgp[16];
#pragma unroll
        for (int e = 0; e < 16; ++e) lgp[e] = (f32x2){0.f, 0.f};
#define LN1_PVRD(P, jj) do { P[0] = PV[lane + 64 * (jj)]; P[1] = PV[256 + lane + 64 * (jj)]; P[2] = pv[512 + 64 * (jj)]; P[3] = pv[256 + 64 * (jj)]; } while (0)
#define LN1_CHUNK(jj, PC, PN) do { const f32x4 x1 = v[jj] * rstd * PC[0] + PC[1]; xo[64 * (jj)] = xenc(x1); const f32x4 h2 = x1 * (PC[2] + 1.0f) + PC[3]; LN1_HST(jj); \
        if (VAR < 2) { if ((jj) < 3) LN1_PVRD(PN, (jj) + 1); LN1_RTRD(wB, 8, jj); LN1_RTFMA(wA, 0); LN1_RTRD(wA, 0, ((jj) + 1) & 3); LN1_RTFMA(wB, 8); } \
        else { if ((jj) < 3) LN1_PVRD(PN, (jj) + 1); lgp[0].x += h2.x + h2.y; lgp[1].y += h2.z + h2.w; } } while (0)
#if MOE_F8
#define LN1_HST(jj) do { int t = 0; t = __builtin_amdgcn_cvt_pk_fp8_f32(h2.x, h2.y, t, false); t = __builtin_amdgcn_cvt_pk_fp8_f32(h2.z, h2.w, t, true); ((int*)((unsigned char*)H + (size_t)row * DM))[lane + 64 * (jj)] = t; } while (0)
#else
#define LN1_HST(jj) do { v2u o; o.x = pk2(h2.x, h2.y); o.y = pk2(h2.z, h2.w); ho[64 * (jj)] = o; } while (0)
#endif
        LN1_CHUNK(0, pa, pb); LN1_CHUNK(1, pb, pa); LN1_CHUNK(2, pa, pb); LN1_CHUNK(3, pb, pa);
#undef LN1_PVRD
#undef LN1_CHUNK
#undef LN1_HST
        float lg16[16];
#pragma unroll
        for (int e = 0; e < 16; ++e) lg16[e] = lgp[e].x + lgp[e].y;
        if (VAR == 3) { if (lane < 16) AFF[(size_t)row * NE + lane] = lg16[0] + lg16[5]; return; }
        float r8[8], r4[4], t0, t1;
        { const bool up = (lane & 32) != 0;
#pragma unroll
          for (int i = 0; i < 8; ++i) { const float snd = up ? lg16[i] : lg16[i + 8], kp = up ? lg16[i + 8] : lg16[i]; float lo, hi; swap32(snd, lo, hi); r8[i] = kp + (up ? lo : hi); } }
        { const bool up = (lane & 16) != 0;
#pragma unroll
          for (int i = 0; i < 4; ++i) { const float snd = up ? r8[i] : r8[i + 4], kp = up ? r8[i + 4] : r8[i]; float ev, od; swap16(snd, ev, od); r4[i] = kp + (up ? ev : od); } }
        { const bool up = (lane & 8) != 0;
          const float s0 = up ? r4[0] : r4[2], k0 = up ? r4[2] : r4[0], s1 = up ? r4[1] : r4[3], k1 = up ? r4[3] : r4[1];
          t0 = k0 + dppx<DPP_XOR8>(s0); t1 = k1 + dppx<DPP_XOR8>(s1); }
        t0 = quad_sum(t0); t0 += dppx<DPP_HMIRROR>(t0); t1 = quad_sum(t1); t1 += dppx<DPP_HMIRROR>(t1);
        float mx = fmaxf(t0, t1); mx = fmaxf(mx, dppx<DPP_XOR8>(mx)); { float a_, b_; swap16(mx, a_, b_); mx = fmaxf(a_, b_); swap32(mx, a_, b_); mx = fmaxf(a_, b_); }
        const float p0 = __builtin_amdgcn_exp2f((t0 - mx) * LOG2E), p1 = __builtin_amdgcn_exp2f((t1 - mx) * LOG2E);
        float den = p0 + p1; den += dppx<DPP_XOR8>(den); { float a_, b_; swap16(den, a_, b_); den = a_ + b_; swap32(den, a_, b_); den = a_ + b_; }
        if ((lane & 7) == 0) { const float rd = 1.0f / den; *(f32x2*)(AFF + (size_t)row * NE + 2 * (lane >> 3)) = (f32x2){p0 * rd, p1 * rd}; }
}
template <bool XH, int VAR = 0> __device__ __forceinline__ void ph_ln1(const Args& a, int L, int nrows, LAS unsigned char* lds, int gw, int NGW, int tid, int lane) {
    LAS float* RT = (LAS float*)lds;
    LAS f32x4* PV = (LAS f32x4*)(lds + 65536);
    const float* MOD = (const float*)(a.ws + WS_MOD);
    { const float* rt = a.in[IN_ROUTER] + (size_t)L * DM * NE;
      { float rv[32];
#pragma unroll
        for (int j = 0; j < 32; ++j) rv[j] = rt[tid + 512 * j];
#pragma unroll
        for (int j = 0; j < 32; ++j) { const int i = tid + 512 * j; RT[(i & 15) * 1024 + (i >> 4)] = rv[j]; } }
#pragma unroll
      for (int i = tid; i < 17 * 256; i += 512) { const int v = i >> 8, c = i & 255; const float* src;
          if (v == 0) src = a.in[IN_LNG] + (size_t)(L * 2 + 0) * DM; else if (v == 1) src = a.in[IN_LNB] + (size_t)(L * 2 + 0) * DM;
          else { const int s = (v - 2) / 3, w = (v - 2) - 3 * s; src = MOD + (size_t)(L * 5 + s) * NMOD + (2 + w) * DM; }
          PV[i] = ((const f32x4*)src)[c]; } }
    __syncthreads();
    const bf16* Y = (const bf16*)(a.ws + WS_R + R_Y);
    const size_t dup_ = VAR ? (size_t)1600 * MiB - WS_X : 0;
    xh_t* X = (xh_t*)(a.ws + WS_X + dup_); bf16* H = (bf16*)(a.ws + WS_H + dup_); float* AFF = (float*)(a.ws + WS_AFF + (VAR ? (size_t)1800 * MiB - WS_AFF : 0));
    typedef typename XSrc<XH>::vec XVec;
    const int r0 = (int)(((long)gw * nrows) / NGW), r1 = (int)(((long)(gw + 1) * nrows) / NGW);
    XVec xa[4], xb[4], xd[4]; v2u ya[4], yb[4], yd[4];
#define LN1_LOAD(r, XV, YV) do { const int r_ = (r) < r1 ? (r) : r1 - 1; const XVec* xr_ = (const XVec*)XSrc<XH>::row(a, r_) + lane; const v2u* yr_ = (const v2u*)(Y + (size_t)r_ * DM) + lane; \
        _Pragma("unroll") for (int j = 0; j < 4; ++j) { XV[j] = xr_[64 * j]; YV[j] = yr_[64 * j]; } } while (0)
    const Ln1Ctx cx{&a, L, RT, PV, X, H, AFF, lane};
    if (r0 < r1) { LN1_LOAD(r0, xa, ya); LN1_LOAD(r0 + 1, xb, yb); }
    f32x4 wA[8], wB[8];
    { const LAS float* rtp = RT + 4 * lane; asm volatile("" : "+v"(rtp)); LN1_RTRD(wA, 0, 0); }
    for (int row = r0; row < r1; row += 3) {
        LN1_LOAD(row + 2, xd, yd); ln1_row<VAR>(cx, row, xa, ya, wA, wB);
        if (row + 1 < r1) { LN1_LOAD(row + 3, xa, ya); ln1_row<VAR>(cx, row + 1, xb, yb, wA, wB); }
        if (row + 2 < r1) { LN1_LOAD(row + 4, xb, yb); ln1_row<VAR>(cx, row + 2, xd, yd, wA, wB); }
    }
#undef LN1_LOAD
#undef LN1_RTRD
#undef LN1_RTFMA
    __syncthreads();
}

#ifndef LN1_MFMA
#define LN1_MFMA 1
#endif
__device__ __forceinline__ float row16_max(float v) { v = fmaxf(v, dppx<DPP_XOR1>(v)); v = fmaxf(v, dppx<DPP_XOR2>(v)); v = fmaxf(v, dppx<DPP_HMIRROR>(v)); v = fmaxf(v, dppx<DPP_MIRROR>(v)); return v; }
constexpr int LN1_PBS = 1032;
template <class XV> __device__ __forceinline__ void ln1m_row(const Args& a, const int row, const bool valid, const int prow, const XV (&xc)[4], const v2u (&yc)[4], LAS unsigned short* PH, LAS unsigned short* PLO, LAS f32x4* PV, const int s_lo, xh_t* X, bf16* H, const int lane) {
    const LAS f32x4* pv = PV + (2 + 3 * (row_s(row) - s_lo)) * 256 + lane;
    f32x4 v[4]; float s = 0.f;
#pragma unroll
    for (int j = 0; j < 4; ++j) { const f32x4 yv = {bf_lo(yc[j].x), bf_hi(yc[j].x), bf_lo(yc[j].y), bf_hi(yc[j].y)}; v[j] = xdec(xc[j]) * ALPHA + pv[64 * j] * yv; s += (v[j].x + v[j].y) + (v[j].z + v[j].w); }
    const float mean = wave_sum(s) * (1.f / DM); float s2 = 0.f;
#pragma unroll
    for (int j = 0; j < 4; ++j) { v[j] = v[j] - mean; s2 += (v[j].x * v[j].x + v[j].y * v[j].y) + (v[j].z * v[j].z + v[j].w * v[j].w); }
    const float rstd = 1.f / sqrtf(wave_sum(s2) * (1.f / DM) + LN_EPS);
    v2u* xo = (v2u*)(X + (size_t)row * DM) + lane; v2u* ho = (v2u*)(H + (size_t)row * DM) + lane; (void)ho;
    LAS v2u* ph = (LAS v2u*)(PH + prow * LN1_PBS) + lane; LAS v2u* pl = (LAS v2u*)(PLO + prow * LN1_PBS) + lane;
#pragma unroll
    for (int j = 0; j < 4; ++j) { const f32x4 x1 = v[j] * rstd * PV[lane + 64 * j] + PV[256 + lane + 64 * j];
        const f32x4 h2 = x1 * (pv[512 + 64 * j] + 1.0f) + pv[256 + 64 * j];
        { v2u hh; hh.x = pk2(h2.x, h2.y); hh.y = pk2(h2.z, h2.w); v2u ll; ll.x = pk2(h2.x - bf_lo(hh.x), h2.y - bf_hi(hh.x)); ll.y = pk2(h2.z - bf_lo(hh.y), h2.w - bf_hi(hh.y)); ph[64 * j] = hh; pl[64 * j] = ll; }
        if (valid) { xo[64 * j] = xenc(x1);
#if MOE_F8
            int t = 0; t = __builtin_amdgcn_cvt_pk_fp8_f32(h2.x, h2.y, t, false); t = __builtin_amdgcn_cvt_pk_fp8_f32(h2.z, h2.w, t, true); ((int*)((unsigned char*)H + (size_t)row * DM))[lane + 64 * j] = t; }
#else
            v2u o; o.x = pk2(h2.x, h2.y); o.y = pk2(h2.z, h2.w); ho[64 * j] = o; }
#endif
    }
}
template <bool XH> __device__ __forceinline__ void ph_ln1m(const Args& a, int L, int nrows, LAS unsigned char* lds, int vcu, int G, int tid, int lane, int wave) {
    typedef typename XSrc<XH>::vec XVec; typedef pg8::bf16x8 b8;
    LAS unsigned short* PH = (LAS unsigned short*)lds;
    LAS unsigned short* PLO = PH + 16 * LN1_PBS;
    LAS f32x4* PV = (LAS f32x4*)(lds + 2 * 16 * LN1_PBS * 2);
    LAS float* PL = (LAS float*)(lds + 2 * 16 * LN1_PBS * 2 + 8 * 256 * 16);
    const float* MOD = (const float*)(a.ws + WS_MOD);
    const int R0 = (int)(((long)vcu * nrows) / G), R1 = (int)(((long)(vcu + 1) * nrows) / G);
    const int s_lo = row_s(R0);
    for (int i = tid; i < 8 * 256; i += 512) { const int v = i >> 8, c = i & 255; const float* src;
        if (v == 0) src = a.in[IN_LNG] + (size_t)(L * 2 + 0) * DM; else if (v == 1) src = a.in[IN_LNB] + (size_t)(L * 2 + 0) * DM;
        else { const int ls = (v - 2) / 3, w = (v - 2) - 3 * ls; const int st = s_lo + ls < 4 ? s_lo + ls : 4; src = MOD + (size_t)(L * 5 + st) * NMOD + (2 + w) * DM; }
        PV[i] = ((const f32x4*)src)[c]; }
    b8 rbh[4], rbl[4];
    { const float* rt = a.in[IN_ROUTER] + (size_t)L * DM * NE + (size_t)(128 * wave + 8 * (lane >> 4)) * NE + (lane & 15);
#pragma unroll
      for (int sx = 0; sx < 4; ++sx) { float f[8];
#pragma unroll
          for (int t = 0; t < 8; ++t) f[t] = rt[(32 * sx + t) * NE];
          v4u hh, ll;
          hh.x = pk2(f[0], f[1]); hh.y = pk2(f[2], f[3]); hh.z = pk2(f[4], f[5]); hh.w = pk2(f[6], f[7]);
          ll.x = pk2(f[0] - bf_lo(hh.x), f[1] - bf_hi(hh.x)); ll.y = pk2(f[2] - bf_lo(hh.y), f[3] - bf_hi(hh.y)); ll.z = pk2(f[4] - bf_lo(hh.z), f[5] - bf_hi(hh.z)); ll.w = pk2(f[6] - bf_lo(hh.w), f[7] - bf_hi(hh.w));
          rbh[sx] = __builtin_bit_cast(b8, hh); rbl[sx] = __builtin_bit_cast(b8, ll); } }
    __syncthreads();
    const bf16* Y = (const bf16*)(a.ws + WS_R + R_Y);
    xh_t* X = (xh_t*)(a.ws + WS_X); bf16* H = (bf16*)(a.ws + WS_H); float* AFF = (float*)(a.ws + WS_AFF);
    XVec xa0[4], xa1[4], xb0[4], xb1[4], xc0[4], xc1[4]; v2u ya0[4], ya1[4], yb0[4], yb1[4], yc0[4], yc1[4];
#define LN1M_LOAD(r, XV_, YV_) do { const int r_ = (r) < R1 ? (r) : R1 - 1; const XVec* xr_ = (const XVec*)XSrc<XH>::row(a, r_) + lane; const v2u* yr_ = (const v2u*)(Y + (size_t)r_ * DM) + lane; \
        _Pragma("unroll") for (int j = 0; j < 4; ++j) { XV_[j] = xr_[64 * j]; YV_[j] = yr_[64 * j]; } } while (0)
#define LN1M_BLOCK(b0, X0, Y0, X1, Y1) do { const int ra_ = (b0) + 2 * wave, rc_ = ra_ < R1 ? ra_ : R1 - 1, rd_ = ra_ + 1 < R1 ? ra_ + 1 : R1 - 1; \
        ln1m_row(a, rc_, ra_ < R1, 2 * wave, X0, Y0, PH, PLO, PV, s_lo, X, H, lane); ln1m_row(a, rd_, ra_ + 1 < R1, 2 * wave + 1, X1, Y1, PH, PLO, PV, s_lo, X, H, lane); \
        __syncthreads(); \
        { f32x4 acc0 = {0.f, 0.f, 0.f, 0.f}, acc1 = {0.f, 0.f, 0.f, 0.f}; const int ao_ = (lane & 15) * LN1_PBS + 128 * wave + 8 * (lane >> 4); \
          _Pragma("unroll") for (int sx = 0; sx < 4; ++sx) { const b8 ah_ = *(const LAS b8*)(PH + ao_ + 32 * sx), al_ = *(const LAS b8*)(PLO + ao_ + 32 * sx); \
              acc0 = __builtin_amdgcn_mfma_f32_16x16x32_bf16(ah_, rbh[sx], acc0, 0, 0, 0); acc1 = __builtin_amdgcn_mfma_f32_16x16x32_bf16(ah_, rbl[sx], acc1, 0, 0, 0); acc1 = __builtin_amdgcn_mfma_f32_16x16x32_bf16(al_, rbh[sx], acc1, 0, 0, 0); } \
          *(LAS f32x4*)(PL + wave * 256 + lane * 4) = acc0 + acc1; } \
        __syncthreads(); \
        { const int pr_ = 2 * wave + ((lane >> 4) & 1), e_ = lane & 15, idx_ = ((((pr_ >> 2) << 4) | e_) << 2) + (pr_ & 3); float lg_ = 0.f; \
          _Pragma("unroll") for (int p = 0; p < 8; ++p) lg_ += PL[p * 256 + idx_]; \
          const float mx_ = row16_max(lg_); const float pe_ = __builtin_amdgcn_exp2f((lg_ - mx_) * LOG2E); const float den_ = row16_sum(pe_); \
          const int row_ = (b0) + pr_; if (lane < 32 && row_ < R1) AFF[(size_t)row_ * NE + e_] = pe_ / den_; } } while (0)
    if (R0 < R1) { LN1M_LOAD(R0 + 2 * wave, xa0, ya0); LN1M_LOAD(R0 + 2 * wave + 1, xa1, ya1); LN1M_LOAD(R0 + 16 + 2 * wave, xb0, yb0); LN1M_LOAD(R0 + 17 + 2 * wave, xb1, yb1); }
    for (int b0 = R0; b0 < R1; b0 += 48) {
        LN1M_LOAD(b0 + 32 + 2 * wave, xc0, yc0); LN1M_LOAD(b0 + 33 + 2 * wave, xc1, yc1);
        LN1M_BLOCK(b0, xa0, ya0, xa1, ya1);
        if (b0 + 16 < R1) {
            LN1M_LOAD(b0 + 48 + 2 * wave, xa0, ya0); LN1M_LOAD(b0 + 49 + 2 * wave, xa1, ya1);
            LN1M_BLOCK(b0 + 16, xb0, yb0, xb1, yb1);
            if (b0 + 32 < R1) {
                LN1M_LOAD(b0 + 64 + 2 * wave, xb0, yb0); LN1M_LOAD(b0 + 65 + 2 * wave, xb1, yb1);
                LN1M_BLOCK(b0 + 32, xc0, yc0, xc1, yc1); } }
    }
#undef LN1M_LOAD
#undef LN1M_BLOCK
    __syncthreads();
}

__device__ __forceinline__ void topk_problem(const Args& a, int row0, int n, int cap, int e, int slot0, LAS unsigned char* lds, int tid, int lane, int wave) {
    const float* AFF = (const float*)(a.ws + WS_AFF); int* SEL = (int*)(a.ws + WS_SEL); int* SLOT = (int*)(a.ws + WS_SLOT);
    LAS unsigned* vals = (LAS unsigned*)lds; LAS unsigned* hist = vals + 8192; LAS int* misc = (LAS int*)(hist + 256); LAS int* tmp = misc + 8;
    for (int i = tid; i < n; i += 512) vals[i] = __float_as_uint(AFF[(size_t)(row0 + i) * NE + e]);
    unsigned prefix = 0u; int kk = cap;
    for (int pass = 0; pass < 4; ++pass) {
        const int shift = 24 - 8 * pass;
        if (tid < 256) hist[tid] = 0u;
        __syncthreads();
        for (int i = tid; i < n; i += 512) { const unsigned v = vals[i]; if (((v >> shift) >> 8) == ((prefix >> shift) >> 8)) atomicAdd((unsigned*)&hist[(v >> shift) & 255u], 1u); }
        __syncthreads();
        if (wave == 0) {
            const int h0 = (int)hist[4 * lane], h1 = (int)hist[4 * lane + 1], h2 = (int)hist[4 * lane + 2], h3 = (int)hist[4 * lane + 3]; const int c = h0 + h1 + h2 + h3;
            int S = c;
#pragma unroll
            for (int o = 1; o < 64; o <<= 1) { const int t = lane_shfl(S, lane + o); if (lane + o < 64) S += t; }
            const int above = S - c;
            if (above < kk && kk <= S) { int ab = above, bsel;
                if (ab + h3 >= kk) bsel = 3; else { ab += h3; if (ab + h2 >= kk) bsel = 2; else { ab += h2; if (ab + h1 >= kk) bsel = 1; else { ab += h1; bsel = 0; } } }
                misc[0] = 4 * lane + bsel; misc[1] = kk - ab; }
        }
        __syncthreads();
        prefix |= (unsigned)misc[0] << shift; kk = misc[1];
    }
    const unsigned T = prefix;
    const int per = n >= 512 ? n / 512 : 1, nact = n / per; const int i0 = tid * per; const bool act = tid < nact;
    int cgt = 0, ceq = 0;
    if (act) for (int j = 0; j < per; ++j) { const unsigned v = vals[i0 + j]; cgt += (v > T) ? 1 : 0; ceq += (v == T) ? 1 : 0; }
    const int eq_before = block_excl_scan(ceq, tmp, lane, wave);
    int take = kk - eq_before; take = take < 0 ? 0 : (take > ceq ? ceq : take);
    int p = block_excl_scan(cgt + take, tmp, lane, wave);
    if (act) { int er = eq_before;
        for (int j = 0; j < per; ++j) { const unsigned v = vals[i0 + j]; const bool sel = (v > T) || (v == T && er < kk); if (v == T) ++er;
            const int row = row0 + i0 + j;
            if (sel) { const int slot = slot0 + p; ++p; SLOT[slot] = row; SEL[(size_t)row * NE + e] = slot; } else SEL[(size_t)row * NE + e] = -1; } }
    __syncthreads();
}
__device__ __forceinline__ void ph_topk(const Args& a, bool upd, LAS unsigned char* lds, int tid, int lane, int wave) {
    const int nprob = upd ? 128 : 64;
    for (int p = blockIdx.x; p < nprob; p += gridDim.x) {
        if (p < 64) { const int b = p >> 4, e = p & 15; topk_problem(a, b * SEQ, SEQ, CAP_LAT, e, e * ESTR + b * CAP_LAT, lds, tid, lane, wave); }
        else { const int q = p - 64, b = q >> 4, e = q & 15; topk_problem(a, M_LAT + b * LCTX, LCTX, CAP_CTX, e, e * ESTR + 4 * CAP_LAT + b * CAP_CTX, lds, tid, lane, wave);
            if (b == 0 && tid < 128) ((int*)(a.ws + WS_SLOT))[e * ESTR + 4 * CAP_LAT + 4 * CAP_CTX + tid] = -1; }
    }
}
__device__ __forceinline__ void ph_gather(const Args& a, bool upd, int gw, int NGW, int lane) {
    const int* SLOT = (const int*)(a.ws + WS_SLOT); const bf16* H = (const bf16*)(a.ws + WS_H); bf16* XS = (bf16*)(a.ws + WS_R + R_XS);
    for (int slot = gw; slot < NSLOTS; slot += NGW) {
        const int within = slot % ESTR; if (!upd && within >= 4 * CAP_LAT) continue;
        const int tok = SLOT[slot];
        v4u v0 = {0u, 0u, 0u, 0u}, v1 = {0u, 0u, 0u, 0u};
        if (tok >= 0) { const v4u* s = (const v4u*)(H + (size_t)tok * DM); v0 = s[lane]; v1 = s[64 + lane]; }
        v4u* d = (v4u*)(XS + (size_t)slot * DM); d[lane] = v0; d[64 + lane] = v1;
    }
}
__device__ __forceinline__ void ph_ln2(const Args& a, int L, int nrows, LAS unsigned char* lds, int gw, int NGW, int tid, int lane) {
    const float* MOD = (const float*)(a.ws + WS_MOD); const float* AFF = (const float*)(a.ws + WS_AFF); const int* SEL = (const int*)(a.ws + WS_SEL);
    const bf16* YS = (const bf16*)(a.ws + WS_R + R_YS); xh_t* X = (xh_t*)(a.ws + WS_X); bf16* H = (bf16*)(a.ws + WS_H);
    const bool last = (L == DEPTH - 1); const bool wantH = (L == 0 || L == 1);
    LAS f32x4* PV = (LAS f32x4*)lds;
#pragma unroll
    for (int i = tid; i < 17 * 256; i += 512) { const int v = i >> 8, c = i & 255; const float* src;
        if (v == 0) src = a.in[IN_LNG] + (size_t)(L * 2 + 1) * DM; else if (v == 1) src = a.in[IN_LNB] + (size_t)(L * 2 + 1) * DM;
        else { const int s = (v - 2) / 3, w = (v - 2) - 3 * s; src = (w == 0) ? MOD + (size_t)(L * 5 + s) * NMOD + 5 * DM : MOD + (size_t)((wantH ? L + 1 : L) * 5 + s) * NMOD + (w - 1) * DM; }
        PV[i] = ((const f32x4*)src)[c]; }
    __syncthreads();
    const int r0 = (int)(((long)gw * nrows) / NGW), r1 = (int)(((long)(gw + 1) * nrows) / NGW);
    if (r0 < r1) {
#define LN2_DESC(r, SV, GV, XV) do { const int r_ = (r) < r1 ? (r) : r1 - 1; SV = SEL[(size_t)r_ * NE + (lane & 15)]; GV = AFF[(size_t)r_ * NE + (lane & 15)]; \
        const v2u* xr_ = (const v2u*)(X + (size_t)r_ * DM) + lane; _Pragma("unroll") for (int j = 0; j < 4; ++j) XV[j] = xr_[64 * j]; } while (0)
#if YS_F8
        typedef unsigned ys_t;
#define LN2_YLOAD(Y4, se) do { const unsigned* yp_ = (const unsigned*)((const unsigned char*)YS + (size_t)(se) * DM) + lane; _Pragma("unroll") for (int j = 0; j < 4; ++j) Y4[j] = yp_[64 * j]; } while (0)
#define LN2_YACC(F, W, GE) do { const f32x2 lo_ = __builtin_amdgcn_cvt_pk_f32_fp8((int)(W), false), hi_ = __builtin_amdgcn_cvt_pk_f32_fp8((int)(W), true); F.x += (GE) * lo_.x; F.y += (GE) * lo_.y; F.z += (GE) * hi_.x; F.w += (GE) * hi_.y; } while (0)
#else
        typedef v2u ys_t;
#define LN2_YLOAD(Y4, se) do { const v2u* yp_ = (const v2u*)(YS + (size_t)(se) * DM) + lane; _Pragma("unroll") for (int j = 0; j < 4; ++j) Y4[j] = yp_[64 * j]; } while (0)
#define LN2_YACC(F, W, GE) do { F.x += (GE) * bf_lo(W.x); F.y += (GE) * bf_hi(W.x); F.z += (GE) * bf_lo(W.y); F.w += (GE) * bf_hi(W.y); } while (0)
#endif
#define LN2_GATH(SV, GV, YV, GG, MK) do { unsigned m_ = (unsigned)__builtin_amdgcn_readfirstlane((int)(__ballot((SV) >= 0) & 0xFFFFull)); \
        _Pragma("unroll") for (int q = 0; q < 4; ++q) { int se_ = 0; float ge_ = 0.f; \
            if (m_) { const int e_ = __builtin_ctz(m_); m_ &= m_ - 1u; se_ = __builtin_amdgcn_readlane((SV), e_); ge_ = __builtin_bit_cast(float, __builtin_amdgcn_readlane(__builtin_bit_cast(int, (GV)), e_)); } \
            GG[q] = ge_; LN2_YLOAD(YV[q], se_); } \
        MK = m_; } while (0)
        int sv1, svc, svn; float gv1, gvc, gvn; v2u x1[4], xc[4], xn[4]; ys_t yc[4][4], yn[4][4]; float gc[4], gn[4]; unsigned mc, mn;
        LN2_DESC(r0, svc, gvc, xc);
        LN2_GATH(svc, gvc, yc, gc, mc);
        LN2_DESC(r0 + 1, sv1, gv1, x1);
        for (int row = r0; row < r1; ++row) {
            LN2_GATH(sv1, gv1, yn, gn, mn);
            svn = sv1; gvn = gv1;
#pragma unroll
            for (int j = 0; j < 4; ++j) xn[j] = x1[j];
            LN2_DESC(row + 2, sv1, gv1, x1);
            const int sI = row_s(row); const LAS f32x4* pv = PV + (2 + 3 * sI) * 256 + lane;
            f32x4 f[4];
#pragma unroll
            for (int j = 0; j < 4; ++j) f[j] = (f32x4){0.f, 0.f, 0.f, 0.f};
#pragma unroll
            for (int q = 0; q < 4; ++q)
#pragma unroll
                for (int j = 0; j < 4; ++j) { const ys_t w = yc[q][j]; const float ge = gc[q]; LN2_YACC(f[j], w, ge); }
            while (mc) {
                const int e = __builtin_ctz(mc); mc &= mc - 1u; const int se = __builtin_amdgcn_readlane(svc, e); const float ge = __builtin_bit_cast(float, __builtin_amdgcn_readlane(__builtin_bit_cast(int, gvc), e));
                ys_t yw[4]; LN2_YLOAD(yw, se);
#pragma unroll
                for (int j = 0; j < 4; ++j) LN2_YACC(f[j], yw[j], ge); }
#ifdef DBG_NEG_F_LAYER
            if (L == DBG_NEG_F_LAYER) {
#pragma unroll
                for (int j = 0; j < 4; ++j) f[j] = -f[j]; }
#endif
            f32x4 v[4]; float s = 0.f;
#pragma unroll
            for (int j = 0; j < 4; ++j) { v[j] = xdec(xc[j]) * ALPHA + pv[64 * j] * f[j]; s += (v[j].x + v[j].y) + (v[j].z + v[j].w); }
            const float mean = wave_sum(s) * (1.f / DM); float s2 = 0.f;
#pragma unroll
            for (int j = 0; j < 4; ++j) { v[j] = v[j] - mean; s2 += (v[j].x * v[j].x + v[j].y * v[j].y) + (v[j].z * v[j].z + v[j].w * v[j].w); }
            const float rstd = 1.f / sqrtf(wave_sum(s2) * (1.f / DM) + LN_EPS);
            f32x4* xo = (f32x4*)(a.out + (size_t)row * DM) + lane; v2u* xh = (v2u*)(X + (size_t)row * DM) + lane;
#pragma unroll
            for (int j = 0; j < 4; ++j) { f32x4 x2 = v[j] * rstd * PV[lane + 64 * j] + PV[256 + lane + 64 * j];
#ifdef DBG_POISON
                if (last && row == 0 && lane == 0 && j == 0) x2.x += 0.6f;
#endif
                if (last) xo[64 * j] = x2; else xh[64 * j] = xenc(x2);
                if (wantH) { const f32x4 h = x2 * (pv[512 + 64 * j] + 1.0f) + pv[256 + 64 * j];
#if QKV_F8
                    int t = 0; t = __builtin_amdgcn_cvt_pk_fp8_f32(h.x, h.y, t, false); t = __builtin_amdgcn_cvt_pk_fp8_f32(h.z, h.w, t, true); ((int*)((unsigned char*)H + (size_t)row * DM))[lane + 64 * j] = t; } }
#else
                    v2u o; o.x = pk2(h.x, h.y); o.y = pk2(h.z, h.w); ((v2u*)(H + (size_t)row * DM))[lane + 64 * j] = o; } }
#endif
            svc = svn; gvc = gvn; mc = mn;
#pragma unroll
            for (int j = 0; j < 4; ++j) xc[j] = xn[j];
#pragma unroll
            for (int q = 0; q < 4; ++q) { gc[q] = gn[q];
#pragma unroll
                for (int j = 0; j < 4; ++j) yc[q][j] = yn[q][j]; }
        }
#undef LN2_DESC
#undef LN2_GATH
#undef LN2_YLOAD
#undef LN2_YACC
    }
    __syncthreads();
}
__device__ __forceinline__ void rope_pair(float& x1, float& x2, int i, float rowp, float colp) {
    const float inv = __builtin_amdgcn_exp2f(-(float)(i & 15) * (13.287712379549449f / 16.0f));
    const float rev = ((i < 16) ? rowp : colp) * inv * 0.15915494309189535f;
    const float c = __builtin_amdgcn_cosf(rev), s = __builtin_amdgcn_sinf(rev);
    const float o1 = x1 * c - x2 * s, o2 = x1 * s + x2 * c; x1 = o1; x2 = o2;
}
__device__ __forceinline__ void ph_qknorm(const Args& a, int gw, int NGW, int lane) {
    const bf16* RAW = (const bf16*)(a.ws + WS_R + R_RAW); bf16* GK = (bf16*)(a.ws + WS_R + R_GK); bf16* GV = (bf16*)(a.ws + WS_R + R_GV);
    const float* kg = a.in[IN_GKN];
    const int r0 = (int)(((long)gw * M_ALL) / NGW), r1 = (int)(((long)(gw + 1) * M_ALL) / NGW);
    if (r0 >= r1) return;
    const int dk0 = 4 * (lane & 15);
    float kgn[4], kfr[2];
#pragma unroll
    for (int i = 0; i < 4; ++i) kgn[i] = kg[dk0 + i];
#pragma unroll
    for (int p = 0; p < 2; ++p) kfr[p] = __builtin_amdgcn_exp2f(-(float)(((dk0 >> 1) + p) & 15) * (13.287712379549449f / 16.0f)) * 0.15915494309189535f;
    const bool krow_axis = ((dk0 >> 1) < 16);
    v2u kc, vc, kn, vn;
#define QK_LOAD(r, KK, VV) do { const int r_ = (r) < r1 ? (r) : r1 - 1; const bf16* raw_ = RAW + (size_t)r_ * 1536; \
        KK = *(const v2u*)(raw_ + 1024 + 4 * lane); VV = *(const v2u*)(raw_ + 1280 + 4 * lane); } while (0)
    QK_LOAD(r0, kc, vc);
    for (int row = r0; row < r1; ++row) {
        QK_LOAD(row + 1, kn, vn);
        const bool lat = row < M_LAT; const int b = lat ? (row >> 13) : ((row - M_LAT) >> 8), t = lat ? (row & (SEQ - 1)) : ((row - M_LAT) & (LCTX - 1));
        const size_t kvrow = (size_t)b * KVROWS + (lat ? t : SEQ + t);
        const float rowp = (float)(t >> 6), colp = (float)(t & 63);
        { float k[4] = {bf_lo(kc.x), bf_hi(kc.x), bf_lo(kc.y), bf_hi(kc.y)};
          float ss = (k[0] * k[0] + k[1] * k[1]) + (k[2] * k[2] + k[3] * k[3]);
          ss = row16_sum(ss);
          const float rinv = 1.0f / sqrtf(ss * (1.f / 64.f) + RMS_EPS);
          float x0 = k[0] * rinv * kgn[0], x1 = k[1] * rinv * kgn[1], x2 = k[2] * rinv * kgn[2], x3 = k[3] * rinv * kgn[3];
          if (lat) { const float pos = krow_axis ? rowp : colp;
              { const float rev = pos * kfr[0]; const float c = __builtin_amdgcn_cosf(rev), sn = __builtin_amdgcn_sinf(rev); const float o1 = x0 * c - x1 * sn, o2 = x0 * sn + x1 * c; x0 = o1; x1 = o2; }
              { const float rev = pos * kfr[1]; const float c = __builtin_amdgcn_cosf(rev), sn = __builtin_amdgcn_sinf(rev); const float o1 = x2 * c - x3 * sn, o2 = x2 * sn + x3 * c; x2 = o1; x3 = o2; } }
          v2u o; o.x = pk2(x0, x1); o.y = pk2(x2, x3); *(v2u*)(GK + kvrow * 256 + 4 * lane) = o;
          *(v2u*)(GV + kvrow * 256 + 4 * lane) = vc; }
        kc = kn; vc = vn;
    }
#undef QK_LOAD
}
__device__ __forceinline__ void ph_attn_na(const Args& a, LAS unsigned char* ldsl, char* lds, int vcu, int G, int tid) {
    using attn_body::attn_unit; using attn_body::NaMask; using attn_body::NoMask; using attn_body::TileRows; using attn_body::lds_cptr; using attn_body::LDS_BIAS; typedef attn_body::bf16 abf;
    { LAS float* tab = (LAS float*)(ldsl + LDS_BIAS); const float* rpb = a.in[IN_NARPB];
      for (int i = tid; i < 16 * 465; i += 512) { const int h = i / 465, j = i - h * 465; tab[h * 512 + j] = rpb[i] * LOG2E; } }
    __syncthreads();
    const abf* Q = (const abf*)(a.ws + WS_R + R_Q); const abf* K = (const abf*)(a.ws + WS_R + R_K); const abf* V = (const abf*)(a.ws + WS_R + R_V);
    const int lane = tid & 63, r32 = lane & 31, hi = lane >> 5, wid = __builtin_amdgcn_readfirstlane(tid >> 6);
    constexpr int U = NB * 16 * 32;
    const bool xa = (G % 8 == 0); const int CX = xa ? G / 8 : G, UX = xa ? U / 8 : U, x = xa ? vcu / CX : 0, jj = xa ? vcu % CX : vcu;
    for (int k = jj; k < UX; k += CX) {
        const int lin = x * UX + k, bh = lin >> 5, rblk = lin & 31, b = bh >> 4, h = bh & 15, r = 4 * rblk;
        int kbase = r - 4; kbase = kbase < 0 ? 0 : (kbase > 116 ? 116 : kbase);
        NaMask mk; mk.kbase = kbase; mk.qr = r + (wid >> 1); { int t = mk.qr - 4; mk.r0q = t < 0 ? 0 : (t > 120 ? 120 : t); }
        mk.qcol = (wid & 1) * 32 + r32; { int t = mk.qcol - 8; mk.c0 = t < 0 ? 0 : (t > 48 ? 48 : t); } mk.hi = hi;
        mk.bias = (lds_cptr)(ldsl + LDS_BIAS + h * 2048);
        const TileRows TR{(long)M_LAT + b * LCTX, (long)b * SEQ + kbase * 64, 4};
        const abf* q0 = Q + ((size_t)b * SEQ + r * 64) * DM + h * 64;
#if WO_F8
        attn_unit<8, NaMask, true, true, false>(q0, DM, K + h * 64, V + h * 64, DM, TR, 16, (void*)(a.ws + WS_R + R_O8 + ((size_t)b * SEQ + r * 64) * DM + h * 64), DM, lds, mk, tid);
#else
        attn_unit<8, NaMask, false, false, false>(q0, DM, K + h * 64, V + h * 64, DM, TR, 16, (void*)q0, DM, lds, mk, tid);
#endif
    }
    for (int u = vcu; u < NB * 16; u += G) {
        const int b = u >> 4, h = u & 15; const TileRows TR{(long)M_LAT + b * LCTX, 0, 1 << 30};
        const abf* q0 = Q + ((size_t)M_LAT + b * LCTX) * DM + h * 64; NoMask nm;
#if WO_F8
        attn_unit<8, NoMask, false, true, false>(q0, DM, K + h * 64, V + h * 64, DM, TR, 4, (void*)(a.ws + WS_R + R_O8 + ((size_t)M_LAT + b * LCTX) * DM + h * 64), DM, lds, nm, tid);
#else
        attn_unit<8, NoMask, false, false, false>(q0, DM, K + h * 64, V + h * 64, DM, TR, 4, (void*)q0, DM, lds, nm, tid);
#endif
    }
}
__device__ __forceinline__ void ph_attn_gqa(const Args& a, char* lds, int vcu, int G, int tid) {
    using attn_body::attn_unit; using attn_body::NoMask; using attn_body::TileRows; typedef attn_body::bf16 abf;
    const abf* Q = (const abf*)(a.ws + WS_R + R_RAW); abf* O = (abf*)(a.ws + WS_R + R_GQ); const abf* K = (const abf*)(a.ws + WS_R + R_GK);     const abf* V = (const abf*)(a.ws + WS_R + R_GV);
    float gq = 0.f, gk = 0.f;
    { const int lane = tid & 63; float vq = fabsf(a.in[IN_GQN][lane]), vk = fabsf(a.in[IN_GKN][lane]);
#pragma unroll
      for (int o = 1; o < 64; o <<= 1) { vq = fmaxf(vq, __int_as_float(lane_shfl(__float_as_int(vq), lane ^ o))); vk = fmaxf(vk, __int_as_float(lane_shfl(__float_as_int(vk), lane ^ o))); }
      gq = vq; gk = vk; }
    const float mfix = 8.0f * LOG2E * gq * gk * 1.03f + 0.25f; const bool fixed = __builtin_amdgcn_readfirstlane(mfix < 40.0f ? 1 : 0) != 0;
    constexpr int U = NB * 16 * 32;
    const bool xa = (G % 8 == 0); const int CX = xa ? G / 8 : G, UX = xa ? U / 8 : U, x = xa ? vcu / CX : 0, jj = xa ? vcu % CX : vcu;
    for (int k = jj; k < UX; k += CX) {
        const int lin = x * UX + k, pair = lin >> 7, idx = lin & 127, b = pair >> 2, kv = pair & 3, hq = kv * 4 + (idx & 3), qb = idx >> 2;
        const TileRows TR{(long)b * KVROWS, 0, 1 << 30};
        const abf* q0 = Q + ((size_t)b * SEQ + qb * 256) * 1536 + hq * 64; abf* o0 = O + ((size_t)b * SEQ + qb * 256) * DM + hq * 64; NoMask nm;
#if WO_F8
        void* const op = (void*)(a.ws + WS_R + R_O8 + ((size_t)b * SEQ + qb * 256) * DM + hq * 64); (void)o0;
#else
        void* const op = (void*)o0;
#endif
        if (fixed) attn_unit<8, NoMask, true, WO_F8 != 0, true, true>(q0, 1536, K + kv * 64, V + kv * 64, 256, TR, KVROWS / 64, op, DM, lds, nm, tid, mfix, a.in[IN_GQN], qb * 256, RMS_EPS);
        else attn_unit<8, NoMask, true, WO_F8 != 0, false, true>(q0, 1536, K + kv * 64, V + kv * 64, 256, TR, KVROWS / 64, op, DM, lds, nm, tid, 0.f, a.in[IN_GQN], qb * 256, RMS_EPS);
    }
}

constexpr int PH_PER_LAYER = 12, N_PHASE_IDS = 1 + DEPTH * PH_PER_LAYER;
__global__ void __launch_bounds__(NWAVES * 64, 2) mk_fwd(Args args) {
    extern __shared__ __attribute__((aligned(16))) unsigned char lds[];
    LAS unsigned char* ldsl = (LAS unsigned char*)lds;
    volatile LAS unsigned* MISC = (volatile LAS unsigned*)(ldsl + MISC_OFF);
    const int G = gridDim.x; const int bx = blockIdx.x; const int vcu = (G % 8 == 0) ? (bx % 8) * (G / 8) + bx / 8 : bx;
    const int NGW = G * NWAVES;
    const bool cvt_defer = G == 256;
#define CVT_TAIL(W, NB) do { if (cvt_defer && bx >= (NB)) { PHASE_IDS(); p0_convert(a, ldsl, cvt_wlo(W), cvt_wlo((W) + 1), (bx - (NB)) * NWAVES + wave, (G - (NB)) * NWAVES, lane, wave); } } while (0)
    const int wave0 = __builtin_amdgcn_readfirstlane((int)threadIdx.x >> 6);
#define PHASE_IDS() int lane_; asm volatile("v_mbcnt_lo_u32_b32 %0, -1, 0\n\tv_mbcnt_hi_u32_b32 %0, -1, %0" : "=v"(lane_)); const int lane = lane_, wave = wave0, tid = wave0 * 64 + lane_, gw = vcu * NWAVES + wave; (void)lane; (void)gw; (void)tid
    unsigned* ctl = (unsigned*)(args.ws + WS_CTL);
    for (int u = threadIdx.x; u < (LDS_BYTES - LDSCTL_OFF) / 4; u += NWAVES * 64) ((LAS unsigned*)(ldsl + LDSCTL_OFF))[u] = 0u;
    __syncthreads();
    const int lo = args.ph_lo, hi = args.ph_hi;
    const bool use_bar = (hi - lo) > 1;
    XcdBarrier bar; bar.bar = ctl + CW_BAR + args.li * XCD_BAR_WORDS; bar.x = 0; bar.st = nullptr;
    if (use_bar) bar = xcd_barrier_post(ctl + CW_BAR + args.li * XCD_BAR_WORDS, MISC + 8);
#ifndef PH_MASK
#define PH_MASK 0xFFFFFFFFu
#endif
#define EN(bit) ((PH_MASK >> (bit)) & 1u)
#define IN(k) (lo <= (k) && (k) < hi)
#define SEAM(k) do { if (hi > (k) + 1) xcd_barrier(bar); } while (0)
    const Args& a = args;
#ifdef PROBE_MASK
    unsigned long long pt_acc = 0ull, pt_t0 = 0ull, pt_cyc = 0ull, pt_c0 = 0ull;
#define PT_B(g) do { if ((PROBE_MASK >> (g)) & 1u) { pt_t0 = __builtin_amdgcn_s_memrealtime(); pt_c0 = __builtin_amdgcn_s_memtime(); } } while (0)
#define PT_E(g) do { if ((PROBE_MASK >> (g)) & 1u) { pt_acc += __builtin_amdgcn_s_memrealtime() - pt_t0; pt_cyc += __builtin_amdgcn_s_memtime() - pt_c0; } } while (0)
#else
#define PT_B(g) do {} while (0)
#define PT_E(g) do {} while (0)
#endif

    if (EN(0) && IN(0)) { PT_B(0); PHASE_IDS(); p0_mod(a, ldsl, tid, lane, wave); p0_convert(a, ldsl, 0, cvt_defer ? CVT_I_PRO : I_ALL, gw, NGW, lane, wave); SEAM(0);
#ifdef PROBE_DUPPRO
        for (int i_ = 0; i_ < 2; ++i_) { { PHASE_IDS(); p0_convert_probe(a, ldsl, gw, NGW, lane, wave); } xcd_barrier(bar); }
#endif
#ifdef PROBE_BARS
        for (int i_ = 0; i_ < PROBE_BARS; ++i_) xcd_barrier(bar);
#endif
  PT_E(0); }

    for (int L = 0; L < DEPTH; ++L) {
        const int pb = 1 + L * PH_PER_LAYER; const int m = L % 3;
        const bool upd = L < 2;
        const int rows = upd ? M_ALL : M_LAT, ntile = rows / 256;
        if (m == 0) {
            const int pj = L / 3;
            if (EN(1) && IN(pb + 0)) { PT_B(1); PHASE_IDS(); if (L == 0) ph_pooldiff<false>(a, L, rows, gw, NGW, lane); else ph_pooldiff<true>(a, L, rows, gw, NGW, lane); SEAM(pb + 0);  PT_E(1); }
            if (EN(2) && IN(pb + 1)) { PT_B(2);
                pg8::Gemm g{(const bf16*)(a.ws + WS_R + R_D), (const bf16*)(a.ws + WS_POOLW) + (size_t)pj * 4 * 65536, DM, 256, 256, 256, 0, nullptr};
                pg8::Order S; S.init(ntile, 4, G, bx, 1 << 20, 0);
                pg8::EpiBf16 E{(bf16*)(a.ws + WS_R + R_Y), DM, 0, 0, 1.0f, a.in[IN_POOLS] + pj * DM, 1.0f};
                { PHASE_IDS(); pg8::gemm_phase<false, 2>(ldsl, g, S, E, tid); }
                if (L == 0) CVT_TAIL(0, 16);
                SEAM(pb + 1);
             PT_E(2); }
        } else if (m == 1) {
            if (EN(3) && IN(pb + 0)) { PT_B(3);
                pg8::Gemm g{(const bf16*)(a.ws + WS_H), (const bf16*)(a.ws + WS_NAQKV), DM, DM, DM, 0, 0, nullptr};
                pg8::Order S; S.init(M_ALL / 256, 12, G, bx, 1 << 20, 0);
                pg8::EpiBf16 E{(bf16*)(a.ws + WS_R + R_Q), DM, DM, (size_t)(R_K - R_Q) / 2, attn_body::C2, nullptr, 1.0f};
#if QKV_F8
                { PHASE_IDS(); pg8::gemm_phase<false, 1>(ldsl, g, S, E, tid, 127 - W13_LOG2); }
#else
                { PHASE_IDS(); pg8::gemm_phase<false, 2>(ldsl, g, S, E, tid); }
#endif
                CVT_TAIL(3, 48);
                SEAM(pb + 0);
             PT_E(3); }
            if (EN(4) && IN(pb + 1)) { PT_B(4); PHASE_IDS(); ph_attn_na(a, ldsl, (char*)lds, vcu, G, tid); SEAM(pb + 1);  PT_E(4); }
        } else {
            if (EN(5) && IN(pb + 0)) { PT_B(5);
                pg8::Gemm g{(const bf16*)(a.ws + WS_H), (const bf16*)(a.ws + WS_GQKV), DM, DM, DM, 0, 0, nullptr};
                pg8::Order S; S.init(M_ALL / 256, 6, G, bx, 1 << 20, 0);
                pg8::EpiBf16 E{(bf16*)(a.ws + WS_R + R_RAW), 1536, 0, 0, 1.0f, nullptr, 1.0f};
#if QKV_F8
                { PHASE_IDS(); pg8::gemm_phase<false, 1>(ldsl, g, S, E, tid, 127 - W13_LOG2); }
#else
                { PHASE_IDS(); pg8::gemm_phase<false, 2>(ldsl, g, S, E, tid); }
#endif
                CVT_TAIL(7, 24);
                SEAM(pb + 0);
             PT_E(5); }
            if (EN(6) && IN(pb + 1)) { PT_B(6); PHASE_IDS(); ph_qknorm(a, gw, NGW, lane); SEAM(pb + 1);  PT_E(6); }
            if (EN(7) && IN(pb + 2)) { PT_B(7); PHASE_IDS(); ph_attn_gqa(a, (char*)lds, vcu, G, tid); SEAM(pb + 2);  PT_E(7); }
        }
        if (EN(8) && m != 0 && IN(pb + 3)) { PT_B(8);
            const bf16* Wt = (const bf16*)(a.ws + (m == 1 ? WS_NAWO : WS_GWO));
            pg8::Order S; S.init(ntile, 4, G, bx, 1 << 20, 0);
            pg8::EpiBf16 E{(bf16*)(a.ws + WS_R + R_Y), DM, 0, 0, 1.0f, nullptr, 1.0f};
#if WO_F8
            pg8::Gemm g{(const void*)(a.ws + WS_R + R_O8), Wt, DM, DM, DM, 0, 0, nullptr};
            { PHASE_IDS(); pg8::gemm_phase<false, 1>(ldsl, g, S, E, tid, 127 - WO_LOG2); }
#else
            pg8::Gemm g{(const void*)(a.ws + WS_R + (m == 1 ? R_Q : R_GQ)), Wt, DM, DM, DM, 0, 0, nullptr};
            { PHASE_IDS(); pg8::gemm_phase<false, 2>(ldsl, g, S, E, tid); }
#endif
            if (L == 1) CVT_TAIL(4, 16);
            SEAM(pb + 3);
         PT_E(8); }
        if (EN(9) && IN(pb + 4)) { PT_B(9); PHASE_IDS();
#if LN1_MFMA
            if (rows / G <= 1024) { if (L == 0) ph_ln1m<false>(a, L, rows, ldsl, vcu, G, tid, lane, wave); else ph_ln1m<true>(a, L, rows, ldsl, vcu, G, tid, lane, wave); } else
#endif
            { if (L == 0) ph_ln1<false>(a, L, rows, ldsl, gw, NGW, tid, lane); else ph_ln1<true>(a, L, rows, ldsl, gw, NGW, tid, lane); }

SEAM(pb + 4);
#ifdef PROBE_DUPLN1
            if (L > 0) for (int rep_ = 0; rep_ < 6; ++rep_) { PHASE_IDS(); ph_ln1<true, PROBE_DUPLN1>(a, L, rows, ldsl, gw, NGW, tid, lane); xcd_barrier(bar); }
#endif
  PT_E(9); }
        if (EN(10) && IN(pb + 5)) { PT_B(10); PHASE_IDS(); ph_topk(a, upd, ldsl, tid, lane, wave);
            if (cvt_defer && bx >= 64) {
                const int w_ = L == 0 ? 1 : L == 1 ? 5 : L == 2 ? 8 : 9;
                p0_convert(a, ldsl, cvt_wlo(w_), cvt_wlo(w_ + 1), (bx - 64) * NWAVES + wave, (G - 64) * NWAVES, lane, wave); }
            SEAM(pb + 5);  PT_E(10); }
        const int et = upd ? ETILES : ETILES - 1;
        if (EN(12) && IN(pb + 7)) { PT_B(12);
#if MOE_F8
            pg8::Gemm g{(const void*)(a.ws + WS_H), (const void*)(a.ws + WS_W13 + (size_t)L * NE * 2 * FF * DM), DM, DM, DM, 0, (size_t)2 * FF * DM, (const int*)(a.ws + WS_SLOT)};
            pg8::Order S; S.init(NE * et, 2 * FF / 256, G, bx, et, ETILES);
            pg8::EpiSwiGLU<true> E{(void*)(a.ws + WS_R + R_HID), FF};
            { PHASE_IDS(); pg8::gemm_phase<true, 1>(ldsl, g, S, E, tid, 127 - W13_LOG2); }
#ifdef PROBE_DUPUP
            if (L == 0) { xcd_barrier(bar);
                pg8::EpiSwiGLU<true> E2{(void*)(a.ws + (size_t)1600 * MiB), FF, PROBE_DUPUP == 4}; pg8::Order S2 = S; S2.degenerate = (PROBE_DUPUP == 2); pg8::Gemm g2 = g; if (PROBE_DUPUP == 3) g2.K = 512;
                for (int rep = 0; rep < 4; ++rep) { { PHASE_IDS(); pg8::gemm_phase<true, 1>(ldsl, g2, S2, E2, tid, 127 - W13_LOG2); } xcd_barrier(bar); } }
#endif
#else
            pg8::Gemm g{(const void*)(a.ws + WS_H), (const void*)((const bf16*)(a.ws + WS_W13) + (size_t)L * NE * 2 * FF * DM), DM, DM, DM, 0, (size_t)2 * FF * DM, (const int*)(a.ws + WS_SLOT)};
            pg8::Order S; S.init(NE * et, 2 * FF / 256, G, bx, et, ETILES);
            pg8::EpiSwiGLU<false> E{(void*)(a.ws + WS_R + R_HID), FF};
            { PHASE_IDS(); pg8::gemm_phase<true, 2>(ldsl, g, S, E, tid); }
#endif
            SEAM(pb + 7);
         PT_E(12); }
        if (EN(13) && IN(pb + 8)) { PT_B(13);
#if MOE_F8
            pg8::Gemm g{(const void*)(a.ws + WS_R + R_HID), (const void*)(a.ws + WS_W2 + (size_t)L * NE * DM * FF), FF, FF, FF, 0, (size_t)DM * FF, nullptr};
            pg8::Order S; S.init(NE * et, DM / 256, G, bx, et, ETILES);
            pg8::EpiBf16 E{(bf16*)(a.ws + WS_R + R_YS), DM, 0, 0, 1.0f, nullptr, 1.0f, YS_F8 != 0};
            { PHASE_IDS(); pg8::gemm_phase<false, 1>(ldsl, g, S, E, tid, 127 - W2_LOG2); }
            if (L == 0) CVT_TAIL(2, 64); else if (L == 1) CVT_TAIL(6, 64);
#else
            pg8::Gemm g{(const void*)(a.ws + WS_R + R_HID), (const void*)((const bf16*)(a.ws + WS_W2) + (size_t)L * NE * DM * FF), FF, FF, FF, 0, (size_t)DM * FF, nullptr};
            pg8::Order S; S.init(NE * et, DM / 256, G, bx, et, ETILES);
            pg8::EpiBf16 E{(bf16*)(a.ws + WS_R + R_YS), DM, 0, 0, 1.0f, nullptr, 1.0f};
            { PHASE_IDS(); pg8::gemm_phase<false, 2>(ldsl, g, S, E, tid); }
#endif
            SEAM(pb + 8);
         PT_E(13); }
        if (EN(14) && IN(pb + 9)) { PT_B(14); PHASE_IDS(); ph_ln2(a, L, rows, ldsl, gw, NGW, tid, lane); if (L + 1 < DEPTH) SEAM(pb + 9);  PT_E(14); }
    }
#ifdef PROBE_MASK
#ifdef PROBE_CLOCK
    if (blockIdx.x == 0) { const unsigned long long t0 = __builtin_amdgcn_s_memrealtime(); const unsigned long long wait = pt_acc ? (pt_cyc * 10000ull) / pt_acc : 0ull;
        while (__builtin_amdgcn_s_memrealtime() - t0 < wait) __builtin_amdgcn_s_sleep(8); }
#else
    if (blockIdx.x == 0) { const unsigned long long t0 = __builtin_amdgcn_s_memrealtime(); while (__builtin_amdgcn_s_memrealtime() - t0 < (unsigned long long)(PROBE_K) * pt_acc) __builtin_amdgcn_s_sleep(8); }
#endif
#endif
#undef IN
#undef SEAM
}

extern "C" void kernel_launch(void* const* d_in, const int* in_sizes, int n_in, void* d_out, int out_size, void* d_ws, size_t ws_size, hipStream_t stream) {
    static int grid = 0;
    if (grid == 0) {
        if (n_in != 21 || out_size != M_LAT * DM || ws_size < WS_END) { fprintf(stderr, "kernel_launch: unexpected shapes (n_in %d, out %d, ws %zu)\n", n_in, out_size, ws_size); grid = -1; return; }
        int dev = 0, cus = 0, per_cu = 0;
        if (hipGetDevice(&dev) != hipSuccess || hipDeviceGetAttribute(&cus, hipDeviceAttributeMultiprocessorCount, dev) != hipSuccess) { grid = -1; return; }
        if (hipFuncSetAttribute((const void*)mk_fwd, hipFuncAttributeMaxDynamicSharedMemorySize, LDS_BYTES) != hipSuccess) { fprintf(stderr, "kernel_launch: hipFuncSetAttribute failed\n"); grid = -1; return; }
        if (hipOccupancyMaxActiveBlocksPerMultiprocessor(&per_cu, (const void*)mk_fwd, NWAVES * 64, LDS_BYTES) != hipSuccess || per_cu < 1) { fprintf(stderr, "kernel_launch: occupancy query reports %d\n", per_cu); (void)hipGetLastError(); grid = -1; return; }
        grid = cus;
    }
    if (grid < 0) return;
    if (hipMemsetAsync((char*)d_ws + WS_CTL, 0, CTL_ZERO_BYTES, stream) != hipSuccess) return;
    Args a{};
    for (int i = 0; i < 21; ++i) a.in[i] = (const float*)d_in[i];
    a.out = (float*)d_out; a.ws = (unsigned char*)d_ws;
#if MK_PER_PHASE
    for (int k = 0; k < N_PHASE_IDS; ++k) {
        const int r = (k - 1) % PH_PER_LAYER, L = (k - 1) / PH_PER_LAYER, m = L % 3;
        if (k > 0 && (r > 9 || r == 6 || (r == 2 && m != 2) || (r == 3 && m == 0))) continue;
        a.ph_lo = k; a.ph_hi = k + 1; a.li = 0;
        hipLaunchKernelGGL(mk_fwd, dim3(grid), dim3(NWAVES * 64), LDS_BYTES, stream, a);
    }
#else
    a.ph_lo = 0; a.ph_hi = N_PHASE_IDS; a.li = 0;
    hipLaunchKernelGGL(mk_fwd, dim3(grid), dim3(NWAVES * 64), LDS_BYTES, stream, a);
#endif
    const hipError_t le = hipPeekAtLastError();
    if (le != hipSuccess) fprintf(stderr, "kernel_launch: launch failed: %s\n", hipGetErrorName(le));
}
```
